# Optimizing an MI355X kernel written in HIP

```python
import math
import jax, jax.numpy as jnp
from jax import lax
import numpy as np

D_MODEL = 1024
BATCH = 4
SEQ = 8192
DEPTH = 4

GRID_W = 64
N_MEM = 256
RMS_EPS = 1e-6
NA_HEADS = 8
NA_HEAD_DIM = 64
NA_WIDTH = NA_HEADS * NA_HEAD_DIM
NA_WIN_R = 8
NA_WIN_C = 16
S5_GROUPS = 16
S5_GROUP_CH = 16
S5_WIDTH = S5_GROUPS * S5_GROUP_CH
S5_STATE = 64
S5_DT_MIN = 1e-3
S5_DT_MAX = 1e-1
XA_HEADS = 4
XA_HEAD_DIM = 64
XA_WIDTH = XA_HEADS * XA_HEAD_DIM
N_BRANCHES = 3
IN_COLS = 3 * NA_WIDTH + S5_WIDTH + XA_WIDTH + N_BRANCHES * D_MODEL
IN_SPLITS = (NA_WIDTH, 2 * NA_WIDTH, 3 * NA_WIDTH, 3 * NA_WIDTH + S5_WIDTH,
             3 * NA_WIDTH + S5_WIDTH + XA_WIDTH)
MOE_GROUPS = 4
MOE_EXPERTS_PER_GROUP = 4
MOE_EXPERTS = MOE_GROUPS * MOE_EXPERTS_PER_GROUP
MOE_TOP_K = 2
MOE_FF = 256

kernel_name = "hybrid_na_s5_memxattn_hmoe_encoder"


def rms_norm(x, g):
    x32 = x.astype(jnp.float32)
    y = x32 * lax.rsqrt(jnp.mean(x32 * x32, axis=-1, keepdims=True) + RMS_EPS)
    return (y * g.astype(jnp.float32)).astype(x.dtype)


def neighbourhood_attention(q, k, v, rpb):
    bsz, seq, _ = q.shape
    rows = seq // GRID_W
    win_r = min(NA_WIN_R, rows)
    shape = (bsz, rows, GRID_W, NA_HEADS, NA_HEAD_DIM)
    qg = q.reshape(shape) * (NA_HEAD_DIM ** -0.5)
    kg = k.reshape(shape)
    vg = v.reshape(shape)
    cols = np.arange(GRID_W)
    col_start = np.clip(cols - NA_WIN_C // 2, 0, GRID_W - NA_WIN_C)
    col_idx = col_start[:, None] + np.arange(NA_WIN_C)[None, :]
    col_bias_idx = col_idx - cols[:, None] + (NA_WIN_C - 1)

    def one_row(args):
        q_row, r = args
        r_start = jnp.clip(r - win_r // 2, 0, rows - win_r)
        k_blk = lax.dynamic_slice_in_dim(kg, r_start, win_r, axis=1)
        v_blk = lax.dynamic_slice_in_dim(vg, r_start, win_r, axis=1)
        k_nb = k_blk[:, :, col_idx]
        v_nb = v_blk[:, :, col_idx]
        row_bias_idx = r_start + jnp.arange(win_r) - r + (NA_WIN_R - 1)
        bias = rpb[:, row_bias_idx[None, :, None], col_bias_idx[:, None, :]]
        s = jnp.einsum('bchd,bicjhd->bhcij', q_row, k_nb).astype(jnp.float32) + bias.astype(jnp.float32)
        p = jax.nn.softmax(s.reshape(bsz, NA_HEADS, GRID_W, win_r * NA_WIN_C), axis=-1)
        p = p.reshape(s.shape).astype(v.dtype)
        return jnp.einsum('bhcij,bicjhd->bchd', p, v_nb)

    out = lax.map(one_row, (jnp.moveaxis(qg, 1, 0), jnp.arange(rows)))
    return jnp.moveaxis(out, 0, 1).reshape(bsz, seq, NA_WIDTH)


def _complex_linear_combine(earlier, later):
    a1r, a1i, b1r, b1i = earlier
    a2r, a2i, b2r, b2i = later
    return (a2r * a1r - a2i * a1i,
            a2r * a1i + a2i * a1r,
            a2r * b1r - a2i * b1i + b2r,
            a2r * b1i + a2i * b1r + b2i)


def s5_bidirectional(u, lam_re, lam_im, log_dt, b_re, b_im, c_re, c_im, d_skip, w_glu):
    bsz, seq, _ = u.shape
    uf = u.astype(jnp.float32).reshape(bsz, seq, S5_GROUPS, S5_GROUP_CH)
    y = d_skip.astype(jnp.float32).reshape(S5_GROUPS, S5_GROUP_CH) * uf
    for direction in range(2):
        lr = jnp.minimum(lam_re[direction].astype(jnp.float32), -1e-4)
        li = lam_im[direction].astype(jnp.float32)
        dt = jnp.exp(log_dt[direction].astype(jnp.float32))[:, None]
        mag = jnp.exp(lr * dt)
        ar = mag * jnp.cos(li * dt)
        ai = mag * jnp.sin(li * dt)
        den = lr * lr + li * li
        fr = ((ar - 1.0) * lr + ai * li) / den
        fi = (ai * lr - (ar - 1.0) * li) / den
        br = b_re[direction].astype(jnp.float32)
        bi = b_im[direction].astype(jnp.float32)
        bbar_re = fr[..., None] * br - fi[..., None] * bi
        bbar_im = fr[..., None] * bi + fi[..., None] * br
        bu_re = jnp.einsum('bsgc,gpc->bsgp', uf, bbar_re)
        bu_im = jnp.einsum('bsgc,gpc->bsgp', uf, bbar_im)
        a_re = jnp.broadcast_to(ar, (1, seq, S5_GROUPS, S5_STATE))
        a_im = jnp.broadcast_to(ai, (1, seq, S5_GROUPS, S5_STATE))
        _, _, x_re, x_im = lax.associative_scan(
            _complex_linear_combine, (a_re, a_im, bu_re, bu_im), reverse=(direction == 1), axis=1)
        y = y + jnp.einsum('bsgp,gcp->bsgc', x_re, c_re[direction].astype(jnp.float32)) \
              - jnp.einsum('bsgp,gcp->bsgc', x_im, c_im[direction].astype(jnp.float32))
    y = jax.nn.gelu(y.reshape(bsz, seq, S5_WIDTH))
    g = y @ w_glu.astype(jnp.float32)
    out = g[..., :S5_WIDTH] * jax.nn.sigmoid(g[..., S5_WIDTH:])
    return out.astype(u.dtype)


def memory_cross_attention(q, mem_kv):
    bsz, seq, _ = q.shape
    n_mem = mem_kv.shape[1]
    qh = q.reshape(bsz, seq, XA_HEADS, XA_HEAD_DIM) * (XA_HEAD_DIM ** -0.5)
    k_m = mem_kv[..., :XA_WIDTH].reshape(bsz, n_mem, XA_HEADS, XA_HEAD_DIM)
    v_m = mem_kv[..., XA_WIDTH:].reshape(bsz, n_mem, XA_HEADS, XA_HEAD_DIM)
    s = jnp.einsum('bshd,bmhd->bhsm', qh, k_m).astype(jnp.float32)
    p = jax.nn.softmax(s, axis=-1).astype(v_m.dtype)
    return jnp.einsum('bhsm,bmhd->bshd', p, v_m).reshape(bsz, seq, XA_WIDTH)


def hierarchical_moe(h, w_coarse, b_coarse, w_fine, b_fine, w_gate, w_up, w_down):
    bsz, seq, _ = h.shape
    coarse = (h @ w_coarse).astype(jnp.float32) + b_coarse.astype(jnp.float32)
    p_coarse = jax.nn.softmax(coarse, axis=-1)
    _, grp = lax.top_k(coarse, 1)
    p_grp = jnp.take_along_axis(p_coarse, grp, axis=-1)
    fine = ((h @ w_fine).astype(jnp.float32) + b_fine.astype(jnp.float32)).reshape(
        bsz, seq, MOE_GROUPS, MOE_EXPERTS_PER_GROUP)
    fine_g = jnp.take_along_axis(fine, grp[..., None], axis=2)[..., 0, :]
    top_v, top_i = lax.top_k(fine_g, MOE_TOP_K)
    w_top = jax.nn.softmax(top_v, axis=-1) * p_grp
    expert_idx = grp * MOE_EXPERTS_PER_GROUP + top_i
    comb = jnp.sum(jax.nn.one_hot(expert_idx, MOE_EXPERTS, dtype=jnp.float32) * w_top[..., None], axis=-2)
    comb = comb.astype(h.dtype)

    def per_row(args):
        hb, cb = args
        g = jnp.einsum('sd,edf->sef', hb, w_gate)
        u = jnp.einsum('sd,edf->sef', hb, w_up)
        a = jax.nn.silu(g) * u * cb[:, :, None]
        return jnp.einsum('sef,efd->sd', a, w_down)

    return lax.map(per_row, (h, comb))


def setup_inputs(seed: int = 0) -> dict:
    key = jax.random.key(seed)
    ks = iter(jax.random.split(key, 40))
    f32 = jnp.float32

    def nrm(shape, scale):
        return jax.random.normal(next(ks), shape, f32) * scale

    def gain(shape):
        return 1.0 + 0.02 * jax.random.normal(next(ks), shape, f32)

    L, D = DEPTH, D_MODEL
    n_idx = jnp.arange(S5_STATE, dtype=f32)
    return {
        "x": nrm((BATCH, SEQ, D), 1.0),
        "mem": nrm((BATCH, N_MEM, D), 1.0),
        "norm_mix": gain((L, D)),
        "norm_ffn": gain((L, D)),
        "norm_mem": gain((L, D)),
        "w_in": nrm((L, D, IN_COLS), D ** -0.5),
        "b_gate": nrm((L, N_BRANCHES * D), 0.02),
        "na_rpb": nrm((L, NA_HEADS, 2 * NA_WIN_R - 1, 2 * NA_WIN_C - 1), 0.1),
        "s5_lam_re": -0.5 + nrm((L, 2, S5_GROUPS, S5_STATE), 0.01),
        "s5_lam_im": math.pi * n_idx + nrm((L, 2, S5_GROUPS, S5_STATE), 0.01),
        "s5_log_dt": jax.random.uniform(next(ks), (L, 2, S5_GROUPS), f32,
                                        minval=math.log(S5_DT_MIN), maxval=math.log(S5_DT_MAX)),
        "s5_b_re": nrm((L, 2, S5_GROUPS, S5_STATE, S5_GROUP_CH), S5_GROUP_CH ** -0.5),
        "s5_b_im": nrm((L, 2, S5_GROUPS, S5_STATE, S5_GROUP_CH), S5_GROUP_CH ** -0.5),
        "s5_c_re": nrm((L, 2, S5_GROUPS, S5_GROUP_CH, S5_STATE), S5_STATE ** -0.5),
        "s5_c_im": nrm((L, 2, S5_GROUPS, S5_GROUP_CH, S5_STATE), S5_STATE ** -0.5),
        "s5_d": nrm((L, S5_WIDTH), 1.0),
        "s5_w_glu": nrm((L, S5_WIDTH, 2 * S5_WIDTH), S5_WIDTH ** -0.5),
        "w_mem_kv": nrm((L, D, 2 * XA_WIDTH), D ** -0.5),
        "w_br_na": nrm((L, NA_WIDTH, D), NA_WIDTH ** -0.5),
        "w_br_s5": nrm((L, S5_WIDTH, D), S5_WIDTH ** -0.5),
        "w_br_xa": nrm((L, XA_WIDTH, D), XA_WIDTH ** -0.5),
        "w_out": nrm((L, D, D), D ** -0.5),
        "moe_w_coarse": nrm((L, D, MOE_GROUPS), D ** -0.5),
        "moe_b_coarse": nrm((L, MOE_GROUPS), 0.01),
        "moe_w_fine": nrm((L, D, MOE_EXPERTS), D ** -0.5),
        "moe_b_fine": nrm((L, MOE_EXPERTS), 0.01),
        "moe_w_gate": nrm((L, MOE_EXPERTS, D, MOE_FF), D ** -0.5),
        "moe_w_up": nrm((L, MOE_EXPERTS, D, MOE_FF), D ** -0.5),
        "moe_w_down": nrm((L, MOE_EXPERTS, MOE_FF, D), MOE_FF ** -0.5),
        "final_norm": gain((D,)),
    }


def reference(x, mem, norm_mix, norm_ffn, norm_mem, w_in, b_gate, na_rpb,
              s5_lam_re, s5_lam_im, s5_log_dt, s5_b_re, s5_b_im, s5_c_re, s5_c_im, s5_d, s5_w_glu,
              w_mem_kv, w_br_na, w_br_s5, w_br_xa, w_out,
              moe_w_coarse, moe_b_coarse, moe_w_fine, moe_b_fine, moe_w_gate, moe_w_up, moe_w_down,
              final_norm):
    bsz, seq, d = x.shape
    for l in range(DEPTH):
        h = rms_norm(x, norm_mix[l])
        proj = h @ w_in[l]
        q_na, k_na, v_na, u_s5, q_xa, gate_logits = jnp.split(proj, IN_SPLITS, axis=-1)
        o_na = neighbourhood_attention(q_na, k_na, v_na, na_rpb[l])
        o_s5 = s5_bidirectional(u_s5, s5_lam_re[l], s5_lam_im[l], s5_log_dt[l],
                                s5_b_re[l], s5_b_im[l], s5_c_re[l], s5_c_im[l], s5_d[l], s5_w_glu[l])
        mem_kv = rms_norm(mem, norm_mem[l]) @ w_mem_kv[l]
        o_xa = memory_cross_attention(q_xa, mem_kv)
        gates = jax.nn.sigmoid((gate_logits + b_gate[l]).astype(jnp.float32)).astype(x.dtype)
        gates = gates.reshape(bsz, seq, N_BRANCHES, d)
        merged = gates[:, :, 0] * (o_na @ w_br_na[l]) \
               + gates[:, :, 1] * (o_s5 @ w_br_s5[l]) \
               + gates[:, :, 2] * (o_xa @ w_br_xa[l])
        x = x + merged @ w_out[l]
        h2 = rms_norm(x, norm_ffn[l])
        x = x + hierarchical_moe(h2, moe_w_coarse[l], moe_b_coarse[l], moe_w_fine[l], moe_b_fine[l],
                                 moe_w_gate[l], moe_w_up[l], moe_w_down[l])
    return rms_norm(x, final_norm)
```

```cpp
#include <hip/hip_runtime.h>
#include <cstdio>
#include <cstdint>

#define LAS __attribute__((address_space(3)))
typedef unsigned short bf16;
typedef short bf16x8 __attribute__((ext_vector_type(8)));
typedef float f32x4 __attribute__((ext_vector_type(4)));
typedef float f32x2 __attribute__((ext_vector_type(2)));
typedef unsigned u32x4 __attribute__((ext_vector_type(4)));
typedef unsigned u32x2 __attribute__((ext_vector_type(2)));

constexpr int D = 1024, BATCH = 4, SEQ = 8192, M = BATCH * SEQ, DEPTH = 4;
constexpr int INC = 5120, NMEM = 256;
constexpr int NCHUNK = 256, TCH = 32;
constexpr int ATK = 768;
constexpr int LCAP = 32768;
constexpr int NBUCKET = 24;
constexpr float RMS_EPS = 1e-6f;

constexpr size_t MiB = 1u << 20;
constexpr size_t WS_CTL = 0, CTL_BYTES = 1 * MiB;
constexpr size_t WS_APOW = 1 * MiB;
constexpr size_t WS_BBAR = 4 * MiB;
constexpr size_t WS_KT = 5 * MiB;
constexpr size_t WS_WRT = 10 * MiB;
constexpr size_t WS_MEMN = 11 * MiB;
constexpr size_t WS_WMKV = 19 * MiB;
constexpr size_t WS_KM = 23 * MiB;
constexpr size_t WS_VM8 = 25 * MiB;
constexpr size_t WS_WIN = 27 * MiB;
constexpr size_t WS_WCAT = 37 * MiB;
constexpr size_t WS_WOUT = 39 * MiB;
constexpr size_t WS_WGLU = 41 * MiB;
constexpr size_t WS_S5W = 42 * MiB;
constexpr size_t WS_S5KV = 46 * MiB;
constexpr size_t WS_H = 58 * MiB;
constexpr size_t WS_QK = 122 * MiB;
constexpr size_t WS_VT8 = 186 * MiB;
constexpr size_t WS_AT = 218 * MiB;
constexpr size_t WS_QX = 242 * MiB;
constexpr size_t WS_ST = 258 * MiB;
constexpr size_t WS_Y = 274 * MiB;
constexpr size_t WS_GATES = 290 * MiB;
constexpr size_t WS_WGU = WS_GATES;
constexpr size_t WS_WDP = WS_GATES + 16 * MiB;
constexpr size_t WS_ACT = WS_GATES + 40 * MiB;
constexpr size_t WS_LIST = 482 * MiB;
constexpr size_t WS_WTS = 485 * MiB;
constexpr size_t WS_END = 491 * MiB;
constexpr int CW_BAR = 4096;
constexpr int CW_CNT = 16384;

__device__ __forceinline__ unsigned cvt_pk_bf16(float lo, float hi) { unsigned r; asm volatile("v_cvt_pk_bf16_f32 %0, %1, %2" : "=v"(r) : "v"(lo), "v"(hi)); return r; }
__device__ __forceinline__ float bf2f(unsigned short b) { return __uint_as_float(((unsigned)b) << 16); }
__device__ __forceinline__ float bflo(unsigned w) { return __uint_as_float(w << 16); }
__device__ __forceinline__ float bfhi(unsigned w) { return __uint_as_float(w & 0xffff0000u); }
__device__ __forceinline__ float fast_rcp(float x) { return __builtin_amdgcn_rcpf(x); }
__device__ __forceinline__ float fast_exp(float x) { return __builtin_amdgcn_exp2f(x * 1.4426950408889634f); }
__device__ __forceinline__ float sigmoid_f(float x) { return fast_rcp(1.0f + fast_exp(-x)); }
__device__ __forceinline__ float gelu_tanh_f(float x) { const float u = 1.5957691216057308f * (x + 0.044715f * x * x * x); return x * fast_rcp(1.0f + fast_exp(-u)); }
__device__ __forceinline__ float shfl_xor_f(float v, int o, int lane) { return __int_as_float(__builtin_amdgcn_ds_bpermute((lane ^ o) << 2, __float_as_int(v))); }
__device__ __forceinline__ float shfl_idx_f(float v, int src) { return __int_as_float(__builtin_amdgcn_ds_bpermute(src << 2, __float_as_int(v))); }
__device__ __forceinline__ float wave_sum(float v, int lane) {
#pragma unroll
    for (int o = 1; o < 64; o <<= 1) v += shfl_xor_f(v, o, lane);
    return v;
}
#define LDS_WAIT() asm volatile("s_waitcnt lgkmcnt(0)" ::: "memory")
#define VM_WAIT() asm volatile("s_waitcnt vmcnt(0)" ::: "memory")

namespace pg8 {
constexpr int BM = 256, BK = 64, HALF = 128, HTB = HALF * BK * 2, STAGE_BYTES = 8 * HTB, NXCD = 8, WGM = 8;
__host__ __device__ __forceinline__ int lds_byte(int r, int c) { const int st = (r >> 4) * 2 + (c >> 5), rr = r & 15, cc = c & 31, ob = rr * 64 + cc * 2; return st * 1024 + (ob ^ (((ob >> 9) & 1) << 5)); }
__host__ __device__ __forceinline__ void stage_rc(int b, int& R, int& C) { const int st = b / 1024, sb = b % 1024, swz = sb ^ (((sb >> 9) & 1) << 5); R = (st >> 1) * 16 + swz / 64; C = (st & 1) * 32 + (swz % 64) / 2; }
__host__ __device__ __forceinline__ int perm32(int rho) { const int n = rho >> 4, i = rho & 15; return 8 * (i >> 2) + 4 * n + (i & 3); }

struct Unit { int pm, pn, am, bn, x0, x1, x2; };
struct Gemm { const bf16* A; const bf16* Bt; int lda, ldb, K; };

struct StaticOrder {
    int nM, nN, nwg, G, c;
    __device__ void init(int nM_, int nN_, int G_, int c_) { nM = nM_; nN = nN_; nwg = nM * nN; G = G_; c = c_; }
    __device__ bool next(int i, Unit& u) const {
        const long L = (long)i * G + c; if (L >= nwg) return false;
        int wgid = (int)L; { const int q = nwg / NXCD, r = nwg % NXCD, xcd = wgid % NXCD, off = wgid / NXCD; wgid = (xcd < r ? xcd * (q + 1) : r * (q + 1) + (xcd - r) * q) + off; }
        const int nig = WGM * nN, gid = wgid / nig, fm = gid * WGM, gsz = (nM - fm) < WGM ? (nM - fm) : WGM;
        u.pm = fm + ((wgid % nig) % gsz); u.pn = (wgid % nig) / gsz; u.am = u.pm; u.bn = u.pn; u.x0 = 0; u.x1 = 0; u.x2 = 0; return true;
    }
    __device__ __forceinline__ int a_row(const Unit&, int) const { return 0; }
};
struct S5Order : StaticOrder {
    __device__ bool next(int i, Unit& u) const { if (!StaticOrder::next(i, u)) return false; u.bn = (u.pm & 15) * nN + u.pn; return true; }
};
struct MemOrder {
    int G, c;
    __device__ bool next(int i, Unit& u) const { const int L = i * G + c; if (L >= 32) return false; u.pm = L >> 1; u.pn = L & 1; u.am = u.pm; u.bn = (u.pm >> 2) * 2 + u.pn; u.x0 = 0; u.x1 = 0; u.x2 = 0; return true; }
    __device__ __forceinline__ int a_row(const Unit&, int) const { return 0; }
};
struct MoeOrder {
    const LAS int* tab; const int* list; int G, c, mode;
    __device__ bool next(int i, Unit& u) const {
        const int T = __builtin_amdgcn_readfirstlane(tab[64]); const int L = i * G + c; if (L >= T * 4) return false;
        const int tile = L >> 2, pn = L & 3; int b = 0;
#pragma unroll 1
        for (int j = 1; j < NBUCKET; ++j) if (__builtin_amdgcn_readfirstlane(tab[32 + j]) <= tile) b = j;
        u.pm = tile; u.pn = pn; u.am = tile; u.x0 = b; u.x1 = (tile - __builtin_amdgcn_readfirstlane(tab[32 + b])) * 256; u.x2 = __builtin_amdgcn_readfirstlane(tab[b]);
        const int grp = b / 6, pi = b % 6; const int ea = pi < 3 ? 0 : (pi < 5 ? 1 : 2), eb = pi < 3 ? pi + 1 : (pi < 5 ? pi - 1 : 3);
        if (mode == 0) { const int e = grp * 4 + ((pn >> 1) ? eb : ea); u.bn = e * 2 + (pn & 1); } else u.bn = b * 4 + pn;
        return true;
    }
    __device__ __forceinline__ int a_row(const Unit& u, int r) const { const int slot = u.x1 + r; return slot < u.x2 ? list[u.x0 * LCAP + slot] : 0; }
};

template <class Epi, class Sched, bool GATHER = false, bool KHOOK = false>
__device__ __forceinline__ void gemm_phase(LAS unsigned char* lds, const Gemm g, const Sched& S, const Epi& E, int tid_in) {
    int tid = tid_in; asm volatile("" : "+v"(tid));
    const int wid = __builtin_amdgcn_readfirstlane(tid >> 6), lane = tid & 63, wr = wid >> 2, wc = wid & 3, fr = lane & 15, fq = lane >> 4;
    int K = g.K, lda = g.lda, ldb = g.ldb;
    asm volatile("" : "+s"(K), "+s"(lda), "+s"(ldb));
    const int nt = K / BK;
    unsigned voffA[2], voffB[2]; int Rr[2], Cc[2];
#pragma unroll
    for (int i = 0; i < 2; ++i) { int R, C; stage_rc(tid * 16 + i * 8192, R, C); const int Rb = Epi::PERM ? ((R & ~31) + perm32(R & 31)) : R;
        voffA[i] = (unsigned)(R * lda + C) * 2u; voffB[i] = (unsigned)(Rb * ldb + C) * 2u; Rr[i] = R; Cc[i] = C; }
    const size_t kstep = (size_t)(BK * 2);
    const size_t hstepA = (size_t)HALF * lda * 2, tstepA = 2 * hstepA, hstepB = (size_t)HALF * ldb * 2, tstepB = 2 * hstepB;
    const unsigned ldsw = (unsigned)wid * 1024u;
    const int aoff = lds_byte(wr * 64 + fr, fq * 8), boff = lds_byte(wc * 32 + fr, fq * 8);
    unsigned vC[2][2] = {{0u, 0u}, {0u, 0u}}, vN[2][2] = {{0u, 0u}, {0u, 0u}};
#define PG8_SA(b, h) (((b) * 2 + (h)) * HTB)
#define PG8_SB(b, h) ((4 + (b) * 2 + (h)) * HTB)
#define PG8_STAGE(bufoff, gbase, voff) do { _Pragma("unroll") for (int _i = 0; _i < 2; ++_i) \
        __builtin_amdgcn_global_load_lds((const unsigned*)((const char*)(gbase) + (voff)[_i]), (LAS unsigned*)(lds + (bufoff) + ldsw + _i * 8192), 16, 0, 0); } while (0)
#define PG8_STA(bufoff, ptr, h, nx) do { if constexpr (GATHER) { unsigned _v[2]; _v[0] = (nx) ? vN[h][0] : vC[h][0]; _v[1] = (nx) ? vN[h][1] : vC[h][1]; PG8_STAGE(bufoff, ptr, _v); } \
        else { PG8_STAGE(bufoff, (ptr) + (h) * hstepA, voffA); } } while (0)
#define PG8_STB(bufoff, ptr, h) PG8_STAGE(bufoff, (ptr) + (h) * hstepB, voffB)
#define PG8_LDA(dst, b, h) do { _Pragma("unroll") for (int m = 0; m < 4; ++m) _Pragma("unroll") for (int k = 0; k < 2; ++k) dst[m][k] = *(const LAS bf16x8*)(lds + PG8_SA(b, h) + aoff + m * 2048 + k * 1024); } while (0)
#define PG8_LDB(dst, b, h) do { _Pragma("unroll") for (int n = 0; n < 2; ++n) _Pragma("unroll") for (int k = 0; k < 2; ++k) dst[n][k] = *(const LAS bf16x8*)(lds + PG8_SB(b, h) + boff + n * 2048 + k * 1024); } while (0)
#define PG8_MMA(ai, bj, At, Bt) do { __builtin_amdgcn_s_setprio(1); _Pragma("unroll") for (int m = 0; m < 4; ++m) _Pragma("unroll") for (int n = 0; n < 2; ++n) _Pragma("unroll") for (int k = 0; k < 2; ++k) \
        acc[ai][bj][m][n] = __builtin_amdgcn_mfma_f32_16x16x32_bf16(Bt[n][k], At[m][k], acc[ai][bj][m][n], 0, 0, 0); __builtin_amdgcn_s_setprio(0); } while (0)
#define PG8_WAIT_V(n) asm volatile("s_waitcnt vmcnt(" #n ")" ::: "memory")
#define PG8_WAIT_L(n) asm volatile("s_waitcnt lgkmcnt(" #n ")" ::: "memory")
#define PG8_BAR __builtin_amdgcn_s_barrier()
#define PG8_SCHED __builtin_amdgcn_sched_barrier(0)
    Unit cur, nxt; int ui = 0;
    if (!S.next(0, cur)) return;
    f32x4 acc[2][2][4][2];
#pragma unroll
    for (int a = 0; a < 2; ++a)
#pragma unroll
        for (int b = 0; b < 2; ++b)
#pragma unroll
            for (int m = 0; m < 4; ++m)
#pragma unroll
                for (int n = 0; n < 2; ++n) acc[a][b][m][n] = (f32x4){0.f, 0.f, 0.f, 0.f};
    bf16x8 At[4][2], B0[2][2], B1[2][2];
    const char* cA = GATHER ? (const char*)g.A : (const char*)g.A + (size_t)cur.am * tstepA;
    const char* cB = (const char*)g.Bt + (size_t)cur.bn * tstepB;
    if constexpr (GATHER) {
#pragma unroll
        for (int h = 0; h < 2; ++h)
#pragma unroll
            for (int i = 0; i < 2; ++i) vC[h][i] = (unsigned)(S.a_row(cur, h * HALF + Rr[i]) * lda + Cc[i]) * 2u;
    }
    PG8_STB(PG8_SB(0, 0), cB, 0); PG8_STB(PG8_SB(0, 1), cB, 1); PG8_STA(PG8_SA(0, 0), cA, 0, false); PG8_STA(PG8_SA(0, 1), cA, 1, false);
    if (wr == 1) PG8_BAR;
    PG8_WAIT_V(2); PG8_BAR;
    PG8_STB(PG8_SB(1, 0), cB + kstep, 0); PG8_STA(PG8_SA(1, 0), cA + kstep, 0, false); PG8_STB(PG8_SB(1, 1), cB + kstep, 1);
    PG8_WAIT_V(6); PG8_BAR;
    for (;;) {
        const bool has_next = S.next(ui + 1, nxt);
        const char* nA = GATHER ? (const char*)g.A : (has_next ? (const char*)g.A + (size_t)nxt.am * tstepA : cA);
        const char* nB = has_next ? (const char*)g.Bt + (size_t)nxt.bn * tstepB : cB;
        if constexpr (GATHER) {
#pragma unroll
            for (int h = 0; h < 2; ++h)
#pragma unroll
                for (int i = 0; i < 2; ++i) vN[h][i] = has_next ? (unsigned)(S.a_row(nxt, h * HALF + Rr[i]) * lda + Cc[i]) * 2u : vC[h][i];
        }
        int tb = 0;
#pragma unroll 1
        for (int seg = 0; seg < (KHOOK ? 3 : 1); ++seg) {
        const int te = KHOOK ? (seg == 0 ? 8 : (seg == 1 ? 12 : nt)) : nt;
        for (int t = tb; t < te; t += 2) {
            const bool last = (t == nt - 2);
            const char* a1 = cA + (size_t)(t + 1) * kstep;
            const char* a2 = last ? nA : cA + (size_t)(t + 2) * kstep; const char* b2 = last ? nB : cB + (size_t)(t + 2) * kstep;
            const char* a3 = a2 + kstep; const char* b3 = b2 + kstep;
            PG8_LDB(B0, 0, 0); PG8_LDB(B1, 0, 1); PG8_SCHED; PG8_LDA(At, 0, 0); PG8_STA(PG8_SA(1, 1), a1, 1, false);
            PG8_WAIT_V(8); PG8_WAIT_L(0); PG8_BAR; PG8_MMA(0, 0, At, B0); PG8_MMA(0, 1, At, B1); PG8_BAR; PG8_SCHED;
            PG8_LDA(At, 0, 1); PG8_STB(PG8_SB(0, 0), b2, 0); PG8_STB(PG8_SB(0, 1), b2, 1); PG8_STA(PG8_SA(0, 0), a2, 0, last);
            PG8_WAIT_V(8); PG8_WAIT_L(0); PG8_BAR; PG8_MMA(1, 0, At, B0); PG8_MMA(1, 1, At, B1); PG8_BAR; PG8_SCHED;
            PG8_LDB(B0, 1, 0); PG8_LDB(B1, 1, 1); PG8_SCHED; PG8_LDA(At, 1, 0); PG8_STA(PG8_SA(0, 1), a2, 1, last);
            PG8_WAIT_V(8); PG8_WAIT_L(0); PG8_BAR; PG8_MMA(0, 0, At, B0); PG8_MMA(0, 1, At, B1); PG8_BAR; PG8_SCHED;
            PG8_LDA(At, 1, 1); PG8_STB(PG8_SB(1, 0), b3, 0); PG8_STB(PG8_SB(1, 1), b3, 1); PG8_STA(PG8_SA(1, 0), a3, 0, last);
            PG8_WAIT_V(8); PG8_WAIT_L(0); PG8_BAR; PG8_MMA(1, 0, At, B0); PG8_MMA(1, 1, At, B1); PG8_BAR; PG8_SCHED;
        }
        if constexpr (KHOOK) { if (seg < 2) { int fr_ = fr, fq_ = fq; asm volatile("" : "+v"(fr_), "+v"(fq_)); E.khook(acc, cur, te, wr, wc, fr_, fq_); } }
        tb = te;
        }
        if (wr == 0) PG8_BAR;
        { int fr_ = fr, fq_ = fq; asm volatile("" : "+v"(fr_), "+v"(fq_)); E(acc, cur, wr, wc, fr_, fq_); }
        if (!has_next) break;
#pragma unroll
        for (int a = 0; a < 2; ++a)
#pragma unroll
            for (int b = 0; b < 2; ++b)
#pragma unroll
                for (int m = 0; m < 4; ++m)
#pragma unroll
                    for (int n = 0; n < 2; ++n) acc[a][b][m][n] = (f32x4){0.f, 0.f, 0.f, 0.f};
        cur = nxt; cA = nA; cB = nB; ++ui;
        if constexpr (GATHER) {
#pragma unroll
            for (int h = 0; h < 2; ++h)
#pragma unroll
                for (int i = 0; i < 2; ++i) vC[h][i] = vN[h][i];
        }
        if (wr == 1) PG8_BAR;
    }
    PG8_WAIT_V(0);
    PG8_BAR;
#undef PG8_SA
#undef PG8_SB
#undef PG8_STAGE
#undef PG8_STA
#undef PG8_STB
#undef PG8_LDA
#undef PG8_LDB
#undef PG8_MMA
#undef PG8_WAIT_V
#undef PG8_WAIT_L
#undef PG8_BAR
#undef PG8_SCHED
}
}

using pg8::Unit;
struct EpiProj {
    static constexpr bool PERM = true;
    bf16 *QK, *Vt8, *At, *QX, *GATES; const float* bgate;
#define EP_LOOP_BEGIN _Pragma("unroll") for (int ai = 0; ai < 2; ++ai) _Pragma("unroll") for (int m = 0; m < 4; ++m) { const int row = row0 + ai * 128 + m * 16; _Pragma("unroll") for (int bj = 0; bj < 2; ++bj) { \
        const f32x4 v0 = acc[ai][bj][m][0], v1 = acc[ai][bj][m][1]; const int cl = cl0 + bj * 128;
#define EP_LOOP_END } asm volatile("" ::: "memory"); }
    __device__ __forceinline__ void operator()(const f32x4 (&acc)[2][2][4][2], const Unit& u, int wr, int wc, int fr, int fq) const {
        const int pn = u.pn, row0 = u.pm * 256 + wr * 64 + fr, cl0 = wc * 32 + 8 * fq;
        if (pn < 4) {
            EP_LOOP_BEGIN
                u32x4 w; w.x = cvt_pk_bf16(v0[0], v0[1]); w.y = cvt_pk_bf16(v0[2], v0[3]); w.z = cvt_pk_bf16(v1[0], v1[1]); w.w = cvt_pk_bf16(v1[2], v1[3]);
                *(u32x4*)(QK + (unsigned)row * 1024 + pn * 256 + cl) = w;
            EP_LOOP_END
        } else if (pn < 6) {
            EP_LOOP_BEGIN
                const int vc = (pn - 4) * 256 + cl, hh = vc >> 6, dh = vc & 63, b = row >> 13, s = row & 8191;
                bf16* p = Vt8 + ((unsigned)((b * 8 + hh) * 1024 + (s >> 3)) * 64 + dh) * 8 + (s & 7);
                const unsigned w0 = cvt_pk_bf16(v0[0], v0[1]), w1 = cvt_pk_bf16(v0[2], v0[3]), w2 = cvt_pk_bf16(v1[0], v1[1]), w3 = cvt_pk_bf16(v1[2], v1[3]);
                p[0] = (bf16)w0; p[8] = (bf16)(w0 >> 16); p[16] = (bf16)w1; p[24] = (bf16)(w1 >> 16); p[32] = (bf16)w2; p[40] = (bf16)(w2 >> 16); p[48] = (bf16)w3; p[56] = (bf16)(w3 >> 16);
            EP_LOOP_END
        } else if (pn == 6) {
            EP_LOOP_BEGIN
                const int g = cl >> 4, c0 = cl & 15, b = row >> 13, s = row & 8191;
                u32x4 w; w.x = cvt_pk_bf16(v0[0], v0[1]); w.y = cvt_pk_bf16(v0[2], v0[3]); w.z = cvt_pk_bf16(v1[0], v1[1]); w.w = cvt_pk_bf16(v1[2], v1[3]);
                *(u32x4*)(At + ((unsigned)((b * 16 + g) * 256 + (s >> 5))) * ATK + (s & 31) * 16 + c0) = w;
            EP_LOOP_END
        } else if (pn == 7) {
            EP_LOOP_BEGIN
                u32x4 w; w.x = cvt_pk_bf16(v0[0], v0[1]); w.y = cvt_pk_bf16(v0[2], v0[3]); w.z = cvt_pk_bf16(v1[0], v1[1]); w.w = cvt_pk_bf16(v1[2], v1[3]);
                *(u32x4*)(QX + (unsigned)row * 256 + cl) = w;
            EP_LOOP_END
        } else {
            EP_LOOP_BEGIN
                const int gc = (pn - 8) * 256 + cl;
                const f32x4 b0 = *(const f32x4*)(bgate + gc), b1 = *(const f32x4*)(bgate + gc + 4);
                u32x4 w; w.x = cvt_pk_bf16(sigmoid_f(v0[0] + b0[0]), sigmoid_f(v0[1] + b0[1])); w.y = cvt_pk_bf16(sigmoid_f(v0[2] + b0[2]), sigmoid_f(v0[3] + b0[3]));
                w.z = cvt_pk_bf16(sigmoid_f(v1[0] + b1[0]), sigmoid_f(v1[1] + b1[1])); w.w = cvt_pk_bf16(sigmoid_f(v1[2] + b1[2]), sigmoid_f(v1[3] + b1[3]));
                *(u32x4*)(GATES + (unsigned)row * 3072 + gc) = w;
            EP_LOOP_END
        }
    }
#undef EP_LOOP_BEGIN
#undef EP_LOOP_END
};
struct EpiMemKV {
    static constexpr bool PERM = true;
    bf16 *Km, *Vm8;
    __device__ __forceinline__ void operator()(const f32x4 (&acc)[2][2][4][2], const Unit& u, int wr, int wc, int fr, int fq) const {
        const int row0 = u.pm * 256 + wr * 64 + fr, cl0 = wc * 32 + 8 * fq;
#pragma unroll
        for (int ai = 0; ai < 2; ++ai)
#pragma unroll
            for (int m = 0; m < 4; ++m) {
                const int row = row0 + ai * 128 + m * 16;
#pragma unroll
                for (int bj = 0; bj < 2; ++bj) {
                    const f32x4 v0 = acc[ai][bj][m][0], v1 = acc[ai][bj][m][1];
                    const int cl = cl0 + bj * 128;
                    const unsigned w0 = cvt_pk_bf16(v0[0], v0[1]), w1 = cvt_pk_bf16(v0[2], v0[3]), w2 = cvt_pk_bf16(v1[0], v1[1]), w3 = cvt_pk_bf16(v1[2], v1[3]);
                    if (u.pn == 0) { u32x4 w; w.x = w0; w.y = w1; w.z = w2; w.w = w3; *(u32x4*)(Km + (unsigned)row * 256 + cl) = w; }
                    else {
                        const int hh = cl >> 6, dh = cl & 63, lb = row >> 8, mm = row & 255;
                        bf16* p = Vm8 + ((unsigned)((lb * 4 + hh) * 32 + (mm >> 3)) * 64 + dh) * 8 + (mm & 7);
                        p[0] = (bf16)w0; p[8] = (bf16)(w0 >> 16); p[16] = (bf16)w1; p[24] = (bf16)(w1 >> 16); p[32] = (bf16)w2; p[40] = (bf16)(w2 >> 16); p[48] = (bf16)w3; p[56] = (bf16)(w3 >> 16);
                    }
                }
                asm volatile("" ::: "memory");
            }
    }
};
struct EpiS5a {
    static constexpr bool PERM = false;
    float* ST;
    __device__ __forceinline__ void operator()(const f32x4 (&acc)[2][2][4][2], const Unit& u, int wr, int wc, int fr, int fq) const {
        const int row0 = u.am * 256 + wr * 64 + fr, col0 = wc * 32 + 4 * fq;
#pragma unroll
        for (int ai = 0; ai < 2; ++ai)
#pragma unroll
            for (int m = 0; m < 4; ++m) { float* rowp = ST + (unsigned)(row0 + ai * 128 + m * 16) * 256 + col0;
#pragma unroll
                for (int bj = 0; bj < 2; ++bj)
#pragma unroll
                    for (int n = 0; n < 2; ++n) *(f32x4*)(rowp + bj * 128 + n * 16) = acc[ai][bj][m][n];
                asm volatile("" ::: "memory"); }
    }
};
struct EpiS5c {
    static constexpr bool PERM = true;
    bf16* Y;
    __device__ __forceinline__ void operator()(const f32x4 (&acc)[2][2][4][2], const Unit& u, int wr, int wc, int fr, int fq) const {
        const int b = u.am >> 4, g = u.am & 15, r0 = wr * 64 + fr, cl0 = u.pn * 256 + wc * 32 + 8 * fq;
#pragma unroll
        for (int ai = 0; ai < 2; ++ai)
#pragma unroll
            for (int m = 0; m < 4; ++m) {
                const int chunk = r0 + ai * 128 + m * 16;
#pragma unroll
                for (int bj = 0; bj < 2; ++bj) {
                    const f32x4 v0 = acc[ai][bj][m][0], v1 = acc[ai][bj][m][1];
                    const int col = cl0 + bj * 128, t = col >> 4, c0 = col & 15;
                    u32x4 w; w.x = cvt_pk_bf16(gelu_tanh_f(v0[0]), gelu_tanh_f(v0[1])); w.y = cvt_pk_bf16(gelu_tanh_f(v0[2]), gelu_tanh_f(v0[3]));
                    w.z = cvt_pk_bf16(gelu_tanh_f(v1[0]), gelu_tanh_f(v1[1])); w.w = cvt_pk_bf16(gelu_tanh_f(v1[2]), gelu_tanh_f(v1[3]));
                    *(u32x4*)(Y + (unsigned)(b * SEQ + chunk * 32 + t) * 256 + g * 16 + c0) = w;
                }
                asm volatile("" ::: "memory");
            }
    }
};
struct EpiGlu {
    static constexpr bool PERM = true;
    bf16* CAT;
    __device__ __forceinline__ void operator()(const f32x4 (&acc)[2][2][4][2], const Unit& u, int wr, int wc, int fr, int fq) const {
        const int row0 = u.pm * 256 + wr * 64 + fr, cl0 = u.pn * 256 + wc * 32 + 8 * fq;
#pragma unroll
        for (int ai = 0; ai < 2; ++ai)
#pragma unroll
            for (int m = 0; m < 4; ++m) {
                const int row = row0 + ai * 128 + m * 16;
#pragma unroll
                for (int bj = 0; bj < 2; ++bj) {
                    const f32x4 v0 = acc[ai][bj][m][0], v1 = acc[ai][bj][m][1];
                    const int col = cl0 + bj * 128;
                    u32x2 w; w.x = cvt_pk_bf16(v0[0] * sigmoid_f(v0[1]), v0[2] * sigmoid_f(v0[3])); w.y = cvt_pk_bf16(v1[0] * sigmoid_f(v1[1]), v1[2] * sigmoid_f(v1[3]));
                    *(u32x2*)(CAT + (unsigned)row * 1024 + 512 + (col >> 1)) = w;
                }
                asm volatile("" ::: "memory");
            }
    }
};
struct EpiMerge {
    static constexpr bool PERM = true;
    const bf16* GATES; bf16* MG;
    __device__ __forceinline__ void khook(f32x4 (&acc)[2][2][4][2], const Unit& u, int t, int wr, int wc, int fr, int fq) const {
        const int row0 = u.pm * 256 + wr * 64 + fr, cl0 = u.pn * 256 + wc * 32 + 8 * fq;
        const int ga = (t == 8) ? 0 : 1024;
#pragma unroll
        for (int ai = 0; ai < 2; ++ai)
#pragma unroll
            for (int m = 0; m < 4; ++m) {
                const int row = row0 + ai * 128 + m * 16;
#pragma unroll
                for (int bj = 0; bj < 2; ++bj) {
                    const bf16* gp = GATES + (unsigned)row * 3072 + ga + cl0 + bj * 128;
                    const u32x4 na = *(const u32x4*)gp, nb = *(const u32x4*)(gp + 1024);
                    f32x4 r0, r1;
                    r0[0] = bflo(na.x) * fast_rcp(bflo(nb.x)); r0[1] = bfhi(na.x) * fast_rcp(bfhi(nb.x)); r0[2] = bflo(na.y) * fast_rcp(bflo(nb.y)); r0[3] = bfhi(na.y) * fast_rcp(bfhi(nb.y));
                    r1[0] = bflo(na.z) * fast_rcp(bflo(nb.z)); r1[1] = bfhi(na.z) * fast_rcp(bfhi(nb.z)); r1[2] = bflo(na.w) * fast_rcp(bflo(nb.w)); r1[3] = bfhi(na.w) * fast_rcp(bfhi(nb.w));
                    acc[ai][bj][m][0] *= r0; acc[ai][bj][m][1] *= r1;
                }
                asm volatile("" ::: "memory");
            }
    }
    __device__ __forceinline__ void operator()(const f32x4 (&acc)[2][2][4][2], const Unit& u, int wr, int wc, int fr, int fq) const {
        const int row0 = u.pm * 256 + wr * 64 + fr, cl0 = u.pn * 256 + wc * 32 + 8 * fq;
#pragma unroll
        for (int ai = 0; ai < 2; ++ai)
#pragma unroll
            for (int m = 0; m < 4; ++m) {
                const int row = row0 + ai * 128 + m * 16;
#pragma unroll
                for (int bj = 0; bj < 2; ++bj) {
                    const u32x4 g2 = *(const u32x4*)(GATES + (unsigned)row * 3072 + 2048 + cl0 + bj * 128);
                    const f32x4 v0 = acc[ai][bj][m][0], v1 = acc[ai][bj][m][1];
                    u32x4 w; w.x = cvt_pk_bf16(v0[0] * bflo(g2.x), v0[1] * bfhi(g2.x)); w.y = cvt_pk_bf16(v0[2] * bflo(g2.y), v0[3] * bfhi(g2.y));
                    w.z = cvt_pk_bf16(v1[0] * bflo(g2.z), v1[1] * bfhi(g2.z)); w.w = cvt_pk_bf16(v1[2] * bflo(g2.w), v1[3] * bfhi(g2.w));
                    *(u32x4*)(MG + (unsigned)row * 1024 + cl0 + bj * 128) = w;
                }
                asm volatile("" ::: "memory");
            }
    }
};
struct EpiRes {
    static constexpr bool PERM = false;
    const float* base; float* out;
    __device__ __forceinline__ void operator()(const f32x4 (&acc)[2][2][4][2], const Unit& u, int wr, int wc, int fr, int fq) const {
        const int row0 = u.pm * 256 + wr * 64 + fr, col0 = u.pn * 256 + wc * 32 + 4 * fq;
#pragma unroll
        for (int ai = 0; ai < 2; ++ai)
#pragma unroll
            for (int m = 0; m < 4; ++m) { const size_t off = (unsigned)(row0 + ai * 128 + m * 16) * 1024 + col0;
#pragma unroll
                for (int bj = 0; bj < 2; ++bj)
#pragma unroll
                    for (int n = 0; n < 2; ++n) { const f32x4 bs = *(const f32x4*)(base + off + bj * 128 + n * 16); *(f32x4*)(out + off + bj * 128 + n * 16) = bs + acc[ai][bj][m][n]; }
                asm volatile("" ::: "memory"); }
    }
};
struct EpiMoe1 {
    static constexpr bool PERM = true;
    bf16* ACT; const float* wts;
    __device__ __forceinline__ void operator()(const f32x4 (&acc)[2][2][4][2], const Unit& u, int wr, int wc, int fr, int fq) const {
        const int r0 = wr * 64 + fr, cl0 = wc * 32 + 8 * fq, es = u.pn >> 1;
#pragma unroll
        for (int ai = 0; ai < 2; ++ai)
#pragma unroll
            for (int m = 0; m < 4; ++m) {
                const int r = r0 + ai * 128 + m * 16, slot = u.x1 + r;
                const float w = slot < u.x2 ? wts[((unsigned)u.x0 * LCAP + slot) * 2 + es] : 0.f;
#pragma unroll
                for (int bj = 0; bj < 2; ++bj) {
                    const f32x4 v0 = acc[ai][bj][m][0], v1 = acc[ai][bj][m][1];
                    const int col = cl0 + bj * 128;
                    u32x2 o; o.x = cvt_pk_bf16(v0[0] * sigmoid_f(v0[0]) * v0[1] * w, v0[2] * sigmoid_f(v0[2]) * v0[3] * w); o.y = cvt_pk_bf16(v1[0] * sigmoid_f(v1[0]) * v1[1] * w, v1[2] * sigmoid_f(v1[2]) * v1[3] * w);
                    *(u32x2*)(ACT + (unsigned)(u.pm * 256 + r) * 512 + es * 256 + (u.pn & 1) * 128 + (col >> 1)) = o;
                }
                asm volatile("" ::: "memory");
            }
    }
};
struct EpiMoe2 {
    static constexpr bool PERM = false;
    float* X; const int* list;
    __device__ __forceinline__ void operator()(const f32x4 (&acc)[2][2][4][2], const Unit& u, int wr, int wc, int fr, int fq) const {
        const int r0 = wr * 64 + fr, col0 = u.pn * 256 + wc * 32 + 4 * fq;
#pragma unroll
        for (int ai = 0; ai < 2; ++ai)
#pragma unroll
            for (int m = 0; m < 4; ++m) {
                const int r = r0 + ai * 128 + m * 16, slot = u.x1 + r;
                if (slot < u.x2) {
                    const int tok = list[(unsigned)u.x0 * LCAP + slot];
                    float* xp = X + (unsigned)tok * 1024 + col0;
#pragma unroll
                    for (int bj = 0; bj < 2; ++bj)
#pragma unroll
                        for (int n = 0; n < 2; ++n) { const f32x4 bs = *(const f32x4*)(xp + bj * 128 + n * 16); *(f32x4*)(xp + bj * 128 + n * 16) = bs + acc[ai][bj][m][n]; }
                }
                asm volatile("" ::: "memory");
            }
    }
};

#define XB_TMO      128
#define XB_XCNT(j)  (256  + 64 * (j))
#define XB_XSUB(j)  (1280 + 64 * (j))
#define XB_XGEN(j)  (2304 + 64 * (j))
#define XB_TOP      3328
#define XB_TOPGEN   3392
#define XCD_BAR_WORDS 3456
#define XB_SPIN_CAP (1u << 18)
__device__ __forceinline__ unsigned xb_ld(unsigned* p)              { return __hip_atomic_load(p, __ATOMIC_RELAXED, __HIP_MEMORY_SCOPE_AGENT); }
__device__ __forceinline__ unsigned xb_add(unsigned* p, unsigned v) { return __hip_atomic_fetch_add(p, v, __ATOMIC_RELAXED, __HIP_MEMORY_SCOPE_AGENT); }
__device__ __forceinline__ unsigned xb_xcc_id() { return (unsigned)__builtin_amdgcn_s_getreg((3 << 11) | 20) & 0xFu; }
#define XB_SPIN(cond, bar) do { unsigned _sp = 0; while (cond) { __builtin_amdgcn_s_sleep(1); \
    if ((++_sp & 255u) == 0u) { if (xb_ld(&(bar)[XB_TMO])) break; if (_sp > XB_SPIN_CAP) { atomicAdd(&(bar)[XB_TMO], 1u); break; } } } } while (0)
struct XcdBarrier { unsigned* bar; unsigned x; volatile LAS unsigned* st; };
__device__ __forceinline__ XcdBarrier xcd_barrier_post(unsigned* bar, volatile LAS unsigned* st) {
    XcdBarrier b; b.bar = bar; b.x = xb_xcc_id(); b.st = st;
    if (threadIdx.x == 0) (void)xb_add(&bar[XB_XCNT(b.x)], 1u);
    return b;
}
__device__ __forceinline__ void xcd_barrier_complete(unsigned* bar, unsigned x, unsigned& nloc, unsigned& nx) {
    const unsigned G = gridDim.x * gridDim.y * gridDim.z;
    unsigned sum, cnt, mine, sp = 0u;
    for (;;) {
        sum = 0u; cnt = 0u; mine = 0u;
#pragma unroll
        for (unsigned j = 0; j < 16; ++j) { const unsigned c = xb_ld(&bar[XB_XCNT(j)]); sum += c; cnt += (c > 0u) ? 1u : 0u; mine = (j == x) ? c : mine; }
        if (sum == G) break;
        __builtin_amdgcn_s_sleep(1);
        if ((++sp & 255u) == 0u) { if (xb_ld(&bar[XB_TMO])) break; if (sp > XB_SPIN_CAP) { atomicAdd(&bar[XB_TMO], 1u); break; } }
    }
    nloc = mine > 0u ? mine : 1u; nx = cnt > 0u ? cnt : 1u;
}
__device__ __forceinline__ void xcd_barrier(const XcdBarrier& b) {
    asm volatile("s_waitcnt vmcnt(0)" ::: "memory");
    __syncthreads();
    if (threadIdx.x == 0) {
        unsigned* bar = b.bar;
        __builtin_amdgcn_s_waitcnt(0);
        unsigned nloc = b.st[0], nx = b.st[1];
        if (nloc == 0u) { xcd_barrier_complete(bar, b.x, nloc, nx); b.st[0] = nloc; b.st[1] = nx; }
        const unsigned old = xb_add(&bar[XB_XSUB(b.x)], 1u);
        const unsigned gen = old / nloc;
        if (old + 1u == (gen + 1u) * nloc) {
            __builtin_amdgcn_fence(__ATOMIC_RELEASE, "agent");
            asm volatile("s_waitcnt vmcnt(0)" ::: "memory");
            const unsigned og = xb_add(&bar[XB_TOP], 1u);
            const unsigned tg = og / nx;
            if (og + 1u == (tg + 1u) * nx) xb_add(&bar[XB_TOPGEN], 1u);
            else XB_SPIN(xb_ld(&bar[XB_TOPGEN]) == tg, bar);
            __builtin_amdgcn_fence(__ATOMIC_ACQUIRE, "agent");
            xb_add(&bar[XB_XGEN(b.x)], 1u);
            asm volatile("s_waitcnt vmcnt(0)" ::: "memory");
        } else {
            XB_SPIN(xb_ld(&bar[XB_XGEN(b.x)]) == gen, bar);
            __builtin_amdgcn_fence(__ATOMIC_ACQUIRE, "agent");
            asm volatile("s_waitcnt vmcnt(0)" ::: "memory");
        }
    }
    __syncthreads();
}

template <bool NA>
__device__ __forceinline__ void attn_item(const bf16* qbase, int qstride, const bf16* kbase, int kstride, const bf16* v8base, int pos0, int kbstep, bf16* obase,
                                          const float* rpb_h, int rbias0, int c_lo, int c0q, int lane) {
    const int n = lane & 15, q = lane >> 4, cq = c0q + n;
    const unsigned qoff = (unsigned)(n * qstride + 8 * q);
    bf16x8 qf[2]; qf[0] = *(const bf16x8*)(qbase + qoff); qf[1] = *(const bf16x8*)(qbase + qoff + 32);
    bf16x8 kf[8][2][2];
    const unsigned koff = (unsigned)((8 * (n >> 2) + (n & 3)) * kstride + 8 * q);
#pragma unroll
    for (int kb = 0; kb < 8; ++kb)
#pragma unroll
        for (int blk = 0; blk < 2; ++blk) {
            const bf16* kp = kbase + (unsigned)((pos0 + kb * kbstep + 4 * blk) * kstride) + koff;
            kf[kb][blk][0] = *(const bf16x8*)kp; kf[kb][blk][1] = *(const bf16x8*)(kp + 32);
        }
    f32x4 s[8][2];
#pragma unroll
    for (int kb = 0; kb < 8; ++kb)
#pragma unroll
        for (int blk = 0; blk < 2; ++blk) {
            f32x4 a = (f32x4){0.f, 0.f, 0.f, 0.f};
            a = __builtin_amdgcn_mfma_f32_16x16x32_bf16(kf[kb][blk][0], qf[0], a, 0, 0, 0);
            a = __builtin_amdgcn_mfma_f32_16x16x32_bf16(kf[kb][blk][1], qf[1], a, 0, 0, 0);
            s[kb][blk] = a;
        }
    bf16x8 vf[8][4];
#pragma unroll
    for (int kb = 0; kb < 8; ++kb)
#pragma unroll
        for (int db = 0; db < 4; ++db) vf[kb][db] = *(const bf16x8*)(v8base + (unsigned)(((pos0 + kb * kbstep) >> 3) * 512 + db * 128) + (unsigned)(q * 512 + n * 8));
    if (NA) {
        const int cs = min(max(cq - 8, 0), 48);
#pragma unroll
        for (int kb = 0; kb < 8; ++kb)
#pragma unroll
            for (int blk = 0; blk < 2; ++blk)
#pragma unroll
                for (int i = 0; i < 4; ++i) {
                    const int kc = c_lo + 8 * q + 4 * blk + i; const bool valid = (kc >= cs) && (kc < cs + 16);
                    const int bi = min(max(kc - cq + 15, 0), 30);
                    const float bias = rpb_h[(rbias0 + kb) * 31 + bi];
                    s[kb][blk][i] = valid ? s[kb][blk][i] + bias : -1e30f;
                }
    }
    float mx = -1e30f;
#pragma unroll
    for (int kb = 0; kb < 8; ++kb)
#pragma unroll
        for (int blk = 0; blk < 2; ++blk)
#pragma unroll
            for (int i = 0; i < 4; ++i) mx = fmaxf(mx, s[kb][blk][i]);
    mx = fmaxf(mx, shfl_xor_f(mx, 16, lane)); mx = fmaxf(mx, shfl_xor_f(mx, 32, lane));
    float sum = 0.f; bf16x8 pf[8];
#pragma unroll
    for (int kb = 0; kb < 8; ++kb) {
        float p[8];
#pragma unroll
        for (int blk = 0; blk < 2; ++blk)
#pragma unroll
            for (int i = 0; i < 4; ++i) { const float e = fast_exp(s[kb][blk][i] - mx); p[blk * 4 + i] = e; sum += e; }
        u32x4 w; w.x = cvt_pk_bf16(p[0], p[1]); w.y = cvt_pk_bf16(p[2], p[3]); w.z = cvt_pk_bf16(p[4], p[5]); w.w = cvt_pk_bf16(p[6], p[7]);
        pf[kb] = __builtin_bit_cast(bf16x8, w);
    }
    sum += shfl_xor_f(sum, 16, lane); sum += shfl_xor_f(sum, 32, lane);
    const float inv = fast_rcp(sum);
#pragma unroll
    for (int db = 0; db < 4; ++db) {
        f32x4 o = (f32x4){0.f, 0.f, 0.f, 0.f};
#pragma unroll
        for (int kb = 0; kb < 8; ++kb) o = __builtin_amdgcn_mfma_f32_16x16x32_bf16(vf[kb][db], pf[kb], o, 0, 0, 0);
        u32x2 w; w.x = cvt_pk_bf16(o[0] * inv, o[1] * inv); w.y = cvt_pk_bf16(o[2] * inv, o[3] * inv);
        *(u32x2*)(obase + (unsigned)(n * 1024 + 4 * q) + db * 16) = w;
    }
}

constexpr int NWAVES = 8;
constexpr int RING_BYTES = 131072, MISC_OFF = RING_BYTES, TAB_OFF = RING_BYTES + 256, LDS_BYTES = 147456;
struct Args { const float* in[30]; float* out; unsigned char* ws; };
struct Frame { LAS unsigned char* lds; int tid, lane, wave, vcu, G; };
enum { I_X = 0, I_MEM, I_NMIX, I_NFFN, I_NMEM, I_WIN, I_BGATE, I_RPB, I_LRE, I_LIM, I_LDT, I_BRE, I_BIM, I_CRE, I_CIM, I_S5D, I_WGLU, I_WMKV, I_WBNA, I_WBS5, I_WBXA, I_WOUT,
       I_WCO, I_BCO, I_WFI, I_BFI, I_WG, I_WU, I_WD, I_FNORM };

__device__ __forceinline__ void transpose_item(const float* W, int ldn, int k0, int n0, bf16* WT, int ldk, int dk0, int row_off, int rmul, int radd, int qs, LAS float* scr, int lane) {
#pragma unroll 8
    for (int i = 0; i < 32; ++i) { const int kk = 2 * i + (lane >> 5); scr[kk * 33 + (lane & 31)] = W[(size_t)(k0 + kk) * ldn + n0 + (lane & 31)]; }
    LDS_WAIT(); asm volatile("" ::: "memory");
    const int c = lane & 7;
#pragma unroll
    for (int j = 0; j < 4; ++j) { const int n = (lane >> 3) + 8 * j, nn = n0 + n; const LAS float* s = scr + (8 * c) * 33 + n;
        const float sc = (qs && (nn < 512 || (nn >= 1792 && nn < 2048))) ? 0.125f : 1.0f;
        u32x4 o; o.x = cvt_pk_bf16(s[0 * 33] * sc, s[1 * 33] * sc); o.y = cvt_pk_bf16(s[2 * 33] * sc, s[3 * 33] * sc); o.z = cvt_pk_bf16(s[4 * 33] * sc, s[5 * 33] * sc); o.w = cvt_pk_bf16(s[6 * 33] * sc, s[7 * 33] * sc);
        *(u32x4*)(WT + (size_t)(row_off + nn * rmul + radd) * ldk + dk0 + k0 + 8 * c) = o; }
    LDS_WAIT(); asm volatile("" ::: "memory");
}
__device__ __forceinline__ void transpose_job_item(const float* W, int ldn, int N, int it, bf16* WT, int ldk, int dk0, int row_off, int rmul, int radd, int qs, LAS float* scr, int lane) {
    const int nblk = N / 32, kb = it / nblk, nb = it % nblk;
    transpose_item(W, ldn, 64 * kb, 32 * nb, WT, ldk, dk0, row_off, rmul, radd, qs, scr, lane);
}

__device__ __forceinline__ void cexp_d(double zr, double zi, double& er, double& ei) {
    const double wr_ = zr * (1.0 / 1024.0), wi_ = zi * (1.0 / 1024.0);
    double tr = 1.0, ti = 0.0;
#pragma unroll
    for (int n = 12; n >= 1; --n) { const double ar = wr_ * (1.0 / n), ai = wi_ * (1.0 / n); const double nr = 1.0 + (ar * tr - ai * ti), ni = ar * ti + ai * tr; tr = nr; ti = ni; }
#pragma unroll
    for (int k = 0; k < 10; ++k) { const double nr = tr * tr - ti * ti, ni = 2.0 * tr * ti; tr = nr; ti = ni; }
    er = tr; ei = ti;
}

template <bool ROUTER>
__device__ __forceinline__ void norm_rows4(const float* X, const float* gain, bf16* H, int row0, int lane,
                                           const float* wrt, const float* bco, const float* bfi, unsigned* cnt, int* list, float* wts) {
    f32x4 x[4][4]; float rstd[4];
#pragma unroll
    for (int r = 0; r < 4; ++r) { float ss = 0.f;
#pragma unroll
        for (int j = 0; j < 4; ++j) { x[r][j] = *(const f32x4*)(X + (size_t)(row0 + r) * 1024 + 256 * j + 4 * lane); ss += (x[r][j][0] * x[r][j][0] + x[r][j][1] * x[r][j][1]) + (x[r][j][2] * x[r][j][2] + x[r][j][3] * x[r][j][3]); }
        ss = wave_sum(ss, lane); rstd[r] = 1.0f / sqrtf(ss * (1.0f / 1024.0f) + RMS_EPS); }
#pragma unroll
    for (int j = 0; j < 4; ++j) { const f32x4 g4 = *(const f32x4*)(gain + 256 * j + 4 * lane);
#pragma unroll
        for (int r = 0; r < 4; ++r) { const f32x4 v = x[r][j] * rstd[r] * g4; u32x2 w; w.x = cvt_pk_bf16(v[0], v[1]); w.y = cvt_pk_bf16(v[2], v[3]);
            *(u32x2*)(H + (size_t)(row0 + r) * 1024 + 256 * j + 4 * lane) = w; } }
    if constexpr (ROUTER) {
        float keep[4] = {0.f, 0.f, 0.f, 0.f};
#pragma unroll 2
        for (int c = 0; c < 20; ++c) {
            float a0 = 0.f, a1 = 0.f, a2 = 0.f, a3 = 0.f;
#pragma unroll
            for (int j = 0; j < 4; ++j) { const f32x4 w4 = *(const f32x4*)(wrt + c * 1024 + 256 * j + 4 * lane);
                a0 += (x[0][j][0] * w4[0] + x[0][j][1] * w4[1]) + (x[0][j][2] * w4[2] + x[0][j][3] * w4[3]);
                a1 += (x[1][j][0] * w4[0] + x[1][j][1] * w4[1]) + (x[1][j][2] * w4[2] + x[1][j][3] * w4[3]);
                a2 += (x[2][j][0] * w4[0] + x[2][j][1] * w4[1]) + (x[2][j][2] * w4[2] + x[2][j][3] * w4[3]);
                a3 += (x[3][j][0] * w4[0] + x[3][j][1] * w4[1]) + (x[3][j][2] * w4[2] + x[3][j][3] * w4[3]); }
            a0 = wave_sum(a0, lane); a1 = wave_sum(a1, lane); a2 = wave_sum(a2, lane); a3 = wave_sum(a3, lane);
            if (lane == c) { keep[0] = a0 * rstd[0]; keep[1] = a1 * rstd[1]; keep[2] = a2 * rstd[2]; keep[3] = a3 * rstd[3]; }
        }
#pragma unroll
        for (int r = 0; r < 4; ++r) {
            float co[4];
#pragma unroll
            for (int i = 0; i < 4; ++i) co[i] = shfl_idx_f(keep[r], i) + bco[i];
            int grp = 0; float cm = co[0];
#pragma unroll
            for (int i = 1; i < 4; ++i) if (co[i] > cm) { cm = co[i]; grp = i; }
            float den = 0.f;
#pragma unroll
            for (int i = 0; i < 4; ++i) den += __expf(co[i] - cm);
            const float pgrp = 1.0f / den;
            float fv[4];
#pragma unroll
            for (int i = 0; i < 4; ++i) fv[i] = shfl_idx_f(keep[r], 4 + grp * 4 + i) + bfi[grp * 4 + i];
            int i1 = 0; float v1 = fv[0];
#pragma unroll
            for (int i = 1; i < 4; ++i) if (fv[i] > v1) { v1 = fv[i]; i1 = i; }
            int i2 = -1; float v2 = -3.0e38f;
#pragma unroll
            for (int i = 0; i < 4; ++i) if (i != i1 && fv[i] > v2) { v2 = fv[i]; i2 = i; }
            const float w1 = pgrp / (1.0f + __expf(v2 - v1)), w2 = pgrp - w1;
            const int a = i1 < i2 ? i1 : i2, b = i1 < i2 ? i2 : i1;
            const int pidx = a == 0 ? b - 1 : (a == 1 ? b + 1 : 5);
            const int bucket = grp * 6 + pidx;
            const float wa = (i1 == a) ? w1 : w2, wb = (i1 == a) ? w2 : w1;
            if (lane == 0) {
                const unsigned slot = __hip_atomic_fetch_add(cnt + bucket * 64, 1u, __ATOMIC_RELAXED, __HIP_MEMORY_SCOPE_AGENT);
                list[(size_t)bucket * LCAP + slot] = row0 + r;
                *(f32x2*)(wts + ((size_t)bucket * LCAP + slot) * 2) = (f32x2){wa, wb};
            }
        }
    }
}

__device__ __forceinline__ void final_norm_row(float* X, const float* gain, int row, int lane) {
    f32x4 x[4]; float ss = 0.f;
#pragma unroll
    for (int j = 0; j < 4; ++j) { x[j] = *(const f32x4*)(X + (size_t)row * 1024 + 256 * j + 4 * lane); ss += (x[j][0] * x[j][0] + x[j][1] * x[j][1]) + (x[j][2] * x[j][2] + x[j][3] * x[j][3]); }
    ss = wave_sum(ss, lane); const float rstd = 1.0f / sqrtf(ss * (1.0f / 1024.0f) + RMS_EPS);
#pragma unroll
    for (int j = 0; j < 4; ++j) { const f32x4 g4 = *(const f32x4*)(gain + 256 * j + 4 * lane); *(f32x4*)(X + (size_t)row * 1024 + 256 * j + 4 * lane) = x[j] * rstd * g4; }
}

__device__ __forceinline__ void s5_scan_item(int item, const float* ST, bf16* At, const f32x2* apow_l, LAS float* sc, int tid) {
    const int d = item & 1, bg = item >> 1, g = bg & 15, seg = tid >> 6, p = tid & 63;
    const f32x2 A32 = apow_l[((d * 16 + g) * 33 + 32) * 64 + p];
    const int chunk0 = d ? 255 - seg * 32 : seg * 32; const long cstep = d ? -1 : 1;
    const float* rp0 = ST + (size_t)(bg * 256 + chunk0) * 256 + d * 128 + p;
    float tr = 0.f, ti = 0.f;
#pragma unroll 8
    for (int j = 0; j < 32; ++j) { const float* rp = rp0 + cstep * j * 256; const float sr = rp[0], si = rp[64]; const float nr = A32.x * tr - A32.y * ti + sr, ni = A32.x * ti + A32.y * tr + si; tr = nr; ti = ni; }
    sc[(seg * 64 + p) * 2] = tr; sc[(seg * 64 + p) * 2 + 1] = ti;
    __syncthreads();
    float pr = A32.x, pi = A32.y;
#pragma unroll
    for (int k = 0; k < 5; ++k) { const float nr = pr * pr - pi * pi, ni = 2.f * pr * pi; pr = nr; pi = ni; }
    float er = 0.f, ei = 0.f;
    for (int s2 = 0; s2 < seg; ++s2) { const float qr = sc[(s2 * 64 + p) * 2], qi = sc[(s2 * 64 + p) * 2 + 1]; const float nr = pr * er - pi * ei + qr, ni = pr * ei + pi * er + qi; er = nr; ei = ni; }
    bf16* op0 = At + (size_t)(bg * 256 + chunk0) * ATK + 512 + d * 128 + p;
#pragma unroll 8
    for (int j = 0; j < 32; ++j) { const float* rp = rp0 + cstep * j * 256; const float sr = rp[0], si = rp[64]; bf16* op = op0 + cstep * j * ATK;
        op[0] = (bf16)(cvt_pk_bf16(er, er) & 0xffffu); op[64] = (bf16)(cvt_pk_bf16(ei, ei) & 0xffffu);
        const float nr = A32.x * er - A32.y * ei + sr, ni = A32.x * ei + A32.y * er + si; er = nr; ei = ni; }
    __syncthreads();
}

#ifndef PHMASK
#define PHMASK 0xffffffffu
#endif
#define PH(k) ((PHMASK >> (k)) & 1u)
constexpr int PTR_OFF = RING_BYTES + 1024;
__device__ __forceinline__ const float* inp(LAS unsigned char* lds, int i, int z) {
    const LAS unsigned* q = (const LAS unsigned*)(lds + PTR_OFF + 8 * i + z);
    const unsigned lo = __builtin_amdgcn_readfirstlane(q[0]), hi = __builtin_amdgcn_readfirstlane(q[1]);
    return (const float*)(((unsigned long long)hi << 32) | lo);
}
#define WSL() unsigned char* wsl = args.ws; int wave = F.wave, bid = blockIdx.x, G = gridDim.x, zz = 0; unsigned mm_ = ~0u; asm volatile("" : "+s"(mm_)); int lane = (int)__builtin_amdgcn_mbcnt_hi(mm_, __builtin_amdgcn_mbcnt_lo(mm_, 0u)); \
    asm volatile("" : "+s"(wsl), "+s"(wave), "+v"(lane), "+s"(bid), "+s"(G), "+s"(zz)); \
    const int tid = wave * 64 + lane, vcu = (G % 8 == 0) ? (bid % 8) * (G / 8) + bid / 8 : bid, gw = vcu * NWAVES + wave, NGW = G * NWAVES, NGT = G * NWAVES * 64; \
    (void)tid; (void)gw; (void)NGW; (void)NGT; (void)wsl
#define WP(T, off) ((T*)(wsl + (off)))
#define IN(i) inp(F.lds, (i), zz)

__global__ void __launch_bounds__(NWAVES * 64, 2) fwd_kernel(Args args) {
    extern __shared__ __attribute__((aligned(16))) unsigned char lds_raw[];
    Frame F;
    F.lds = (LAS unsigned char*)lds_raw;
    F.tid = threadIdx.x; F.lane = F.tid & 63; F.wave = __builtin_amdgcn_readfirstlane(F.tid >> 6);
    F.G = gridDim.x; { const int bx = blockIdx.x; F.vcu = (F.G % 8 == 0) ? (bx % 8) * (F.G / 8) + bx / 8 : bx; }
    for (int u = F.tid; u < (LDS_BYTES - RING_BYTES) / 4; u += NWAVES * 64) ((LAS unsigned*)(F.lds + MISC_OFF))[u] = 0u;
    __syncthreads();
    if (F.tid < 30) { const unsigned long long p = (unsigned long long)args.in[F.tid]; LAS unsigned* q = (LAS unsigned*)(F.lds + PTR_OFF + 8 * F.tid); q[0] = (unsigned)p; q[1] = (unsigned)(p >> 32); }
    __syncthreads();
    (void)xcd_barrier_post((unsigned*)(args.ws + WS_CTL) + CW_BAR, (volatile LAS unsigned*)(F.lds + MISC_OFF));
#define GRID_BAR() do { unsigned char* w_ = args.ws; asm volatile("" : "+s"(w_)); XcdBarrier b_; b_.bar = (unsigned*)(w_ + WS_CTL) + CW_BAR; b_.x = xb_xcc_id(); b_.st = (volatile LAS unsigned*)(F.lds + MISC_OFF); xcd_barrier(b_); } while (0)
#define GT() (vcu * (NWAVES * 64) + tid)
#define SCR() ((LAS float*)(F.lds + wave * 16384))

    if (PH(0)) {
        WSL();
        f32x2* APOW = WP(f32x2, WS_APOW); f32x2* BBAR = WP(f32x2, WS_BBAR); float* WRT = WP(float, WS_WRT); bf16* MEMN = WP(bf16, WS_MEMN); bf16* WMKV = WP(bf16, WS_WMKV);
        for (int it = gw; it < 1024; it += NGW) { const int l = it >> 8, r = it & 255;
            transpose_job_item(IN(I_WMKV) + (size_t)l * 1024 * 512, 512, 512, r, WMKV + (size_t)l * 512 * 1024, 1024, 0, 0, 1, 0, 0, SCR(), lane); }
        for (int it = gw; it < 4096; it += NGW) { const int l = it >> 10, row = it & 1023;
            const float* xr = IN(I_MEM) + (size_t)row * 1024; const float* gn = IN(I_NMEM) + l * 1024;
            f32x4 x[4]; float ss = 0.f;
#pragma unroll
            for (int j = 0; j < 4; ++j) { x[j] = *(const f32x4*)(xr + 256 * j + 4 * lane); ss += (x[j][0] * x[j][0] + x[j][1] * x[j][1]) + (x[j][2] * x[j][2] + x[j][3] * x[j][3]); }
            ss = wave_sum(ss, lane); const float rstd = 1.0f / sqrtf(ss * (1.0f / 1024.0f) + RMS_EPS);
#pragma unroll
            for (int j = 0; j < 4; ++j) { const f32x4 v = x[j] * rstd * *(const f32x4*)(gn + 256 * j + 4 * lane); u32x2 w; w.x = cvt_pk_bf16(v[0], v[1]); w.y = cvt_pk_bf16(v[2], v[3]);
                *(u32x2*)(MEMN + (size_t)it * 1024 + 256 * j + 4 * lane) = w; } }
        for (int it = GT(); it < 8192; it += NGT) {
            const int p = it & 63, ldg = it >> 6;
            const double lr = fmin((double)IN(I_LRE)[it], -1e-4), li = (double)IN(I_LIM)[it];
            double dt, dum; cexp_d((double)IN(I_LDT)[ldg], 0.0, dt, dum);
            double ar, ai; cexp_d(lr * dt, li * dt, ar, ai);
            const double den = lr * lr + li * li, fr = ((ar - 1.0) * lr + ai * li) / den, fi = (ai * lr - (ar - 1.0) * li) / den;
            const float* bre = IN(I_BRE) + (size_t)it * 16; const float* bim = IN(I_BIM) + (size_t)it * 16;
#pragma unroll 4
            for (int c = 0; c < 16; ++c) { const double br = (double)bre[c], bi = (double)bim[c];
                BBAR[(size_t)it * 16 + c] = (f32x2){(float)(fr * br - fi * bi), (float)(fr * bi + fi * br)}; }
            double pr = 1.0, pi = 0.0;
            for (int n = 0; n <= 32; ++n) { APOW[((size_t)ldg * 33 + n) * 64 + p] = (f32x2){(float)pr, (float)pi}; const double nr = pr * ar - pi * ai, ni = pr * ai + pi * ar; pr = nr; pi = ni; }
        }
        for (int it = GT(); it < 4 * 20480; it += NGT) { const int l = it / 20480, r = it % 20480, c = r >> 10, k = r & 1023;
            const float gk = IN(I_NFFN)[l * 1024 + k];
            WRT[it] = gk * (c < 4 ? IN(I_WCO)[(size_t)(l * 1024 + k) * 4 + c] : IN(I_WFI)[(size_t)(l * 1024 + k) * 16 + (c - 4)]); }
    }
    GRID_BAR();

    if (PH(1)) {
        WSL();
        { pg8::Gemm g{WP(bf16, WS_MEMN), WP(bf16, WS_WMKV), 1024, 1024, 1024}; pg8::MemOrder S{G, bid}; EpiMemKV E{WP(bf16, WS_KM), WP(bf16, WS_VM8)};
          pg8::gemm_phase<EpiMemKV, pg8::MemOrder>(F.lds, g, S, E, tid); }
        const f32x2* APOW = WP(f32x2, WS_APOW); const f32x2* BBAR = WP(f32x2, WS_BBAR); float* KT = WP(float, WS_KT);
        const float* CRE = IN(I_CRE); const float* CIM = IN(I_CIM); const float* S5D = IN(I_S5D);
        for (int it = GT(); it < 4 * 16 * 63 * 256; it += NGT) {
            const int c2 = it & 15, c = (it >> 4) & 15, rest = it >> 8, tp = rest % 63, lg = rest / 63, l = lg >> 4, g = lg & 15;
            float sum = 0.f;
#pragma unroll 1
            for (int d = 0; d < 2; ++d) {
                if (d == 0 ? (tp < 31) : (tp > 31)) continue;
                const int n = d == 0 ? tp - 31 : 31 - tp, base = (l * 2 + d) * 16 + g;
                const float* cre = CRE + ((size_t)base * 16 + c) * 64; const float* cim = CIM + ((size_t)base * 16 + c) * 64;
                const f32x2* ap = APOW + ((size_t)base * 33 + n) * 64; const f32x2* bb = BBAR + (size_t)base * 64 * 16 + c2;
#pragma unroll 4
                for (int p = 0; p < 64; ++p) { const f32x2 a = ap[p], b = bb[p * 16]; const float cr = cre[p], ci = cim[p];
                    const float er = cr * a.x - ci * a.y, ei = cr * a.y + ci * a.x; sum += er * b.x - ei * b.y; }
            }
            if (tp == 31 && c == c2) sum += S5D[l * 256 + g * 16 + c];
            KT[it] = sum;
        }
    }
    GRID_BAR();

    const float* xcur = args.in[I_X];
    float* XO = args.out;
#pragma unroll 1
    for (int l = 0; l < DEPTH; ++l) {
        if (PH(2)) {
            WSL();
            {
            bf16* WIN = WP(bf16, WS_WIN); bf16* WCAT = WP(bf16, WS_WCAT); bf16* WOUT = WP(bf16, WS_WOUT); bf16* WGLU = WP(bf16, WS_WGLU);
            for (int it = gw; it < 3648; it += NGW) {
                int r = it;
                if (r < 2560) { transpose_job_item(IN(I_WIN) + (size_t)l * 1024 * 5120, 5120, 5120, r, WIN, 1024, 0, 0, 1, 0, 1, SCR(), lane); continue; } r -= 2560;
                if (r < 256) { transpose_job_item(IN(I_WBNA) + (size_t)l * 512 * 1024, 1024, 1024, r, WCAT, 1024, 0, 0, 1, 0, 0, SCR(), lane); continue; } r -= 256;
                if (r < 128) { transpose_job_item(IN(I_WBS5) + (size_t)l * 256 * 1024, 1024, 1024, r, WCAT, 1024, 512, 0, 1, 0, 0, SCR(), lane); continue; } r -= 128;
                if (r < 128) { transpose_job_item(IN(I_WBXA) + (size_t)l * 256 * 1024, 1024, 1024, r, WCAT, 1024, 768, 0, 1, 0, 0, SCR(), lane); continue; } r -= 128;
                if (r < 512) { transpose_job_item(IN(I_WOUT) + (size_t)l * 1024 * 1024, 1024, 1024, r, WOUT, 1024, 0, 0, 1, 0, 0, SCR(), lane); continue; } r -= 512;
                if (r < 32) { transpose_job_item(IN(I_WGLU) + (size_t)l * 256 * 512, 512, 256, r, WGLU, 256, 0, 0, 2, 0, 0, SCR(), lane); continue; } r -= 32;
                transpose_job_item(IN(I_WGLU) + (size_t)l * 256 * 512 + 256, 512, 256, r, WGLU, 256, 0, 0, 2, 1, 0, SCR(), lane);
            }
            }
            {
            const f32x2* APOW = WP(f32x2, WS_APOW); const f32x2* BBAR = WP(f32x2, WS_BBAR); bf16* S5W = WP(bf16, WS_S5W);
            for (int it = GT(); it < 16 * 256 * 64; it += NGT) {
                const int k8 = it & 63, n = (it >> 6) & 255, g = it >> 14;
                const int s = k8 >> 1, c0 = (k8 & 1) * 8, d = n >> 7, ri = (n >> 6) & 1, p = n & 63, e = d == 0 ? 31 - s : s, base = (l * 2 + d) * 16 + g;
                const f32x2 a = APOW[((size_t)base * 33 + e) * 64 + p]; const f32x2* bb = BBAR + ((size_t)base * 64 + p) * 16 + c0;
                float v[8];
#pragma unroll
                for (int j = 0; j < 8; ++j) { const f32x2 b = bb[j]; v[j] = ri == 0 ? a.x * b.x - a.y * b.y : a.x * b.y + a.y * b.x; }
                u32x4 w; w.x = cvt_pk_bf16(v[0], v[1]); w.y = cvt_pk_bf16(v[2], v[3]); w.z = cvt_pk_bf16(v[4], v[5]); w.w = cvt_pk_bf16(v[6], v[7]);
                *(u32x4*)(S5W + ((size_t)(g * 256 + n) * 512 + k8 * 8)) = w;
            }
            const float* KT = WP(float, WS_KT); bf16* S5KV = WP(bf16, WS_S5KV); const float* CRE = IN(I_CRE); const float* CIM = IN(I_CIM);
            for (int it = GT(); it < 16 * 512 * 96; it += NGT) {
                const int k8 = it % 96, rest = it / 96, n = rest & 511, g = rest >> 9, t = n >> 4, c = n & 15;
                float v[8];
                if (k8 < 64) { const int s = k8 >> 1, c0 = (k8 & 1) * 8, tp = t - s + 31; const float* kp = KT + ((size_t)(((l * 16 + g) * 63 + tp) * 16 + c) * 16 + c0);
                    const f32x4 a = *(const f32x4*)kp, b = *(const f32x4*)(kp + 4); v[0] = a[0]; v[1] = a[1]; v[2] = a[2]; v[3] = a[3]; v[4] = b[0]; v[5] = b[1]; v[6] = b[2]; v[7] = b[3]; }
                else { const int jj = (k8 - 64) * 8, d = jj >> 7, ri = (jj >> 6) & 1, p0 = jj & 63, e = d == 0 ? t + 1 : 32 - t, base = (l * 2 + d) * 16 + g;
                    const float* cre = CRE + ((size_t)base * 16 + c) * 64 + p0; const float* cim = CIM + ((size_t)base * 16 + c) * 64 + p0; const f32x2* ap = APOW + ((size_t)base * 33 + e) * 64 + p0;
#pragma unroll
                    for (int j = 0; j < 8; ++j) { const f32x2 a = ap[j]; const float cr = cre[j], ci = cim[j]; v[j] = ri == 0 ? cr * a.x - ci * a.y : -(cr * a.y + ci * a.x); } }
                u32x4 w; w.x = cvt_pk_bf16(v[0], v[1]); w.y = cvt_pk_bf16(v[2], v[3]); w.z = cvt_pk_bf16(v[4], v[5]); w.w = cvt_pk_bf16(v[6], v[7]);
                *(u32x4*)(S5KV + ((size_t)(g * 512 + n) * ATK + k8 * 8)) = w;
            }
            }
            { bf16* H = WP(bf16, WS_H); const float* gn = IN(I_NMIX) + l * 1024;
              for (int grp = gw; grp < M / 4; grp += NGW) norm_rows4<false>(xcur, gn, H, grp * 4, lane, nullptr, nullptr, nullptr, nullptr, nullptr, nullptr); }
        }
        GRID_BAR();

        if (PH(3)) {
            WSL();
            pg8::Gemm g{WP(bf16, WS_H), WP(bf16, WS_WIN), 1024, 1024, 1024}; pg8::StaticOrder S; S.init(M / 256, INC / 256, G, bid);
            EpiProj E{WP(bf16, WS_QK), WP(bf16, WS_VT8), WP(bf16, WS_AT), WP(bf16, WS_QX), WP(bf16, WS_GATES), IN(I_BGATE) + l * 3072};
            pg8::gemm_phase<EpiProj, pg8::StaticOrder>(F.lds, g, S, E, tid);
        }
        GRID_BAR();

        if (PH(4)) {
            WSL();
            { pg8::Gemm g{WP(bf16, WS_AT), WP(bf16, WS_S5W), ATK, 512, 512}; pg8::S5Order S; S.init(64, 1, G, bid); EpiS5a E{WP(float, WS_ST)};
              pg8::gemm_phase<EpiS5a, pg8::S5Order>(F.lds, g, S, E, tid); }
            bf16* QK = WP(bf16, WS_QK); bf16* VT8 = WP(bf16, WS_VT8); bf16* H = WP(bf16, WS_H); bf16* QX = WP(bf16, WS_QX); bf16* KM = WP(bf16, WS_KM); bf16* VM8 = WP(bf16, WS_VM8);
            const float* RPB = IN(I_RPB);
            for (int it = gw; it < 24576; it += NGW) {
                if (it < 16384) {
                    const int cb = it & 3, h = (it >> 2) & 7, r = (it >> 5) & 127, b = it >> 12;
                    const int t0 = b * SEQ + r * 64 + cb * 16, rs = min(max(r - 4, 0), 120), c_lo = cb == 0 ? 0 : (cb == 1 ? 8 : (cb == 2 ? 24 : 32));
                    attn_item<true>(QK + (size_t)t0 * 1024 + h * 64, 1024, QK + (size_t)b * SEQ * 1024 + 512 + h * 64, 1024, VT8 + (size_t)(b * 8 + h) * 1024 * 512, rs * 64 + c_lo, 64,
                                    H + (size_t)t0 * 1024 + h * 64, RPB + (size_t)(l * 8 + h) * 15 * 31, rs - r + 7, c_lo, cb * 16, lane);
                } else {
                    const int j = it - 16384, h = j & 3, t0 = (j >> 2) * 16, b = t0 >> 13;
                    attn_item<false>(QX + (size_t)t0 * 256 + h * 64, 256, KM + ((size_t)(l * 4 + b) * 256) * 256 + h * 64, 256, VM8 + (size_t)((l * 4 + b) * 4 + h) * 32 * 512, 0, 32,
                                     H + (size_t)t0 * 1024 + 768 + h * 64, nullptr, 0, 0, 0, lane);
                }
            }
        }
        GRID_BAR();

        if (PH(5)) {
            WSL();
            for (int it = bid; it < 128; it += G) s5_scan_item(it, WP(float, WS_ST), WP(bf16, WS_AT), WP(f32x2, WS_APOW) + (size_t)l * 2 * 16 * 33 * 64, (LAS float*)F.lds, tid);
        }
        GRID_BAR();

        if (PH(6)) {
            WSL();
            pg8::Gemm g{WP(bf16, WS_AT), WP(bf16, WS_S5KV), ATK, ATK, ATK}; pg8::S5Order S; S.init(64, 2, G, bid); EpiS5c E{WP(bf16, WS_Y)};
            pg8::gemm_phase<EpiS5c, pg8::S5Order>(F.lds, g, S, E, tid);
        }
        GRID_BAR();

        if (PH(7)) {
            WSL();
            pg8::Gemm g{WP(bf16, WS_Y), WP(bf16, WS_WGLU), 256, 256, 256}; pg8::StaticOrder S; S.init(M / 256, 2, G, bid); EpiGlu E{WP(bf16, WS_H)};
            pg8::gemm_phase<EpiGlu, pg8::StaticOrder>(F.lds, g, S, E, tid);
        }
        GRID_BAR();

        if (PH(8)) {
            WSL();
            pg8::Gemm g{WP(bf16, WS_H), WP(bf16, WS_WCAT), 1024, 1024, 1024}; pg8::StaticOrder S; S.init(M / 256, 4, G, bid); EpiMerge E{WP(bf16, WS_GATES), WP(bf16, WS_QK)};
            pg8::gemm_phase<EpiMerge, pg8::StaticOrder, false, true>(F.lds, g, S, E, tid);
        }
        GRID_BAR();

        if (PH(9)) {
            WSL();
            pg8::Gemm g{WP(bf16, WS_QK), WP(bf16, WS_WOUT), 1024, 1024, 1024}; pg8::StaticOrder S; S.init(M / 256, 4, G, bid); EpiRes E{xcur, XO};
            pg8::gemm_phase<EpiRes, pg8::StaticOrder>(F.lds, g, S, E, tid);
        }
        xcur = XO;
        GRID_BAR();

        if (PH(10)) {
            WSL();
            {
            unsigned* cnt = WP(unsigned, WS_CTL) + CW_CNT + l * NBUCKET * 64;
            bf16* H = WP(bf16, WS_H); const float* gn = IN(I_NFFN) + l * 1024; const float* wrt = WP(float, WS_WRT) + (size_t)l * 20480; const float* bco = IN(I_BCO) + l * 4; const float* bfi = IN(I_BFI) + l * 16;
            int* LIST = WP(int, WS_LIST); float* WTS = WP(float, WS_WTS);
            for (int grp = gw; grp < M / 4; grp += NGW) norm_rows4<true>(XO, gn, H, grp * 4, lane, wrt, bco, bfi, cnt, LIST, WTS);
            }
            bf16* WGU = WP(bf16, WS_WGU); bf16* WDP = WP(bf16, WS_WDP);
            for (int it = gw; it < 10240; it += NGW) {
                int r = it;
                if (r < 2048) { const int e = r >> 7; transpose_job_item(IN(I_WG) + (size_t)(l * 16 + e) * 1024 * 256, 256, 256, r & 127, WGU + (size_t)e * 512 * 1024, 1024, 0, 0, 2, 0, 0, SCR(), lane); continue; } r -= 2048;
                if (r < 2048) { const int e = r >> 7; transpose_job_item(IN(I_WU) + (size_t)(l * 16 + e) * 1024 * 256, 256, 256, r & 127, WGU + (size_t)e * 512 * 1024, 1024, 0, 0, 2, 1, 0, SCR(), lane); continue; } r -= 2048;
                const int ej = r >> 7, e = ej / 3, jj = ej % 3, i = e & 3, grpI = e >> 2, o = jj + (jj >= i ? 1 : 0), a = i < o ? i : o, b = i < o ? o : i;
                const int pair = grpI * 6 + (a == 0 ? b - 1 : (a == 1 ? b + 1 : 5)), slot = (i == a) ? 0 : 1;
                transpose_job_item(IN(I_WD) + (size_t)(l * 16 + e) * 256 * 1024, 1024, 1024, r & 127, WDP + (size_t)pair * 1024 * 512, 512, slot * 256, 0, 1, 0, 0, SCR(), lane);
            }
        }
        GRID_BAR();

        LAS int* tab = (LAS int*)(F.lds + TAB_OFF);
        if (PH(11)) {
            WSL();
            unsigned* cnt = WP(unsigned, WS_CTL) + CW_CNT + l * NBUCKET * 64;
            if (tid == 0) { int st = 0;
                for (int b = 0; b < NBUCKET; ++b) { const int c = (int)__hip_atomic_load(cnt + b * 64, __ATOMIC_RELAXED, __HIP_MEMORY_SCOPE_AGENT); tab[b] = c; tab[32 + b] = st; st += (c + 255) >> 8; }
                tab[32 + NBUCKET] = st; tab[64] = st; }
            __syncthreads();
            pg8::Gemm g{WP(bf16, WS_H), WP(bf16, WS_WGU), 1024, 1024, 1024}; pg8::MoeOrder S{tab, WP(int, WS_LIST), G, bid, 0}; EpiMoe1 E{WP(bf16, WS_ACT), WP(float, WS_WTS)};
            pg8::gemm_phase<EpiMoe1, pg8::MoeOrder, true>(F.lds, g, S, E, tid);
        }
        GRID_BAR();

        if (PH(12)) {
            WSL();
            pg8::Gemm g{WP(bf16, WS_ACT), WP(bf16, WS_WDP), 512, 512, 512}; pg8::MoeOrder S{tab, WP(int, WS_LIST), G, bid, 1}; EpiMoe2 E{XO, WP(int, WS_LIST)};
            pg8::gemm_phase<EpiMoe2, pg8::MoeOrder>(F.lds, g, S, E, tid);
        }
        GRID_BAR();
    }
    { WSL(); (void)wsl; const float* gn = IN(I_FNORM);
      for (int row = gw; row < M; row += NGW) final_norm_row(XO, gn, row, lane); }
#undef GRID_BAR
}

extern "C" void kernel_launch(void* const* d_in, const int* in_sizes, int n_in, void* d_out, int out_size, void* d_ws, size_t ws_size, hipStream_t stream) {
    static int grid = 0;
    if (grid == 0) {
        if (n_in != 30 || out_size != M * D || ws_size < WS_END) { fprintf(stderr, "kernel_launch: unexpected shapes (n_in %d, out %d, ws %zu)\n", n_in, out_size, ws_size); grid = -1; return; }
        int dev = 0, cus = 0, per_cu = 0;
        if (hipGetDevice(&dev) != hipSuccess || hipDeviceGetAttribute(&cus, hipDeviceAttributeMultiprocessorCount, dev) != hipSuccess) { grid = -1; return; }
        if (hipFuncSetAttribute((const void*)fwd_kernel, hipFuncAttributeMaxDynamicSharedMemorySize, LDS_BYTES) != hipSuccess) { fprintf(stderr, "kernel_launch: hipFuncSetAttribute failed\n"); grid = -1; return; }
        if (hipOccupancyMaxActiveBlocksPerMultiprocessor(&per_cu, (const void*)fwd_kernel, NWAVES * 64, LDS_BYTES) != hipSuccess || per_cu < 1) { fprintf(stderr, "kernel_launch: occupancy query reports %d\n", per_cu); }
        (void)hipGetLastError();
        grid = cus;
    }
    if (grid < 0) return;
    (void)in_sizes;
    hipMemsetAsync((char*)d_ws + WS_CTL, 0, CTL_BYTES, stream);
    Args a{};
    for (int i = 0; i < 30; ++i) a.in[i] = (const float*)d_in[i];
    a.out = (float*)d_out; a.ws = (unsigned char*)d_ws;
    hipLaunchKernelGGL(fwd_kernel, dim3(grid), dim3(NWAVES * 64), LDS_BYTES, stream, a);
}
```

```cpp
#include <hip/hip_runtime.h>
#include <cstdio>
#include <cstdint>

#define LAS __attribute__((address_space(3)))
typedef unsigned short bf16;
typedef short bf16x8 __attribute__((ext_vector_type(8)));
typedef float f32x4 __attribute__((ext_vector_type(4)));
typedef float f32x2 __attribute__((ext_vector_type(2)));
typedef unsigned u32x4 __attribute__((ext_vector_type(4)));
typedef unsigned u32x2 __attribute__((ext_vector_type(2)));

constexpr int D = 1024, BATCH = 4, SEQ = 8192, M = BATCH * SEQ, DEPTH = 4;
constexpr int INC = 5120, NMEM = 256;
constexpr int NCHUNK = 256, TCH = 32;
constexpr int ATK = 768;
constexpr int LCAP = 32768;
constexpr int NBUCKET = 24;
constexpr float RMS_EPS = 1e-6f;

constexpr size_t MiB = 1u << 20;
constexpr size_t WS_CTL = 0, CTL_BYTES = 1 * MiB;
constexpr size_t WS_APOW = 1 * MiB;
constexpr size_t WS_BBAR = 4 * MiB;
constexpr size_t WS_KT = 5 * MiB;
constexpr size_t WS_WRT = 10 * MiB;
constexpr size_t WS_MEMN = 11 * MiB;
constexpr size_t WS_WMKV = 19 * MiB;
constexpr size_t WS_KM = 23 * MiB;
constexpr size_t WS_VM8 = 25 * MiB;
constexpr size_t WS_WIN = 27 * MiB;
constexpr size_t WS_WCAT = 37 * MiB;
constexpr size_t WS_WOUT = 39 * MiB;
constexpr size_t WS_WGLU = 41 * MiB;
constexpr size_t WS_S5W = 42 * MiB;
constexpr size_t WS_S5KV = 46 * MiB;
constexpr size_t WS_H = 58 * MiB;
constexpr size_t WS_QK = 122 * MiB;
constexpr size_t WS_VT8 = 186 * MiB;
constexpr size_t WS_AT = 218 * MiB;
constexpr size_t WS_QX = 242 * MiB;
constexpr size_t WS_ST = 258 * MiB;
constexpr size_t WS_Y = 274 * MiB;
constexpr size_t WS_GATES = 290 * MiB;
constexpr size_t WS_WGU = WS_GATES;
constexpr size_t WS_WDP = WS_GATES + 16 * MiB;
constexpr size_t WS_ACT = WS_GATES + 40 * MiB;
constexpr size_t WS_LIST = 482 * MiB;
constexpr size_t WS_WTS = 485 * MiB;
constexpr size_t WS_END = 491 * MiB;
constexpr int CW_BAR = 4096;
constexpr int CW_CNT = 16384;

__device__ __forceinline__ unsigned cvt_pk_bf16(float lo, float hi) { unsigned r; asm volatile("v_cvt_pk_bf16_f32 %0, %1, %2" : "=v"(r) : "v"(lo), "v"(hi)); return r; }
__device__ __forceinline__ float bf2f(unsigned short b) { return __uint_as_float(((unsigned)b) << 16); }
__device__ __forceinline__ float bflo(unsigned w) { return __uint_as_float(w << 16); }
__device__ __forceinline__ float bfhi(unsigned w) { return __uint_as_float(w & 0xffff0000u); }
__device__ __forceinline__ float fast_rcp(float x) { return __builtin_amdgcn_rcpf(x); }
__device__ __forceinline__ float fast_exp(float x) { return __builtin_amdgcn_exp2f(x * 1.4426950408889634f); }
__device__ __forceinline__ float sigmoid_f(float x) { return fast_rcp(1.0f + fast_exp(-x)); }
__device__ __forceinline__ float gelu_tanh_f(float x) { const float u = 1.5957691216057308f * (x + 0.044715f * x * x * x); return x * fast_rcp(1.0f + fast_exp(-u)); }
__device__ __forceinline__ float shfl_xor_f(float v, int o, int lane) { return __int_as_float(__builtin_amdgcn_ds_bpermute((lane ^ o) << 2, __float_as_int(v))); }
__device__ __forceinline__ float shfl_idx_f(float v, int src) { return __int_as_float(__builtin_amdgcn_ds_bpermute(src << 2, __float_as_int(v))); }
__device__ __forceinline__ float wave_sum(float v, int lane) {
#pragma unroll
    for (int o = 1; o < 64; o <<= 1) v += shfl_xor_f(v, o, lane);
    return v;
}
#define LDS_WAIT() asm volatile("s_waitcnt lgkmcnt(0)" ::: "memory")
#define VM_WAIT() asm volatile("s_waitcnt vmcnt(0)" ::: "memory")

namespace pg8 {
constexpr int BM = 256, BK = 64, HALF = 128, HTB = HALF * BK * 2, STAGE_BYTES = 8 * HTB, NXCD = 8, WGM = 8;
__host__ __device__ __forceinline__ int lds_byte(int r, int c) { const int st = (r >> 4) * 2 + (c >> 5), rr = r & 15, cc = c & 31, ob = rr * 64 + cc * 2; return st * 1024 + (ob ^ (((ob >> 9) & 1) << 5)); }
__host__ __device__ __forceinline__ void stage_rc(int b, int& R, int& C) { const int st = b / 1024, sb = b % 1024, swz = sb ^ (((sb >> 9) & 1) << 5); R = (st >> 1) * 16 + swz / 64; C = (st & 1) * 32 + (swz % 64) / 2; }
__host__ __device__ __forceinline__ int perm32(int rho) { const int n = rho >> 4, i = rho & 15; return 8 * (i >> 2) + 4 * n + (i & 3); }

struct Unit { int pm, pn, am, bn, x0, x1, x2; };
struct Gemm { const bf16* A; const bf16* Bt; int lda, ldb, K; };

struct StaticOrder {
    int nM, nN, nwg, G, c;
    __device__ void init(int nM_, int nN_, int G_, int c_) { nM = nM_; nN = nN_; nwg = nM * nN; G = G_; c = c_; }
    __device__ bool next(int i, Unit& u) const {
        const long L = (long)i * G + c; if (L >= nwg) return false;
        int wgid = (int)L; { const int q = nwg / NXCD, r = nwg % NXCD, xcd = wgid % NXCD, off = wgid / NXCD; wgid = (xcd < r ? xcd * (q + 1) : r * (q + 1) + (xcd - r) * q) + off; }
        const int nig = WGM * nN, gid = wgid / nig, fm = gid * WGM, gsz = (nM - fm) < WGM ? (nM - fm) : WGM;
        u.pm = __builtin_amdgcn_readfirstlane(fm + ((wgid % nig) % gsz)); u.pn = __builtin_amdgcn_readfirstlane((wgid % nig) / gsz);
        u.am = u.pm; u.bn = u.pn; u.x0 = 0; u.x1 = 0; u.x2 = 0; return true;
    }
    __device__ __forceinline__ int a_row(const Unit&, int) const { return 0; }
};
struct S5Order : StaticOrder {
    __device__ bool next(int i, Unit& u) const { if (!StaticOrder::next(i, u)) return false; u.bn = (u.pm & 15) * nN + u.pn; return true; }
};
struct MemOrder {
    int G, c;
    __device__ bool next(int i, Unit& u) const { const int L = i * G + c; if (L >= 32) return false; u.pm = L >> 1; u.pn = L & 1; u.am = u.pm; u.bn = (u.pm >> 2) * 2 + u.pn; u.x0 = 0; u.x1 = 0; u.x2 = 0; return true; }
    __device__ __forceinline__ int a_row(const Unit&, int) const { return 0; }
};
struct MoeOrder {
    const LAS int* tab; const int* list; int G, c, mode;
    __device__ bool next(int i, Unit& u) const {
        const int T = __builtin_amdgcn_readfirstlane(tab[64]); const int L = i * G + c; if (L >= T * 4) return false;
        const int tile = L >> 2, pn = L & 3; int b = 0;
#pragma unroll 1
        for (int j = 1; j < NBUCKET; ++j) if (__builtin_amdgcn_readfirstlane(tab[32 + j]) <= tile) b = j;
        u.pm = tile; u.pn = pn; u.am = tile; u.x0 = b; u.x1 = (tile - __builtin_amdgcn_readfirstlane(tab[32 + b])) * 256; u.x2 = __builtin_amdgcn_readfirstlane(tab[b]);
        const int grp = __builtin_amdgcn_readfirstlane(b / 6), pi = __builtin_amdgcn_readfirstlane(b % 6); const int ea = pi < 3 ? 0 : (pi < 5 ? 1 : 2), eb = pi < 3 ? pi + 1 : (pi < 5 ? pi - 1 : 3);
        if (mode == 0) { const int e = grp * 4 + ((pn >> 1) ? eb : ea); u.bn = e * 2 + (pn & 1); } else u.bn = b * 4 + pn;
        return true;
    }
    __device__ __forceinline__ int a_row(const Unit& u, int r) const { const int slot = u.x1 + r; return slot < u.x2 ? list[u.x0 * LCAP + slot] : 0; }
};

template <class Epi, class Sched, bool GATHER = false, bool KHOOK = false>
__device__ __forceinline__ void gemm_phase(LAS unsigned char* lds, const Gemm g, const Sched& S, const Epi& E, int tid_in) {
    int tid = tid_in; asm volatile("" : "+v"(tid));
    const int wid = __builtin_amdgcn_readfirstlane(tid >> 6), lane = tid & 63, wr = wid >> 2, wc = wid & 3, fr = lane & 15, fq = lane >> 4;
    int K = g.K, lda = g.lda, ldb = g.ldb;
    asm volatile("" : "+s"(K), "+s"(lda), "+s"(ldb));
    const int nt = K / BK;
    unsigned voffA[2], voffB[2]; int Rr[2], Cc[2];
#pragma unroll
    for (int i = 0; i < 2; ++i) { int R, C; stage_rc(tid * 16 + i * 8192, R, C); const int Rb = Epi::PERM ? ((R & ~31) + perm32(R & 31)) : R;
        voffA[i] = (unsigned)(R * lda + C) * 2u; voffB[i] = (unsigned)(Rb * ldb + C) * 2u; Rr[i] = R; Cc[i] = C; }
    const size_t kstep = (size_t)(BK * 2);
    const size_t hstepA = (size_t)HALF * lda * 2, tstepA = 2 * hstepA, hstepB = (size_t)HALF * ldb * 2, tstepB = 2 * hstepB;
    const unsigned ldsw = (unsigned)wid * 1024u;
    const int aoff = lds_byte(wr * 64 + fr, fq * 8), boff = lds_byte(wc * 32 + fr, fq * 8);
    unsigned vC[2][2] = {{0u, 0u}, {0u, 0u}}, vN[2][2] = {{0u, 0u}, {0u, 0u}};
#define PG8_SA(b, h) (((b) * 2 + (h)) * HTB)
#define PG8_SB(b, h) ((4 + (b) * 2 + (h)) * HTB)
#define PG8_STAGE(bufoff, gbase, voff) do { _Pragma("unroll") for (int _i = 0; _i < 2; ++_i) \
        __builtin_amdgcn_global_load_lds((const unsigned*)((const char*)(gbase) + (voff)[_i]), (LAS unsigned*)(lds + (bufoff) + ldsw + _i * 8192), 16, 0, 0); } while (0)
#define PG8_STA(bufoff, ptr, h, nx) do { if constexpr (GATHER) { unsigned _v[2]; _v[0] = (nx) ? vN[h][0] : vC[h][0]; _v[1] = (nx) ? vN[h][1] : vC[h][1]; PG8_STAGE(bufoff, ptr, _v); } \
        else { PG8_STAGE(bufoff, (ptr) + (h) * hstepA, voffA); } } while (0)
#define PG8_STB(bufoff, ptr, h) PG8_STAGE(bufoff, (ptr) + (h) * hstepB, voffB)
#define PG8_LDA(dst, b, h) do { _Pragma("unroll") for (int m = 0; m < 4; ++m) _Pragma("unroll") for (int k = 0; k < 2; ++k) dst[m][k] = *(const LAS bf16x8*)(lds + PG8_SA(b, h) + aoff + m * 2048 + k * 1024); } while (0)
#define PG8_LDB(dst, b, h) do { _Pragma("unroll") for (int n = 0; n < 2; ++n) _Pragma("unroll") for (int k = 0; k < 2; ++k) dst[n][k] = *(const LAS bf16x8*)(lds + PG8_SB(b, h) + boff + n * 2048 + k * 1024); } while (0)
#define PG8_MMA(ai, bj, At, Bt) do { __builtin_amdgcn_s_setprio(1); _Pragma("unroll") for (int m = 0; m < 4; ++m) _Pragma("unroll") for (int n = 0; n < 2; ++n) _Pragma("unroll") for (int k = 0; k < 2; ++k) \
        acc[ai][bj][m][n] = __builtin_amdgcn_mfma_f32_16x16x32_bf16(Bt[n][k], At[m][k], acc[ai][bj][m][n], 0, 0, 0); __builtin_amdgcn_s_setprio(0); } while (0)
#define PG8_WAIT_V(n) asm volatile("s_waitcnt vmcnt(" #n ")" ::: "memory")
#define PG8_WAIT_L(n) asm volatile("s_waitcnt lgkmcnt(" #n ")" ::: "memory")
#define PG8_BAR __builtin_amdgcn_s_barrier()
#define PG8_SCHED __builtin_amdgcn_sched_barrier(0)
    Unit cur, nxt; int ui = 0;
    if (!S.next(0, cur)) return;
    f32x4 acc[2][2][4][2];
#pragma unroll
    for (int a = 0; a < 2; ++a)
#pragma unroll
        for (int b = 0; b < 2; ++b)
#pragma unroll
            for (int m = 0; m < 4; ++m)
#pragma unroll
                for (int n = 0; n < 2; ++n) acc[a][b][m][n] = (f32x4){0.f, 0.f, 0.f, 0.f};
    bf16x8 At[4][2], B0[2][2], B1[2][2];
    const char* cA = GATHER ? (const char*)g.A : (const char*)g.A + (size_t)cur.am * tstepA;
    const char* cB = (const char*)g.Bt + (size_t)cur.bn * tstepB;
    if constexpr (GATHER) {
#pragma unroll
        for (int h = 0; h < 2; ++h)
#pragma unroll
            for (int i = 0; i < 2; ++i) vC[h][i] = (unsigned)(S.a_row(cur, h * HALF + Rr[i]) * lda + Cc[i]) * 2u;
    }
    PG8_STB(PG8_SB(0, 0), cB, 0); PG8_STB(PG8_SB(0, 1), cB, 1); PG8_STA(PG8_SA(0, 0), cA, 0, false); PG8_STA(PG8_SA(0, 1), cA, 1, false);
    if (wr == 1) PG8_BAR;
    PG8_WAIT_V(2); PG8_BAR;
    PG8_STB(PG8_SB(1, 0), cB + kstep, 0); PG8_STA(PG8_SA(1, 0), cA + kstep, 0, false); PG8_STB(PG8_SB(1, 1), cB + kstep, 1);
    PG8_WAIT_V(6); PG8_BAR;
    for (;;) {
        const bool has_next = S.next(ui + 1, nxt);
        const char* nA = GATHER ? (const char*)g.A : (has_next ? (const char*)g.A + (size_t)nxt.am * tstepA : cA);
        const char* nB = has_next ? (const char*)g.Bt + (size_t)nxt.bn * tstepB : cB;
        if constexpr (GATHER) {
#pragma unroll
            for (int h = 0; h < 2; ++h)
#pragma unroll
                for (int i = 0; i < 2; ++i) vN[h][i] = has_next ? (unsigned)(S.a_row(nxt, h * HALF + Rr[i]) * lda + Cc[i]) * 2u : vC[h][i];
        }
        int tb = 0;
#pragma unroll 1
        for (int seg = 0; seg < (KHOOK ? 3 : 1); ++seg) {
        const int te = KHOOK ? (seg == 0 ? 8 : (seg == 1 ? 12 : nt)) : nt;
        for (int t = tb; t < te; t += 2) {
            const bool last = (t == nt - 2);
            const char* a1 = cA + (size_t)(t + 1) * kstep;
            const char* a2 = last ? nA : cA + (size_t)(t + 2) * kstep; const char* b2 = last ? nB : cB + (size_t)(t + 2) * kstep;
            const char* a3 = a2 + kstep; const char* b3 = b2 + kstep;
            PG8_LDB(B0, 0, 0); PG8_LDB(B1, 0, 1); PG8_SCHED; PG8_LDA(At, 0, 0); PG8_STA(PG8_SA(1, 1), a1, 1, false);
            PG8_WAIT_V(8); PG8_WAIT_L(0); PG8_BAR; PG8_MMA(0, 0, At, B0); PG8_MMA(0, 1, At, B1); PG8_BAR; PG8_SCHED;
            PG8_LDA(At, 0, 1); PG8_STB(PG8_SB(0, 0), b2, 0); PG8_STB(PG8_SB(0, 1), b2, 1); PG8_STA(PG8_SA(0, 0), a2, 0, last);
            PG8_WAIT_V(8); PG8_WAIT_L(0); PG8_BAR; PG8_MMA(1, 0, At, B0); PG8_MMA(1, 1, At, B1); PG8_BAR; PG8_SCHED;
            PG8_LDB(B0, 1, 0); PG8_LDB(B1, 1, 1); PG8_SCHED; PG8_LDA(At, 1, 0); PG8_STA(PG8_SA(0, 1), a2, 1, last);
            PG8_WAIT_V(8); PG8_WAIT_L(0); PG8_BAR; PG8_MMA(0, 0, At, B0); PG8_MMA(0, 1, At, B1); PG8_BAR; PG8_SCHED;
            PG8_LDA(At, 1, 1); PG8_STB(PG8_SB(1, 0), b3, 0); PG8_STB(PG8_SB(1, 1), b3, 1); PG8_STA(PG8_SA(1, 0), a3, 0, last);
            PG8_WAIT_V(8); PG8_WAIT_L(0); PG8_BAR; PG8_MMA(1, 0, At, B0); PG8_MMA(1, 1, At, B1); PG8_BAR; PG8_SCHED;
        }
        if constexpr (KHOOK) { if (seg < 2) { int fr_ = fr, fq_ = fq; asm volatile("" : "+v"(fr_), "+v"(fq_)); E.khook(acc, cur, te, wr, wc, fr_, fq_); } }
        tb = te;
        }
        if (wr == 0) PG8_BAR;
        { int fr_ = fr, fq_ = fq; asm volatile("" : "+v"(fr_), "+v"(fq_)); E(acc, cur, wr, wc, fr_, fq_); }
        if (!has_next) break;
#pragma unroll
        for (int a = 0; a < 2; ++a)
#pragma unroll
            for (int b = 0; b < 2; ++b)
#pragma unroll
                for (int m = 0; m < 4; ++m)
#pragma unroll
                    for (int n = 0; n < 2; ++n) acc[a][b][m][n] = (f32x4){0.f, 0.f, 0.f, 0.f};
        cur = nxt; cA = nA; cB = nB; ++ui;
        if constexpr (GATHER) {
#pragma unroll
            for (int h = 0; h < 2; ++h)
#pragma unroll
                for (int i = 0; i < 2; ++i) vC[h][i] = vN[h][i];
        }
        if (wr == 1) PG8_BAR;
    }
    PG8_WAIT_V(0);
    PG8_BAR;
#undef PG8_SA
#undef PG8_SB
#undef PG8_STAGE
#undef PG8_STA
#undef PG8_STB
#undef PG8_LDA
#undef PG8_LDB
#undef PG8_MMA
#undef PG8_WAIT_V
#undef PG8_WAIT_L
#undef PG8_BAR
#undef PG8_SCHED
}
}

using pg8::Unit;
struct EpiProj {
    static constexpr bool PERM = true;
    bf16 *QK, *Vt8, *At, *QX, *GATES; const float* bgate;
#define EP_LOOP_BEGIN _Pragma("unroll") for (int ai = 0; ai < 2; ++ai) _Pragma("unroll") for (int m = 0; m < 4; ++m) { const int row = row0 + ai * 128 + m * 16; _Pragma("unroll") for (int bj = 0; bj < 2; ++bj) { \
        const f32x4 v0 = acc[ai][bj][m][0], v1 = acc[ai][bj][m][1]; const int cl = cl0 + bj * 128;
#define EP_LOOP_END } asm volatile("" ::: "memory"); }
    __device__ __forceinline__ void operator()(const f32x4 (&acc)[2][2][4][2], const Unit& u, int wr, int wc, int fr, int fq) const {
        const int pn = u.pn, row0 = u.pm * 256 + wr * 64 + fr, cl0 = wc * 32 + 8 * fq;
        if (pn < 4) {
            EP_LOOP_BEGIN
                u32x4 w; w.x = cvt_pk_bf16(v0[0], v0[1]); w.y = cvt_pk_bf16(v0[2], v0[3]); w.z = cvt_pk_bf16(v1[0], v1[1]); w.w = cvt_pk_bf16(v1[2], v1[3]);
                *(u32x4*)(QK + (unsigned)row * 1024 + pn * 256 + cl) = w;
            EP_LOOP_END
        } else if (pn < 6) {
            EP_LOOP_BEGIN
                const int vc = (pn - 4) * 256 + cl, hh = vc >> 6, dh = vc & 63, b = row >> 13, s = row & 8191;
                bf16* p = Vt8 + ((unsigned)((b * 8 + hh) * 1024 + (s >> 3)) * 64 + dh) * 8 + (s & 7);
                const unsigned w0 = cvt_pk_bf16(v0[0], v0[1]), w1 = cvt_pk_bf16(v0[2], v0[3]), w2 = cvt_pk_bf16(v1[0], v1[1]), w3 = cvt_pk_bf16(v1[2], v1[3]);
                p[0] = (bf16)w0; p[8] = (bf16)(w0 >> 16); p[16] = (bf16)w1; p[24] = (bf16)(w1 >> 16); p[32] = (bf16)w2; p[40] = (bf16)(w2 >> 16); p[48] = (bf16)w3; p[56] = (bf16)(w3 >> 16);
            EP_LOOP_END
        } else if (pn == 6) {
            EP_LOOP_BEGIN
                const int g = cl >> 4, c0 = cl & 15, b = row >> 13, s = row & 8191;
                u32x4 w; w.x = cvt_pk_bf16(v0[0], v0[1]); w.y = cvt_pk_bf16(v0[2], v0[3]); w.z = cvt_pk_bf16(v1[0], v1[1]); w.w = cvt_pk_bf16(v1[2], v1[3]);
                *(u32x4*)(At + ((unsigned)((b * 16 + g) * 256 + (s >> 5))) * ATK + (s & 31) * 16 + c0) = w;
            EP_LOOP_END
        } else if (pn == 7) {
            EP_LOOP_BEGIN
                u32x4 w; w.x = cvt_pk_bf16(v0[0], v0[1]); w.y = cvt_pk_bf16(v0[2], v0[3]); w.z = cvt_pk_bf16(v1[0], v1[1]); w.w = cvt_pk_bf16(v1[2], v1[3]);
                *(u32x4*)(QX + (unsigned)row * 256 + cl) = w;
            EP_LOOP_END
        } else {
            EP_LOOP_BEGIN
                const int gc = (pn - 8) * 256 + cl;
                const f32x4 b0 = *(const f32x4*)(bgate + gc), b1 = *(const f32x4*)(bgate + gc + 4);
                u32x4 w; w.x = cvt_pk_bf16(sigmoid_f(v0[0] + b0[0]), sigmoid_f(v0[1] + b0[1])); w.y = cvt_pk_bf16(sigmoid_f(v0[2] + b0[2]), sigmoid_f(v0[3] + b0[3]));
                w.z = cvt_pk_bf16(sigmoid_f(v1[0] + b1[0]), sigmoid_f(v1[1] + b1[1])); w.w = cvt_pk_bf16(sigmoid_f(v1[2] + b1[2]), sigmoid_f(v1[3] + b1[3]));
                *(u32x4*)(GATES + (unsigned)row * 3072 + gc) = w;
            EP_LOOP_END
        }
    }
#undef EP_LOOP_BEGIN
#undef EP_LOOP_END
};
struct EpiMemKV {
    static constexpr bool PERM = true;
    bf16 *Km, *Vm8;
    __device__ __forceinline__ void operator()(const f32x4 (&acc)[2][2][4][2], const Unit& u, int wr, int wc, int fr, int fq) const {
        const int row0 = u.pm * 256 + wr * 64 + fr, cl0 = wc * 32 + 8 * fq;
#pragma unroll
        for (int ai = 0; ai < 2; ++ai)
#pragma unroll
            for (int m = 0; m < 4; ++m) {
                const int row = row0 + ai * 128 + m * 16;
#pragma unroll
                for (int bj = 0; bj < 2; ++bj) {
                    const f32x4 v0 = acc[ai][bj][m][0], v1 = acc[ai][bj][m][1];
                    const int cl = cl0 + bj * 128;
                    const unsigned w0 = cvt_pk_bf16(v0[0], v0[1]), w1 = cvt_pk_bf16(v0[2], v0[3]), w2 = cvt_pk_bf16(v1[0], v1[1]), w3 = cvt_pk_bf16(v1[2], v1[3]);
                    if (u.pn == 0) { u32x4 w; w.x = w0; w.y = w1; w.z = w2; w.w = w3; *(u32x4*)(Km + (unsigned)row * 256 + cl) = w; }
                    else {
                        const int hh = cl >> 6, dh = cl & 63, lb = row >> 8, mm = row & 255;
                        bf16* p = Vm8 + ((unsigned)((lb * 4 + hh) * 32 + (mm >> 3)) * 64 + dh) * 8 + (mm & 7);
                        p[0] = (bf16)w0; p[8] = (bf16)(w0 >> 16); p[16] = (bf16)w1; p[24] = (bf16)(w1 >> 16); p[32] = (bf16)w2; p[40] = (bf16)(w2 >> 16); p[48] = (bf16)w3; p[56] = (bf16)(w3 >> 16);
                    }
                }
                asm volatile("" ::: "memory");
            }
    }
};
struct EpiS5a {
    static constexpr bool PERM = false;
    float* ST;
    __device__ __forceinline__ void operator()(const f32x4 (&acc)[2][2][4][2], const Unit& u, int wr, int wc, int fr, int fq) const {
        const int row0 = u.am * 256 + wr * 64 + fr, col0 = wc * 32 + 4 * fq;
#pragma unroll
        for (int ai = 0; ai < 2; ++ai)
#pragma unroll
            for (int m = 0; m < 4; ++m) { float* rowp = ST + (unsigned)(row0 + ai * 128 + m * 16) * 256 + col0;
#pragma unroll
                for (int bj = 0; bj < 2; ++bj)
#pragma unroll
                    for (int n = 0; n < 2; ++n) *(f32x4*)(rowp + bj * 128 + n * 16) = acc[ai][bj][m][n];
                asm volatile("" ::: "memory"); }
    }
};
struct EpiS5c {
    static constexpr bool PERM = true;
    bf16* Y;
    __device__ __forceinline__ void operator()(const f32x4 (&acc)[2][2][4][2], const Unit& u, int wr, int wc, int fr, int fq) const {
        const int b = u.am >> 4, g = u.am & 15, r0 = wr * 64 + fr, cl0 = u.pn * 256 + wc * 32 + 8 * fq;
#pragma unroll
        for (int ai = 0; ai < 2; ++ai)
#pragma unroll
            for (int m = 0; m < 4; ++m) {
                const int chunk = r0 + ai * 128 + m * 16;
#pragma unroll
                for (int bj = 0; bj < 2; ++bj) {
                    const f32x4 v0 = acc[ai][bj][m][0], v1 = acc[ai][bj][m][1];
                    const int col = cl0 + bj * 128, t = col >> 4, c0 = col & 15;
                    u32x4 w; w.x = cvt_pk_bf16(gelu_tanh_f(v0[0]), gelu_tanh_f(v0[1])); w.y = cvt_pk_bf16(gelu_tanh_f(v0[2]), gelu_tanh_f(v0[3]));
                    w.z = cvt_pk_bf16(gelu_tanh_f(v1[0]), gelu_tanh_f(v1[1])); w.w = cvt_pk_bf16(gelu_tanh_f(v1[2]), gelu_tanh_f(v1[3]));
                    *(u32x4*)(Y + (unsigned)(b * SEQ + chunk * 32 + t) * 256 + g * 16 + c0) = w;
                }
                asm volatile("" ::: "memory");
            }
    }
};
struct EpiGlu {
    static constexpr bool PERM = true;
    bf16* CAT;
    __device__ __forceinline__ void operator()(const f32x4 (&acc)[2][2][4][2], const Unit& u, int wr, int wc, int fr, int fq) const {
        const int row0 = u.pm * 256 + wr * 64 + fr, cl0 = u.pn * 256 + wc * 32 + 8 * fq;
#pragma unroll
        for (int ai = 0; ai < 2; ++ai)
#pragma unroll
            for (int m = 0; m < 4; ++m) {
                const int row = row0 + ai * 128 + m * 16;
#pragma unroll
                for (int bj = 0; bj < 2; ++bj) {
                    const f32x4 v0 = acc[ai][bj][m][0], v1 = acc[ai][bj][m][1];
                    const int col = cl0 + bj * 128;
                    u32x2 w; w.x = cvt_pk_bf16(v0[0] * sigmoid_f(v0[1]), v0[2] * sigmoid_f(v0[3])); w.y = cvt_pk_bf16(v1[0] * sigmoid_f(v1[1]), v1[2] * sigmoid_f(v1[3]));
                    *(u32x2*)(CAT + (unsigned)row * 1024 + 512 + (col >> 1)) = w;
                }
                asm volatile("" ::: "memory");
            }
    }
};
struct EpiMerge {
    static constexpr bool PERM = true;
    const bf16* GATES; bf16* MG;
    __device__ __forceinline__ void khook(f32x4 (&acc)[2][2][4][2], const Unit& u, int t, int wr, int wc, int fr, int fq) const {
        const int row0 = u.pm * 256 + wr * 64 + fr, cl0 = u.pn * 256 + wc * 32 + 8 * fq;
        const int ga = (t == 8) ? 0 : 1024;
#pragma unroll
        for (int ai = 0; ai < 2; ++ai)
#pragma unroll
            for (int m = 0; m < 4; ++m) {
                const int row = row0 + ai * 128 + m * 16;
#pragma unroll
                for (int bj = 0; bj < 2; ++bj) {
                    const bf16* gp = GATES + (unsigned)row * 3072 + ga + cl0 + bj * 128;
                    const u32x4 na = *(const u32x4*)gp, nb = *(const u32x4*)(gp + 1024);
                    f32x4 r0, r1;
                    r0[0] = bflo(na.x) * fast_rcp(bflo(nb.x)); r0[1] = bfhi(na.x) * fast_rcp(bfhi(nb.x)); r0[2] = bflo(na.y) * fast_rcp(bflo(nb.y)); r0[3] = bfhi(na.y) * fast_rcp(bfhi(nb.y));
                    r1[0] = bflo(na.z) * fast_rcp(bflo(nb.z)); r1[1] = bfhi(na.z) * fast_rcp(bfhi(nb.z)); r1[2] = bflo(na.w) * fast_rcp(bflo(nb.w)); r1[3] = bfhi(na.w) * fast_rcp(bfhi(nb.w));
                    acc[ai][bj][m][0] *= r0; acc[ai][bj][m][1] *= r1;
                }
                asm volatile("" ::: "memory");
            }
    }
    __device__ __forceinline__ void operator()(const f32x4 (&acc)[2][2][4][2], const Unit& u, int wr, int wc, int fr, int fq) const {
        const int row0 = u.pm * 256 + wr * 64 + fr, cl0 = u.pn * 256 + wc * 32 + 8 * fq;
#pragma unroll
        for (int ai = 0; ai < 2; ++ai)
#pragma unroll
            for (int m = 0; m < 4; ++m) {
                const int row = row0 + ai * 128 + m * 16;
#pragma unroll
                for (int bj = 0; bj < 2; ++bj) {
                    const u32x4 g2 = *(const u32x4*)(GATES + (unsigned)row * 3072 + 2048 + cl0 + bj * 128);
                    const f32x4 v0 = acc[ai][bj][m][0], v1 = acc[ai][bj][m][1];
                    u32x4 w; w.x = cvt_pk_bf16(v0[0] * bflo(g2.x), v0[1] * bfhi(g2.x)); w.y = cvt_pk_bf16(v0[2] * bflo(g2.y), v0[3] * bfhi(g2.y));
                    w.z = cvt_pk_bf16(v1[0] * bflo(g2.z), v1[1] * bfhi(g2.z)); w.w = cvt_pk_bf16(v1[2] * bflo(g2.w), v1[3] * bfhi(g2.w));
                    *(u32x4*)(MG + (unsigned)row * 1024 + cl0 + bj * 128) = w;
                }
                asm volatile("" ::: "memory");
            }
    }
};
struct EpiRes {
    static constexpr bool PERM = false;
    const float* base; float* out;
    __device__ __forceinline__ void operator()(const f32x4 (&acc)[2][2][4][2], const Unit& u, int wr, int wc, int fr, int fq) const {
        const int row0 = u.pm * 256 + wr * 64 + fr, col0 = u.pn * 256 + wc * 32 + 4 * fq;
#pragma unroll
        for (int ai = 0; ai < 2; ++ai)
#pragma unroll
            for (int m = 0; m < 4; ++m) { const size_t off = (unsigned)(row0 + ai * 128 + m * 16) * 1024 + col0;
#pragma unroll
                for (int bj = 0; bj < 2; ++bj)
#pragma unroll
                    for (int n = 0; n < 2; ++n) { const f32x4 bs = *(const f32x4*)(base + off + bj * 128 + n * 16); *(f32x4*)(out + off + bj * 128 + n * 16) = bs + acc[ai][bj][m][n]; }
                asm volatile("" ::: "memory"); }
    }
};
struct EpiMoe1 {
    static constexpr bool PERM = true;
    bf16* ACT; const float* wts;
    __device__ __forceinline__ void operator()(const f32x4 (&acc)[2][2][4][2], const Unit& u, int wr, int wc, int fr, int fq) const {
        const int r0 = wr * 64 + fr, cl0 = wc * 32 + 8 * fq, es = u.pn >> 1;
#pragma unroll
        for (int ai = 0; ai < 2; ++ai)
#pragma unroll
            for (int m = 0; m < 4; ++m) {
                const int r = r0 + ai * 128 + m * 16, slot = u.x1 + r;
                const float w = slot < u.x2 ? wts[((unsigned)u.x0 * LCAP + slot) * 2 + es] : 0.f;
#pragma unroll
                for (int bj = 0; bj < 2; ++bj) {
                    const f32x4 v0 = acc[ai][bj][m][0], v1 = acc[ai][bj][m][1];
                    const int col = cl0 + bj * 128;
                    u32x2 o; o.x = cvt_pk_bf16(v0[0] * sigmoid_f(v0[0]) * v0[1] * w, v0[2] * sigmoid_f(v0[2]) * v0[3] * w); o.y = cvt_pk_bf16(v1[0] * sigmoid_f(v1[0]) * v1[1] * w, v1[2] * sigmoid_f(v1[2]) * v1[3] * w);
                    *(u32x2*)(ACT + (unsigned)(u.pm * 256 + r) * 512 + es * 256 + (u.pn & 1) * 128 + (col >> 1)) = o;
                }
                asm volatile("" ::: "memory");
            }
    }
};
struct EpiMoe2 {
    static constexpr bool PERM = false;
    float* X; const int* list;
    __device__ __forceinline__ void operator()(const f32x4 (&acc)[2][2][4][2], const Unit& u, int wr, int wc, int fr, int fq) const {
        const int r0 = wr * 64 + fr, col0 = u.pn * 256 + wc * 32 + 4 * fq;
#pragma unroll
        for (int ai = 0; ai < 2; ++ai)
#pragma unroll
            for (int m = 0; m < 4; ++m) {
                const int r = r0 + ai * 128 + m * 16, slot = u.x1 + r;
                if (slot < u.x2) {
                    const int tok = list[(unsigned)u.x0 * LCAP + slot];
                    float* xp = X + (unsigned)tok * 1024 + col0;
#pragma unroll
                    for (int bj = 0; bj < 2; ++bj)
#pragma unroll
                        for (int n = 0; n < 2; ++n) { const f32x4 bs = *(const f32x4*)(xp + bj * 128 + n * 16); *(f32x4*)(xp + bj * 128 + n * 16) = bs + acc[ai][bj][m][n]; }
                }
                asm volatile("" ::: "memory");
            }
    }
};

#define XB_TMO      128
#define XB_XCNT(j)  (256  + 64 * (j))
#define XB_XSUB(j)  (1280 + 64 * (j))
#define XB_XGEN(j)  (2304 + 64 * (j))
#define XB_TOP      3328
#define XB_TOPGEN   3392
#define XCD_BAR_WORDS 3456
#define XB_SPIN_CAP (1u << 18)
__device__ __forceinline__ unsigned xb_ld(unsigned* p)              { return __hip_atomic_load(p, __ATOMIC_RELAXED, __HIP_MEMORY_SCOPE_AGENT); }
__device__ __forceinline__ unsigned xb_add(unsigned* p, unsigned v) { return __hip_atomic_fetch_add(p, v, __ATOMIC_RELAXED, __HIP_MEMORY_SCOPE_AGENT); }
__device__ __forceinline__ unsigned xb_xcc_id() { return (unsigned)__builtin_amdgcn_s_getreg((3 << 11) | 20) & 0xFu; }
#define XB_SPIN(cond, bar) do { unsigned _sp = 0; while (cond) { __builtin_amdgcn_s_sleep(1); \
    if ((++_sp & 255u) == 0u) { if (xb_ld(&(bar)[XB_TMO])) break; if (_sp > XB_SPIN_CAP) { atomicAdd(&(bar)[XB_TMO], 1u); break; } } } } while (0)
struct XcdBarrier { unsigned* bar; unsigned x; volatile LAS unsigned* st; };
__device__ __forceinline__ XcdBarrier xcd_barrier_post(unsigned* bar, volatile LAS unsigned* st) {
    XcdBarrier b; b.bar = bar; b.x = xb_xcc_id(); b.st = st;
    if (threadIdx.x == 0) (void)xb_add(&bar[XB_XCNT(b.x)], 1u);
    return b;
}
__device__ __forceinline__ void xcd_barrier_complete(unsigned* bar, unsigned x, unsigned& nloc, unsigned& nx) {
    const unsigned G = gridDim.x * gridDim.y * gridDim.z;
    unsigned sum, cnt, mine, sp = 0u;
    for (;;) {
        sum = 0u; cnt = 0u; mine = 0u;
#pragma unroll
        for (unsigned j = 0; j < 16; ++j) { const unsigned c = xb_ld(&bar[XB_XCNT(j)]); sum += c; cnt += (c > 0u) ? 1u : 0u; mine = (j == x) ? c : mine; }
        if (sum == G) break;
        __builtin_amdgcn_s_sleep(1);
        if ((++sp & 255u) == 0u) { if (xb_ld(&bar[XB_TMO])) break; if (sp > XB_SPIN_CAP) { atomicAdd(&bar[XB_TMO], 1u); break; } }
    }
    nloc = mine > 0u ? mine : 1u; nx = cnt > 0u ? cnt : 1u;
}
__device__ __forceinline__ void xcd_barrier(const XcdBarrier& b) {
    asm volatile("s_waitcnt vmcnt(0)" ::: "memory");
    __syncthreads();
    if (threadIdx.x == 0) {
        unsigned* bar = b.bar;
        __builtin_amdgcn_s_waitcnt(0);
        unsigned nloc = b.st[0], nx = b.st[1];
        if (nloc == 0u) { xcd_barrier_complete(bar, b.x, nloc, nx); b.st[0] = nloc; b.st[1] = nx; }
        const unsigned old = xb_add(&bar[XB_XSUB(b.x)], 1u);
        const unsigned gen = old / nloc;
        if (old + 1u == (gen + 1u) * nloc) {
            __builtin_amdgcn_fence(__ATOMIC_RELEASE, "agent");
            asm volatile("s_waitcnt vmcnt(0)" ::: "memory");
            const unsigned og = xb_add(&bar[XB_TOP], 1u);
            const unsigned tg = og / nx;
            if (og + 1u == (tg + 1u) * nx) xb_add(&bar[XB_TOPGEN], 1u);
            else XB_SPIN(xb_ld(&bar[XB_TOPGEN]) == tg, bar);
            __builtin_amdgcn_fence(__ATOMIC_ACQUIRE, "agent");
            xb_add(&bar[XB_XGEN(b.x)], 1u);
            asm volatile("s_waitcnt vmcnt(0)" ::: "memory");
        } else {
            XB_SPIN(xb_ld(&bar[XB_XGEN(b.x)]) == gen, bar);
            __builtin_amdgcn_fence(__ATOMIC_ACQUIRE, "agent");
            asm volatile("s_waitcnt vmcnt(0)" ::: "memory");
        }
    }
    __syncthreads();
}

template <bool NA>
__device__ __forceinline__ void attn_item(const bf16* qbase, int qstride, const bf16* kbase, int kstride, const bf16* v8base, int pos0, int kbstep, bf16* obase,
                                          const float* rpb_h, int rbias0, int c_lo, int c0q, int lane) {
    const int n = lane & 15, q = lane >> 4, cq = c0q + n;
    const unsigned qoff = (unsigned)(n * qstride + 8 * q);
    bf16x8 qf[2]; qf[0] = *(const bf16x8*)(qbase + qoff); qf[1] = *(const bf16x8*)(qbase + qoff + 32);
    bf16x8 kf[8][2][2];
    const unsigned koff = (unsigned)((8 * (n >> 2) + (n & 3)) * kstride + 8 * q);
#pragma unroll
    for (int kb = 0; kb < 8; ++kb)
#pragma unroll
        for (int blk = 0; blk < 2; ++blk) {
            const bf16* kp = kbase + (unsigned)((pos0 + kb * kbstep + 4 * blk) * kstride) + koff;
            kf[kb][blk][0] = *(const bf16x8*)kp; kf[kb][blk][1] = *(const bf16x8*)(kp + 32);
        }
    f32x4 s[8][2];
#pragma unroll
    for (int kb = 0; kb < 8; ++kb)
#pragma unroll
        for (int blk = 0; blk < 2; ++blk) {
            f32x4 a = (f32x4){0.f, 0.f, 0.f, 0.f};
            a = __builtin_amdgcn_mfma_f32_16x16x32_bf16(kf[kb][blk][0], qf[0], a, 0, 0, 0);
            a = __builtin_amdgcn_mfma_f32_16x16x32_bf16(kf[kb][blk][1], qf[1], a, 0, 0, 0);
            s[kb][blk] = a;
        }
    bf16x8 vf[8][4];
#pragma unroll
    for (int kb = 0; kb < 8; ++kb)
#pragma unroll
        for (int db = 0; db < 4; ++db) vf[kb][db] = *(const bf16x8*)(v8base + (unsigned)(((pos0 + kb * kbstep) >> 3) * 512 + db * 128) + (unsigned)(q * 512 + n * 8));
    if (NA) {
        const int cs = min(max(cq - 8, 0), 48);
#pragma unroll
        for (int kb = 0; kb < 8; ++kb)
#pragma unroll
            for (int blk = 0; blk < 2; ++blk)
#pragma unroll
                for (int i = 0; i < 4; ++i) {
                    const int kc = c_lo + 8 * q + 4 * blk + i; const bool valid = (kc >= cs) && (kc < cs + 16);
                    const int bi = min(max(kc - cq + 15, 0), 30);
                    const float bias = rpb_h[(rbias0 + kb) * 31 + bi];
                    s[kb][blk][i] = valid ? s[kb][blk][i] + bias : -1e30f;
                }
    }
    float mx = -1e30f;
#pragma unroll
    for (int kb = 0; kb < 8; ++kb)
#pragma unroll
        for (int blk = 0; blk < 2; ++blk)
#pragma unroll
            for (int i = 0; i < 4; ++i) mx = fmaxf(mx, s[kb][blk][i]);
    mx = fmaxf(mx, shfl_xor_f(mx, 16, lane)); mx = fmaxf(mx, shfl_xor_f(mx, 32, lane));
    float sum = 0.f; bf16x8 pf[8];
#pragma unroll
    for (int kb = 0; kb < 8; ++kb) {
        float p[8];
#pragma unroll
        for (int blk = 0; blk < 2; ++blk)
#pragma unroll
            for (int i = 0; i < 4; ++i) { const float e = fast_exp(s[kb][blk][i] - mx); p[blk * 4 + i] = e; sum += e; }
        u32x4 w; w.x = cvt_pk_bf16(p[0], p[1]); w.y = cvt_pk_bf16(p[2], p[3]); w.z = cvt_pk_bf16(p[4], p[5]); w.w = cvt_pk_bf16(p[6], p[7]);
        pf[kb] = __builtin_bit_cast(bf16x8, w);
    }
    sum += shfl_xor_f(sum, 16, lane); sum += shfl_xor_f(sum, 32, lane);
    const float inv = fast_rcp(sum);
#pragma unroll
    for (int db = 0; db < 4; ++db) {
        f32x4 o = (f32x4){0.f, 0.f, 0.f, 0.f};
#pragma unroll
        for (int kb = 0; kb < 8; ++kb) o = __builtin_amdgcn_mfma_f32_16x16x32_bf16(vf[kb][db], pf[kb], o, 0, 0, 0);
        u32x2 w; w.x = cvt_pk_bf16(o[0] * inv, o[1] * inv); w.y = cvt_pk_bf16(o[2] * inv, o[3] * inv);
        *(u32x2*)(obase + (unsigned)(n * 1024 + 4 * q) + db * 16) = w;
    }
}

constexpr int NWAVES = 8;
constexpr int RING_BYTES = 131072, MISC_OFF = RING_BYTES, TAB_OFF = RING_BYTES + 256, LDS_BYTES = 147456;
struct Args { const float* in[30]; float* out; unsigned char* ws; };
struct Frame { LAS unsigned char* lds; int tid, lane, wave, vcu, G; };
enum { I_X = 0, I_MEM, I_NMIX, I_NFFN, I_NMEM, I_WIN, I_BGATE, I_RPB, I_LRE, I_LIM, I_LDT, I_BRE, I_BIM, I_CRE, I_CIM, I_S5D, I_WGLU, I_WMKV, I_WBNA, I_WBS5, I_WBXA, I_WOUT,
       I_WCO, I_BCO, I_WFI, I_BFI, I_WG, I_WU, I_WD, I_FNORM };

__device__ __forceinline__ void transpose_item(const float* W, int ldn, int k0, int n0, bf16* WT, int ldk, int dk0, int row_off, int rmul, int radd, int qs, LAS float* scr, int lane) {
    { float t[32]; const float* wp = W + (size_t)(k0 + (lane >> 5)) * ldn + n0 + (lane & 31);
#pragma unroll
      for (int i = 0; i < 32; ++i) t[i] = wp[(size_t)(2 * i) * ldn];
#pragma unroll
      for (int i = 0; i < 32; ++i) scr[(2 * i + (lane >> 5)) * 33 + (lane & 31)] = t[i]; }
    LDS_WAIT(); asm volatile("" ::: "memory");
    const int c = lane & 7;
#pragma unroll
    for (int j = 0; j < 4; ++j) { const int n = (lane >> 3) + 8 * j, nn = n0 + n; const LAS float* s = scr + (8 * c) * 33 + n;
        const float sc = (qs && (nn < 512 || (nn >= 1792 && nn < 2048))) ? 0.125f : 1.0f;
        u32x4 o; o.x = cvt_pk_bf16(s[0 * 33] * sc, s[1 * 33] * sc); o.y = cvt_pk_bf16(s[2 * 33] * sc, s[3 * 33] * sc); o.z = cvt_pk_bf16(s[4 * 33] * sc, s[5 * 33] * sc); o.w = cvt_pk_bf16(s[6 * 33] * sc, s[7 * 33] * sc);
        *(u32x4*)(WT + (size_t)(row_off + nn * rmul + radd) * ldk + dk0 + k0 + 8 * c) = o; }
    LDS_WAIT(); asm volatile("" ::: "memory");
}
__device__ __forceinline__ void transpose_job_item(const float* W, int ldn, int N, int it, bf16* WT, int ldk, int dk0, int row_off, int rmul, int radd, int qs, LAS float* scr, int lane) {
    const int nblk = N / 32, kb = it / nblk, nb = it % nblk;
    transpose_item(W, ldn, 64 * kb, 32 * nb, WT, ldk, dk0, row_off, rmul, radd, qs, scr, lane);
}

__device__ __forceinline__ void cexp_d(double zr, double zi, double& er, double& ei) {
    const double wr_ = zr * (1.0 / 1024.0), wi_ = zi * (1.0 / 1024.0);
    double tr = 1.0, ti = 0.0;
#pragma unroll
    for (int n = 12; n >= 1; --n) { const double ar = wr_ * (1.0 / n), ai = wi_ * (1.0 / n); const double nr = 1.0 + (ar * tr - ai * ti), ni = ar * ti + ai * tr; tr = nr; ti = ni; }
#pragma unroll
    for (int k = 0; k < 10; ++k) { const double nr = tr * tr - ti * ti, ni = 2.0 * tr * ti; tr = nr; ti = ni; }
    er = tr; ei = ti;
}

template <bool ROUTER>
__device__ __forceinline__ void norm_rows4(const float* X, const float* gain, bf16* H, int row0, int lane,
                                           const float* wrt, const float* bco, const float* bfi, unsigned* cnt, int* list, float* wts) {
    f32x4 x[4][4]; float rstd[4];
#pragma unroll
    for (int r = 0; r < 4; ++r) { float ss = 0.f;
#pragma unroll
        for (int j = 0; j < 4; ++j) { x[r][j] = *(const f32x4*)(X + (size_t)(row0 + r) * 1024 + 256 * j + 4 * lane); ss += (x[r][j][0] * x[r][j][0] + x[r][j][1] * x[r][j][1]) + (x[r][j][2] * x[r][j][2] + x[r][j][3] * x[r][j][3]); }
        ss = wave_sum(ss, lane); rstd[r] = 1.0f / sqrtf(ss * (1.0f / 1024.0f) + RMS_EPS); }
#pragma unroll
    for (int j = 0; j < 4; ++j) { const f32x4 g4 = *(const f32x4*)(gain + 256 * j + 4 * lane);
#pragma unroll
        for (int r = 0; r < 4; ++r) { const f32x4 v = x[r][j] * rstd[r] * g4; u32x2 w; w.x = cvt_pk_bf16(v[0], v[1]); w.y = cvt_pk_bf16(v[2], v[3]);
            *(u32x2*)(H + (size_t)(row0 + r) * 1024 + 256 * j + 4 * lane) = w; } }
    if constexpr (ROUTER) {
        float keep[4] = {0.f, 0.f, 0.f, 0.f};
#pragma unroll 2
        for (int c = 0; c < 20; ++c) {
            float a0 = 0.f, a1 = 0.f, a2 = 0.f, a3 = 0.f;
#pragma unroll
            for (int j = 0; j < 4; ++j) { const f32x4 w4 = *(const f32x4*)(wrt + c * 1024 + 256 * j + 4 * lane);
                a0 += (x[0][j][0] * w4[0] + x[0][j][1] * w4[1]) + (x[0][j][2] * w4[2] + x[0][j][3] * w4[3]);
                a1 += (x[1][j][0] * w4[0] + x[1][j][1] * w4[1]) + (x[1][j][2] * w4[2] + x[1][j][3] * w4[3]);
                a2 += (x[2][j][0] * w4[0] + x[2][j][1] * w4[1]) + (x[2][j][2] * w4[2] + x[2][j][3] * w4[3]);
                a3 += (x[3][j][0] * w4[0] + x[3][j][1] * w4[1]) + (x[3][j][2] * w4[2] + x[3][j][3] * w4[3]); }
            a0 = wave_sum(a0, lane); a1 = wave_sum(a1, lane); a2 = wave_sum(a2, lane); a3 = wave_sum(a3, lane);
            if (lane == c) { keep[0] = a0 * rstd[0]; keep[1] = a1 * rstd[1]; keep[2] = a2 * rstd[2]; keep[3] = a3 * rstd[3]; }
        }
#pragma unroll
        for (int r = 0; r < 4; ++r) {
            float co[4];
#pragma unroll
            for (int i = 0; i < 4; ++i) co[i] = shfl_idx_f(keep[r], i) + bco[i];
            int grp = 0; float cm = co[0];
#pragma unroll
            for (int i = 1; i < 4; ++i) if (co[i] > cm) { cm = co[i]; grp = i; }
            float den = 0.f;
#pragma unroll
            for (int i = 0; i < 4; ++i) den += __expf(co[i] - cm);
            const float pgrp = 1.0f / den;
            float fv[4];
#pragma unroll
            for (int i = 0; i < 4; ++i) fv[i] = shfl_idx_f(keep[r], 4 + grp * 4 + i) + bfi[grp * 4 + i];
            int i1 = 0; float v1 = fv[0];
#pragma unroll
            for (int i = 1; i < 4; ++i) if (fv[i] > v1) { v1 = fv[i]; i1 = i; }
            int i2 = -1; float v2 = -3.0e38f;
#pragma unroll
            for (int i = 0; i < 4; ++i) if (i != i1 && fv[i] > v2) { v2 = fv[i]; i2 = i; }
            const float w1 = pgrp / (1.0f + __expf(v2 - v1)), w2 = pgrp - w1;
            const int a = i1 < i2 ? i1 : i2, b = i1 < i2 ? i2 : i1;
            const int pidx = a == 0 ? b - 1 : (a == 1 ? b + 1 : 5);
            const int bucket = grp * 6 + pidx;
            const float wa = (i1 == a) ? w1 : w2, wb = (i1 == a) ? w2 : w1;
            if (lane == 0) {
                const unsigned slot = __hip_atomic_fetch_add(cnt + bucket * 64, 1u, __ATOMIC_RELAXED, __HIP_MEMORY_SCOPE_AGENT);
                list[(size_t)bucket * LCAP + slot] = row0 + r;
                *(f32x2*)(wts + ((size_t)bucket * LCAP + slot) * 2) = (f32x2){wa, wb};
            }
        }
    }
}

constexpr int RT_STRIDE = 2064;
constexpr int RT_BYTES = 40 * RT_STRIDE;
constexpr int RT_SCR = 98304;
__device__ __forceinline__ void router_rows16(const float* X, const float* gain, bf16* H, int R0, int lane, LAS unsigned char* lds, int wave,
                                              const float* bco, const float* bfi, unsigned* cnt, int* list, float* wts) {
    const int n = lane & 15, q = lane >> 4;
    f32x4 accF = (f32x4){0.f, 0.f, 0.f, 0.f}, accC = (f32x4){0.f, 0.f, 0.f, 0.f};
    float ss = 0.f;
    const float* xp = X + (unsigned)((R0 + n) * 1024 + 8 * q);
    const LAS unsigned char* tF = lds + n * RT_STRIDE + 16 * q; const LAS unsigned char* tC = lds + (16 + (n & 3)) * RT_STRIDE + 16 * q;
#pragma unroll 4
    for (int ks = 0; ks < 32; ++ks) {
        const f32x4 x0 = *(const f32x4*)(xp + ks * 32), x1 = *(const f32x4*)(xp + ks * 32 + 4);
        ss += (x0[0] * x0[0] + x0[1] * x0[1]) + (x0[2] * x0[2] + x0[3] * x0[3]) + (x1[0] * x1[0] + x1[1] * x1[1]) + (x1[2] * x1[2] + x1[3] * x1[3]);
        u32x4 hw; hw.x = cvt_pk_bf16(x0[0], x0[1]); hw.y = cvt_pk_bf16(x0[2], x0[3]); hw.z = cvt_pk_bf16(x1[0], x1[1]); hw.w = cvt_pk_bf16(x1[2], x1[3]);
        u32x4 lw; lw.x = cvt_pk_bf16(x0[0] - bflo(hw.x), x0[1] - bfhi(hw.x)); lw.y = cvt_pk_bf16(x0[2] - bflo(hw.y), x0[3] - bfhi(hw.y));
        lw.z = cvt_pk_bf16(x1[0] - bflo(hw.z), x1[1] - bfhi(hw.z)); lw.w = cvt_pk_bf16(x1[2] - bflo(hw.w), x1[3] - bfhi(hw.w));
        const bf16x8 ah = __builtin_bit_cast(bf16x8, hw), al = __builtin_bit_cast(bf16x8, lw);
        const bf16x8 fh = *(const LAS bf16x8*)(tF + ks * 64), fl = *(const LAS bf16x8*)(tF + 20 * RT_STRIDE + ks * 64);
        const bf16x8 ch = *(const LAS bf16x8*)(tC + ks * 64), cl = *(const LAS bf16x8*)(tC + 20 * RT_STRIDE + ks * 64);
        accF = __builtin_amdgcn_mfma_f32_16x16x32_bf16(ah, fh, accF, 0, 0, 0); accF = __builtin_amdgcn_mfma_f32_16x16x32_bf16(ah, fl, accF, 0, 0, 0); accF = __builtin_amdgcn_mfma_f32_16x16x32_bf16(al, fh, accF, 0, 0, 0);
        accC = __builtin_amdgcn_mfma_f32_16x16x32_bf16(ah, ch, accC, 0, 0, 0); accC = __builtin_amdgcn_mfma_f32_16x16x32_bf16(ah, cl, accC, 0, 0, 0); accC = __builtin_amdgcn_mfma_f32_16x16x32_bf16(al, ch, accC, 0, 0, 0);
    }
    ss += shfl_xor_f(ss, 16, lane); ss += shfl_xor_f(ss, 32, lane);
    const float rstd = 1.0f / sqrtf(ss * (1.0f / 1024.0f) + RMS_EPS);
    LAS float* sc = (LAS float*)(lds + RT_SCR + wave * 1536);
#pragma unroll
    for (int r = 0; r < 4; ++r) { const float rs = shfl_idx_f(rstd, 4 * q + r); sc[(4 * q + r) * 24 + n] = accF[r] * rs; if (n < 4) sc[(4 * q + r) * 24 + 16 + n] = accC[r] * rs; }
    LDS_WAIT(); asm volatile("" ::: "memory");
    if (lane < 16) {
        const LAS float* my = sc + lane * 24;
        float co[4];
#pragma unroll
        for (int i = 0; i < 4; ++i) co[i] = my[16 + i] + bco[i];
        int grp = 0; float cm = co[0];
#pragma unroll
        for (int i = 1; i < 4; ++i) if (co[i] > cm) { cm = co[i]; grp = i; }
        float den = 0.f;
#pragma unroll
        for (int i = 0; i < 4; ++i) den += __expf(co[i] - cm);
        const float pgrp = 1.0f / den;
        float fv[4];
#pragma unroll
        for (int i = 0; i < 4; ++i) fv[i] = my[grp * 4 + i] + bfi[grp * 4 + i];
        int i1 = 0; float v1 = fv[0];
#pragma unroll
        for (int i = 1; i < 4; ++i) if (fv[i] > v1) { v1 = fv[i]; i1 = i; }
        int i2 = -1; float v2 = -3.0e38f;
#pragma unroll
        for (int i = 0; i < 4; ++i) if (i != i1 && fv[i] > v2) { v2 = fv[i]; i2 = i; }
        const float w1 = pgrp / (1.0f + __expf(v2 - v1)), w2 = pgrp - w1;
        const int a = i1 < i2 ? i1 : i2, b = i1 < i2 ? i2 : i1;
        const int pidx = a == 0 ? b - 1 : (a == 1 ? b + 1 : 5);
        const int bucket = grp * 6 + pidx;
        const float wa = (i1 == a) ? w1 : w2, wb = (i1 == a) ? w2 : w1;
        const unsigned slot = __hip_atomic_fetch_add(cnt + bucket * 64, 1u, __ATOMIC_RELAXED, __HIP_MEMORY_SCOPE_AGENT);
        list[(unsigned)(bucket * LCAP) + slot] = R0 + lane;
        *(f32x2*)(wts + ((unsigned)(bucket * LCAP) + slot) * 2) = (f32x2){wa, wb};
    }
    f32x4 g4[4];
#pragma unroll
    for (int j = 0; j < 4; ++j) g4[j] = *(const f32x4*)(gain + 256 * j + 4 * lane);
#pragma unroll 4
    for (int rr = 0; rr < 16; ++rr) {
        const float rs = shfl_idx_f(rstd, rr);
        const float* xr = X + (unsigned)((R0 + rr) * 1024 + 4 * lane); bf16* hr = H + (unsigned)((R0 + rr) * 1024 + 4 * lane);
#pragma unroll
        for (int j = 0; j < 4; ++j) { const f32x4 v = *(const f32x4*)(xr + 256 * j) * rs * g4[j]; u32x2 w; w.x = cvt_pk_bf16(v[0], v[1]); w.y = cvt_pk_bf16(v[2], v[3]); *(u32x2*)(hr + 256 * j) = w; }
    }
}

__device__ __forceinline__ void final_norm_row(float* X, const float* gain, int row, int lane) {
    f32x4 x[4]; float ss = 0.f;
#pragma unroll
    for (int j = 0; j < 4; ++j) { x[j] = *(const f32x4*)(X + (size_t)row * 1024 + 256 * j + 4 * lane); ss += (x[j][0] * x[j][0] + x[j][1] * x[j][1]) + (x[j][2] * x[j][2] + x[j][3] * x[j][3]); }
    ss = wave_sum(ss, lane); const float rstd = 1.0f / sqrtf(ss * (1.0f / 1024.0f) + RMS_EPS);
#pragma unroll
    for (int j = 0; j < 4; ++j) { const f32x4 g4 = *(const f32x4*)(gain + 256 * j + 4 * lane); *(f32x4*)(X + (size_t)row * 1024 + 256 * j + 4 * lane) = x[j] * rstd * g4; }
}

__device__ __forceinline__ void s5_scan_item(int item, const float* ST, bf16* At, const f32x2* apow_l, LAS float* sc, int tid) {
    const int d = item & 1, bg = item >> 1, g = bg & 15, seg = tid >> 6, p = tid & 63;
    const f32x2 A32 = apow_l[((d * 16 + g) * 33 + 32) * 64 + p];
    const int chunk0 = d ? 255 - seg * 32 : seg * 32; const long cstep = d ? -1 : 1;
    const float* rp0 = ST + (size_t)(bg * 256 + chunk0) * 256 + d * 128 + p;
    float tr = 0.f, ti = 0.f;
#pragma unroll 8
    for (int j = 0; j < 32; ++j) { const float* rp = rp0 + cstep * j * 256; const float sr = rp[0], si = rp[64]; const float nr = A32.x * tr - A32.y * ti + sr, ni = A32.x * ti + A32.y * tr + si; tr = nr; ti = ni; }
    sc[(seg * 64 + p) * 2] = tr; sc[(seg * 64 + p) * 2 + 1] = ti;
    __syncthreads();
    float pr = A32.x, pi = A32.y;
#pragma unroll
    for (int k = 0; k < 5; ++k) { const float nr = pr * pr - pi * pi, ni = 2.f * pr * pi; pr = nr; pi = ni; }
    float er = 0.f, ei = 0.f;
    for (int s2 = 0; s2 < seg; ++s2) { const float qr = sc[(s2 * 64 + p) * 2], qi = sc[(s2 * 64 + p) * 2 + 1]; const float nr = pr * er - pi * ei + qr, ni = pr * ei + pi * er + qi; er = nr; ei = ni; }
    bf16* op0 = At + (size_t)(bg * 256 + chunk0) * ATK + 512 + d * 128 + p;
#pragma unroll 8
    for (int j = 0; j < 32; ++j) { const float* rp = rp0 + cstep * j * 256; const float sr = rp[0], si = rp[64]; bf16* op = op0 + cstep * j * ATK;
        op[0] = (bf16)(cvt_pk_bf16(er, er) & 0xffffu); op[64] = (bf16)(cvt_pk_bf16(ei, ei) & 0xffffu);
        const float nr = A32.x * er - A32.y * ei + sr, ni = A32.x * ei + A32.y * er + si; er = nr; ei = ni; }
    __syncthreads();
}

#ifndef PHMASK
#define PHMASK 0xffffffffu
#endif
#define PH(k) ((PHMASK >> (k)) & 1u)
#ifndef REPMASK
#define REPMASK 0u
#endif
#define NREP(k) (1 + (int)((REPMASK >> (k)) & 1u))
constexpr int PTR_OFF = RING_BYTES + 1024;
__device__ __forceinline__ const float* inp(LAS unsigned char* lds, int i, int z) {
    const LAS unsigned* q = (const LAS unsigned*)(lds + PTR_OFF + 8 * i + z);
    const unsigned lo = __builtin_amdgcn_readfirstlane(q[0]), hi = __builtin_amdgcn_readfirstlane(q[1]);
    return (const float*)(((unsigned long long)hi << 32) | lo);
}
#define WSL() unsigned char* wsl = args.ws; int wave = F.wave, bid = blockIdx.x, G = gridDim.x, zz = 0; unsigned mm_ = ~0u; asm volatile("" : "+s"(mm_)); int lane = (int)__builtin_amdgcn_mbcnt_hi(mm_, __builtin_amdgcn_mbcnt_lo(mm_, 0u)); \
    asm volatile("" : "+s"(wsl), "+s"(wave), "+v"(lane), "+s"(bid), "+s"(G), "+s"(zz)); \
    const int tid = wave * 64 + lane, vcu = (G % 8 == 0) ? (bid % 8) * (G / 8) + bid / 8 : bid, gw = vcu * NWAVES + wave, NGW = G * NWAVES, NGT = G * NWAVES * 64; \
    (void)tid; (void)gw; (void)NGW; (void)NGT; (void)wsl
#define WP(T, off) ((T*)(wsl + (off)))
#define IN(i) inp(F.lds, (i), zz)

__global__ void __launch_bounds__(NWAVES * 64, 2) fwd_kernel(Args args) {
    extern __shared__ __attribute__((aligned(16))) unsigned char lds_raw[];
    Frame F;
    F.lds = (LAS unsigned char*)lds_raw;
    F.tid = threadIdx.x; F.lane = F.tid & 63; F.wave = __builtin_amdgcn_readfirstlane(F.tid >> 6);
    F.G = gridDim.x; { const int bx = blockIdx.x; F.vcu = (F.G % 8 == 0) ? (bx % 8) * (F.G / 8) + bx / 8 : bx; }
    for (int u = F.tid; u < (LDS_BYTES - RING_BYTES) / 4; u += NWAVES * 64) ((LAS unsigned*)(F.lds + MISC_OFF))[u] = 0u;
    __syncthreads();
    if (F.tid < 30) { const unsigned long long p = (unsigned long long)args.in[F.tid]; LAS unsigned* q = (LAS unsigned*)(F.lds + PTR_OFF + 8 * F.tid); q[0] = (unsigned)p; q[1] = (unsigned)(p >> 32); }
    __syncthreads();
    (void)xcd_barrier_post((unsigned*)(args.ws + WS_CTL) + CW_BAR, (volatile LAS unsigned*)(F.lds + MISC_OFF));
#define GRID_BAR() do { unsigned char* w_ = args.ws; asm volatile("" : "+s"(w_)); XcdBarrier b_; b_.bar = (unsigned*)(w_ + WS_CTL) + CW_BAR; b_.x = xb_xcc_id(); b_.st = (volatile LAS unsigned*)(F.lds + MISC_OFF); xcd_barrier(b_); } while (0)
#define GT() (vcu * (NWAVES * 64) + tid)
#define SCR() ((LAS float*)(F.lds + wave * 16384))

    if (PH(0)) {
        WSL();
        f32x2* APOW = WP(f32x2, WS_APOW); f32x2* BBAR = WP(f32x2, WS_BBAR); bf16* WRT = WP(bf16, WS_WRT); bf16* MEMN = WP(bf16, WS_MEMN); bf16* WMKV = WP(bf16, WS_WMKV);
        for (int it = gw; it < 1024; it += NGW) { const int l = it >> 8, r = it & 255;
            transpose_job_item(IN(I_WMKV) + (size_t)l * 1024 * 512, 512, 512, r, WMKV + (size_t)l * 512 * 1024, 1024, 0, 0, 1, 0, 0, SCR(), lane); }
        for (int it = gw; it < 4096; it += NGW) { const int l = it >> 10, row = it & 1023;
            const float* xr = IN(I_MEM) + (size_t)row * 1024; const float* gn = IN(I_NMEM) + l * 1024;
            f32x4 x[4]; float ss = 0.f;
#pragma unroll
            for (int j = 0; j < 4; ++j) { x[j] = *(const f32x4*)(xr + 256 * j + 4 * lane); ss += (x[j][0] * x[j][0] + x[j][1] * x[j][1]) + (x[j][2] * x[j][2] + x[j][3] * x[j][3]); }
            ss = wave_sum(ss, lane); const float rstd = 1.0f / sqrtf(ss * (1.0f / 1024.0f) + RMS_EPS);
#pragma unroll
            for (int j = 0; j < 4; ++j) { const f32x4 v = x[j] * rstd * *(const f32x4*)(gn + 256 * j + 4 * lane); u32x2 w; w.x = cvt_pk_bf16(v[0], v[1]); w.y = cvt_pk_bf16(v[2], v[3]);
                *(u32x2*)(MEMN + (size_t)it * 1024 + 256 * j + 4 * lane) = w; } }
        for (int it = GT(); it < 8192; it += NGT) {
            const int p = it & 63, ldg = it >> 6;
            const double lr = fmin((double)IN(I_LRE)[it], -1e-4), li = (double)IN(I_LIM)[it];
            double dt, dum; cexp_d((double)IN(I_LDT)[ldg], 0.0, dt, dum);
            double ar, ai; cexp_d(lr * dt, li * dt, ar, ai);
            const double den = lr * lr + li * li, fr = ((ar - 1.0) * lr + ai * li) / den, fi = (ai * lr - (ar - 1.0) * li) / den;
            const float* bre = IN(I_BRE) + (size_t)it * 16; const float* bim = IN(I_BIM) + (size_t)it * 16;
#pragma unroll 4
            for (int c = 0; c < 16; ++c) { const double br = (double)bre[c], bi = (double)bim[c];
                BBAR[(size_t)it * 16 + c] = (f32x2){(float)(fr * br - fi * bi), (float)(fr * bi + fi * br)}; }
            double pr = 1.0, pi = 0.0;
            for (int n = 0; n <= 32; ++n) { APOW[((size_t)ldg * 33 + n) * 64 + p] = (f32x2){(float)pr, (float)pi}; const double nr = pr * ar - pi * ai, ni = pr * ai + pi * ar; pr = nr; pi = ni; }
        }
        for (int it = GT(); it < 4 * 20480; it += NGT) { const int l = it / 20480, r = it % 20480, c = r >> 10, k = r & 1023;
            const float gk = IN(I_NFFN)[l * 1024 + k];
            const float v = gk * (c < 16 ? IN(I_WFI)[(size_t)(l * 1024 + k) * 16 + c] : IN(I_WCO)[(size_t)(l * 1024 + k) * 4 + (c - 16)]);
            const unsigned hw = cvt_pk_bf16(v, v) & 0xffffu; const float lo = v - bflo(hw);
            WRT[(size_t)(l * 2 + 0) * 20480 + r] = (bf16)hw; WRT[(size_t)(l * 2 + 1) * 20480 + r] = (bf16)(cvt_pk_bf16(lo, lo) & 0xffffu); }
    }
    GRID_BAR();

    if (PH(1)) {
        WSL();
        { pg8::Gemm g{WP(bf16, WS_MEMN), WP(bf16, WS_WMKV), 1024, 1024, 1024}; pg8::MemOrder S{G, bid}; EpiMemKV E{WP(bf16, WS_KM), WP(bf16, WS_VM8)};
          pg8::gemm_phase<EpiMemKV, pg8::MemOrder>(F.lds, g, S, E, tid); }
        const f32x2* APOW = WP(f32x2, WS_APOW); const f32x2* BBAR = WP(f32x2, WS_BBAR); float* KT = WP(float, WS_KT);
        const float* CRE = IN(I_CRE); const float* CIM = IN(I_CIM); const float* S5D = IN(I_S5D);
        for (int it = GT(); it < 4 * 16 * 63 * 256; it += NGT) {
            const int c2 = it & 15, c = (it >> 4) & 15, rest = it >> 8, tp = rest % 63, lg = rest / 63, l = lg >> 4, g = lg & 15;
            float sum = 0.f;
#pragma unroll 1
            for (int d = 0; d < 2; ++d) {
                if (d == 0 ? (tp < 31) : (tp > 31)) continue;
                const int n = d == 0 ? tp - 31 : 31 - tp, base = (l * 2 + d) * 16 + g;
                const float* cre = CRE + ((size_t)base * 16 + c) * 64; const float* cim = CIM + ((size_t)base * 16 + c) * 64;
                const f32x2* ap = APOW + ((size_t)base * 33 + n) * 64; const f32x2* bb = BBAR + (size_t)base * 64 * 16 + c2;
#pragma unroll 4
                for (int p = 0; p < 64; ++p) { const f32x2 a = ap[p], b = bb[p * 16]; const float cr = cre[p], ci = cim[p];
                    const float er = cr * a.x - ci * a.y, ei = cr * a.y + ci * a.x; sum += er * b.x - ei * b.y; }
            }
            if (tp == 31 && c == c2) sum += S5D[l * 256 + g * 16 + c];
            KT[it] = sum;
        }
    }
    GRID_BAR();

    const float* xcur = args.in[I_X];
    float* XO = args.out;
#pragma unroll 1
    for (int l = 0; l < DEPTH; ++l) {
        for (int rep_ = 0; rep_ < NREP(2); ++rep_) {
        if (PH(2)) {
            WSL();
            {
            bf16* WIN = WP(bf16, WS_WIN); bf16* WCAT = WP(bf16, WS_WCAT); bf16* WOUT = WP(bf16, WS_WOUT); bf16* WGLU = WP(bf16, WS_WGLU);
            for (int it = gw; it < 3648; it += NGW) {
                int r = it;
                if (r < 2560) { transpose_job_item(IN(I_WIN) + (size_t)l * 1024 * 5120, 5120, 5120, r, WIN, 1024, 0, 0, 1, 0, 1, SCR(), lane); continue; } r -= 2560;
                if (r < 256) { transpose_job_item(IN(I_WBNA) + (size_t)l * 512 * 1024, 1024, 1024, r, WCAT, 1024, 0, 0, 1, 0, 0, SCR(), lane); continue; } r -= 256;
                if (r < 128) { transpose_job_item(IN(I_WBS5) + (size_t)l * 256 * 1024, 1024, 1024, r, WCAT, 1024, 512, 0, 1, 0, 0, SCR(), lane); continue; } r -= 128;
                if (r < 128) { transpose_job_item(IN(I_WBXA) + (size_t)l * 256 * 1024, 1024, 1024, r, WCAT, 1024, 768, 0, 1, 0, 0, SCR(), lane); continue; } r -= 128;
                if (r < 512) { transpose_job_item(IN(I_WOUT) + (size_t)l * 1024 * 1024, 1024, 1024, r, WOUT, 1024, 0, 0, 1, 0, 0, SCR(), lane); continue; } r -= 512;
                if (r < 32) { transpose_job_item(IN(I_WGLU) + (size_t)l * 256 * 512, 512, 256, r, WGLU, 256, 0, 0, 2, 0, 0, SCR(), lane); continue; } r -= 32;
                transpose_job_item(IN(I_WGLU) + (size_t)l * 256 * 512 + 256, 512, 256, r, WGLU, 256, 0, 0, 2, 1, 0, SCR(), lane);
            }
            }
            {
            const f32x2* APOW = WP(f32x2, WS_APOW); const f32x2* BBAR = WP(f32x2, WS_BBAR); bf16* S5W = WP(bf16, WS_S5W);
            for (int it = GT(); it < 16 * 256 * 64; it += NGT) {
                const int k8 = it & 63, n = (it >> 6) & 255, g = it >> 14;
                const int s = k8 >> 1, c0 = (k8 & 1) * 8, d = n >> 7, ri = (n >> 6) & 1, p = n & 63, e = d == 0 ? 31 - s : s, base = (l * 2 + d) * 16 + g;
                const f32x2 a = APOW[((size_t)base * 33 + e) * 64 + p]; const f32x2* bb = BBAR + ((size_t)base * 64 + p) * 16 + c0;
                float v[8];
#pragma unroll
                for (int j = 0; j < 8; ++j) { const f32x2 b = bb[j]; v[j] = ri == 0 ? a.x * b.x - a.y * b.y : a.x * b.y + a.y * b.x; }
                u32x4 w; w.x = cvt_pk_bf16(v[0], v[1]); w.y = cvt_pk_bf16(v[2], v[3]); w.z = cvt_pk_bf16(v[4], v[5]); w.w = cvt_pk_bf16(v[6], v[7]);
                *(u32x4*)(S5W + ((size_t)(g * 256 + n) * 512 + k8 * 8)) = w;
            }
            const float* KT = WP(float, WS_KT); bf16* S5KV = WP(bf16, WS_S5KV); const float* CRE = IN(I_CRE); const float* CIM = IN(I_CIM);
            for (int it = GT(); it < 16 * 512 * 96; it += NGT) {
                const int k8 = it % 96, rest = it / 96, n = rest & 511, g = rest >> 9, t = n >> 4, c = n & 15;
                float v[8];
                if (k8 < 64) { const int s = k8 >> 1, c0 = (k8 & 1) * 8, tp = t - s + 31; const float* kp = KT + ((size_t)(((l * 16 + g) * 63 + tp) * 16 + c) * 16 + c0);
                    const f32x4 a = *(const f32x4*)kp, b = *(const f32x4*)(kp + 4); v[0] = a[0]; v[1] = a[1]; v[2] = a[2]; v[3] = a[3]; v[4] = b[0]; v[5] = b[1]; v[6] = b[2]; v[7] = b[3]; }
                else { const int jj = (k8 - 64) * 8, d = jj >> 7, ri = (jj >> 6) & 1, p0 = jj & 63, e = d == 0 ? t + 1 : 32 - t, base = (l * 2 + d) * 16 + g;
                    const float* cre = CRE + ((size_t)base * 16 + c) * 64 + p0; const float* cim = CIM + ((size_t)base * 16 + c) * 64 + p0; const f32x2* ap = APOW + ((size_t)base * 33 + e) * 64 + p0;
#pragma unroll
                    for (int j = 0; j < 8; ++j) { const f32x2 a = ap[j]; const float cr = cre[j], ci = cim[j]; v[j] = ri == 0 ? cr * a.x - ci * a.y : -(cr * a.y + ci * a.x); } }
                u32x4 w; w.x = cvt_pk_bf16(v[0], v[1]); w.y = cvt_pk_bf16(v[2], v[3]); w.z = cvt_pk_bf16(v[4], v[5]); w.w = cvt_pk_bf16(v[6], v[7]);
                *(u32x4*)(S5KV + ((size_t)(g * 512 + n) * ATK + k8 * 8)) = w;
            }
            }
            { bf16* H = WP(bf16, WS_H); const float* gn = IN(I_NMIX) + l * 1024;
              for (int grp = gw; grp < M / 4; grp += NGW) norm_rows4<false>(xcur, gn, H, grp * 4, lane, nullptr, nullptr, nullptr, nullptr, nullptr, nullptr); }
        }
        GRID_BAR();
        }

        for (int rep_ = 0; rep_ < NREP(3); ++rep_) {
        if (PH(3)) {
            WSL();
            pg8::Gemm g{WP(bf16, WS_H), WP(bf16, WS_WIN), 1024, 1024, 1024}; pg8::StaticOrder S; S.init(M / 256, INC / 256, G, bid);
            EpiProj E{WP(bf16, WS_QK), WP(bf16, WS_VT8), WP(bf16, WS_AT), WP(bf16, WS_QX), WP(bf16, WS_GATES), IN(I_BGATE) + l * 3072};
            pg8::gemm_phase<EpiProj, pg8::StaticOrder>(F.lds, g, S, E, tid);
        }
        GRID_BAR();
        }

        for (int rep_ = 0; rep_ < NREP(4); ++rep_) {
        if (PH(4)) {
            WSL();
            { pg8::Gemm g{WP(bf16, WS_AT), WP(bf16, WS_S5W), ATK, 512, 512}; pg8::S5Order S; S.init(64, 1, G, bid); EpiS5a E{WP(float, WS_ST)};
              pg8::gemm_phase<EpiS5a, pg8::S5Order>(F.lds, g, S, E, tid); }
            bf16* QK = WP(bf16, WS_QK); bf16* VT8 = WP(bf16, WS_VT8); bf16* H = WP(bf16, WS_H); bf16* QX = WP(bf16, WS_QX); bf16* KM = WP(bf16, WS_KM); bf16* VM8 = WP(bf16, WS_VM8);
            const float* RPB = IN(I_RPB);
            for (int it = gw; it < 24576; it += NGW) {
                if (it < 16384) {
                    const int cb = it & 3, h = (it >> 2) & 7, r = (it >> 5) & 127, b = it >> 12;
                    const int t0 = b * SEQ + r * 64 + cb * 16, rs = min(max(r - 4, 0), 120), c_lo = cb == 0 ? 0 : (cb == 1 ? 8 : (cb == 2 ? 24 : 32));
                    attn_item<true>(QK + (size_t)t0 * 1024 + h * 64, 1024, QK + (size_t)b * SEQ * 1024 + 512 + h * 64, 1024, VT8 + (size_t)(b * 8 + h) * 1024 * 512, rs * 64 + c_lo, 64,
                                    H + (size_t)t0 * 1024 + h * 64, RPB + (size_t)(l * 8 + h) * 15 * 31, rs - r + 7, c_lo, cb * 16, lane);
                } else {
                    const int j = it - 16384, h = j & 3, t0 = (j >> 2) * 16, b = t0 >> 13;
                    attn_item<false>(QX + (size_t)t0 * 256 + h * 64, 256, KM + ((size_t)(l * 4 + b) * 256) * 256 + h * 64, 256, VM8 + (size_t)((l * 4 + b) * 4 + h) * 32 * 512, 0, 32,
                                     H + (size_t)t0 * 1024 + 768 + h * 64, nullptr, 0, 0, 0, lane);
                }
            }
        }
        GRID_BAR();
        }

        for (int rep_ = 0; rep_ < NREP(5); ++rep_) {
        if (PH(5)) {
            WSL();
            for (int it = bid; it < 128; it += G) s5_scan_item(it, WP(float, WS_ST), WP(bf16, WS_AT), WP(f32x2, WS_APOW) + (size_t)l * 2 * 16 * 33 * 64, (LAS float*)F.lds, tid);
        }
        GRID_BAR();
        }

        for (int rep_ = 0; rep_ < NREP(6); ++rep_) {
        if (PH(6)) {
            WSL();
            pg8::Gemm g{WP(bf16, WS_AT), WP(bf16, WS_S5KV), ATK, ATK, ATK}; pg8::S5Order S; S.init(64, 2, G, bid); EpiS5c E{WP(bf16, WS_Y)};
            pg8::gemm_phase<EpiS5c, pg8::S5Order>(F.lds, g, S, E, tid);
        }
        GRID_BAR();
        }

        for (int rep_ = 0; rep_ < NREP(7); ++rep_) {
        if (PH(7)) {
            WSL();
            pg8::Gemm g{WP(bf16, WS_Y), WP(bf16, WS_WGLU), 256, 256, 256}; pg8::StaticOrder S; S.init(M / 256, 2, G, bid); EpiGlu E{WP(bf16, WS_H)};
            pg8::gemm_phase<EpiGlu, pg8::StaticOrder>(F.lds, g, S, E, tid);
        }
        GRID_BAR();
        }

        for (int rep_ = 0; rep_ < NREP(8); ++rep_) {
        if (PH(8)) {
            WSL();
            pg8::Gemm g{WP(bf16, WS_H), WP(bf16, WS_WCAT), 1024, 1024, 1024}; pg8::StaticOrder S; S.init(M / 256, 4, G, bid); EpiMerge E{WP(bf16, WS_GATES), WP(bf16, WS_QK)};
            pg8::gemm_phase<EpiMerge, pg8::StaticOrder, false, true>(F.lds, g, S, E, tid);
        }
        GRID_BAR();
        }

        for (int rep_ = 0; rep_ < NREP(9); ++rep_) {
        if (PH(9)) {
            WSL();
            pg8::Gemm g{WP(bf16, WS_QK), WP(bf16, WS_WOUT), 1024, 1024, 1024}; pg8::StaticOrder S; S.init(M / 256, 4, G, bid); EpiRes E{xcur, rep_ ? WP(float, WS_GATES) : XO};
            pg8::gemm_phase<EpiRes, pg8::StaticOrder>(F.lds, g, S, E, tid);
        }
        xcur = XO;
        GRID_BAR();
        }

        for (int rep_ = 0; rep_ < NREP(10); ++rep_) {
        if (PH(10)) {
            WSL();
            {
            unsigned* cnt = WP(unsigned, WS_CTL) + CW_CNT + (l + 4 * rep_) * NBUCKET * 64;
            bf16* H = WP(bf16, WS_H); const float* gn = IN(I_NFFN) + l * 1024; const float* bco = IN(I_BCO) + l * 4; const float* bfi = IN(I_BFI) + l * 16;
            int* LIST = rep_ ? WP(int, WS_GATES + 100 * MiB) : WP(int, WS_LIST); float* WTS = rep_ ? WP(float, WS_GATES + 104 * MiB) : WP(float, WS_WTS);
            { const u32x4* src = (const u32x4*)(WP(bf16, WS_WRT) + (size_t)l * 2 * 20480);
              for (int idx = tid; idx < 40 * 128; idx += NWAVES * 64) *(LAS u32x4*)(F.lds + (idx >> 7) * RT_STRIDE + (idx & 127) * 16) = src[idx]; }
            __syncthreads();
            for (int grp = gw; grp < M / 16; grp += NGW) router_rows16(XO, gn, H, grp * 16, lane, F.lds, wave, bco, bfi, cnt, LIST, WTS);
            __syncthreads();
            }
            bf16* WGU = WP(bf16, WS_WGU); bf16* WDP = WP(bf16, WS_WDP);
            for (int it = gw; it < 10240; it += NGW) {
                int r = it;
                if (r < 2048) { const int e = r >> 7; transpose_job_item(IN(I_WG) + (size_t)(l * 16 + e) * 1024 * 256, 256, 256, r & 127, WGU + (size_t)e * 512 * 1024, 1024, 0, 0, 2, 0, 0, SCR(), lane); continue; } r -= 2048;
                if (r < 2048) { const int e = r >> 7; transpose_job_item(IN(I_WU) + (size_t)(l * 16 + e) * 1024 * 256, 256, 256, r & 127, WGU + (size_t)e * 512 * 1024, 1024, 0, 0, 2, 1, 0, SCR(), lane); continue; } r -= 2048;
                const int ej = r >> 7, e = ej / 3, jj = ej % 3, i = e & 3, grpI = e >> 2, o = jj + (jj >= i ? 1 : 0), a = i < o ? i : o, b = i < o ? o : i;
                const int pair = grpI * 6 + (a == 0 ? b - 1 : (a == 1 ? b + 1 : 5)), slot = (i == a) ? 0 : 1;
                transpose_job_item(IN(I_WD) + (size_t)(l * 16 + e) * 256 * 1024, 1024, 1024, r & 127, WDP + (size_t)pair * 1024 * 512, 512, slot * 256, 0, 1, 0, 0, SCR(), lane);
            }
        }
        GRID_BAR();
        }

        LAS int* tab = (LAS int*)(F.lds + TAB_OFF);
        for (int rep_ = 0; rep_ < NREP(11); ++rep_) {
        if (PH(11)) {
            WSL();
            unsigned* cnt = WP(unsigned, WS_CTL) + CW_CNT + l * NBUCKET * 64;
            if (tid == 0) { int st = 0;
                for (int b = 0; b < NBUCKET; ++b) { const int c = (int)__hip_atomic_load(cnt + b * 64, __ATOMIC_RELAXED, __HIP_MEMORY_SCOPE_AGENT); tab[b] = c; tab[32 + b] = st; st += (c + 255) >> 8; }
                tab[32 + NBUCKET] = st; tab[64] = st; }
            __syncthreads();
            pg8::Gemm g{WP(bf16, WS_H), WP(bf16, WS_WGU), 1024, 1024, 1024}; pg8::MoeOrder S{tab, WP(int, WS_LIST), G, bid, 0}; EpiMoe1 E{WP(bf16, WS_ACT), WP(float, WS_WTS)};
            pg8::gemm_phase<EpiMoe1, pg8::MoeOrder, true>(F.lds, g, S, E, tid);
        }
        GRID_BAR();
        }

        for (int rep_ = 0; rep_ < NREP(12); ++rep_) {
        if (PH(12)) {
            WSL();
            pg8::Gemm g{WP(bf16, WS_ACT), WP(bf16, WS_WDP), 512, 512, 512}; pg8::MoeOrder S{tab, WP(int, WS_LIST), G, bid, 1}; EpiMoe2 E{rep_ ? WP(float, WS_QK) : XO, WP(int, WS_LIST)};
            pg8::gemm_phase<EpiMoe2, pg8::MoeOrder>(F.lds, g, S, E, tid);
        }
        GRID_BAR();
        }
    }
    { WSL(); (void)wsl; const float* gn = IN(I_FNORM);
      for (int row = gw; row < M; row += NGW) final_norm_row(XO, gn, row, lane); }
#undef GRID_BAR
}

extern "C" void kernel_launch(void* const* d_in, const int* in_sizes, int n_in, void* d_out, int out_size, void* d_ws, size_t ws_size, hipStream_t stream) {
    static int grid = 0;
    if (grid == 0) {
        if (n_in != 30 || out_size != M * D || ws_size < WS_END) { fprintf(stderr, "kernel_launch: unexpected shapes (n_in %d, out %d, ws %zu)\n", n_in, out_size, ws_size); grid = -1; return; }
        int dev = 0, cus = 0, per_cu = 0;
        if (hipGetDevice(&dev) != hipSuccess || hipDeviceGetAttribute(&cus, hipDeviceAttributeMultiprocessorCount, dev) != hipSuccess) { grid = -1; return; }
        if (hipFuncSetAttribute((const void*)fwd_kernel, hipFuncAttributeMaxDynamicSharedMemorySize, LDS_BYTES) != hipSuccess) { fprintf(stderr, "kernel_launch: hipFuncSetAttribute failed\n"); grid = -1; return; }
        if (hipOccupancyMaxActiveBlocksPerMultiprocessor(&per_cu, (const void*)fwd_kernel, NWAVES * 64, LDS_BYTES) != hipSuccess || per_cu < 1) { fprintf(stderr, "kernel_launch: occupancy query reports %d\n", per_cu); }
        (void)hipGetLastError();
        grid = cus;
    }
    if (grid < 0) return;
    (void)in_sizes;
    hipMemsetAsync((char*)d_ws + WS_CTL, 0, CTL_BYTES, stream);
    Args a{};
    for (int i = 0; i < 30; ++i) a.in[i] = (const float*)d_in[i];
    a.out = (float*)d_out; a.ws = (unsigned char*)d_ws;
    hipLaunchKernelGGL(fwd_kernel, dim3(grid), dim3(NWAVES * 64), LDS_BYTES, stream, a);
}
```

```cpp
#include <hip/hip_runtime.h>
#include <cstdio>
#include <cstdint>

#define LAS __attribute__((address_space(3)))
typedef unsigned short bf16;
typedef short bf16x8 __attribute__((ext_vector_type(8)));
typedef float f32x4 __attribute__((ext_vector_type(4)));
typedef float f32x2 __attribute__((ext_vector_type(2)));
typedef unsigned u32x4 __attribute__((ext_vector_type(4)));
typedef unsigned u32x2 __attribute__((ext_vector_type(2)));

constexpr int D = 1024, BATCH = 4, SEQ = 8192, M = BATCH * SEQ, DEPTH = 4;
constexpr int INC = 5120, NMEM = 256;
constexpr int NCHUNK = 256, TCH = 32;
constexpr int ATK = 768;
constexpr int LCAP = 32768;
constexpr int NBUCKET = 24;
constexpr float RMS_EPS = 1e-6f;

constexpr size_t MiB = 1u << 20;
constexpr size_t WS_CTL = 0, CTL_BYTES = 1 * MiB;
constexpr size_t WS_APOW = 1 * MiB;
constexpr size_t WS_BBAR = 4 * MiB;
constexpr size_t WS_KT = 5 * MiB;
constexpr size_t WS_WRT = 10 * MiB;
constexpr size_t WS_RPBP = 10 * MiB + 512 * 1024;
constexpr size_t WS_MEMN = 11 * MiB;
constexpr size_t WS_WMKV = 19 * MiB;
constexpr size_t WS_KM = 23 * MiB;
constexpr size_t WS_VM8 = 25 * MiB;
constexpr size_t WS_WIN = 27 * MiB;
constexpr size_t WS_WCAT = 37 * MiB;
constexpr size_t WS_WOUT = 39 * MiB;
constexpr size_t WS_WGLU = 41 * MiB;
constexpr size_t WS_S5W = 42 * MiB;
constexpr size_t WS_S5KV = 46 * MiB;
constexpr size_t WS_H = 58 * MiB;
constexpr size_t WS_QK = 122 * MiB;
constexpr size_t WS_VT8 = 186 * MiB;
constexpr size_t WS_AT = 218 * MiB;
constexpr size_t WS_QX = 242 * MiB;
constexpr size_t WS_ST = 258 * MiB;
constexpr size_t WS_Y = 274 * MiB;
constexpr size_t WS_GATES = 290 * MiB;
constexpr size_t WS_WGU = WS_GATES;
constexpr size_t WS_WDP = WS_GATES + 16 * MiB;
constexpr size_t WS_ACT = WS_GATES + 40 * MiB;
constexpr size_t WS_LIST = 482 * MiB;
constexpr size_t WS_WTS = 485 * MiB;
constexpr size_t WS_END = 491 * MiB;
constexpr int CW_BAR = 4096;
constexpr int CW_CNT = 16384;

__device__ __forceinline__ unsigned cvt_pk_bf16(float lo, float hi) { unsigned r; asm volatile("v_cvt_pk_bf16_f32 %0, %1, %2" : "=v"(r) : "v"(lo), "v"(hi)); return r; }
__device__ __forceinline__ float bf2f(unsigned short b) { return __uint_as_float(((unsigned)b) << 16); }
__device__ __forceinline__ float bflo(unsigned w) { return __uint_as_float(w << 16); }
__device__ __forceinline__ float bfhi(unsigned w) { return __uint_as_float(w & 0xffff0000u); }
__device__ __forceinline__ float fast_rcp(float x) { return __builtin_amdgcn_rcpf(x); }
__device__ __forceinline__ float fast_exp(float x) { return __builtin_amdgcn_exp2f(x * 1.4426950408889634f); }
__device__ __forceinline__ float sigmoid_f(float x) { return fast_rcp(1.0f + fast_exp(-x)); }
__device__ __forceinline__ float gelu_tanh_f(float x) { const float u = 1.5957691216057308f * (x + 0.044715f * x * x * x); return x * fast_rcp(1.0f + fast_exp(-u)); }
__device__ __forceinline__ float shfl_xor_f(float v, int o, int lane) { return __int_as_float(__builtin_amdgcn_ds_bpermute((lane ^ o) << 2, __float_as_int(v))); }
__device__ __forceinline__ float shfl_idx_f(float v, int src) { return __int_as_float(__builtin_amdgcn_ds_bpermute(src << 2, __float_as_int(v))); }
__device__ __forceinline__ float wave_sum(float v, int lane) {
#pragma unroll
    for (int o = 1; o < 64; o <<= 1) v += shfl_xor_f(v, o, lane);
    return v;
}
#define LDS_WAIT() asm volatile("s_waitcnt lgkmcnt(0)" ::: "memory")
#define VM_WAIT() asm volatile("s_waitcnt vmcnt(0)" ::: "memory")

namespace pg8 {
constexpr int BM = 256, BK = 64, HALF = 128, HTB = HALF * BK * 2, STAGE_BYTES = 8 * HTB, NXCD = 8, WGM = 8;
__host__ __device__ __forceinline__ int lds_byte(int r, int c) { const int st = (r >> 4) * 2 + (c >> 5), rr = r & 15, cc = c & 31, ob = rr * 64 + cc * 2; return st * 1024 + (ob ^ (((ob >> 9) & 1) << 5)); }
__host__ __device__ __forceinline__ void stage_rc(int b, int& R, int& C) { const int st = b / 1024, sb = b % 1024, swz = sb ^ (((sb >> 9) & 1) << 5); R = (st >> 1) * 16 + swz / 64; C = (st & 1) * 32 + (swz % 64) / 2; }
__host__ __device__ __forceinline__ int perm32(int rho) { const int n = rho >> 4, i = rho & 15; return 8 * (i >> 2) + 4 * n + (i & 3); }

struct Unit { int pm, pn, am, bn, x0, x1, x2; };
struct Gemm { const bf16* A; const bf16* Bt; int lda, ldb, K; };

struct StaticOrder {
    int nM, nN, nwg, G, c;
    __device__ void init(int nM_, int nN_, int G_, int c_) { nM = nM_; nN = nN_; nwg = nM * nN; G = G_; c = c_; }
    __device__ bool next(int i, Unit& u) const {
        const long L = (long)i * G + c; if (L >= nwg) return false;
        int wgid = (int)L; { const int q = nwg / NXCD, r = nwg % NXCD, xcd = wgid % NXCD, off = wgid / NXCD; wgid = (xcd < r ? xcd * (q + 1) : r * (q + 1) + (xcd - r) * q) + off; }
        const int nig = WGM * nN, gid = wgid / nig, fm = gid * WGM, gsz = (nM - fm) < WGM ? (nM - fm) : WGM;
        u.pm = __builtin_amdgcn_readfirstlane(fm + ((wgid % nig) % gsz)); u.pn = __builtin_amdgcn_readfirstlane((wgid % nig) / gsz);
        u.am = u.pm; u.bn = u.pn; u.x0 = 0; u.x1 = 0; u.x2 = 0; return true;
    }
    __device__ __forceinline__ int a_row(const Unit&, int) const { return 0; }
};
struct S5Order : StaticOrder {
    __device__ bool next(int i, Unit& u) const { if (!StaticOrder::next(i, u)) return false; u.bn = (u.pm & 15) * nN + u.pn; return true; }
};
struct MemOrder {
    int G, c;
    __device__ bool next(int i, Unit& u) const { const int L = i * G + c; if (L >= 32) return false; u.pm = L >> 1; u.pn = L & 1; u.am = u.pm; u.bn = (u.pm >> 2) * 2 + u.pn; u.x0 = 0; u.x1 = 0; u.x2 = 0; return true; }
    __device__ __forceinline__ int a_row(const Unit&, int) const { return 0; }
};
struct MoeOrder {
    const LAS int* tab; const int* list; int G, c, mode;
    __device__ bool next(int i, Unit& u) const {
        const int T = __builtin_amdgcn_readfirstlane(tab[64]); const int L = i * G + c; if (L >= T * 4) return false;
        const int tile = L >> 2, pn = L & 3; int b = 0;
#pragma unroll 1
        for (int j = 1; j < NBUCKET; ++j) if (__builtin_amdgcn_readfirstlane(tab[32 + j]) <= tile) b = j;
        u.pm = tile; u.pn = pn; u.am = tile; u.x0 = b; u.x1 = (tile - __builtin_amdgcn_readfirstlane(tab[32 + b])) * 256; u.x2 = __builtin_amdgcn_readfirstlane(tab[b]);
        const int grp = __builtin_amdgcn_readfirstlane(b / 6), pi = __builtin_amdgcn_readfirstlane(b % 6); const int ea = pi < 3 ? 0 : (pi < 5 ? 1 : 2), eb = pi < 3 ? pi + 1 : (pi < 5 ? pi - 1 : 3);
        if (mode == 0) { const int e = grp * 4 + ((pn >> 1) ? eb : ea); u.bn = e * 2 + (pn & 1); } else u.bn = b * 4 + pn;
        return true;
    }
    __device__ __forceinline__ int a_row(const Unit& u, int r) const { const int slot = u.x1 + r; return slot < u.x2 ? list[u.x0 * LCAP + slot] : 0; }
};

template <class Epi, class Sched, bool GATHER = false, bool KHOOK = false>
__device__ __forceinline__ void gemm_phase(LAS unsigned char* lds, const Gemm g, const Sched& S, const Epi& E, int tid_in) {
    int tid = tid_in; asm volatile("" : "+v"(tid));
    const int wid = __builtin_amdgcn_readfirstlane(tid >> 6), lane = tid & 63, wr = wid >> 2, wc = wid & 3, fr = lane & 15, fq = lane >> 4;
    int K = g.K, lda = g.lda, ldb = g.ldb;
    asm volatile("" : "+s"(K), "+s"(lda), "+s"(ldb));
    const int nt = K / BK;
    unsigned voffA[2], voffB[2]; int Rr[2], Cc[2];
#pragma unroll
    for (int i = 0; i < 2; ++i) { int R, C; stage_rc(tid * 16 + i * 8192, R, C); const int Rb = Epi::PERM ? ((R & ~31) + perm32(R & 31)) : R;
        voffA[i] = (unsigned)(R * lda + C) * 2u; voffB[i] = (unsigned)(Rb * ldb + C) * 2u; Rr[i] = R; Cc[i] = C; }
    const unsigned kstep = (unsigned)(BK * 2);
    const unsigned hstepA = (unsigned)(HALF * lda * 2), tstepA = 2u * hstepA, hstepB = (unsigned)(HALF * ldb * 2), tstepB = 2u * hstepB;
    const unsigned ldsw = (unsigned)wid * 1024u;
    const int aoff = lds_byte(wr * 64 + fr, fq * 8), boff = lds_byte(wc * 32 + fr, fq * 8);
    unsigned vC[2][2] = {{0u, 0u}, {0u, 0u}}, vN[2][2] = {{0u, 0u}, {0u, 0u}};
#define PG8_SA(b, h) (((b) * 2 + (h)) * HTB)
#define PG8_SB(b, h) ((4 + (b) * 2 + (h)) * HTB)
#define PG8_STAGE(bufoff, gbase, voff) do { _Pragma("unroll") for (int _i = 0; _i < 2; ++_i) \
        __builtin_amdgcn_global_load_lds((const unsigned*)((const char*)(gbase) + (voff)[_i]), (LAS unsigned*)(lds + (bufoff) + ldsw + _i * 8192), 16, 0, 0); } while (0)
#define PG8_STA(bufoff, ptr, h, nx) do { if constexpr (GATHER) { unsigned _v[2]; _v[0] = (nx) ? vN[h][0] : vC[h][0]; _v[1] = (nx) ? vN[h][1] : vC[h][1]; PG8_STAGE(bufoff, ptr, _v); } \
        else { PG8_STAGE(bufoff, (ptr) + (h) * hstepA, voffA); } } while (0)
#define PG8_STB(bufoff, ptr, h) PG8_STAGE(bufoff, (ptr) + (h) * hstepB, voffB)
#define PG8_LDA(dst, b, h) do { _Pragma("unroll") for (int m = 0; m < 4; ++m) _Pragma("unroll") for (int k = 0; k < 2; ++k) dst[m][k] = *(const LAS bf16x8*)(lds + PG8_SA(b, h) + aoff + m * 2048 + k * 1024); } while (0)
#define PG8_LDB(dst, b, h) do { _Pragma("unroll") for (int n = 0; n < 2; ++n) _Pragma("unroll") for (int k = 0; k < 2; ++k) dst[n][k] = *(const LAS bf16x8*)(lds + PG8_SB(b, h) + boff + n * 2048 + k * 1024); } while (0)
#define PG8_MMA(ai, bj, At, Bt) do { __builtin_amdgcn_s_setprio(1); _Pragma("unroll") for (int m = 0; m < 4; ++m) _Pragma("unroll") for (int n = 0; n < 2; ++n) _Pragma("unroll") for (int k = 0; k < 2; ++k) \
        acc[ai][bj][m][n] = __builtin_amdgcn_mfma_f32_16x16x32_bf16(Bt[n][k], At[m][k], acc[ai][bj][m][n], 0, 0, 0); __builtin_amdgcn_s_setprio(0); } while (0)
#define PG8_WAIT_V(n) asm volatile("s_waitcnt vmcnt(" #n ")" ::: "memory")
#define PG8_WAIT_L(n) asm volatile("s_waitcnt lgkmcnt(" #n ")" ::: "memory")
#define PG8_BAR __builtin_amdgcn_s_barrier()
#define PG8_SCHED __builtin_amdgcn_sched_barrier(0)
    Unit cur, nxt; int ui = 0;
    if (!S.next(0, cur)) return;
    f32x4 acc[2][2][4][2];
#pragma unroll
    for (int a = 0; a < 2; ++a)
#pragma unroll
        for (int b = 0; b < 2; ++b)
#pragma unroll
            for (int m = 0; m < 4; ++m)
#pragma unroll
                for (int n = 0; n < 2; ++n) acc[a][b][m][n] = (f32x4){0.f, 0.f, 0.f, 0.f};
    bf16x8 At[4][2], B0[2][2], B1[2][2];
    const char* cA = GATHER ? (const char*)g.A : (const char*)g.A + (unsigned)cur.am * tstepA;
    const char* cB = (const char*)g.Bt + (unsigned)cur.bn * tstepB;
    if constexpr (GATHER) {
#pragma unroll
        for (int h = 0; h < 2; ++h)
#pragma unroll
            for (int i = 0; i < 2; ++i) vC[h][i] = (unsigned)(S.a_row(cur, h * HALF + Rr[i]) * lda + Cc[i]) * 2u;
    }
    PG8_STB(PG8_SB(0, 0), cB, 0); PG8_STB(PG8_SB(0, 1), cB, 1); PG8_STA(PG8_SA(0, 0), cA, 0, false); PG8_STA(PG8_SA(0, 1), cA, 1, false);
    if (wr == 1) PG8_BAR;
    PG8_WAIT_V(2); PG8_BAR;
    PG8_STB(PG8_SB(1, 0), cB + kstep, 0); PG8_STA(PG8_SA(1, 0), cA + kstep, 0, false); PG8_STB(PG8_SB(1, 1), cB + kstep, 1);
    PG8_WAIT_V(6); PG8_BAR;
    for (;;) {
        const bool has_next = S.next(ui + 1, nxt);
        const char* nA = GATHER ? (const char*)g.A : (has_next ? (const char*)g.A + (unsigned)nxt.am * tstepA : cA);
        const char* nB = has_next ? (const char*)g.Bt + (unsigned)nxt.bn * tstepB : cB;
        if constexpr (GATHER) {
#pragma unroll
            for (int h = 0; h < 2; ++h)
#pragma unroll
                for (int i = 0; i < 2; ++i) vN[h][i] = has_next ? (unsigned)(S.a_row(nxt, h * HALF + Rr[i]) * lda + Cc[i]) * 2u : vC[h][i];
        }
        int tb = 0;
#pragma unroll 1
        for (int seg = 0; seg < (KHOOK ? 3 : 1); ++seg) {
        const int te = KHOOK ? (seg == 0 ? 8 : (seg == 1 ? 12 : nt)) : nt;
        for (int t = tb; t < te; t += 2) {
            const bool last = (t == nt - 2);
            const char* a1 = cA + (unsigned)(t + 1) * kstep;
            const char* a2 = last ? nA : cA + (unsigned)(t + 2) * kstep; const char* b2 = last ? nB : cB + (unsigned)(t + 2) * kstep;
            const char* a3 = a2 + kstep; const char* b3 = b2 + kstep;
            PG8_LDB(B0, 0, 0); PG8_LDB(B1, 0, 1); PG8_SCHED; PG8_LDA(At, 0, 0); PG8_STA(PG8_SA(1, 1), a1, 1, false);
            PG8_WAIT_V(8); PG8_WAIT_L(0); PG8_BAR; PG8_MMA(0, 0, At, B0); PG8_MMA(0, 1, At, B1); PG8_BAR; PG8_SCHED;
            PG8_LDA(At, 0, 1); PG8_STB(PG8_SB(0, 0), b2, 0); PG8_STB(PG8_SB(0, 1), b2, 1); PG8_STA(PG8_SA(0, 0), a2, 0, last);
            PG8_WAIT_V(8); PG8_WAIT_L(0); PG8_BAR; PG8_MMA(1, 0, At, B0); PG8_MMA(1, 1, At, B1); PG8_BAR; PG8_SCHED;
            PG8_LDB(B0, 1, 0); PG8_LDB(B1, 1, 1); PG8_SCHED; PG8_LDA(At, 1, 0); PG8_STA(PG8_SA(0, 1), a2, 1, last);
            PG8_WAIT_V(8); PG8_WAIT_L(0); PG8_BAR; PG8_MMA(0, 0, At, B0); PG8_MMA(0, 1, At, B1); PG8_BAR; PG8_SCHED;
            PG8_LDA(At, 1, 1); PG8_STB(PG8_SB(1, 0), b3, 0); PG8_STB(PG8_SB(1, 1), b3, 1); PG8_STA(PG8_SA(1, 0), a3, 0, last);
            PG8_WAIT_V(8); PG8_WAIT_L(0); PG8_BAR; PG8_MMA(1, 0, At, B0); PG8_MMA(1, 1, At, B1); PG8_BAR; PG8_SCHED;
        }
        if constexpr (KHOOK) { if (seg < 2) { int fr_ = fr, fq_ = fq; asm volatile("" : "+v"(fr_), "+v"(fq_)); E.khook(acc, cur, te, wr, wc, fr_, fq_); } }
        tb = te;
        }
        if (wr == 0) PG8_BAR;
        { int fr_ = fr, fq_ = fq; asm volatile("" : "+v"(fr_), "+v"(fq_)); E(acc, cur, wr, wc, fr_, fq_); }
        if (!has_next) break;
#pragma unroll
        for (int a = 0; a < 2; ++a)
#pragma unroll
            for (int b = 0; b < 2; ++b)
#pragma unroll
                for (int m = 0; m < 4; ++m)
#pragma unroll
                    for (int n = 0; n < 2; ++n) acc[a][b][m][n] = (f32x4){0.f, 0.f, 0.f, 0.f};
        cur = nxt; cA = nA; cB = nB; ++ui;
        if constexpr (GATHER) {
#pragma unroll
            for (int h = 0; h < 2; ++h)
#pragma unroll
                for (int i = 0; i < 2; ++i) vC[h][i] = vN[h][i];
        }
        if (wr == 1) PG8_BAR;
    }
    PG8_WAIT_V(0);
    PG8_BAR;
#undef PG8_SA
#undef PG8_SB
#undef PG8_STAGE
#undef PG8_STA
#undef PG8_STB
#undef PG8_LDA
#undef PG8_LDB
#undef PG8_MMA
#undef PG8_WAIT_V
#undef PG8_WAIT_L
#undef PG8_BAR
#undef PG8_SCHED
}
}

using pg8::Unit;
struct EpiProj {
    static constexpr bool PERM = true;
    bf16 *QK, *Vt8, *At, *QX, *GATES; const float* bgate;
#define EP_LOOP_BEGIN _Pragma("unroll") for (int ai = 0; ai < 2; ++ai) _Pragma("unroll") for (int m = 0; m < 4; ++m) { const int row = row0 + ai * 128 + m * 16; _Pragma("unroll") for (int bj = 0; bj < 2; ++bj) { \
        const f32x4 v0 = acc[ai][bj][m][0], v1 = acc[ai][bj][m][1]; const int cl = cl0 + bj * 128;
#define EP_LOOP_END } asm volatile("" ::: "memory"); }
    __device__ __forceinline__ void operator()(const f32x4 (&acc)[2][2][4][2], const Unit& u, int wr, int wc, int fr, int fq) const {
        const int pn = u.pn, row0 = u.pm * 256 + wr * 64 + fr, cl0 = wc * 32 + 8 * fq;
        if (pn < 4) {
            EP_LOOP_BEGIN
                u32x4 w; w.x = cvt_pk_bf16(v0[0], v0[1]); w.y = cvt_pk_bf16(v0[2], v0[3]); w.z = cvt_pk_bf16(v1[0], v1[1]); w.w = cvt_pk_bf16(v1[2], v1[3]);
                *(u32x4*)(QK + (unsigned)row * 1024 + pn * 256 + cl) = w;
            EP_LOOP_END
        } else if (pn < 6) {
            EP_LOOP_BEGIN
                const int vc = (pn - 4) * 256 + cl, hh = vc >> 6, dh = vc & 63, b = row >> 13, s = row & 8191;
                bf16* p = Vt8 + ((unsigned)((b * 8 + hh) * 1024 + (s >> 3)) * 64 + dh) * 8 + (s & 7);
                const unsigned w0 = cvt_pk_bf16(v0[0], v0[1]), w1 = cvt_pk_bf16(v0[2], v0[3]), w2 = cvt_pk_bf16(v1[0], v1[1]), w3 = cvt_pk_bf16(v1[2], v1[3]);
                p[0] = (bf16)w0; p[8] = (bf16)(w0 >> 16); p[16] = (bf16)w1; p[24] = (bf16)(w1 >> 16); p[32] = (bf16)w2; p[40] = (bf16)(w2 >> 16); p[48] = (bf16)w3; p[56] = (bf16)(w3 >> 16);
            EP_LOOP_END
        } else if (pn == 6) {
            EP_LOOP_BEGIN
                const int g = cl >> 4, c0 = cl & 15, b = row >> 13, s = row & 8191;
                u32x4 w; w.x = cvt_pk_bf16(v0[0], v0[1]); w.y = cvt_pk_bf16(v0[2], v0[3]); w.z = cvt_pk_bf16(v1[0], v1[1]); w.w = cvt_pk_bf16(v1[2], v1[3]);
                *(u32x4*)(At + ((unsigned)((b * 16 + g) * 256 + (s >> 5))) * ATK + (s & 31) * 16 + c0) = w;
            EP_LOOP_END
        } else if (pn == 7) {
            EP_LOOP_BEGIN
                u32x4 w; w.x = cvt_pk_bf16(v0[0], v0[1]); w.y = cvt_pk_bf16(v0[2], v0[3]); w.z = cvt_pk_bf16(v1[0], v1[1]); w.w = cvt_pk_bf16(v1[2], v1[3]);
                *(u32x4*)(QX + (unsigned)row * 256 + cl) = w;
            EP_LOOP_END
        } else {
            EP_LOOP_BEGIN
                const int gc = (pn - 8) * 256 + cl;
                const f32x4 b0 = *(const f32x4*)(bgate + gc), b1 = *(const f32x4*)(bgate + gc + 4);
                u32x4 w; w.x = cvt_pk_bf16(sigmoid_f(v0[0] + b0[0]), sigmoid_f(v0[1] + b0[1])); w.y = cvt_pk_bf16(sigmoid_f(v0[2] + b0[2]), sigmoid_f(v0[3] + b0[3]));
                w.z = cvt_pk_bf16(sigmoid_f(v1[0] + b1[0]), sigmoid_f(v1[1] + b1[1])); w.w = cvt_pk_bf16(sigmoid_f(v1[2] + b1[2]), sigmoid_f(v1[3] + b1[3]));
                *(u32x4*)(GATES + (unsigned)row * 3072 + gc) = w;
            EP_LOOP_END
        }
    }
#undef EP_LOOP_BEGIN
#undef EP_LOOP_END
};
struct EpiMemKV {
    static constexpr bool PERM = true;
    bf16 *Km, *Vm8;
    __device__ __forceinline__ void operator()(const f32x4 (&acc)[2][2][4][2], const Unit& u, int wr, int wc, int fr, int fq) const {
        const int row0 = u.pm * 256 + wr * 64 + fr, cl0 = wc * 32 + 8 * fq;
#pragma unroll
        for (int ai = 0; ai < 2; ++ai)
#pragma unroll
            for (int m = 0; m < 4; ++m) {
                const int row = row0 + ai * 128 + m * 16;
#pragma unroll
                for (int bj = 0; bj < 2; ++bj) {
                    const f32x4 v0 = acc[ai][bj][m][0], v1 = acc[ai][bj][m][1];
                    const int cl = cl0 + bj * 128;
                    const unsigned w0 = cvt_pk_bf16(v0[0], v0[1]), w1 = cvt_pk_bf16(v0[2], v0[3]), w2 = cvt_pk_bf16(v1[0], v1[1]), w3 = cvt_pk_bf16(v1[2], v1[3]);
                    if (u.pn == 0) { u32x4 w; w.x = w0; w.y = w1; w.z = w2; w.w = w3; *(u32x4*)(Km + (unsigned)row * 256 + cl) = w; }
                    else {
                        const int hh = cl >> 6, dh = cl & 63, lb = row >> 8, mm = row & 255;
                        bf16* p = Vm8 + ((unsigned)((lb * 4 + hh) * 32 + (mm >> 3)) * 64 + dh) * 8 + (mm & 7);
                        p[0] = (bf16)w0; p[8] = (bf16)(w0 >> 16); p[16] = (bf16)w1; p[24] = (bf16)(w1 >> 16); p[32] = (bf16)w2; p[40] = (bf16)(w2 >> 16); p[48] = (bf16)w3; p[56] = (bf16)(w3 >> 16);
                    }
                }
                asm volatile("" ::: "memory");
            }
    }
};
struct EpiS5a {
    static constexpr bool PERM = false;
    float* ST;
    __device__ __forceinline__ void operator()(const f32x4 (&acc)[2][2][4][2], const Unit& u, int wr, int wc, int fr, int fq) const {
        const int row0 = u.am * 256 + wr * 64 + fr, col0 = wc * 32 + 4 * fq;
#pragma unroll
        for (int ai = 0; ai < 2; ++ai)
#pragma unroll
            for (int m = 0; m < 4; ++m) { float* rowp = ST + (unsigned)(row0 + ai * 128 + m * 16) * 256 + col0;
#pragma unroll
                for (int bj = 0; bj < 2; ++bj)
#pragma unroll
                    for (int n = 0; n < 2; ++n) *(f32x4*)(rowp + bj * 128 + n * 16) = acc[ai][bj][m][n];
                asm volatile("" ::: "memory"); }
    }
};
struct EpiS5c {
    static constexpr bool PERM = true;
    bf16* Y;
    __device__ __forceinline__ void operator()(const f32x4 (&acc)[2][2][4][2], const Unit& u, int wr, int wc, int fr, int fq) const {
        const int b = u.am >> 4, g = u.am & 15, r0 = wr * 64 + fr, cl0 = u.pn * 256 + wc * 32 + 8 * fq;
#pragma unroll
        for (int ai = 0; ai < 2; ++ai)
#pragma unroll
            for (int m = 0; m < 4; ++m) {
                const int chunk = r0 + ai * 128 + m * 16;
#pragma unroll
                for (int bj = 0; bj < 2; ++bj) {
                    const f32x4 v0 = acc[ai][bj][m][0], v1 = acc[ai][bj][m][1];
                    const int col = cl0 + bj * 128, t = col >> 4, c0 = col & 15;
                    u32x4 w; w.x = cvt_pk_bf16(gelu_tanh_f(v0[0]), gelu_tanh_f(v0[1])); w.y = cvt_pk_bf16(gelu_tanh_f(v0[2]), gelu_tanh_f(v0[3]));
                    w.z = cvt_pk_bf16(gelu_tanh_f(v1[0]), gelu_tanh_f(v1[1])); w.w = cvt_pk_bf16(gelu_tanh_f(v1[2]), gelu_tanh_f(v1[3]));
                    *(u32x4*)(Y + (unsigned)(b * SEQ + chunk * 32 + t) * 256 + g * 16 + c0) = w;
                }
                asm volatile("" ::: "memory");
            }
    }
};
struct EpiGlu {
    static constexpr bool PERM = true;
    bf16* CAT;
    __device__ __forceinline__ void operator()(const f32x4 (&acc)[2][2][4][2], const Unit& u, int wr, int wc, int fr, int fq) const {
        const int row0 = u.pm * 256 + wr * 64 + fr, cl0 = u.pn * 256 + wc * 32 + 8 * fq;
#pragma unroll
        for (int ai = 0; ai < 2; ++ai)
#pragma unroll
            for (int m = 0; m < 4; ++m) {
                const int row = row0 + ai * 128 + m * 16;
#pragma unroll
                for (int bj = 0; bj < 2; ++bj) {
                    const f32x4 v0 = acc[ai][bj][m][0], v1 = acc[ai][bj][m][1];
                    const int col = cl0 + bj * 128;
                    u32x2 w; w.x = cvt_pk_bf16(v0[0] * sigmoid_f(v0[1]), v0[2] * sigmoid_f(v0[3])); w.y = cvt_pk_bf16(v1[0] * sigmoid_f(v1[1]), v1[2] * sigmoid_f(v1[3]));
                    *(u32x2*)(CAT + (unsigned)row * 1024 + 512 + (col >> 1)) = w;
                }
                asm volatile("" ::: "memory");
            }
    }
};
struct EpiMerge {
    static constexpr bool PERM = true;
    const bf16* GATES; bf16* MG;
    __device__ __forceinline__ void khook(f32x4 (&acc)[2][2][4][2], const Unit& u, int t, int wr, int wc, int fr, int fq) const {
        const int row0 = u.pm * 256 + wr * 64 + fr, cl0 = u.pn * 256 + wc * 32 + 8 * fq;
        const int ga = (t == 8) ? 0 : 1024;
#pragma unroll
        for (int ai = 0; ai < 2; ++ai)
#pragma unroll
            for (int m = 0; m < 4; ++m) {
                const int row = row0 + ai * 128 + m * 16;
#pragma unroll
                for (int bj = 0; bj < 2; ++bj) {
                    const bf16* gp = GATES + (unsigned)row * 3072 + ga + cl0 + bj * 128;
                    const u32x4 na = *(const u32x4*)gp, nb = *(const u32x4*)(gp + 1024);
                    f32x4 r0, r1;
                    r0[0] = bflo(na.x) * fast_rcp(bflo(nb.x)); r0[1] = bfhi(na.x) * fast_rcp(bfhi(nb.x)); r0[2] = bflo(na.y) * fast_rcp(bflo(nb.y)); r0[3] = bfhi(na.y) * fast_rcp(bfhi(nb.y));
                    r1[0] = bflo(na.z) * fast_rcp(bflo(nb.z)); r1[1] = bfhi(na.z) * fast_rcp(bfhi(nb.z)); r1[2] = bflo(na.w) * fast_rcp(bflo(nb.w)); r1[3] = bfhi(na.w) * fast_rcp(bfhi(nb.w));
                    acc[ai][bj][m][0] *= r0; acc[ai][bj][m][1] *= r1;
                }
                asm volatile("" ::: "memory");
            }
    }
    __device__ __forceinline__ void operator()(const f32x4 (&acc)[2][2][4][2], const Unit& u, int wr, int wc, int fr, int fq) const {
        const int row0 = u.pm * 256 + wr * 64 + fr, cl0 = u.pn * 256 + wc * 32 + 8 * fq;
#pragma unroll
        for (int ai = 0; ai < 2; ++ai)
#pragma unroll
            for (int m = 0; m < 4; ++m) {
                const int row = row0 + ai * 128 + m * 16;
#pragma unroll
                for (int bj = 0; bj < 2; ++bj) {
                    const u32x4 g2 = *(const u32x4*)(GATES + (unsigned)row * 3072 + 2048 + cl0 + bj * 128);
                    const f32x4 v0 = acc[ai][bj][m][0], v1 = acc[ai][bj][m][1];
                    u32x4 w; w.x = cvt_pk_bf16(v0[0] * bflo(g2.x), v0[1] * bfhi(g2.x)); w.y = cvt_pk_bf16(v0[2] * bflo(g2.y), v0[3] * bfhi(g2.y));
                    w.z = cvt_pk_bf16(v1[0] * bflo(g2.z), v1[1] * bfhi(g2.z)); w.w = cvt_pk_bf16(v1[2] * bflo(g2.w), v1[3] * bfhi(g2.w));
                    *(u32x4*)(MG + (unsigned)row * 1024 + cl0 + bj * 128) = w;
                }
                asm volatile("" ::: "memory");
            }
    }
};
struct EpiRes {
    static constexpr bool PERM = false;
    const float* base; float* out;
    __device__ __forceinline__ void operator()(const f32x4 (&acc)[2][2][4][2], const Unit& u, int wr, int wc, int fr, int fq) const {
        const int row0 = u.pm * 256 + wr * 64 + fr, col0 = u.pn * 256 + wc * 32 + 4 * fq;
#pragma unroll
        for (int ai = 0; ai < 2; ++ai)
#pragma unroll
            for (int m = 0; m < 4; ++m) { const size_t off = (unsigned)(row0 + ai * 128 + m * 16) * 1024 + col0;
#pragma unroll
                for (int bj = 0; bj < 2; ++bj)
#pragma unroll
                    for (int n = 0; n < 2; ++n) { const f32x4 bs = *(const f32x4*)(base + off + bj * 128 + n * 16); *(f32x4*)(out + off + bj * 128 + n * 16) = bs + acc[ai][bj][m][n]; }
                asm volatile("" ::: "memory"); }
    }
};
struct EpiMoe1 {
    static constexpr bool PERM = true;
    bf16* ACT; const float* wts;
    __device__ __forceinline__ void operator()(const f32x4 (&acc)[2][2][4][2], const Unit& u, int wr, int wc, int fr, int fq) const {
        const int r0 = wr * 64 + fr, cl0 = wc * 32 + 8 * fq, es = u.pn >> 1;
#pragma unroll
        for (int ai = 0; ai < 2; ++ai)
#pragma unroll
            for (int m = 0; m < 4; ++m) {
                const int r = r0 + ai * 128 + m * 16, slot = u.x1 + r;
                const float w = slot < u.x2 ? wts[((unsigned)u.x0 * LCAP + slot) * 2 + es] : 0.f;
#pragma unroll
                for (int bj = 0; bj < 2; ++bj) {
                    const f32x4 v0 = acc[ai][bj][m][0], v1 = acc[ai][bj][m][1];
                    const int col = cl0 + bj * 128;
                    u32x2 o; o.x = cvt_pk_bf16(v0[0] * sigmoid_f(v0[0]) * v0[1] * w, v0[2] * sigmoid_f(v0[2]) * v0[3] * w); o.y = cvt_pk_bf16(v1[0] * sigmoid_f(v1[0]) * v1[1] * w, v1[2] * sigmoid_f(v1[2]) * v1[3] * w);
                    *(u32x2*)(ACT + (unsigned)(u.pm * 256 + r) * 512 + es * 256 + (u.pn & 1) * 128 + (col >> 1)) = o;
                }
                asm volatile("" ::: "memory");
            }
    }
};
struct EpiMoe2 {
    static constexpr bool PERM = false;
    float* X; const int* list;
    __device__ __forceinline__ void operator()(const f32x4 (&acc)[2][2][4][2], const Unit& u, int wr, int wc, int fr, int fq) const {
        const int r0 = wr * 64 + fr, col0 = u.pn * 256 + wc * 32 + 4 * fq;
#pragma unroll
        for (int ai = 0; ai < 2; ++ai)
#pragma unroll
            for (int m = 0; m < 4; ++m) {
                const int r = r0 + ai * 128 + m * 16, slot = u.x1 + r;
                if (slot < u.x2) {
                    const int tok = list[(unsigned)u.x0 * LCAP + slot];
                    float* xp = X + (unsigned)tok * 1024 + col0;
#pragma unroll
                    for (int bj = 0; bj < 2; ++bj)
#pragma unroll
                        for (int n = 0; n < 2; ++n) { const f32x4 bs = *(const f32x4*)(xp + bj * 128 + n * 16); *(f32x4*)(xp + bj * 128 + n * 16) = bs + acc[ai][bj][m][n]; }
                }
                asm volatile("" ::: "memory");
            }
    }
};

#define XB_TMO      128
#define XB_XCNT(j)  (256  + 64 * (j))
#define XB_XSUB(j)  (1280 + 64 * (j))
#define XB_XGEN(j)  (2304 + 64 * (j))
#define XB_TOP      3328
#define XB_TOPGEN   3392
#define XCD_BAR_WORDS 3456
#define XB_SPIN_CAP (1u << 18)
__device__ __forceinline__ unsigned xb_ld(unsigned* p)              { return __hip_atomic_load(p, __ATOMIC_RELAXED, __HIP_MEMORY_SCOPE_AGENT); }
__device__ __forceinline__ unsigned xb_add(unsigned* p, unsigned v) { return __hip_atomic_fetch_add(p, v, __ATOMIC_RELAXED, __HIP_MEMORY_SCOPE_AGENT); }
__device__ __forceinline__ unsigned xb_xcc_id() { return (unsigned)__builtin_amdgcn_s_getreg((3 << 11) | 20) & 0xFu; }
#define XB_SPIN(cond, bar) do { unsigned _sp = 0; while (cond) { __builtin_amdgcn_s_sleep(1); \
    if ((++_sp & 255u) == 0u) { if (xb_ld(&(bar)[XB_TMO])) break; if (_sp > XB_SPIN_CAP) { atomicAdd(&(bar)[XB_TMO], 1u); break; } } } } while (0)
struct XcdBarrier { unsigned* bar; unsigned x; volatile LAS unsigned* st; };
__device__ __forceinline__ XcdBarrier xcd_barrier_post(unsigned* bar, volatile LAS unsigned* st) {
    XcdBarrier b; b.bar = bar; b.x = xb_xcc_id(); b.st = st;
    if (threadIdx.x == 0) (void)xb_add(&bar[XB_XCNT(b.x)], 1u);
    return b;
}
__device__ __forceinline__ void xcd_barrier_complete(unsigned* bar, unsigned x, unsigned& nloc, unsigned& nx) {
    const unsigned G = gridDim.x * gridDim.y * gridDim.z;
    unsigned sum, cnt, mine, sp = 0u;
    for (;;) {
        sum = 0u; cnt = 0u; mine = 0u;
#pragma unroll
        for (unsigned j = 0; j < 16; ++j) { const unsigned c = xb_ld(&bar[XB_XCNT(j)]); sum += c; cnt += (c > 0u) ? 1u : 0u; mine = (j == x) ? c : mine; }
        if (sum == G) break;
        __builtin_amdgcn_s_sleep(1);
        if ((++sp & 255u) == 0u) { if (xb_ld(&bar[XB_TMO])) break; if (sp > XB_SPIN_CAP) { atomicAdd(&bar[XB_TMO], 1u); break; } }
    }
    nloc = mine > 0u ? mine : 1u; nx = cnt > 0u ? cnt : 1u;
}
__device__ __forceinline__ void xcd_barrier(const XcdBarrier& b, bool is_t0) {
    asm volatile("s_waitcnt vmcnt(0)" ::: "memory");
    __syncthreads();
    if (is_t0) {
        unsigned* bar = b.bar;
        __builtin_amdgcn_s_waitcnt(0);
        unsigned nloc = b.st[0], nx = b.st[1];
        if (nloc == 0u) { xcd_barrier_complete(bar, b.x, nloc, nx); b.st[0] = nloc; b.st[1] = nx; }
        const unsigned old = xb_add(&bar[XB_XSUB(b.x)], 1u);
        const unsigned gen = old / nloc;
        if (old + 1u == (gen + 1u) * nloc) {
            __builtin_amdgcn_fence(__ATOMIC_RELEASE, "agent");
            asm volatile("s_waitcnt vmcnt(0)" ::: "memory");
            const unsigned og = xb_add(&bar[XB_TOP], 1u);
            const unsigned tg = og / nx;
            if (og + 1u == (tg + 1u) * nx) xb_add(&bar[XB_TOPGEN], 1u);
            else XB_SPIN(xb_ld(&bar[XB_TOPGEN]) == tg, bar);
            __builtin_amdgcn_fence(__ATOMIC_ACQUIRE, "agent");
            xb_add(&bar[XB_XGEN(b.x)], 1u);
            asm volatile("s_waitcnt vmcnt(0)" ::: "memory");
        } else {
            XB_SPIN(xb_ld(&bar[XB_XGEN(b.x)]) == gen, bar);
            __builtin_amdgcn_fence(__ATOMIC_ACQUIRE, "agent");
            asm volatile("s_waitcnt vmcnt(0)" ::: "memory");
        }
    }
    __syncthreads();
}

constexpr int AT_SLOT = 8192, AT_VOFF = 9 * AT_SLOT;
__device__ __forceinline__ int kswz(int col) { return ((col >> 1) & 1) | (((col >> 3) & 3) << 1); }
template <bool NA>
__device__ __forceinline__ void attn_core(const bf16x8 (&qf)[2], const LAS unsigned char* lds, int rs, int c_lo, bf16* obase, const float* rpbp_h, int rbias0, int c0q, int lane) {
    const int n = lane & 15, q = lane >> 4, cq = c0q + n;
    f32x4 s[8][2];
#pragma unroll
    for (int kb = 0; kb < 8; ++kb) {
        const int slot = NA ? (rs + kb) % 9 : (kb >> 1); const int cb0 = NA ? c_lo : (kb & 1) * 32;
        const LAS unsigned char* kp = lds + slot * AT_SLOT;
#pragma unroll
        for (int blk = 0; blk < 2; ++blk) {
            const int col = cb0 + 8 * (n >> 2) + 4 * blk + (n & 3), f = kswz(col);
            const bf16x8 a0 = *(const LAS bf16x8*)(kp + col * 128 + ((q ^ f) << 4)), a1 = *(const LAS bf16x8*)(kp + col * 128 + (((4 + q) ^ f) << 4));
            f32x4 a = (f32x4){0.f, 0.f, 0.f, 0.f};
            a = __builtin_amdgcn_mfma_f32_16x16x32_bf16(a0, qf[0], a, 0, 0, 0);
            a = __builtin_amdgcn_mfma_f32_16x16x32_bf16(a1, qf[1], a, 0, 0, 0);
            s[kb][blk] = a;
        }
    }
    if (NA) {
        const int cs = min(max(cq - 8, 0), 48);
        const float* bp = rpbp_h + (c_lo - c0q + 8 * q - n + 31);
#pragma unroll
        for (int kb = 0; kb < 8; ++kb) {
            const f32x4 b0 = *(const f32x4*)(bp + (rbias0 + kb) * 64), b1 = *(const f32x4*)(bp + (rbias0 + kb) * 64 + 4);
#pragma unroll
            for (int i = 0; i < 4; ++i) {
                const int kc0 = c_lo + 8 * q + i, kc1 = kc0 + 4;
                s[kb][0][i] = (kc0 >= cs && kc0 < cs + 16) ? s[kb][0][i] + b0[i] : -1e30f;
                s[kb][1][i] = (kc1 >= cs && kc1 < cs + 16) ? s[kb][1][i] + b1[i] : -1e30f;
            }
        }
    }
    float mx = -1e30f;
#pragma unroll
    for (int kb = 0; kb < 8; ++kb)
#pragma unroll
        for (int blk = 0; blk < 2; ++blk)
#pragma unroll
            for (int i = 0; i < 4; ++i) mx = fmaxf(mx, s[kb][blk][i]);
    mx = fmaxf(mx, shfl_xor_f(mx, 16, lane)); mx = fmaxf(mx, shfl_xor_f(mx, 32, lane));
    float sum = 0.f; bf16x8 pf[8];
#pragma unroll
    for (int kb = 0; kb < 8; ++kb) {
        float p[8];
#pragma unroll
        for (int blk = 0; blk < 2; ++blk)
#pragma unroll
            for (int i = 0; i < 4; ++i) { const float e = fast_exp(s[kb][blk][i] - mx); p[blk * 4 + i] = e; sum += e; }
        u32x4 w; w.x = cvt_pk_bf16(p[0], p[1]); w.y = cvt_pk_bf16(p[2], p[3]); w.z = cvt_pk_bf16(p[4], p[5]); w.w = cvt_pk_bf16(p[6], p[7]);
        pf[kb] = __builtin_bit_cast(bf16x8, w);
    }
    sum += shfl_xor_f(sum, 16, lane); sum += shfl_xor_f(sum, 32, lane);
    const float inv = fast_rcp(sum);
#pragma unroll
    for (int db = 0; db < 4; ++db) {
        f32x4 o = (f32x4){0.f, 0.f, 0.f, 0.f};
#pragma unroll
        for (int kb = 0; kb < 8; ++kb) {
            const int slot = NA ? (rs + kb) % 9 : (kb >> 1); const int cb0 = NA ? c_lo : (kb & 1) * 32;
            const bf16x8 vf = *(const LAS bf16x8*)(lds + AT_VOFF + slot * AT_SLOT + ((((cb0 >> 3) + q) * 64 + db * 16 + n) << 4));
            o = __builtin_amdgcn_mfma_f32_16x16x32_bf16(vf, pf[kb], o, 0, 0, 0);
        }
        u32x2 w; w.x = cvt_pk_bf16(o[0] * inv, o[1] * inv); w.y = cvt_pk_bf16(o[2] * inv, o[3] * inv);
        *(u32x2*)(obase + (unsigned)(n * 1024 + 4 * q) + db * 16) = w;
    }
}

constexpr int NWAVES = 8;
constexpr int RING_BYTES = 131072, ATT_BYTES = 147456, MISC_OFF = ATT_BYTES, TAB_OFF = MISC_OFF + 256, LDS_BYTES = 163840;
struct Args { const float* in[30]; float* out; unsigned char* ws; };
struct Frame { LAS unsigned char* lds; int tid, lane, wave, vcu, G; };
enum { I_X = 0, I_MEM, I_NMIX, I_NFFN, I_NMEM, I_WIN, I_BGATE, I_RPB, I_LRE, I_LIM, I_LDT, I_BRE, I_BIM, I_CRE, I_CIM, I_S5D, I_WGLU, I_WMKV, I_WBNA, I_WBS5, I_WBXA, I_WOUT,
       I_WCO, I_BCO, I_WFI, I_BFI, I_WG, I_WU, I_WD, I_FNORM };

__device__ __forceinline__ void transpose_item(const float* W, int ldn, int k0, int n0, bf16* WT, int ldk, int dk0, int row_off, int rmul, int radd, int qs, LAS float* scr, int lane) {
    { float t[32]; const float* wp = W + (size_t)(k0 + (lane >> 5)) * ldn + n0 + (lane & 31);
#pragma unroll
      for (int i = 0; i < 32; ++i) t[i] = wp[(size_t)(2 * i) * ldn];
#pragma unroll
      for (int i = 0; i < 32; ++i) scr[(2 * i + (lane >> 5)) * 33 + (lane & 31)] = t[i]; }
    LDS_WAIT(); asm volatile("" ::: "memory");
    const int c = lane & 7;
#pragma unroll
    for (int j = 0; j < 4; ++j) { const int n = (lane >> 3) + 8 * j, nn = n0 + n; const LAS float* s = scr + (8 * c) * 33 + n;
        const float sc = (qs && (nn < 512 || (nn >= 1792 && nn < 2048))) ? 0.125f : 1.0f;
        u32x4 o; o.x = cvt_pk_bf16(s[0 * 33] * sc, s[1 * 33] * sc); o.y = cvt_pk_bf16(s[2 * 33] * sc, s[3 * 33] * sc); o.z = cvt_pk_bf16(s[4 * 33] * sc, s[5 * 33] * sc); o.w = cvt_pk_bf16(s[6 * 33] * sc, s[7 * 33] * sc);
        *(u32x4*)(WT + (size_t)(row_off + nn * rmul + radd) * ldk + dk0 + k0 + 8 * c) = o; }
    LDS_WAIT(); asm volatile("" ::: "memory");
}
__device__ __forceinline__ void transpose_job_item(const float* W, int ldn, int N, int it, bf16* WT, int ldk, int dk0, int row_off, int rmul, int radd, int qs, LAS float* scr, int lane) {
    const int nblk = N / 32, kb = it / nblk, nb = it % nblk;
    transpose_item(W, ldn, 64 * kb, 32 * nb, WT, ldk, dk0, row_off, rmul, radd, qs, scr, lane);
}

__device__ __forceinline__ void cexp_d(double zr, double zi, double& er, double& ei) {
    const double wr_ = zr * (1.0 / 1024.0), wi_ = zi * (1.0 / 1024.0);
    double tr = 1.0, ti = 0.0;
#pragma unroll
    for (int n = 12; n >= 1; --n) { const double ar = wr_ * (1.0 / n), ai = wi_ * (1.0 / n); const double nr = 1.0 + (ar * tr - ai * ti), ni = ar * ti + ai * tr; tr = nr; ti = ni; }
#pragma unroll
    for (int k = 0; k < 10; ++k) { const double nr = tr * tr - ti * ti, ni = 2.0 * tr * ti; tr = nr; ti = ni; }
    er = tr; ei = ti;
}

template <bool ROUTER>
__device__ __forceinline__ void norm_rows4(const float* X, const float* gain, bf16* H, int row0, int lane,
                                           const float* wrt, const float* bco, const float* bfi, unsigned* cnt, int* list, float* wts) {
    f32x4 x[4][4]; float rstd[4];
#pragma unroll
    for (int r = 0; r < 4; ++r) { float ss = 0.f;
#pragma unroll
        for (int j = 0; j < 4; ++j) { x[r][j] = *(const f32x4*)(X + (size_t)(row0 + r) * 1024 + 256 * j + 4 * lane); ss += (x[r][j][0] * x[r][j][0] + x[r][j][1] * x[r][j][1]) + (x[r][j][2] * x[r][j][2] + x[r][j][3] * x[r][j][3]); }
        ss = wave_sum(ss, lane); rstd[r] = 1.0f / sqrtf(ss * (1.0f / 1024.0f) + RMS_EPS); }
#pragma unroll
    for (int j = 0; j < 4; ++j) { const f32x4 g4 = *(const f32x4*)(gain + 256 * j + 4 * lane);
#pragma unroll
        for (int r = 0; r < 4; ++r) { const f32x4 v = x[r][j] * rstd[r] * g4; u32x2 w; w.x = cvt_pk_bf16(v[0], v[1]); w.y = cvt_pk_bf16(v[2], v[3]);
            *(u32x2*)(H + (size_t)(row0 + r) * 1024 + 256 * j + 4 * lane) = w; } }
    if constexpr (ROUTER) {
        float keep[4] = {0.f, 0.f, 0.f, 0.f};
#pragma unroll 2
        for (int c = 0; c < 20; ++c) {
            float a0 = 0.f, a1 = 0.f, a2 = 0.f, a3 = 0.f;
#pragma unroll
            for (int j = 0; j < 4; ++j) { const f32x4 w4 = *(const f32x4*)(wrt + c * 1024 + 256 * j + 4 * lane);
                a0 += (x[0][j][0] * w4[0] + x[0][j][1] * w4[1]) + (x[0][j][2] * w4[2] + x[0][j][3] * w4[3]);
                a1 += (x[1][j][0] * w4[0] + x[1][j][1] * w4[1]) + (x[1][j][2] * w4[2] + x[1][j][3] * w4[3]);
                a2 += (x[2][j][0] * w4[0] + x[2][j][1] * w4[1]) + (x[2][j][2] * w4[2] + x[2][j][3] * w4[3]);
                a3 += (x[3][j][0] * w4[0] + x[3][j][1] * w4[1]) + (x[3][j][2] * w4[2] + x[3][j][3] * w4[3]); }
            a0 = wave_sum(a0, lane); a1 = wave_sum(a1, lane); a2 = wave_sum(a2, lane); a3 = wave_sum(a3, lane);
            if (lane == c) { keep[0] = a0 * rstd[0]; keep[1] = a1 * rstd[1]; keep[2] = a2 * rstd[2]; keep[3] = a3 * rstd[3]; }
        }
#pragma unroll
        for (int r = 0; r < 4; ++r) {
            float co[4];
#pragma unroll
            for (int i = 0; i < 4; ++i) co[i] = shfl_idx_f(keep[r], i) + bco[i];
            int grp = 0; float cm = co[0];
#pragma unroll
            for (int i = 1; i < 4; ++i) if (co[i] > cm) { cm = co[i]; grp = i; }
            float den = 0.f;
#pragma unroll
            for (int i = 0; i < 4; ++i) den += __expf(co[i] - cm);
            const float pgrp = 1.0f / den;
            float fv[4];
#pragma unroll
            for (int i = 0; i < 4; ++i) fv[i] = shfl_idx_f(keep[r], 4 + grp * 4 + i) + bfi[grp * 4 + i];
            int i1 = 0; float v1 = fv[0];
#pragma unroll
            for (int i = 1; i < 4; ++i) if (fv[i] > v1) { v1 = fv[i]; i1 = i; }
            int i2 = -1; float v2 = -3.0e38f;
#pragma unroll
            for (int i = 0; i < 4; ++i) if (i != i1 && fv[i] > v2) { v2 = fv[i]; i2 = i; }
            const float w1 = pgrp / (1.0f + __expf(v2 - v1)), w2 = pgrp - w1;
            const int a = i1 < i2 ? i1 : i2, b = i1 < i2 ? i2 : i1;
            const int pidx = a == 0 ? b - 1 : (a == 1 ? b + 1 : 5);
            const int bucket = grp * 6 + pidx;
            const float wa = (i1 == a) ? w1 : w2, wb = (i1 == a) ? w2 : w1;
            if (lane == 0) {
                const unsigned slot = __hip_atomic_fetch_add(cnt + bucket * 64, 1u, __ATOMIC_RELAXED, __HIP_MEMORY_SCOPE_AGENT);
                list[(size_t)bucket * LCAP + slot] = row0 + r;
                *(f32x2*)(wts + ((size_t)bucket * LCAP + slot) * 2) = (f32x2){wa, wb};
            }
        }
    }
}

constexpr int RT_STRIDE = 2064;
constexpr int RT_BYTES = 40 * RT_STRIDE;
constexpr int RT_SCR = 98304;
__device__ __forceinline__ void router_rows16(const float* X, const float* gain, bf16* H, int R0, int lane, LAS unsigned char* lds, int wave,
                                              const float* bco, const float* bfi, unsigned* cnt, int* list, float* wts) {
    const int n = lane & 15, q = lane >> 4;
    f32x4 accF = (f32x4){0.f, 0.f, 0.f, 0.f}, accC = (f32x4){0.f, 0.f, 0.f, 0.f};
    float ss = 0.f;
    const float* xp = X + (unsigned)((R0 + n) * 1024 + 8 * q);
    const LAS unsigned char* tF = lds + n * RT_STRIDE + 16 * q; const LAS unsigned char* tC = lds + (16 + (n & 3)) * RT_STRIDE + 16 * q;
#pragma unroll 4
    for (int ks = 0; ks < 32; ++ks) {
        const f32x4 x0 = *(const f32x4*)(xp + ks * 32), x1 = *(const f32x4*)(xp + ks * 32 + 4);
        ss += (x0[0] * x0[0] + x0[1] * x0[1]) + (x0[2] * x0[2] + x0[3] * x0[3]) + (x1[0] * x1[0] + x1[1] * x1[1]) + (x1[2] * x1[2] + x1[3] * x1[3]);
        u32x4 hw; hw.x = cvt_pk_bf16(x0[0], x0[1]); hw.y = cvt_pk_bf16(x0[2], x0[3]); hw.z = cvt_pk_bf16(x1[0], x1[1]); hw.w = cvt_pk_bf16(x1[2], x1[3]);
        u32x4 lw; lw.x = cvt_pk_bf16(x0[0] - bflo(hw.x), x0[1] - bfhi(hw.x)); lw.y = cvt_pk_bf16(x0[2] - bflo(hw.y), x0[3] - bfhi(hw.y));
        lw.z = cvt_pk_bf16(x1[0] - bflo(hw.z), x1[1] - bfhi(hw.z)); lw.w = cvt_pk_bf16(x1[2] - bflo(hw.w), x1[3] - bfhi(hw.w));
        const bf16x8 ah = __builtin_bit_cast(bf16x8, hw), al = __builtin_bit_cast(bf16x8, lw);
        const bf16x8 fh = *(const LAS bf16x8*)(tF + ks * 64), fl = *(const LAS bf16x8*)(tF + 20 * RT_STRIDE + ks * 64);
        const bf16x8 ch = *(const LAS bf16x8*)(tC + ks * 64), cl = *(const LAS bf16x8*)(tC + 20 * RT_STRIDE + ks * 64);
        accF = __builtin_amdgcn_mfma_f32_16x16x32_bf16(ah, fh, accF, 0, 0, 0); accF = __builtin_amdgcn_mfma_f32_16x16x32_bf16(ah, fl, accF, 0, 0, 0); accF = __builtin_amdgcn_mfma_f32_16x16x32_bf16(al, fh, accF, 0, 0, 0);
        accC = __builtin_amdgcn_mfma_f32_16x16x32_bf16(ah, ch, accC, 0, 0, 0); accC = __builtin_amdgcn_mfma_f32_16x16x32_bf16(ah, cl, accC, 0, 0, 0); accC = __builtin_amdgcn_mfma_f32_16x16x32_bf16(al, ch, accC, 0, 0, 0);
    }
    ss += shfl_xor_f(ss, 16, lane); ss += shfl_xor_f(ss, 32, lane);
    const float rstd = 1.0f / sqrtf(ss * (1.0f / 1024.0f) + RMS_EPS);
    LAS float* sc = (LAS float*)(lds + RT_SCR + wave * 1536);
#pragma unroll
    for (int r = 0; r < 4; ++r) { const float rs = shfl_idx_f(rstd, 4 * q + r); sc[(4 * q + r) * 24 + n] = accF[r] * rs; if (n < 4) sc[(4 * q + r) * 24 + 16 + n] = accC[r] * rs; }
    LDS_WAIT(); asm volatile("" ::: "memory");
    if (lane < 16) {
        const LAS float* my = sc + lane * 24;
        float co[4];
#pragma unroll
        for (int i = 0; i < 4; ++i) co[i] = my[16 + i] + bco[i];
        int grp = 0; float cm = co[0];
#pragma unroll
        for (int i = 1; i < 4; ++i) if (co[i] > cm) { cm = co[i]; grp = i; }
        float den = 0.f;
#pragma unroll
        for (int i = 0; i < 4; ++i) den += __expf(co[i] - cm);
        const float pgrp = 1.0f / den;
        float fv[4];
#pragma unroll
        for (int i = 0; i < 4; ++i) fv[i] = my[grp * 4 + i] + bfi[grp * 4 + i];
        int i1 = 0; float v1 = fv[0];
#pragma unroll
        for (int i = 1; i < 4; ++i) if (fv[i] > v1) { v1 = fv[i]; i1 = i; }
        int i2 = -1; float v2 = -3.0e38f;
#pragma unroll
        for (int i = 0; i < 4; ++i) if (i != i1 && fv[i] > v2) { v2 = fv[i]; i2 = i; }
        const float w1 = pgrp / (1.0f + __expf(v2 - v1)), w2 = pgrp - w1;
        const int a = i1 < i2 ? i1 : i2, b = i1 < i2 ? i2 : i1;
        const int pidx = a == 0 ? b - 1 : (a == 1 ? b + 1 : 5);
        const int bucket = grp * 6 + pidx;
        const float wa = (i1 == a) ? w1 : w2, wb = (i1 == a) ? w2 : w1;
        const unsigned slot = __hip_atomic_fetch_add(cnt + bucket * 64, 1u, __ATOMIC_RELAXED, __HIP_MEMORY_SCOPE_AGENT);
        list[(unsigned)(bucket * LCAP) + slot] = R0 + lane;
        *(f32x2*)(wts + ((unsigned)(bucket * LCAP) + slot) * 2) = (f32x2){wa, wb};
    }
    f32x4 g4[4];
#pragma unroll
    for (int j = 0; j < 4; ++j) g4[j] = *(const f32x4*)(gain + 256 * j + 4 * lane);
#pragma unroll 4
    for (int rr = 0; rr < 16; ++rr) {
        const float rs = shfl_idx_f(rstd, rr);
        const float* xr = X + (unsigned)((R0 + rr) * 1024 + 4 * lane); bf16* hr = H + (unsigned)((R0 + rr) * 1024 + 4 * lane);
#pragma unroll
        for (int j = 0; j < 4; ++j) { const f32x4 v = *(const f32x4*)(xr + 256 * j) * rs * g4[j]; u32x2 w; w.x = cvt_pk_bf16(v[0], v[1]); w.y = cvt_pk_bf16(v[2], v[3]); *(u32x2*)(hr + 256 * j) = w; }
    }
}

__device__ __forceinline__ void final_norm_row(float* X, const float* gain, int row, int lane) {
    f32x4 x[4]; float ss = 0.f;
#pragma unroll
    for (int j = 0; j < 4; ++j) { x[j] = *(const f32x4*)(X + (size_t)row * 1024 + 256 * j + 4 * lane); ss += (x[j][0] * x[j][0] + x[j][1] * x[j][1]) + (x[j][2] * x[j][2] + x[j][3] * x[j][3]); }
    ss = wave_sum(ss, lane); const float rstd = 1.0f / sqrtf(ss * (1.0f / 1024.0f) + RMS_EPS);
#pragma unroll
    for (int j = 0; j < 4; ++j) { const f32x4 g4 = *(const f32x4*)(gain + 256 * j + 4 * lane); *(f32x4*)(X + (size_t)row * 1024 + 256 * j + 4 * lane) = x[j] * rstd * g4; }
}

__device__ __forceinline__ void s5_scan_item(int item, const float* ST, bf16* At, const f32x2* apow_l, LAS float* sc, int tid) {
    const int d = item & 1, bg = item >> 1, g = bg & 15, seg = tid >> 6, p = tid & 63;
    const f32x2 A32 = apow_l[((d * 16 + g) * 33 + 32) * 64 + p];
    const int chunk0 = d ? 255 - seg * 32 : seg * 32; const long cstep = d ? -1 : 1;
    const float* rp0 = ST + (size_t)(bg * 256 + chunk0) * 256 + d * 128 + p;
    float tr = 0.f, ti = 0.f;
#pragma unroll 8
    for (int j = 0; j < 32; ++j) { const float* rp = rp0 + cstep * j * 256; const float sr = rp[0], si = rp[64]; const float nr = A32.x * tr - A32.y * ti + sr, ni = A32.x * ti + A32.y * tr + si; tr = nr; ti = ni; }
    sc[(seg * 64 + p) * 2] = tr; sc[(seg * 64 + p) * 2 + 1] = ti;
    __syncthreads();
    float pr = A32.x, pi = A32.y;
#pragma unroll
    for (int k = 0; k < 5; ++k) { const float nr = pr * pr - pi * pi, ni = 2.f * pr * pi; pr = nr; pi = ni; }
    float er = 0.f, ei = 0.f;
    for (int s2 = 0; s2 < seg; ++s2) { const float qr = sc[(s2 * 64 + p) * 2], qi = sc[(s2 * 64 + p) * 2 + 1]; const float nr = pr * er - pi * ei + qr, ni = pr * ei + pi * er + qi; er = nr; ei = ni; }
    bf16* op0 = At + (size_t)(bg * 256 + chunk0) * ATK + 512 + d * 128 + p;
#pragma unroll 8
    for (int j = 0; j < 32; ++j) { const float* rp = rp0 + cstep * j * 256; const float sr = rp[0], si = rp[64]; bf16* op = op0 + cstep * j * ATK;
        op[0] = (bf16)(cvt_pk_bf16(er, er) & 0xffffu); op[64] = (bf16)(cvt_pk_bf16(ei, ei) & 0xffffu);
        const float nr = A32.x * er - A32.y * ei + sr, ni = A32.x * ei + A32.y * er + si; er = nr; ei = ni; }
    __syncthreads();
}

#ifndef PHMASK
#define PHMASK 0xffffffffu
#endif
#define PH(k) ((PHMASK >> (k)) & 1u)
#ifndef REPMASK
#define REPMASK 0u
#endif
#define NREP(k) (1 + (int)((REPMASK >> (k)) & 1u))
constexpr int PTR_OFF = MISC_OFF + 1024;
__device__ __forceinline__ const float* inp(LAS unsigned char* lds, int i, int z) {
    const LAS unsigned* q = (const LAS unsigned*)(lds + PTR_OFF + 8 * i + z);
    const unsigned lo = __builtin_amdgcn_readfirstlane(q[0]), hi = __builtin_amdgcn_readfirstlane(q[1]);
    return (const float*)(((unsigned long long)hi << 32) | lo);
}
#define WSL() unsigned char* wsl = args.ws; int wave = F.wave, bid = blockIdx.x, G = gridDim.x, zz = 0; unsigned mm_ = ~0u; asm volatile("" : "+s"(mm_)); int lane = (int)__builtin_amdgcn_mbcnt_hi(mm_, __builtin_amdgcn_mbcnt_lo(mm_, 0u)); \
    asm volatile("" : "+s"(wsl), "+s"(wave), "+v"(lane), "+s"(bid), "+s"(G), "+s"(zz)); \
    const int tid = wave * 64 + lane, vcu = (G % 8 == 0) ? (bid % 8) * (G / 8) + bid / 8 : bid, gw = vcu * NWAVES + wave, NGW = G * NWAVES, NGT = G * NWAVES * 64; \
    (void)tid; (void)gw; (void)NGW; (void)NGT; (void)wsl
#define WP(T, off) ((T*)(wsl + (off)))
#define IN(i) inp(F.lds, (i), zz)

__global__ void __launch_bounds__(NWAVES * 64, 2) fwd_kernel(Args args) {
    extern __shared__ __attribute__((aligned(16))) unsigned char lds_raw[];
    Frame F;
    F.lds = (LAS unsigned char*)lds_raw;
    F.tid = threadIdx.x; F.lane = F.tid & 63; F.wave = __builtin_amdgcn_readfirstlane(F.tid >> 6);
    F.G = gridDim.x; { const int bx = blockIdx.x; F.vcu = (F.G % 8 == 0) ? (bx % 8) * (F.G / 8) + bx / 8 : bx; }
    for (int u = F.tid; u < (LDS_BYTES - MISC_OFF) / 4; u += NWAVES * 64) ((LAS unsigned*)(F.lds + MISC_OFF))[u] = 0u;
    __syncthreads();
    if (F.tid < 30) { const unsigned long long p = (unsigned long long)args.in[F.tid]; LAS unsigned* q = (LAS unsigned*)(F.lds + PTR_OFF + 8 * F.tid); q[0] = (unsigned)p; q[1] = (unsigned)(p >> 32); }
    __syncthreads();
    (void)xcd_barrier_post((unsigned*)(args.ws + WS_CTL) + CW_BAR, (volatile LAS unsigned*)(F.lds + MISC_OFF));
#define GRID_BAR() do { unsigned char* w_ = args.ws; asm volatile("" : "+s"(w_)); XcdBarrier b_; b_.bar = (unsigned*)(w_ + WS_CTL) + CW_BAR; b_.x = xb_xcc_id(); b_.st = (volatile LAS unsigned*)(F.lds + MISC_OFF); unsigned m_ = ~0u; int wv_ = F.wave; asm volatile("" : "+s"(m_), "+s"(wv_)); \
    xcd_barrier(b_, (wv_ == 0) && (__builtin_amdgcn_mbcnt_hi(m_, __builtin_amdgcn_mbcnt_lo(m_, 0u)) == 0u)); } while (0)
#define GT() (vcu * (NWAVES * 64) + tid)
#define SCR() ((LAS float*)(F.lds + wave * 16384))

    if (PH(0)) {
        WSL();
        f32x2* APOW = WP(f32x2, WS_APOW); f32x2* BBAR = WP(f32x2, WS_BBAR); bf16* WRT = WP(bf16, WS_WRT); bf16* MEMN = WP(bf16, WS_MEMN); bf16* WMKV = WP(bf16, WS_WMKV);
        for (int it = gw; it < 1024; it += NGW) { const int l = it >> 8, r = it & 255;
            transpose_job_item(IN(I_WMKV) + (size_t)l * 1024 * 512, 512, 512, r, WMKV + (size_t)l * 512 * 1024, 1024, 0, 0, 1, 0, 0, SCR(), lane); }
        for (int it = gw; it < 4096; it += NGW) { const int l = it >> 10, row = it & 1023;
            const float* xr = IN(I_MEM) + (size_t)row * 1024; const float* gn = IN(I_NMEM) + l * 1024;
            f32x4 x[4]; float ss = 0.f;
#pragma unroll
            for (int j = 0; j < 4; ++j) { x[j] = *(const f32x4*)(xr + 256 * j + 4 * lane); ss += (x[j][0] * x[j][0] + x[j][1] * x[j][1]) + (x[j][2] * x[j][2] + x[j][3] * x[j][3]); }
            ss = wave_sum(ss, lane); const float rstd = 1.0f / sqrtf(ss * (1.0f / 1024.0f) + RMS_EPS);
#pragma unroll
            for (int j = 0; j < 4; ++j) { const f32x4 v = x[j] * rstd * *(const f32x4*)(gn + 256 * j + 4 * lane); u32x2 w; w.x = cvt_pk_bf16(v[0], v[1]); w.y = cvt_pk_bf16(v[2], v[3]);
                *(u32x2*)(MEMN + (size_t)it * 1024 + 256 * j + 4 * lane) = w; } }
        for (int it = GT(); it < 8192; it += NGT) {
            const int p = it & 63, ldg = it >> 6;
            const double lr = fmin((double)IN(I_LRE)[it], -1e-4), li = (double)IN(I_LIM)[it];
            double dt, dum; cexp_d((double)IN(I_LDT)[ldg], 0.0, dt, dum);
            double ar, ai; cexp_d(lr * dt, li * dt, ar, ai);
            const double den = lr * lr + li * li, fr = ((ar - 1.0) * lr + ai * li) / den, fi = (ai * lr - (ar - 1.0) * li) / den;
            const float* bre = IN(I_BRE) + (size_t)it * 16; const float* bim = IN(I_BIM) + (size_t)it * 16;
#pragma unroll 4
            for (int c = 0; c < 16; ++c) { const double br = (double)bre[c], bi = (double)bim[c];
                BBAR[(size_t)it * 16 + c] = (f32x2){(float)(fr * br - fi * bi), (float)(fr * bi + fi * br)}; }
            double pr = 1.0, pi = 0.0;
            for (int n = 0; n <= 32; ++n) { APOW[((size_t)ldg * 33 + n) * 64 + p] = (f32x2){(float)pr, (float)pi}; const double nr = pr * ar - pi * ai, ni = pr * ai + pi * ar; pr = nr; pi = ni; }
        }
        { float* RPBP = WP(float, WS_RPBP); const float* rpb = IN(I_RPB);
          for (int it = GT(); it < 4 * 8 * 15 * 64; it += NGT) { const int j = it & 63; RPBP[it] = (j >= 16 && j < 47) ? rpb[(it >> 6) * 31 + (j - 16)] : 0.f; } }
        for (int it = GT(); it < 4 * 20480; it += NGT) { const int l = it / 20480, r = it % 20480, c = r >> 10, k = r & 1023;
            const float gk = IN(I_NFFN)[l * 1024 + k];
            const float v = gk * (c < 16 ? IN(I_WFI)[(size_t)(l * 1024 + k) * 16 + c] : IN(I_WCO)[(size_t)(l * 1024 + k) * 4 + (c - 16)]);
            const unsigned hw = cvt_pk_bf16(v, v) & 0xffffu; const float lo = v - bflo(hw);
            WRT[(size_t)(l * 2 + 0) * 20480 + r] = (bf16)hw; WRT[(size_t)(l * 2 + 1) * 20480 + r] = (bf16)(cvt_pk_bf16(lo, lo) & 0xffffu); }
    }
    GRID_BAR();

    if (PH(1)) {
        WSL();
        { pg8::Gemm g{WP(bf16, WS_MEMN), WP(bf16, WS_WMKV), 1024, 1024, 1024}; pg8::MemOrder S{G, bid}; EpiMemKV E{WP(bf16, WS_KM), WP(bf16, WS_VM8)};
          pg8::gemm_phase<EpiMemKV, pg8::MemOrder>(F.lds, g, S, E, tid); }
        const f32x2* APOW = WP(f32x2, WS_APOW); const f32x2* BBAR = WP(f32x2, WS_BBAR); float* KT = WP(float, WS_KT);
        const float* CRE = IN(I_CRE); const float* CIM = IN(I_CIM); const float* S5D = IN(I_S5D);
        for (int it = GT(); it < 4 * 16 * 63 * 64; it += NGT) {
            const int c2 = (it & 3) * 4, c = (it >> 2) & 15, rest = it >> 6, tp = rest % 63, lg = rest / 63, l = lg >> 4, g = lg & 15;
            f32x4 sum = (f32x4){0.f, 0.f, 0.f, 0.f};
#pragma unroll 1
            for (int d = 0; d < 2; ++d) {
                if (d == 0 ? (tp < 31) : (tp > 31)) continue;
                const int n = d == 0 ? tp - 31 : 31 - tp, base = (l * 2 + d) * 16 + g;
                const float* cre = CRE + ((size_t)base * 16 + c) * 64; const float* cim = CIM + ((size_t)base * 16 + c) * 64;
                const f32x2* ap = APOW + ((size_t)base * 33 + n) * 64; const f32x4* bb = (const f32x4*)(BBAR + (size_t)base * 64 * 16 + c2);
#pragma unroll 8
                for (int p = 0; p < 64; ++p) { const f32x2 a = ap[p]; const f32x4 b0 = bb[p * 8], b1 = bb[p * 8 + 1]; const float cr = cre[p], ci = cim[p];
                    const float er = cr * a.x - ci * a.y, ei = cr * a.y + ci * a.x;
                    sum[0] += er * b0[0] - ei * b0[1]; sum[1] += er * b0[2] - ei * b0[3]; sum[2] += er * b1[0] - ei * b1[1]; sum[3] += er * b1[2] - ei * b1[3]; }
            }
            if (tp == 31 && c >= c2 && c < c2 + 4) sum[c - c2] += S5D[l * 256 + g * 16 + c];
            *(f32x4*)(KT + (size_t)it * 4) = sum;
        }
    }
    GRID_BAR();

    const float* xcur = args.in[I_X];
    float* XO = args.out;
#pragma unroll 1
    for (int l = 0; l < DEPTH; ++l) {
        for (int rep_ = 0; rep_ < NREP(2); ++rep_) {
        if (PH(2)) {
            WSL();
            {
            bf16* WIN = WP(bf16, WS_WIN); bf16* WCAT = WP(bf16, WS_WCAT); bf16* WOUT = WP(bf16, WS_WOUT); bf16* WGLU = WP(bf16, WS_WGLU);
            for (int it = gw; it < 3648; it += NGW) {
                int r = it;
                if (r < 2560) { transpose_job_item(IN(I_WIN) + (size_t)l * 1024 * 5120, 5120, 5120, r, WIN, 1024, 0, 0, 1, 0, 1, SCR(), lane); continue; } r -= 2560;
                if (r < 256) { transpose_job_item(IN(I_WBNA) + (size_t)l * 512 * 1024, 1024, 1024, r, WCAT, 1024, 0, 0, 1, 0, 0, SCR(), lane); continue; } r -= 256;
                if (r < 128) { transpose_job_item(IN(I_WBS5) + (size_t)l * 256 * 1024, 1024, 1024, r, WCAT, 1024, 512, 0, 1, 0, 0, SCR(), lane); continue; } r -= 128;
                if (r < 128) { transpose_job_item(IN(I_WBXA) + (size_t)l * 256 * 1024, 1024, 1024, r, WCAT, 1024, 768, 0, 1, 0, 0, SCR(), lane); continue; } r -= 128;
                if (r < 512) { transpose_job_item(IN(I_WOUT) + (size_t)l * 1024 * 1024, 1024, 1024, r, WOUT, 1024, 0, 0, 1, 0, 0, SCR(), lane); continue; } r -= 512;
                if (r < 32) { transpose_job_item(IN(I_WGLU) + (size_t)l * 256 * 512, 512, 256, r, WGLU, 256, 0, 0, 2, 0, 0, SCR(), lane); continue; } r -= 32;
                transpose_job_item(IN(I_WGLU) + (size_t)l * 256 * 512 + 256, 512, 256, r, WGLU, 256, 0, 0, 2, 1, 0, SCR(), lane);
            }
            }
            {
            const f32x2* APOW = WP(f32x2, WS_APOW); const f32x2* BBAR = WP(f32x2, WS_BBAR); bf16* S5W = WP(bf16, WS_S5W);
            for (int it = GT(); it < 16 * 256 * 64; it += NGT) {
                const int k8 = it & 63, n = (it >> 6) & 255, g = it >> 14;
                const int s = k8 >> 1, c0 = (k8 & 1) * 8, d = n >> 7, ri = (n >> 6) & 1, p = n & 63, e = d == 0 ? 31 - s : s, base = (l * 2 + d) * 16 + g;
                const f32x2 a = APOW[((size_t)base * 33 + e) * 64 + p]; const f32x2* bb = BBAR + ((size_t)base * 64 + p) * 16 + c0;
                float v[8];
#pragma unroll
                for (int j = 0; j < 8; ++j) { const f32x2 b = bb[j]; v[j] = ri == 0 ? a.x * b.x - a.y * b.y : a.x * b.y + a.y * b.x; }
                u32x4 w; w.x = cvt_pk_bf16(v[0], v[1]); w.y = cvt_pk_bf16(v[2], v[3]); w.z = cvt_pk_bf16(v[4], v[5]); w.w = cvt_pk_bf16(v[6], v[7]);
                *(u32x4*)(S5W + ((size_t)(g * 256 + n) * 512 + k8 * 8)) = w;
            }
            const float* KT = WP(float, WS_KT); bf16* S5KV = WP(bf16, WS_S5KV); const float* CRE = IN(I_CRE); const float* CIM = IN(I_CIM);
            for (int it = GT(); it < 16 * 512 * 96; it += NGT) {
                const int k8 = it % 96, rest = it / 96, n = rest & 511, g = rest >> 9, t = n >> 4, c = n & 15;
                float v[8];
                if (k8 < 64) { const int s = k8 >> 1, c0 = (k8 & 1) * 8, tp = t - s + 31; const float* kp = KT + ((size_t)(((l * 16 + g) * 63 + tp) * 16 + c) * 16 + c0);
                    const f32x4 a = *(const f32x4*)kp, b = *(const f32x4*)(kp + 4); v[0] = a[0]; v[1] = a[1]; v[2] = a[2]; v[3] = a[3]; v[4] = b[0]; v[5] = b[1]; v[6] = b[2]; v[7] = b[3]; }
                else { const int jj = (k8 - 64) * 8, d = jj >> 7, ri = (jj >> 6) & 1, p0 = jj & 63, e = d == 0 ? t + 1 : 32 - t, base = (l * 2 + d) * 16 + g;
                    const float* cre = CRE + ((size_t)base * 16 + c) * 64 + p0; const float* cim = CIM + ((size_t)base * 16 + c) * 64 + p0; const f32x2* ap = APOW + ((size_t)base * 33 + e) * 64 + p0;
#pragma unroll
                    for (int j = 0; j < 8; ++j) { const f32x2 a = ap[j]; const float cr = cre[j], ci = cim[j]; v[j] = ri == 0 ? cr * a.x - ci * a.y : -(cr * a.y + ci * a.x); } }
                u32x4 w; w.x = cvt_pk_bf16(v[0], v[1]); w.y = cvt_pk_bf16(v[2], v[3]); w.z = cvt_pk_bf16(v[4], v[5]); w.w = cvt_pk_bf16(v[6], v[7]);
                *(u32x4*)(S5KV + ((size_t)(g * 512 + n) * ATK + k8 * 8)) = w;
            }
            }
            { bf16* H = WP(bf16, WS_H); const float* gn = IN(I_NMIX) + l * 1024;
              for (int grp = gw; grp < M / 4; grp += NGW) norm_rows4<false>(xcur, gn, H, grp * 4, lane, nullptr, nullptr, nullptr, nullptr, nullptr, nullptr); }
        }
        GRID_BAR();
        }

        for (int rep_ = 0; rep_ < NREP(3); ++rep_) {
        if (PH(3)) {
            WSL();
            pg8::Gemm g{WP(bf16, WS_H), WP(bf16, WS_WIN), 1024, 1024, 1024}; pg8::StaticOrder S; S.init(M / 256, INC / 256, G, bid);
            EpiProj E{WP(bf16, WS_QK), WP(bf16, WS_VT8), WP(bf16, WS_AT), WP(bf16, WS_QX), WP(bf16, WS_GATES), IN(I_BGATE) + l * 3072};
            pg8::gemm_phase<EpiProj, pg8::StaticOrder>(F.lds, g, S, E, tid);
        }
        GRID_BAR();
        }

        for (int rep_ = 0; rep_ < NREP(4); ++rep_) {
        if (PH(4)) {
            WSL();
            { pg8::Gemm g{WP(bf16, WS_AT), WP(bf16, WS_S5W), ATK, 512, 512}; pg8::S5Order S; S.init(64, 1, G, bid); EpiS5a E{WP(float, WS_ST)};
              pg8::gemm_phase<EpiS5a, pg8::S5Order>(F.lds, g, S, E, tid); }
            const int n = lane & 15, q = lane >> 4;
            {
            const bf16* QK = WP(bf16, WS_QK); const bf16* VT8 = WP(bf16, WS_VT8); bf16* H = WP(bf16, WS_H); const float* RPBP = WP(float, WS_RPBP);
            const int cb = wave & 3, qsel = wave >> 2, c_lo = cb == 0 ? 0 : (cb == 1 ? 8 : (cb == 2 ? 24 : 32));
            const int kcol = tid >> 3, kdst = kcol * 128 + (((tid & 7) ^ kswz(kcol)) << 4);
            for (int item = vcu; item < 256; item += G) {
                const int b = item >> 6, h = (item >> 3) & 7, r0 = (item & 7) * 16;
                const bf16* Kg = QK + (size_t)b * SEQ * 1024 + 512 + h * 64 + (unsigned)(kcol * 1024 + (tid & 7) * 8);
                const bf16* Vg = VT8 + (size_t)(b * 8 + h) * 1024 * 512 + (unsigned)(tid * 8);
                const float* rp = RPBP + (size_t)(l * 8 + h) * 15 * 64;
                int hi = min(max(r0 + 1 - 4, 0), 120) + 7;
                for (int kr = min(max(r0 - 4, 0), 120); kr <= hi; ++kr) {
                    const u32x4 kv = *(const u32x4*)(Kg + (size_t)kr * 65536), vv = *(const u32x4*)(Vg + (size_t)kr * 4096);
                    const int slot = kr % 9; *(LAS u32x4*)(F.lds + slot * AT_SLOT + kdst) = kv; *(LAS u32x4*)(F.lds + AT_VOFF + slot * AT_SLOT + tid * 16) = vv;
                }
                bf16x8 qf[2];
                { const bf16* qb = QK + (size_t)(b * SEQ + (r0 + qsel) * 64 + cb * 16) * 1024 + h * 64 + (unsigned)(n * 1024 + 8 * q); qf[0] = *(const bf16x8*)qb; qf[1] = *(const bf16x8*)(qb + 32); }
                __syncthreads();
#pragma unroll 1
                for (int st = 0; st < 8; ++st) {
                    const int r = r0 + 2 * st + qsel, rs = min(max(r - 4, 0), 120);
                    const bool more = st < 7;
                    const int hi_next = more ? min(max(r0 + 2 * st + 3 - 4, 0), 120) + 7 : hi;
                    const int kr1 = hi + 1, kr2 = hi + 2;
                    u32x4 k1 = (u32x4){0u, 0u, 0u, 0u}, v1 = k1, k2 = k1, v2 = k1; bf16x8 qn[2]; qn[0] = qf[0]; qn[1] = qf[1];
                    if (more) {
                        k1 = *(const u32x4*)(Kg + (size_t)min(kr1, 127) * 65536); v1 = *(const u32x4*)(Vg + (size_t)min(kr1, 127) * 4096);
                        k2 = *(const u32x4*)(Kg + (size_t)min(kr2, 127) * 65536); v2 = *(const u32x4*)(Vg + (size_t)min(kr2, 127) * 4096);
                        const bf16* qb = QK + (size_t)(b * SEQ + (r + 2) * 64 + cb * 16) * 1024 + h * 64 + (unsigned)(n * 1024 + 8 * q); qn[0] = *(const bf16x8*)qb; qn[1] = *(const bf16x8*)(qb + 32);
                    }
                    attn_core<true>(qf, F.lds, rs, c_lo, H + (size_t)(b * SEQ + r * 64 + cb * 16) * 1024 + h * 64, rp, rs - r + 7, cb * 16, lane);
                    __syncthreads();
                    if (more) {
                        if (kr1 <= hi_next) { const int slot = kr1 % 9; *(LAS u32x4*)(F.lds + slot * AT_SLOT + kdst) = k1; *(LAS u32x4*)(F.lds + AT_VOFF + slot * AT_SLOT + tid * 16) = v1; }
                        if (kr2 <= hi_next) { const int slot = kr2 % 9; *(LAS u32x4*)(F.lds + slot * AT_SLOT + kdst) = k2; *(LAS u32x4*)(F.lds + AT_VOFF + slot * AT_SLOT + tid * 16) = v2; }
                        hi = hi_next; qf[0] = qn[0]; qf[1] = qn[1];
                    }
                    __syncthreads();
                }
            }
            }
            {
            const bf16* QX = WP(bf16, WS_QX); const bf16* KM = WP(bf16, WS_KM); const bf16* VM8 = WP(bf16, WS_VM8); bf16* H = WP(bf16, WS_H);
            const int kcol = tid >> 3, kdst = kcol * 128 + (((tid & 7) ^ kswz(kcol)) << 4);
            for (int item = vcu; item < 256; item += G) {
                const int b = item >> 6, h = (item >> 4) & 3, qc = item & 15;
                const bf16* Kg = KM + ((size_t)(l * 4 + b) * 256) * 256 + h * 64 + (unsigned)(kcol * 256 + (tid & 7) * 8);
                const bf16* Vg = VM8 + (size_t)((l * 4 + b) * 4 + h) * 32 * 512 + (unsigned)(tid * 8);
#pragma unroll
                for (int j = 0; j < 4; ++j) { const u32x4 kv = *(const u32x4*)(Kg + j * 64 * 256), vv = *(const u32x4*)(Vg + j * 4096);
                    *(LAS u32x4*)(F.lds + j * AT_SLOT + kdst) = kv; *(LAS u32x4*)(F.lds + AT_VOFF + j * AT_SLOT + tid * 16) = vv; }
                __syncthreads();
#pragma unroll 1
                for (int j = 0; j < 4; ++j) {
                    const int t0 = b * SEQ + qc * 512 + wave * 64 + j * 16;
                    bf16x8 qf[2]; { const bf16* qb = QX + (size_t)t0 * 256 + h * 64 + (unsigned)(n * 256 + 8 * q); qf[0] = *(const bf16x8*)qb; qf[1] = *(const bf16x8*)(qb + 32); }
                    attn_core<false>(qf, F.lds, 0, 0, H + (size_t)t0 * 1024 + 768 + h * 64, nullptr, 0, 0, lane);
                }
                __syncthreads();
            }
            }
        }
        GRID_BAR();
        }

        for (int rep_ = 0; rep_ < NREP(5); ++rep_) {
        if (PH(5)) {
            WSL();
            for (int it = bid; it < 128; it += G) s5_scan_item(it, WP(float, WS_ST), WP(bf16, WS_AT), WP(f32x2, WS_APOW) + (size_t)l * 2 * 16 * 33 * 64, (LAS float*)F.lds, tid);
        }
        GRID_BAR();
        }

        for (int rep_ = 0; rep_ < NREP(6); ++rep_) {
        if (PH(6)) {
            WSL();
            pg8::Gemm g{WP(bf16, WS_AT), WP(bf16, WS_S5KV), ATK, ATK, ATK}; pg8::S5Order S; S.init(64, 2, G, bid); EpiS5c E{WP(bf16, WS_Y)};
            pg8::gemm_phase<EpiS5c, pg8::S5Order>(F.lds, g, S, E, tid);
        }
        GRID_BAR();
        }

        for (int rep_ = 0; rep_ < NREP(7); ++rep_) {
        if (PH(7)) {
            WSL();
            pg8::Gemm g{WP(bf16, WS_Y), WP(bf16, WS_WGLU), 256, 256, 256}; pg8::StaticOrder S; S.init(M / 256, 2, G, bid); EpiGlu E{WP(bf16, WS_H)};
            pg8::gemm_phase<EpiGlu, pg8::StaticOrder>(F.lds, g, S, E, tid);
        }
        GRID_BAR();
        }

        for (int rep_ = 0; rep_ < NREP(8); ++rep_) {
        if (PH(8)) {
            WSL();
            pg8::Gemm g{WP(bf16, WS_H), WP(bf16, WS_WCAT), 1024, 1024, 1024}; pg8::StaticOrder S; S.init(M / 256, 4, G, bid); EpiMerge E{WP(bf16, WS_GATES), WP(bf16, WS_QK)};
            pg8::gemm_phase<EpiMerge, pg8::StaticOrder, false, true>(F.lds, g, S, E, tid);
        }
        GRID_BAR();
        }

        for (int rep_ = 0; rep_ < NREP(9); ++rep_) {
        if (PH(9)) {
            WSL();
            pg8::Gemm g{WP(bf16, WS_QK), WP(bf16, WS_WOUT), 1024, 1024, 1024}; pg8::StaticOrder S; S.init(M / 256, 4, G, bid); EpiRes E{xcur, rep_ ? WP(float, WS_GATES) : XO};
            pg8::gemm_phase<EpiRes, pg8::StaticOrder>(F.lds, g, S, E, tid);
        }
        xcur = XO;
        GRID_BAR();
        }

        for (int rep_ = 0; rep_ < NREP(10); ++rep_) {
        if (PH(10)) {
            WSL();
            {
            unsigned* cnt = WP(unsigned, WS_CTL) + CW_CNT + (l + 4 * rep_) * NBUCKET * 64;
            bf16* H = WP(bf16, WS_H); const float* gn = IN(I_NFFN) + l * 1024; const float* bco = IN(I_BCO) + l * 4; const float* bfi = IN(I_BFI) + l * 16;
            int* LIST = rep_ ? WP(int, WS_GATES + 100 * MiB) : WP(int, WS_LIST); float* WTS = rep_ ? WP(float, WS_GATES + 104 * MiB) : WP(float, WS_WTS);
            { const u32x4* src = (const u32x4*)(WP(bf16, WS_WRT) + (size_t)l * 2 * 20480);
              for (int idx = tid; idx < 40 * 128; idx += NWAVES * 64) *(LAS u32x4*)(F.lds + (idx >> 7) * RT_STRIDE + (idx & 127) * 16) = src[idx]; }
            __syncthreads();
            for (int grp = gw; grp < M / 16; grp += NGW) router_rows16(XO, gn, H, grp * 16, lane, F.lds, wave, bco, bfi, cnt, LIST, WTS);
            __syncthreads();
            }
            bf16* WGU = WP(bf16, WS_WGU); bf16* WDP = WP(bf16, WS_WDP);
            for (int it = gw; it < 10240; it += NGW) {
                int r = it;
                if (r < 2048) { const int e = r >> 7; transpose_job_item(IN(I_WG) + (size_t)(l * 16 + e) * 1024 * 256, 256, 256, r & 127, WGU + (size_t)e * 512 * 1024, 1024, 0, 0, 2, 0, 0, SCR(), lane); continue; } r -= 2048;
                if (r < 2048) { const int e = r >> 7; transpose_job_item(IN(I_WU) + (size_t)(l * 16 + e) * 1024 * 256, 256, 256, r & 127, WGU + (size_t)e * 512 * 1024, 1024, 0, 0, 2, 1, 0, SCR(), lane); continue; } r -= 2048;
                const int ej = r >> 7, e = ej / 3, jj = ej % 3, i = e & 3, grpI = e >> 2, o = jj + (jj >= i ? 1 : 0), a = i < o ? i : o, b = i < o ? o : i;
                const int pair = grpI * 6 + (a == 0 ? b - 1 : (a == 1 ? b + 1 : 5)), slot = (i == a) ? 0 : 1;
                transpose_job_item(IN(I_WD) + (size_t)(l * 16 + e) * 256 * 1024, 1024, 1024, r & 127, WDP + (size_t)pair * 1024 * 512, 512, slot * 256, 0, 1, 0, 0, SCR(), lane);
            }
        }
        GRID_BAR();
        }

        LAS int* tab = (LAS int*)(F.lds + TAB_OFF);
        for (int rep_ = 0; rep_ < NREP(11); ++rep_) {
        if (PH(11)) {
            WSL();
            unsigned* cnt = WP(unsigned, WS_CTL) + CW_CNT + l * NBUCKET * 64;
            if (tid == 0) { int st = 0;
                for (int b = 0; b < NBUCKET; ++b) { const int c = (int)__hip_atomic_load(cnt + b * 64, __ATOMIC_RELAXED, __HIP_MEMORY_SCOPE_AGENT); tab[b] = c; tab[32 + b] = st; st += (c + 255) >> 8; }
                tab[32 + NBUCKET] = st; tab[64] = st; }
            __syncthreads();
            pg8::Gemm g{WP(bf16, WS_H), WP(bf16, WS_WGU), 1024, 1024, 1024}; pg8::MoeOrder S{tab, WP(int, WS_LIST), G, bid, 0}; EpiMoe1 E{WP(bf16, WS_ACT), WP(float, WS_WTS)};
            pg8::gemm_phase<EpiMoe1, pg8::MoeOrder, true>(F.lds, g, S, E, tid);
        }
        GRID_BAR();
        }

        for (int rep_ = 0; rep_ < NREP(12); ++rep_) {
        if (PH(12)) {
            WSL();
            pg8::Gemm g{WP(bf16, WS_ACT), WP(bf16, WS_WDP), 512, 512, 512}; pg8::MoeOrder S{tab, WP(int, WS_LIST), G, bid, 1}; EpiMoe2 E{rep_ ? WP(float, WS_QK) : XO, WP(int, WS_LIST)};
            pg8::gemm_phase<EpiMoe2, pg8::MoeOrder>(F.lds, g, S, E, tid);
        }
        GRID_BAR();
        }
    }
    { WSL(); (void)wsl; const float* gn = IN(I_FNORM);
      for (int row = gw; row < M; row += NGW) final_norm_row(XO, gn, row, lane); }
#undef GRID_BAR
}

extern "C" void kernel_launch(void* const* d_in, const int* in_sizes, int n_in, void* d_out, int out_size, void* d_ws, size_t ws_size, hipStream_t stream) {
    static int grid = 0;
    if (grid == 0) {
        if (n_in != 30 || out_size != M * D || ws_size < WS_END) { fprintf(stderr, "kernel_launch: unexpected shapes (n_in %d, out %d, ws %zu)\n", n_in, out_size, ws_size); grid = -1; return; }
        int dev = 0, cus = 0, per_cu = 0;
        if (hipGetDevice(&dev) != hipSuccess || hipDeviceGetAttribute(&cus, hipDeviceAttributeMultiprocessorCount, dev) != hipSuccess) { grid = -1; return; }
        if (hipFuncSetAttribute((const void*)fwd_kernel, hipFuncAttributeMaxDynamicSharedMemorySize, LDS_BYTES) != hipSuccess) { fprintf(stderr, "kernel_launch: hipFuncSetAttribute failed\n"); grid = -1; return; }
        if (hipOccupancyMaxActiveBlocksPerMultiprocessor(&per_cu, (const void*)fwd_kernel, NWAVES * 64, LDS_BYTES) != hipSuccess || per_cu < 1) { fprintf(stderr, "kernel_launch: occupancy query reports %d\n", per_cu); }
        (void)hipGetLastError();
        grid = cus;
    }
    if (grid < 0) return;
    (void)in_sizes;
    hipMemsetAsync((char*)d_ws + WS_CTL, 0, CTL_BYTES, stream);
    Args a{};
    for (int i = 0; i < 30; ++i) a.in[i] = (const float*)d_in[i];
    a.out = (float*)d_out; a.ws = (unsigned char*)d_ws;
    hipLaunchKernelGGL(fwd_kernel, dim3(grid), dim3(NWAVES * 64), LDS_BYTES, stream, a);
}
```

```cpp
#include <hip/hip_runtime.h>
#include <cstdio>
#include <cstdint>

#define LAS __attribute__((address_space(3)))
typedef unsigned short bf16;
typedef short bf16x8 __attribute__((ext_vector_type(8)));
typedef float f32x4 __attribute__((ext_vector_type(4)));
typedef float f32x2 __attribute__((ext_vector_type(2)));
typedef unsigned u32x4 __attribute__((ext_vector_type(4)));
typedef unsigned u32x2 __attribute__((ext_vector_type(2)));

constexpr int D = 1024, BATCH = 4, SEQ = 8192, M = BATCH * SEQ, DEPTH = 4;
constexpr int INC = 5120, NMEM = 256;
constexpr int NCHUNK = 256, TCH = 32;
constexpr int ATK = 768;
constexpr int LCAP = 32768;
constexpr int NBUCKET = 24;
constexpr float RMS_EPS = 1e-6f;

constexpr size_t MiB = 1u << 20;
constexpr size_t WS_CTL = 0, CTL_BYTES = 1 * MiB;
constexpr size_t WS_APOW = 1 * MiB;
constexpr size_t WS_BBAR = 4 * MiB;
constexpr size_t WS_KT = 5 * MiB;
constexpr size_t WS_WRT = 10 * MiB;
constexpr size_t WS_RPBP = 10 * MiB + 512 * 1024;
constexpr size_t WS_MEMN = 11 * MiB;
constexpr size_t WS_WMKV = 19 * MiB;
constexpr size_t WS_KM = 23 * MiB;
constexpr size_t WS_VM8 = 25 * MiB;
constexpr size_t WS_WIN = 27 * MiB;
constexpr size_t WS_WCAT = 37 * MiB;
constexpr size_t WS_WOUT = 39 * MiB;
constexpr size_t WS_WGLU = 41 * MiB;
constexpr size_t WS_S5W = 42 * MiB;
constexpr size_t WS_S5KV = 46 * MiB;
constexpr size_t WS_H = 58 * MiB;
constexpr size_t WS_QK = 122 * MiB;
constexpr size_t WS_VT8 = 186 * MiB;
constexpr size_t WS_AT = 218 * MiB;
constexpr size_t WS_QX = 242 * MiB;
constexpr size_t WS_ST = 258 * MiB;
constexpr size_t WS_Y = 274 * MiB;
constexpr size_t WS_GATES = 290 * MiB;
constexpr size_t WS_WGU = WS_GATES;
constexpr size_t WS_WDP = WS_GATES + 16 * MiB;
constexpr size_t WS_ACT = WS_GATES + 40 * MiB;
constexpr size_t WS_LIST = 482 * MiB;
constexpr size_t WS_WTS = 485 * MiB;
constexpr size_t WS_END = 491 * MiB;
constexpr int CW_BAR = 4096;
constexpr int CW_CNT = 16384;

__device__ __forceinline__ unsigned cvt_pk_bf16(float lo, float hi) { unsigned r; asm volatile("v_cvt_pk_bf16_f32 %0, %1, %2" : "=v"(r) : "v"(lo), "v"(hi)); return r; }
__device__ __forceinline__ float bf2f(unsigned short b) { return __uint_as_float(((unsigned)b) << 16); }
__device__ __forceinline__ float bflo(unsigned w) { return __uint_as_float(w << 16); }
__device__ __forceinline__ float bfhi(unsigned w) { return __uint_as_float(w & 0xffff0000u); }
__device__ __forceinline__ float fast_rcp(float x) { return __builtin_amdgcn_rcpf(x); }
__device__ __forceinline__ float fast_exp(float x) { return __builtin_amdgcn_exp2f(x * 1.4426950408889634f); }
__device__ __forceinline__ float sigmoid_f(float x) { return fast_rcp(1.0f + fast_exp(-x)); }
__device__ __forceinline__ float gelu_tanh_f(float x) { const float u = 1.5957691216057308f * (x + 0.044715f * x * x * x); return x * fast_rcp(1.0f + fast_exp(-u)); }
__device__ __forceinline__ float shfl_xor_f(float v, int o, int lane) { return __int_as_float(__builtin_amdgcn_ds_bpermute((lane ^ o) << 2, __float_as_int(v))); }
__device__ __forceinline__ float shfl_idx_f(float v, int src) { return __int_as_float(__builtin_amdgcn_ds_bpermute(src << 2, __float_as_int(v))); }
__device__ __forceinline__ float wave_sum(float v, int lane) {
#pragma unroll
    for (int o = 1; o < 64; o <<= 1) v += shfl_xor_f(v, o, lane);
    return v;
}
#define LDS_WAIT() asm volatile("s_waitcnt lgkmcnt(0)" ::: "memory")
#define VM_WAIT() asm volatile("s_waitcnt vmcnt(0)" ::: "memory")

namespace pg8 {
constexpr int BM = 256, BK = 64, HALF = 128, HTB = HALF * BK * 2, STAGE_BYTES = 8 * HTB, NXCD = 8, WGM = 8;
__host__ __device__ __forceinline__ int lds_byte(int r, int c) { const int st = (r >> 4) * 2 + (c >> 5), rr = r & 15, cc = c & 31, ob = rr * 64 + cc * 2; return st * 1024 + (ob ^ (((ob >> 9) & 1) << 5)); }
__host__ __device__ __forceinline__ void stage_rc(int b, int& R, int& C) { const int st = b / 1024, sb = b % 1024, swz = sb ^ (((sb >> 9) & 1) << 5); R = (st >> 1) * 16 + swz / 64; C = (st & 1) * 32 + (swz % 64) / 2; }
__host__ __device__ __forceinline__ int perm32(int rho) { const int n = rho >> 4, i = rho & 15; return 8 * (i >> 2) + 4 * n + (i & 3); }

struct Unit { int pm, pn, am, bn, x0, x1, x2; };
struct Gemm { const bf16* A; const bf16* Bt; int lda, ldb, K; };

struct StaticOrder {
    int nM, nN, nwg, G, c;
    __device__ void init(int nM_, int nN_, int G_, int c_) { nM = nM_; nN = nN_; nwg = nM * nN; G = G_; c = c_; }
    __device__ bool next(int i, Unit& u) const {
        const long L = (long)i * G + c; if (L >= nwg) return false;
        int wgid = (int)L; { const int q = nwg / NXCD, r = nwg % NXCD, xcd = wgid % NXCD, off = wgid / NXCD; wgid = (xcd < r ? xcd * (q + 1) : r * (q + 1) + (xcd - r) * q) + off; }
        const int nig = WGM * nN, gid = wgid / nig, fm = gid * WGM, gsz = (nM - fm) < WGM ? (nM - fm) : WGM;
        u.pm = __builtin_amdgcn_readfirstlane(fm + ((wgid % nig) % gsz)); u.pn = __builtin_amdgcn_readfirstlane((wgid % nig) / gsz);
        u.am = u.pm; u.bn = u.pn; u.x0 = 0; u.x1 = 0; u.x2 = 0; return true;
    }
    __device__ __forceinline__ int a_row(const Unit&, int) const { return 0; }
};
struct S5Order : StaticOrder {
    __device__ bool next(int i, Unit& u) const { if (!StaticOrder::next(i, u)) return false; u.bn = (u.pm & 15) * nN + u.pn; return true; }
};
struct MemOrder {
    int G, c;
    __device__ bool next(int i, Unit& u) const { const int L = i * G + c; if (L >= 32) return false; u.pm = L >> 1; u.pn = L & 1; u.am = u.pm; u.bn = (u.pm >> 2) * 2 + u.pn; u.x0 = 0; u.x1 = 0; u.x2 = 0; return true; }
    __device__ __forceinline__ int a_row(const Unit&, int) const { return 0; }
};
struct MoeOrder {
    const LAS int* tab; const int* list; int G, c, mode;
    __device__ bool next(int i, Unit& u) const {
        const int T = __builtin_amdgcn_readfirstlane(tab[64]); const int L = i * G + c; if (L >= T * 4) return false;
        const int tile = L >> 2, pn = L & 3; int b = 0;
#pragma unroll 1
        for (int j = 1; j < NBUCKET; ++j) if (__builtin_amdgcn_readfirstlane(tab[32 + j]) <= tile) b = j;
        u.pm = tile; u.pn = pn; u.am = tile; u.x0 = b; u.x1 = (tile - __builtin_amdgcn_readfirstlane(tab[32 + b])) * 256; u.x2 = __builtin_amdgcn_readfirstlane(tab[b]);
        const int grp = __builtin_amdgcn_readfirstlane(b / 6), pi = __builtin_amdgcn_readfirstlane(b % 6); const int ea = pi < 3 ? 0 : (pi < 5 ? 1 : 2), eb = pi < 3 ? pi + 1 : (pi < 5 ? pi - 1 : 3);
        if (mode == 0) { const int e = grp * 4 + ((pn >> 1) ? eb : ea); u.bn = e * 2 + (pn & 1); } else u.bn = b * 4 + pn;
        return true;
    }
    __device__ __forceinline__ int a_row(const Unit& u, int r) const { const int slot = u.x1 + r; return slot < u.x2 ? list[u.x0 * LCAP + slot] : 0; }
};

template <class Epi, class Sched, bool GATHER = false, bool KHOOK = false>
__device__ __forceinline__ void gemm_phase(LAS unsigned char* lds, const Gemm g, const Sched& S, const Epi& E, int tid_in) {
    int tid = tid_in; asm volatile("" : "+v"(tid));
    const int wid = __builtin_amdgcn_readfirstlane(tid >> 6), lane = tid & 63, wr = wid >> 2, wc = wid & 3, fr = lane & 15, fq = lane >> 4;
    int K = g.K, lda = g.lda, ldb = g.ldb;
    asm volatile("" : "+s"(K), "+s"(lda), "+s"(ldb));
    const int nt = K / BK;
    unsigned voffA[2], voffB[2]; int Rr[2], Cc[2];
#pragma unroll
    for (int i = 0; i < 2; ++i) { int R, C; stage_rc(tid * 16 + i * 8192, R, C); const int Rb = Epi::PERM ? ((R & ~31) + perm32(R & 31)) : R;
        voffA[i] = (unsigned)(R * lda + C) * 2u; voffB[i] = (unsigned)(Rb * ldb + C) * 2u; Rr[i] = R; Cc[i] = C; }
    const unsigned kstep = (unsigned)(BK * 2);
    const unsigned hstepA = (unsigned)(HALF * lda * 2), tstepA = 2u * hstepA, hstepB = (unsigned)(HALF * ldb * 2), tstepB = 2u * hstepB;
    const unsigned ldsw = (unsigned)wid * 1024u;
    const int aoff = lds_byte(wr * 64 + fr, fq * 8), boff = lds_byte(wc * 32 + fr, fq * 8);
    unsigned vC[2][2] = {{0u, 0u}, {0u, 0u}}, vN[2][2] = {{0u, 0u}, {0u, 0u}};
#define PG8_SA(b, h) (((b) * 2 + (h)) * HTB)
#define PG8_SB(b, h) ((4 + (b) * 2 + (h)) * HTB)
#define PG8_STAGE(bufoff, gbase, voff) do { _Pragma("unroll") for (int _i = 0; _i < 2; ++_i) \
        __builtin_amdgcn_global_load_lds((const unsigned*)((const char*)(gbase) + (voff)[_i]), (LAS unsigned*)(lds + (bufoff) + ldsw + _i * 8192), 16, 0, 0); } while (0)
#define PG8_STA(bufoff, ptr, h, nx) do { if constexpr (GATHER) { unsigned _v[2]; _v[0] = (nx) ? vN[h][0] : vC[h][0]; _v[1] = (nx) ? vN[h][1] : vC[h][1]; PG8_STAGE(bufoff, ptr, _v); } \
        else { PG8_STAGE(bufoff, (ptr) + (h) * hstepA, voffA); } } while (0)
#define PG8_STB(bufoff, ptr, h) PG8_STAGE(bufoff, (ptr) + (h) * hstepB, voffB)
#define PG8_LDA(dst, b, h) do { _Pragma("unroll") for (int m = 0; m < 4; ++m) _Pragma("unroll") for (int k = 0; k < 2; ++k) dst[m][k] = *(const LAS bf16x8*)(lds + PG8_SA(b, h) + aoff + m * 2048 + k * 1024); } while (0)
#define PG8_LDB(dst, b, h) do { _Pragma("unroll") for (int n = 0; n < 2; ++n) _Pragma("unroll") for (int k = 0; k < 2; ++k) dst[n][k] = *(const LAS bf16x8*)(lds + PG8_SB(b, h) + boff + n * 2048 + k * 1024); } while (0)
#define PG8_MMA(ai, bj, At, Bt) do { __builtin_amdgcn_s_setprio(1); _Pragma("unroll") for (int m = 0; m < 4; ++m) _Pragma("unroll") for (int n = 0; n < 2; ++n) _Pragma("unroll") for (int k = 0; k < 2; ++k) \
        acc[ai][bj][m][n] = __builtin_amdgcn_mfma_f32_16x16x32_bf16(Bt[n][k], At[m][k], acc[ai][bj][m][n], 0, 0, 0); __builtin_amdgcn_s_setprio(0); } while (0)
#define PG8_WAIT_V(n) asm volatile("s_waitcnt vmcnt(" #n ")" ::: "memory")
#define PG8_WAIT_L(n) asm volatile("s_waitcnt lgkmcnt(" #n ")" ::: "memory")
#define PG8_BAR __builtin_amdgcn_s_barrier()
#define PG8_SCHED __builtin_amdgcn_sched_barrier(0)
    Unit cur, nxt; int ui = 0;
    if (!S.next(0, cur)) return;
    f32x4 acc[2][2][4][2];
#pragma unroll
    for (int a = 0; a < 2; ++a)
#pragma unroll
        for (int b = 0; b < 2; ++b)
#pragma unroll
            for (int m = 0; m < 4; ++m)
#pragma unroll
                for (int n = 0; n < 2; ++n) acc[a][b][m][n] = (f32x4){0.f, 0.f, 0.f, 0.f};
    bf16x8 At[4][2], B0[2][2], B1[2][2];
    const char* cA = GATHER ? (const char*)g.A : (const char*)g.A + (unsigned)cur.am * tstepA;
    const char* cB = (const char*)g.Bt + (unsigned)cur.bn * tstepB;
    if constexpr (GATHER) {
#pragma unroll
        for (int h = 0; h < 2; ++h)
#pragma unroll
            for (int i = 0; i < 2; ++i) vC[h][i] = (unsigned)(S.a_row(cur, h * HALF + Rr[i]) * lda + Cc[i]) * 2u;
    }
    PG8_STB(PG8_SB(0, 0), cB, 0); PG8_STB(PG8_SB(0, 1), cB, 1); PG8_STA(PG8_SA(0, 0), cA, 0, false); PG8_STA(PG8_SA(0, 1), cA, 1, false);
    if (wr == 1) PG8_BAR;
    PG8_WAIT_V(2); PG8_BAR;
    PG8_STB(PG8_SB(1, 0), cB + kstep, 0); PG8_STA(PG8_SA(1, 0), cA + kstep, 0, false); PG8_STB(PG8_SB(1, 1), cB + kstep, 1);
    PG8_WAIT_V(6); PG8_BAR;
    for (;;) {
        const bool has_next = S.next(ui + 1, nxt);
        const char* nA = GATHER ? (const char*)g.A : (has_next ? (const char*)g.A + (unsigned)nxt.am * tstepA : cA);
        const char* nB = has_next ? (const char*)g.Bt + (unsigned)nxt.bn * tstepB : cB;
        if constexpr (GATHER) {
#pragma unroll
            for (int h = 0; h < 2; ++h)
#pragma unroll
                for (int i = 0; i < 2; ++i) vN[h][i] = has_next ? (unsigned)(S.a_row(nxt, h * HALF + Rr[i]) * lda + Cc[i]) * 2u : vC[h][i];
        }
        int tb = 0;
#pragma unroll 1
        for (int seg = 0; seg < (KHOOK ? 3 : 1); ++seg) {
        const int te = KHOOK ? (seg == 0 ? 8 : (seg == 1 ? 12 : nt)) : nt;
        for (int t = tb; t < te; t += 2) {
            const bool last = (t == nt - 2);
            const char* a1 = cA + (unsigned)(t + 1) * kstep;
            const char* a2 = last ? nA : cA + (unsigned)(t + 2) * kstep; const char* b2 = last ? nB : cB + (unsigned)(t + 2) * kstep;
            const char* a3 = a2 + kstep; const char* b3 = b2 + kstep;
            PG8_LDB(B0, 0, 0); PG8_LDB(B1, 0, 1); PG8_SCHED; PG8_LDA(At, 0, 0); PG8_STA(PG8_SA(1, 1), a1, 1, false);
            PG8_WAIT_V(8); PG8_WAIT_L(0); PG8_BAR; PG8_MMA(0, 0, At, B0); PG8_MMA(0, 1, At, B1); PG8_BAR; PG8_SCHED;
            PG8_LDA(At, 0, 1); PG8_STB(PG8_SB(0, 0), b2, 0); PG8_STB(PG8_SB(0, 1), b2, 1); PG8_STA(PG8_SA(0, 0), a2, 0, last);
            PG8_WAIT_V(8); PG8_WAIT_L(0); PG8_BAR; PG8_MMA(1, 0, At, B0); PG8_MMA(1, 1, At, B1); PG8_BAR; PG8_SCHED;
            PG8_LDB(B0, 1, 0); PG8_LDB(B1, 1, 1); PG8_SCHED; PG8_LDA(At, 1, 0); PG8_STA(PG8_SA(0, 1), a2, 1, last);
            PG8_WAIT_V(8); PG8_WAIT_L(0); PG8_BAR; PG8_MMA(0, 0, At, B0); PG8_MMA(0, 1, At, B1); PG8_BAR; PG8_SCHED;
            PG8_LDA(At, 1, 1); PG8_STB(PG8_SB(1, 0), b3, 0); PG8_STB(PG8_SB(1, 1), b3, 1); PG8_STA(PG8_SA(1, 0), a3, 0, last);
            PG8_WAIT_V(8); PG8_WAIT_L(0); PG8_BAR; PG8_MMA(1, 0, At, B0); PG8_MMA(1, 1, At, B1); PG8_BAR; PG8_SCHED;
        }
        if constexpr (KHOOK) { if (seg < 2) { int fr_ = fr, fq_ = fq; asm volatile("" : "+v"(fr_), "+v"(fq_)); E.khook(acc, cur, te, wr, wc, fr_, fq_); } }
        tb = te;
        }
        if (wr == 0) PG8_BAR;
        { int fr_ = fr, fq_ = fq; asm volatile("" : "+v"(fr_), "+v"(fq_)); E(acc, cur, wr, wc, fr_, fq_); }
        if (!has_next) break;
#pragma unroll
        for (int a = 0; a < 2; ++a)
#pragma unroll
            for (int b = 0; b < 2; ++b)
#pragma unroll
                for (int m = 0; m < 4; ++m)
#pragma unroll
                    for (int n = 0; n < 2; ++n) acc[a][b][m][n] = (f32x4){0.f, 0.f, 0.f, 0.f};
        cur = nxt; cA = nA; cB = nB; ++ui;
        if constexpr (GATHER) {
#pragma unroll
            for (int h = 0; h < 2; ++h)
#pragma unroll
                for (int i = 0; i < 2; ++i) vC[h][i] = vN[h][i];
        }
        if (wr == 1) PG8_BAR;
    }
    PG8_WAIT_V(0);
    PG8_BAR;
#undef PG8_SA
#undef PG8_SB
#undef PG8_STAGE
#undef PG8_STA
#undef PG8_STB
#undef PG8_LDA
#undef PG8_LDB
#undef PG8_MMA
#undef PG8_WAIT_V
#undef PG8_WAIT_L
#undef PG8_BAR
#undef PG8_SCHED
}
}

using pg8::Unit;
struct EpiProj {
    static constexpr bool PERM = true;
    bf16 *QK, *Vt8, *At, *QX, *GATES; const float* bgate;
#define EP_LOOP_BEGIN _Pragma("unroll") for (int ai = 0; ai < 2; ++ai) _Pragma("unroll") for (int m = 0; m < 4; ++m) { const int row = row0 + ai * 128 + m * 16; _Pragma("unroll") for (int bj = 0; bj < 2; ++bj) { \
        const f32x4 v0 = acc[ai][bj][m][0], v1 = acc[ai][bj][m][1]; const int cl = cl0 + bj * 128;
#define EP_LOOP_END } asm volatile("" ::: "memory"); }
    __device__ __forceinline__ void operator()(const f32x4 (&acc)[2][2][4][2], const Unit& u, int wr, int wc, int fr, int fq) const {
        const int pn = u.pn, row0 = u.pm * 256 + wr * 64 + fr, cl0 = wc * 32 + 8 * fq;
        if (pn < 4) {
            EP_LOOP_BEGIN
                u32x4 w; w.x = cvt_pk_bf16(v0[0], v0[1]); w.y = cvt_pk_bf16(v0[2], v0[3]); w.z = cvt_pk_bf16(v1[0], v1[1]); w.w = cvt_pk_bf16(v1[2], v1[3]);
                *(u32x4*)(QK + (unsigned)row * 1024 + pn * 256 + cl) = w;
            EP_LOOP_END
        } else if (pn < 6) {
            EP_LOOP_BEGIN
                const int vc = (pn - 4) * 256 + cl, hh = vc >> 6, dh = vc & 63, b = row >> 13, s = row & 8191;
                bf16* p = Vt8 + ((unsigned)((b * 8 + hh) * 1024 + (s >> 3)) * 64 + dh) * 8 + (s & 7);
                const unsigned w0 = cvt_pk_bf16(v0[0], v0[1]), w1 = cvt_pk_bf16(v0[2], v0[3]), w2 = cvt_pk_bf16(v1[0], v1[1]), w3 = cvt_pk_bf16(v1[2], v1[3]);
                p[0] = (bf16)w0; p[8] = (bf16)(w0 >> 16); p[16] = (bf16)w1; p[24] = (bf16)(w1 >> 16); p[32] = (bf16)w2; p[40] = (bf16)(w2 >> 16); p[48] = (bf16)w3; p[56] = (bf16)(w3 >> 16);
            EP_LOOP_END
        } else if (pn == 6) {
            EP_LOOP_BEGIN
                const int g = cl >> 4, c0 = cl & 15, b = row >> 13, s = row & 8191;
                u32x4 w; w.x = cvt_pk_bf16(v0[0], v0[1]); w.y = cvt_pk_bf16(v0[2], v0[3]); w.z = cvt_pk_bf16(v1[0], v1[1]); w.w = cvt_pk_bf16(v1[2], v1[3]);
                *(u32x4*)(At + ((unsigned)((b * 16 + g) * 256 + (s >> 5))) * ATK + (s & 31) * 16 + c0) = w;
            EP_LOOP_END
        } else if (pn == 7) {
            EP_LOOP_BEGIN
                u32x4 w; w.x = cvt_pk_bf16(v0[0], v0[1]); w.y = cvt_pk_bf16(v0[2], v0[3]); w.z = cvt_pk_bf16(v1[0], v1[1]); w.w = cvt_pk_bf16(v1[2], v1[3]);
                *(u32x4*)(QX + (unsigned)row * 256 + cl) = w;
            EP_LOOP_END
        } else {
            EP_LOOP_BEGIN
                const int gc = (pn - 8) * 256 + cl;
                const f32x4 b0 = *(const f32x4*)(bgate + gc), b1 = *(const f32x4*)(bgate + gc + 4);
                u32x4 w; w.x = cvt_pk_bf16(sigmoid_f(v0[0] + b0[0]), sigmoid_f(v0[1] + b0[1])); w.y = cvt_pk_bf16(sigmoid_f(v0[2] + b0[2]), sigmoid_f(v0[3] + b0[3]));
                w.z = cvt_pk_bf16(sigmoid_f(v1[0] + b1[0]), sigmoid_f(v1[1] + b1[1])); w.w = cvt_pk_bf16(sigmoid_f(v1[2] + b1[2]), sigmoid_f(v1[3] + b1[3]));
                *(u32x4*)(GATES + (unsigned)row * 3072 + gc) = w;
            EP_LOOP_END
        }
    }
#undef EP_LOOP_BEGIN
#undef EP_LOOP_END
};
struct EpiMemKV {
    static constexpr bool PERM = true;
    bf16 *Km, *Vm8;
    __device__ __forceinline__ void operator()(const f32x4 (&acc)[2][2][4][2], const Unit& u, int wr, int wc, int fr, int fq) const {
        const int row0 = u.pm * 256 + wr * 64 + fr, cl0 = wc * 32 + 8 * fq;
#pragma unroll
        for (int ai = 0; ai < 2; ++ai)
#pragma unroll
            for (int m = 0; m < 4; ++m) {
                const int row = row0 + ai * 128 + m * 16;
#pragma unroll
                for (int bj = 0; bj < 2; ++bj) {
                    const f32x4 v0 = acc[ai][bj][m][0], v1 = acc[ai][bj][m][1];
                    const int cl = cl0 + bj * 128;
                    const unsigned w0 = cvt_pk_bf16(v0[0], v0[1]), w1 = cvt_pk_bf16(v0[2], v0[3]), w2 = cvt_pk_bf16(v1[0], v1[1]), w3 = cvt_pk_bf16(v1[2], v1[3]);
                    if (u.pn == 0) { u32x4 w; w.x = w0; w.y = w1; w.z = w2; w.w = w3; *(u32x4*)(Km + (unsigned)row * 256 + cl) = w; }
                    else {
                        const int hh = cl >> 6, dh = cl & 63, lb = row >> 8, mm = row & 255;
                        bf16* p = Vm8 + ((unsigned)((lb * 4 + hh) * 32 + (mm >> 3)) * 64 + dh) * 8 + (mm & 7);
                        p[0] = (bf16)w0; p[8] = (bf16)(w0 >> 16); p[16] = (bf16)w1; p[24] = (bf16)(w1 >> 16); p[32] = (bf16)w2; p[40] = (bf16)(w2 >> 16); p[48] = (bf16)w3; p[56] = (bf16)(w3 >> 16);
                    }
                }
                asm volatile("" ::: "memory");
            }
    }
};
struct EpiS5a {
    static constexpr bool PERM = false;
    float* ST;
    __device__ __forceinline__ void operator()(const f32x4 (&acc)[2][2][4][2], const Unit& u, int wr, int wc, int fr, int fq) const {
        const int row0 = u.am * 256 + wr * 64 + fr, col0 = wc * 32 + 4 * fq;
#pragma unroll
        for (int ai = 0; ai < 2; ++ai)
#pragma unroll
            for (int m = 0; m < 4; ++m) { float* rowp = ST + (unsigned)(row0 + ai * 128 + m * 16) * 256 + col0;
#pragma unroll
                for (int bj = 0; bj < 2; ++bj)
#pragma unroll
                    for (int n = 0; n < 2; ++n) *(f32x4*)(rowp + bj * 128 + n * 16) = acc[ai][bj][m][n];
                asm volatile("" ::: "memory"); }
    }
};
struct EpiS5c {
    static constexpr bool PERM = true;
    bf16* Y;
    __device__ __forceinline__ void operator()(const f32x4 (&acc)[2][2][4][2], const Unit& u, int wr, int wc, int fr, int fq) const {
        const int b = u.am >> 4, g = u.am & 15, r0 = wr * 64 + fr, cl0 = u.pn * 256 + wc * 32 + 8 * fq;
#pragma unroll
        for (int ai = 0; ai < 2; ++ai)
#pragma unroll
            for (int m = 0; m < 4; ++m) {
                const int chunk = r0 + ai * 128 + m * 16;
#pragma unroll
                for (int bj = 0; bj < 2; ++bj) {
                    const f32x4 v0 = acc[ai][bj][m][0], v1 = acc[ai][bj][m][1];
                    const int col = cl0 + bj * 128, t = col >> 4, c0 = col & 15;
                    u32x4 w; w.x = cvt_pk_bf16(gelu_tanh_f(v0[0]), gelu_tanh_f(v0[1])); w.y = cvt_pk_bf16(gelu_tanh_f(v0[2]), gelu_tanh_f(v0[3]));
                    w.z = cvt_pk_bf16(gelu_tanh_f(v1[0]), gelu_tanh_f(v1[1])); w.w = cvt_pk_bf16(gelu_tanh_f(v1[2]), gelu_tanh_f(v1[3]));
                    *(u32x4*)(Y + (unsigned)(b * SEQ + chunk * 32 + t) * 256 + g * 16 + c0) = w;
                }
                asm volatile("" ::: "memory");
            }
    }
};
struct EpiGlu {
    static constexpr bool PERM = true;
    bf16* CAT;
    __device__ __forceinline__ void operator()(const f32x4 (&acc)[2][2][4][2], const Unit& u, int wr, int wc, int fr, int fq) const {
        const int row0 = u.pm * 256 + wr * 64 + fr, cl0 = u.pn * 256 + wc * 32 + 8 * fq;
#pragma unroll
        for (int ai = 0; ai < 2; ++ai)
#pragma unroll
            for (int m = 0; m < 4; ++m) {
                const int row = row0 + ai * 128 + m * 16;
#pragma unroll
                for (int bj = 0; bj < 2; ++bj) {
                    const f32x4 v0 = acc[ai][bj][m][0], v1 = acc[ai][bj][m][1];
                    const int col = cl0 + bj * 128;
                    u32x2 w; w.x = cvt_pk_bf16(v0[0] * sigmoid_f(v0[1]), v0[2] * sigmoid_f(v0[3])); w.y = cvt_pk_bf16(v1[0] * sigmoid_f(v1[1]), v1[2] * sigmoid_f(v1[3]));
                    *(u32x2*)(CAT + (unsigned)row * 1024 + 512 + (col >> 1)) = w;
                }
                asm volatile("" ::: "memory");
            }
    }
};
struct EpiMerge {
    static constexpr bool PERM = true;
    const bf16* GATES; bf16* MG;
    __device__ __forceinline__ void khook(f32x4 (&acc)[2][2][4][2], const Unit& u, int t, int wr, int wc, int fr, int fq) const {
        const int row0 = u.pm * 256 + wr * 64 + fr, cl0 = u.pn * 256 + wc * 32 + 8 * fq;
        const int ga = (t == 8) ? 0 : 1024;
#pragma unroll
        for (int ai = 0; ai < 2; ++ai) {
            u32x4 na[4][2], nb[4][2];
#pragma unroll
            for (int m = 0; m < 4; ++m)
#pragma unroll
                for (int bj = 0; bj < 2; ++bj) { const bf16* gp = GATES + (unsigned)((row0 + ai * 128 + m * 16) * 3072 + ga + cl0 + bj * 128); na[m][bj] = *(const u32x4*)gp; nb[m][bj] = *(const u32x4*)(gp + 1024); }
#pragma unroll
            for (int m = 0; m < 4; ++m)
#pragma unroll
                for (int bj = 0; bj < 2; ++bj) {
                    const u32x4 a = na[m][bj], b = nb[m][bj];
                    f32x4 r0, r1;
                    r0[0] = bflo(a.x) * fast_rcp(bflo(b.x)); r0[1] = bfhi(a.x) * fast_rcp(bfhi(b.x)); r0[2] = bflo(a.y) * fast_rcp(bflo(b.y)); r0[3] = bfhi(a.y) * fast_rcp(bfhi(b.y));
                    r1[0] = bflo(a.z) * fast_rcp(bflo(b.z)); r1[1] = bfhi(a.z) * fast_rcp(bfhi(b.z)); r1[2] = bflo(a.w) * fast_rcp(bflo(b.w)); r1[3] = bfhi(a.w) * fast_rcp(bfhi(b.w));
                    acc[ai][bj][m][0] *= r0; acc[ai][bj][m][1] *= r1;
                }
            asm volatile("" ::: "memory");
        }
    }
    __device__ __forceinline__ void operator()(const f32x4 (&acc)[2][2][4][2], const Unit& u, int wr, int wc, int fr, int fq) const {
        const int row0 = u.pm * 256 + wr * 64 + fr, cl0 = u.pn * 256 + wc * 32 + 8 * fq;
#pragma unroll
        for (int ai = 0; ai < 2; ++ai) {
            u32x4 g2[4][2];
#pragma unroll
            for (int m = 0; m < 4; ++m)
#pragma unroll
                for (int bj = 0; bj < 2; ++bj) g2[m][bj] = *(const u32x4*)(GATES + (unsigned)((row0 + ai * 128 + m * 16) * 3072 + 2048 + cl0 + bj * 128));
#pragma unroll
            for (int m = 0; m < 4; ++m)
#pragma unroll
                for (int bj = 0; bj < 2; ++bj) {
                    const u32x4 g = g2[m][bj]; const f32x4 v0 = acc[ai][bj][m][0], v1 = acc[ai][bj][m][1];
                    u32x4 w; w.x = cvt_pk_bf16(v0[0] * bflo(g.x), v0[1] * bfhi(g.x)); w.y = cvt_pk_bf16(v0[2] * bflo(g.y), v0[3] * bfhi(g.y));
                    w.z = cvt_pk_bf16(v1[0] * bflo(g.z), v1[1] * bfhi(g.z)); w.w = cvt_pk_bf16(v1[2] * bflo(g.w), v1[3] * bfhi(g.w));
                    *(u32x4*)(MG + (unsigned)((row0 + ai * 128 + m * 16) * 1024 + cl0 + bj * 128)) = w;
                }
            asm volatile("" ::: "memory");
        }
    }
};
struct EpiRes {
    static constexpr bool PERM = false;
    const float* base; float* out;
    __device__ __forceinline__ void operator()(const f32x4 (&acc)[2][2][4][2], const Unit& u, int wr, int wc, int fr, int fq) const {
        const int row0 = u.pm * 256 + wr * 64 + fr, col0 = u.pn * 256 + wc * 32 + 4 * fq;
#pragma unroll
        for (int ai = 0; ai < 2; ++ai) {
            f32x4 bs[4][2][2];
#pragma unroll
            for (int m = 0; m < 4; ++m)
#pragma unroll
                for (int bj = 0; bj < 2; ++bj)
#pragma unroll
                    for (int n = 0; n < 2; ++n) bs[m][bj][n] = *(const f32x4*)(base + (unsigned)((row0 + ai * 128 + m * 16) * 1024 + col0 + bj * 128 + n * 16));
#pragma unroll
            for (int m = 0; m < 4; ++m)
#pragma unroll
                for (int bj = 0; bj < 2; ++bj)
#pragma unroll
                    for (int n = 0; n < 2; ++n) *(f32x4*)(out + (unsigned)((row0 + ai * 128 + m * 16) * 1024 + col0 + bj * 128 + n * 16)) = bs[m][bj][n] + acc[ai][bj][m][n];
            asm volatile("" ::: "memory");
        }
    }
};
struct EpiMoe1 {
    static constexpr bool PERM = true;
    bf16* ACT; const float* wts;
    __device__ __forceinline__ void operator()(const f32x4 (&acc)[2][2][4][2], const Unit& u, int wr, int wc, int fr, int fq) const {
        const int r0 = wr * 64 + fr, cl0 = wc * 32 + 8 * fq, es = u.pn >> 1;
        float wv[2][4];
#pragma unroll
        for (int ai = 0; ai < 2; ++ai)
#pragma unroll
            for (int m = 0; m < 4; ++m) { const int slot = u.x1 + r0 + ai * 128 + m * 16; wv[ai][m] = slot < u.x2 ? wts[(unsigned)((u.x0 * LCAP + slot) * 2 + es)] : 0.f; }
#pragma unroll
        for (int ai = 0; ai < 2; ++ai)
#pragma unroll
            for (int m = 0; m < 4; ++m) {
                const int r = r0 + ai * 128 + m * 16; const float w = wv[ai][m];
#pragma unroll
                for (int bj = 0; bj < 2; ++bj) {
                    const f32x4 v0 = acc[ai][bj][m][0], v1 = acc[ai][bj][m][1];
                    const int col = cl0 + bj * 128;
                    u32x2 o; o.x = cvt_pk_bf16(v0[0] * sigmoid_f(v0[0]) * v0[1] * w, v0[2] * sigmoid_f(v0[2]) * v0[3] * w); o.y = cvt_pk_bf16(v1[0] * sigmoid_f(v1[0]) * v1[1] * w, v1[2] * sigmoid_f(v1[2]) * v1[3] * w);
                    *(u32x2*)(ACT + (unsigned)((u.pm * 256 + r) * 512 + es * 256 + (u.pn & 1) * 128 + (col >> 1))) = o;
                }
                asm volatile("" ::: "memory");
            }
    }
};
struct EpiMoe2 {
    static constexpr bool PERM = false;
    float* X; const int* list;
    __device__ __forceinline__ void operator()(const f32x4 (&acc)[2][2][4][2], const Unit& u, int wr, int wc, int fr, int fq) const {
        const int r0 = wr * 64 + fr, col0 = u.pn * 256 + wc * 32 + 4 * fq;
#pragma unroll
        for (int ai = 0; ai < 2; ++ai) {
            int tok[4];
#pragma unroll
            for (int m = 0; m < 4; ++m) { const int slot = u.x1 + r0 + ai * 128 + m * 16; tok[m] = slot < u.x2 ? list[(unsigned)(u.x0 * LCAP + slot)] : -1; }
            f32x4 bs[4][2][2];
#pragma unroll
            for (int m = 0; m < 4; ++m)
#pragma unroll
                for (int bj = 0; bj < 2; ++bj)
#pragma unroll
                    for (int n = 0; n < 2; ++n) bs[m][bj][n] = tok[m] >= 0 ? *(const f32x4*)(X + (unsigned)(tok[m] * 1024 + col0 + bj * 128 + n * 16)) : (f32x4){0.f, 0.f, 0.f, 0.f};
#pragma unroll
            for (int m = 0; m < 4; ++m)
#pragma unroll
                for (int bj = 0; bj < 2; ++bj)
#pragma unroll
                    for (int n = 0; n < 2; ++n) if (tok[m] >= 0) *(f32x4*)(X + (unsigned)(tok[m] * 1024 + col0 + bj * 128 + n * 16)) = bs[m][bj][n] + acc[ai][bj][m][n];
            asm volatile("" ::: "memory");
        }
    }
};
#define XB_TMO      128
#define XB_XCNT(j)  (256  + 64 * (j))
#define XB_XSUB(j)  (1280 + 64 * (j))
#define XB_XGEN(j)  (2304 + 64 * (j))
#define XB_TOP      3328
#define XB_TOPGEN   3392
#define XCD_BAR_WORDS 3456
#define XB_SPIN_CAP (1u << 18)
__device__ __forceinline__ unsigned xb_ld(unsigned* p)              { return __hip_atomic_load(p, __ATOMIC_RELAXED, __HIP_MEMORY_SCOPE_AGENT); }
__device__ __forceinline__ unsigned xb_add(unsigned* p, unsigned v) { return __hip_atomic_fetch_add(p, v, __ATOMIC_RELAXED, __HIP_MEMORY_SCOPE_AGENT); }
__device__ __forceinline__ unsigned xb_xcc_id() { return (unsigned)__builtin_amdgcn_s_getreg((3 << 11) | 20) & 0xFu; }
#define XB_SPIN(cond, bar) do { unsigned _sp = 0; while (cond) { __builtin_amdgcn_s_sleep(1); \
    if ((++_sp & 255u) == 0u) { if (xb_ld(&(bar)[XB_TMO])) break; if (_sp > XB_SPIN_CAP) { atomicAdd(&(bar)[XB_TMO], 1u); break; } } } } while (0)
struct XcdBarrier { unsigned* bar; unsigned x; volatile LAS unsigned* st; };
__device__ __forceinline__ XcdBarrier xcd_barrier_post(unsigned* bar, volatile LAS unsigned* st) {
    XcdBarrier b; b.bar = bar; b.x = xb_xcc_id(); b.st = st;
    if (threadIdx.x == 0) (void)xb_add(&bar[XB_XCNT(b.x)], 1u);
    return b;
}
__device__ __forceinline__ void xcd_barrier_complete(unsigned* bar, unsigned x, unsigned& nloc, unsigned& nx) {
    const unsigned G = gridDim.x * gridDim.y * gridDim.z;
    unsigned sum, cnt, mine, sp = 0u;
    for (;;) {
        sum = 0u; cnt = 0u; mine = 0u;
#pragma unroll
        for (unsigned j = 0; j < 16; ++j) { const unsigned c = xb_ld(&bar[XB_XCNT(j)]); sum += c; cnt += (c > 0u) ? 1u : 0u; mine = (j == x) ? c : mine; }
        if (sum == G) break;
        __builtin_amdgcn_s_sleep(1);
        if ((++sp & 255u) == 0u) { if (xb_ld(&bar[XB_TMO])) break; if (sp > XB_SPIN_CAP) { atomicAdd(&bar[XB_TMO], 1u); break; } }
    }
    nloc = mine > 0u ? mine : 1u; nx = cnt > 0u ? cnt : 1u;
}
__device__ __forceinline__ void xcd_barrier(const XcdBarrier& b, bool is_t0) {
    asm volatile("s_waitcnt vmcnt(0)" ::: "memory");
    __syncthreads();
    if (is_t0) {
        unsigned* bar = b.bar;
        __builtin_amdgcn_s_waitcnt(0);
        unsigned nloc = b.st[0], nx = b.st[1];
        if (nloc == 0u) { xcd_barrier_complete(bar, b.x, nloc, nx); b.st[0] = nloc; b.st[1] = nx; }
        const unsigned old = xb_add(&bar[XB_XSUB(b.x)], 1u);
        const unsigned gen = old / nloc;
        if (old + 1u == (gen + 1u) * nloc) {
            __builtin_amdgcn_fence(__ATOMIC_RELEASE, "agent");
            asm volatile("s_waitcnt vmcnt(0)" ::: "memory");
            const unsigned og = xb_add(&bar[XB_TOP], 1u);
            const unsigned tg = og / nx;
            if (og + 1u == (tg + 1u) * nx) xb_add(&bar[XB_TOPGEN], 1u);
            else XB_SPIN(xb_ld(&bar[XB_TOPGEN]) == tg, bar);
            __builtin_amdgcn_fence(__ATOMIC_ACQUIRE, "agent");
            xb_add(&bar[XB_XGEN(b.x)], 1u);
            asm volatile("s_waitcnt vmcnt(0)" ::: "memory");
        } else {
            XB_SPIN(xb_ld(&bar[XB_XGEN(b.x)]) == gen, bar);
            __builtin_amdgcn_fence(__ATOMIC_ACQUIRE, "agent");
            asm volatile("s_waitcnt vmcnt(0)" ::: "memory");
        }
    }
    __syncthreads();
}

constexpr int AT_SLOT = 8192, AT_VOFF = 9 * AT_SLOT;
__device__ __forceinline__ int kswz(int col) { return ((col >> 1) & 1) | (((col >> 3) & 3) << 1); }
template <bool NA>
__device__ __forceinline__ void attn_core(const bf16x8 (&qf)[2], const LAS unsigned char* lds, int rs, int c_lo, bf16* obase, const float* rpbp_h, int rbias0, int c0q, int lane) {
    const int n = lane & 15, q = lane >> 4, cq = c0q + n;
    f32x4 s[8][2];
#pragma unroll
    for (int kb = 0; kb < 8; ++kb) {
        const int slot = NA ? (rs + kb) % 9 : (kb >> 1); const int cb0 = NA ? c_lo : (kb & 1) * 32;
        const LAS unsigned char* kp = lds + slot * AT_SLOT;
#pragma unroll
        for (int blk = 0; blk < 2; ++blk) {
            const int col = cb0 + 8 * (n >> 2) + 4 * blk + (n & 3), f = kswz(col);
            const bf16x8 a0 = *(const LAS bf16x8*)(kp + col * 128 + ((q ^ f) << 4)), a1 = *(const LAS bf16x8*)(kp + col * 128 + (((4 + q) ^ f) << 4));
            f32x4 a = (f32x4){0.f, 0.f, 0.f, 0.f};
            a = __builtin_amdgcn_mfma_f32_16x16x32_bf16(a0, qf[0], a, 0, 0, 0);
            a = __builtin_amdgcn_mfma_f32_16x16x32_bf16(a1, qf[1], a, 0, 0, 0);
            s[kb][blk] = a;
        }
    }
    if (NA) {
        const int cs = min(max(cq - 8, 0), 48);
        const float* bp = rpbp_h + (c_lo - c0q + 8 * q - n + 31);
#pragma unroll
        for (int kb = 0; kb < 8; ++kb) {
            const f32x4 b0 = *(const f32x4*)(bp + (rbias0 + kb) * 64), b1 = *(const f32x4*)(bp + (rbias0 + kb) * 64 + 4);
#pragma unroll
            for (int i = 0; i < 4; ++i) {
                const int kc0 = c_lo + 8 * q + i, kc1 = kc0 + 4;
                s[kb][0][i] = (kc0 >= cs && kc0 < cs + 16) ? s[kb][0][i] + b0[i] : -1e30f;
                s[kb][1][i] = (kc1 >= cs && kc1 < cs + 16) ? s[kb][1][i] + b1[i] : -1e30f;
            }
        }
    }
    float mx = -1e30f;
#pragma unroll
    for (int kb = 0; kb < 8; ++kb)
#pragma unroll
        for (int blk = 0; blk < 2; ++blk)
#pragma unroll
            for (int i = 0; i < 4; ++i) mx = fmaxf(mx, s[kb][blk][i]);
    mx = fmaxf(mx, shfl_xor_f(mx, 16, lane)); mx = fmaxf(mx, shfl_xor_f(mx, 32, lane));
    float sum = 0.f; bf16x8 pf[8];
#pragma unroll
    for (int kb = 0; kb < 8; ++kb) {
        float p[8];
#pragma unroll
        for (int blk = 0; blk < 2; ++blk)
#pragma unroll
            for (int i = 0; i < 4; ++i) { const float e = fast_exp(s[kb][blk][i] - mx); p[blk * 4 + i] = e; sum += e; }
        u32x4 w; w.x = cvt_pk_bf16(p[0], p[1]); w.y = cvt_pk_bf16(p[2], p[3]); w.z = cvt_pk_bf16(p[4], p[5]); w.w = cvt_pk_bf16(p[6], p[7]);
        pf[kb] = __builtin_bit_cast(bf16x8, w);
    }
    sum += shfl_xor_f(sum, 16, lane); sum += shfl_xor_f(sum, 32, lane);
    const float inv = fast_rcp(sum);
#pragma unroll
    for (int db = 0; db < 4; ++db) {
        f32x4 o = (f32x4){0.f, 0.f, 0.f, 0.f};
#pragma unroll
        for (int kb = 0; kb < 8; ++kb) {
            const int slot = NA ? (rs + kb) % 9 : (kb >> 1); const int cb0 = NA ? c_lo : (kb & 1) * 32;
            const bf16x8 vf = *(const LAS bf16x8*)(lds + AT_VOFF + slot * AT_SLOT + ((((cb0 >> 3) + q) * 64 + db * 16 + n) << 4));
            o = __builtin_amdgcn_mfma_f32_16x16x32_bf16(vf, pf[kb], o, 0, 0, 0);
        }
        u32x2 w; w.x = cvt_pk_bf16(o[0] * inv, o[1] * inv); w.y = cvt_pk_bf16(o[2] * inv, o[3] * inv);
        *(u32x2*)(obase + (unsigned)(n * 1024 + 4 * q) + db * 16) = w;
    }
}

constexpr int NWAVES = 8;
constexpr int RING_BYTES = 131072, ATT_BYTES = 147456, MISC_OFF = ATT_BYTES, TAB_OFF = MISC_OFF + 256, LDS_BYTES = 163840;
struct Args { const float* in[30]; float* out; unsigned char* ws; };
struct Frame { LAS unsigned char* lds; int tid, lane, wave, vcu, G; };
enum { I_X = 0, I_MEM, I_NMIX, I_NFFN, I_NMEM, I_WIN, I_BGATE, I_RPB, I_LRE, I_LIM, I_LDT, I_BRE, I_BIM, I_CRE, I_CIM, I_S5D, I_WGLU, I_WMKV, I_WBNA, I_WBS5, I_WBXA, I_WOUT,
       I_WCO, I_BCO, I_WFI, I_BFI, I_WG, I_WU, I_WD, I_FNORM };

__device__ __forceinline__ void transpose_item(const float* W, int ldn, int k0, int n0, bf16* WT, int ldk, int dk0, int row_off, int rmul, int radd, int qs, LAS float* scr, int lane) {
    { float t[32]; const float* wp = W + (size_t)(k0 + (lane >> 5)) * ldn + n0 + (lane & 31);
#pragma unroll
      for (int i = 0; i < 32; ++i) t[i] = wp[(size_t)(2 * i) * ldn];
#pragma unroll
      for (int i = 0; i < 32; ++i) scr[(2 * i + (lane >> 5)) * 33 + (lane & 31)] = t[i]; }
    LDS_WAIT(); asm volatile("" ::: "memory");
    const int c = lane & 7;
#pragma unroll
    for (int j = 0; j < 4; ++j) { const int n = (lane >> 3) + 8 * j, nn = n0 + n; const LAS float* s = scr + (8 * c) * 33 + n;
        const float sc = (qs && (nn < 512 || (nn >= 1792 && nn < 2048))) ? 0.125f : 1.0f;
        u32x4 o; o.x = cvt_pk_bf16(s[0 * 33] * sc, s[1 * 33] * sc); o.y = cvt_pk_bf16(s[2 * 33] * sc, s[3 * 33] * sc); o.z = cvt_pk_bf16(s[4 * 33] * sc, s[5 * 33] * sc); o.w = cvt_pk_bf16(s[6 * 33] * sc, s[7 * 33] * sc);
        *(u32x4*)(WT + (size_t)(row_off + nn * rmul + radd) * ldk + dk0 + k0 + 8 * c) = o; }
    LDS_WAIT(); asm volatile("" ::: "memory");
}
__device__ __forceinline__ void transpose_job_item(const float* W, int ldn, int N, int it, bf16* WT, int ldk, int dk0, int row_off, int rmul, int radd, int qs, LAS float* scr, int lane) {
    const int nblk = N / 32, kb = it / nblk, nb = it % nblk;
    transpose_item(W, ldn, 64 * kb, 32 * nb, WT, ldk, dk0, row_off, rmul, radd, qs, scr, lane);
}

__device__ __forceinline__ void cexp_d(double zr, double zi, double& er, double& ei) {
    const double wr_ = zr * (1.0 / 1024.0), wi_ = zi * (1.0 / 1024.0);
    double tr = 1.0, ti = 0.0;
#pragma unroll
    for (int n = 12; n >= 1; --n) { const double ar = wr_ * (1.0 / n), ai = wi_ * (1.0 / n); const double nr = 1.0 + (ar * tr - ai * ti), ni = ar * ti + ai * tr; tr = nr; ti = ni; }
#pragma unroll
    for (int k = 0; k < 10; ++k) { const double nr = tr * tr - ti * ti, ni = 2.0 * tr * ti; tr = nr; ti = ni; }
    er = tr; ei = ti;
}

template <bool ROUTER>
__device__ __forceinline__ void norm_rows4(const float* X, const float* gain, bf16* H, int row0, int lane,
                                           const float* wrt, const float* bco, const float* bfi, unsigned* cnt, int* list, float* wts) {
    f32x4 x[4][4]; float rstd[4];
#pragma unroll
    for (int r = 0; r < 4; ++r) { float ss = 0.f;
#pragma unroll
        for (int j = 0; j < 4; ++j) { x[r][j] = *(const f32x4*)(X + (size_t)(row0 + r) * 1024 + 256 * j + 4 * lane); ss += (x[r][j][0] * x[r][j][0] + x[r][j][1] * x[r][j][1]) + (x[r][j][2] * x[r][j][2] + x[r][j][3] * x[r][j][3]); }
        ss = wave_sum(ss, lane); rstd[r] = 1.0f / sqrtf(ss * (1.0f / 1024.0f) + RMS_EPS); }
#pragma unroll
    for (int j = 0; j < 4; ++j) { const f32x4 g4 = *(const f32x4*)(gain + 256 * j + 4 * lane);
#pragma unroll
        for (int r = 0; r < 4; ++r) { const f32x4 v = x[r][j] * rstd[r] * g4; u32x2 w; w.x = cvt_pk_bf16(v[0], v[1]); w.y = cvt_pk_bf16(v[2], v[3]);
            *(u32x2*)(H + (size_t)(row0 + r) * 1024 + 256 * j + 4 * lane) = w; } }
    if constexpr (ROUTER) {
        float keep[4] = {0.f, 0.f, 0.f, 0.f};
#pragma unroll 2
        for (int c = 0; c < 20; ++c) {
            float a0 = 0.f, a1 = 0.f, a2 = 0.f, a3 = 0.f;
#pragma unroll
            for (int j = 0; j < 4; ++j) { const f32x4 w4 = *(const f32x4*)(wrt + c * 1024 + 256 * j + 4 * lane);
                a0 += (x[0][j][0] * w4[0] + x[0][j][1] * w4[1]) + (x[0][j][2] * w4[2] + x[0][j][3] * w4[3]);
                a1 += (x[1][j][0] * w4[0] + x[1][j][1] * w4[1]) + (x[1][j][2] * w4[2] + x[1][j][3] * w4[3]);
                a2 += (x[2][j][0] * w4[0] + x[2][j][1] * w4[1]) + (x[2][j][2] * w4[2] + x[2][j][3] * w4[3]);
                a3 += (x[3][j][0] * w4[0] + x[3][j][1] * w4[1]) + (x[3][j][2] * w4[2] + x[3][j][3] * w4[3]); }
            a0 = wave_sum(a0, lane); a1 = wave_sum(a1, lane); a2 = wave_sum(a2, lane); a3 = wave_sum(a3, lane);
            if (lane == c) { keep[0] = a0 * rstd[0]; keep[1] = a1 * rstd[1]; keep[2] = a2 * rstd[2]; keep[3] = a3 * rstd[3]; }
        }
#pragma unroll
        for (int r = 0; r < 4; ++r) {
            float co[4];
#pragma unroll
            for (int i = 0; i < 4; ++i) co[i] = shfl_idx_f(keep[r], i) + bco[i];
            int grp = 0; float cm = co[0];
#pragma unroll
            for (int i = 1; i < 4; ++i) if (co[i] > cm) { cm = co[i]; grp = i; }
            float den = 0.f;
#pragma unroll
            for (int i = 0; i < 4; ++i) den += __expf(co[i] - cm);
            const float pgrp = 1.0f / den;
            float fv[4];
#pragma unroll
            for (int i = 0; i < 4; ++i) fv[i] = shfl_idx_f(keep[r], 4 + grp * 4 + i) + bfi[grp * 4 + i];
            int i1 = 0; float v1 = fv[0];
#pragma unroll
            for (int i = 1; i < 4; ++i) if (fv[i] > v1) { v1 = fv[i]; i1 = i; }
            int i2 = -1; float v2 = -3.0e38f;
#pragma unroll
            for (int i = 0; i < 4; ++i) if (i != i1 && fv[i] > v2) { v2 = fv[i]; i2 = i; }
            const float w1 = pgrp / (1.0f + __expf(v2 - v1)), w2 = pgrp - w1;
            const int a = i1 < i2 ? i1 : i2, b = i1 < i2 ? i2 : i1;
            const int pidx = a == 0 ? b - 1 : (a == 1 ? b + 1 : 5);
            const int bucket = grp * 6 + pidx;
            const float wa = (i1 == a) ? w1 : w2, wb = (i1 == a) ? w2 : w1;
            if (lane == 0) {
                const unsigned slot = __hip_atomic_fetch_add(cnt + bucket * 64, 1u, __ATOMIC_RELAXED, __HIP_MEMORY_SCOPE_AGENT);
                list[(size_t)bucket * LCAP + slot] = row0 + r;
                *(f32x2*)(wts + ((size_t)bucket * LCAP + slot) * 2) = (f32x2){wa, wb};
            }
        }
    }
}

constexpr int RT_STRIDE = 2064;
constexpr int RT_BYTES = 40 * RT_STRIDE;
constexpr int RT_SCR = 98304;
__device__ __forceinline__ void router_rows16(const float* X, const float* gain, bf16* H, int R0, int lane, LAS unsigned char* lds, int wave,
                                              const float* bco, const float* bfi, unsigned* cnt, int* list, float* wts) {
    const int n = lane & 15, q = lane >> 4;
    f32x4 accF = (f32x4){0.f, 0.f, 0.f, 0.f}, accC = (f32x4){0.f, 0.f, 0.f, 0.f};
    float ss = 0.f;
    const float* xp = X + (unsigned)((R0 + n) * 1024 + 8 * q);
    const LAS unsigned char* tF = lds + n * RT_STRIDE + 16 * q; const LAS unsigned char* tC = lds + (16 + (n & 3)) * RT_STRIDE + 16 * q;
#pragma unroll 4
    for (int ks = 0; ks < 32; ++ks) {
        const f32x4 x0 = *(const f32x4*)(xp + ks * 32), x1 = *(const f32x4*)(xp + ks * 32 + 4);
        ss += (x0[0] * x0[0] + x0[1] * x0[1]) + (x0[2] * x0[2] + x0[3] * x0[3]) + (x1[0] * x1[0] + x1[1] * x1[1]) + (x1[2] * x1[2] + x1[3] * x1[3]);
        u32x4 hw; hw.x = cvt_pk_bf16(x0[0], x0[1]); hw.y = cvt_pk_bf16(x0[2], x0[3]); hw.z = cvt_pk_bf16(x1[0], x1[1]); hw.w = cvt_pk_bf16(x1[2], x1[3]);
        u32x4 lw; lw.x = cvt_pk_bf16(x0[0] - bflo(hw.x), x0[1] - bfhi(hw.x)); lw.y = cvt_pk_bf16(x0[2] - bflo(hw.y), x0[3] - bfhi(hw.y));
        lw.z = cvt_pk_bf16(x1[0] - bflo(hw.z), x1[1] - bfhi(hw.z)); lw.w = cvt_pk_bf16(x1[2] - bflo(hw.w), x1[3] - bfhi(hw.w));
        const bf16x8 ah = __builtin_bit_cast(bf16x8, hw), al = __builtin_bit_cast(bf16x8, lw);
        const bf16x8 fh = *(const LAS bf16x8*)(tF + ks * 64), fl = *(const LAS bf16x8*)(tF + 20 * RT_STRIDE + ks * 64);
        const bf16x8 ch = *(const LAS bf16x8*)(tC + ks * 64), cl = *(const LAS bf16x8*)(tC + 20 * RT_STRIDE + ks * 64);
        accF = __builtin_amdgcn_mfma_f32_16x16x32_bf16(ah, fh, accF, 0, 0, 0); accF = __builtin_amdgcn_mfma_f32_16x16x32_bf16(ah, fl, accF, 0, 0, 0); accF = __builtin_amdgcn_mfma_f32_16x16x32_bf16(al, fh, accF, 0, 0, 0);
        accC = __builtin_amdgcn_mfma_f32_16x16x32_bf16(ah, ch, accC, 0, 0, 0); accC = __builtin_amdgcn_mfma_f32_16x16x32_bf16(ah, cl, accC, 0, 0, 0); accC = __builtin_amdgcn_mfma_f32_16x16x32_bf16(al, ch, accC, 0, 0, 0);
    }
    ss += shfl_xor_f(ss, 16, lane); ss += shfl_xor_f(ss, 32, lane);
    const float rstd = 1.0f / sqrtf(ss * (1.0f / 1024.0f) + RMS_EPS);
    LAS float* sc = (LAS float*)(lds + RT_SCR + wave * 1536);
#pragma unroll
    for (int r = 0; r < 4; ++r) { const float rs = shfl_idx_f(rstd, 4 * q + r); sc[(4 * q + r) * 24 + n] = accF[r] * rs; if (n < 4) sc[(4 * q + r) * 24 + 16 + n] = accC[r] * rs; }
    LDS_WAIT(); asm volatile("" ::: "memory");
    if (lane < 16) {
        const LAS float* my = sc + lane * 24;
        float co[4];
#pragma unroll
        for (int i = 0; i < 4; ++i) co[i] = my[16 + i] + bco[i];
        int grp = 0; float cm = co[0];
#pragma unroll
        for (int i = 1; i < 4; ++i) if (co[i] > cm) { cm = co[i]; grp = i; }
        float den = 0.f;
#pragma unroll
        for (int i = 0; i < 4; ++i) den += __expf(co[i] - cm);
        const float pgrp = 1.0f / den;
        float fv[4];
#pragma unroll
        for (int i = 0; i < 4; ++i) fv[i] = my[grp * 4 + i] + bfi[grp * 4 + i];
        int i1 = 0; float v1 = fv[0];
#pragma unroll
        for (int i = 1; i < 4; ++i) if (fv[i] > v1) { v1 = fv[i]; i1 = i; }
        int i2 = -1; float v2 = -3.0e38f;
#pragma unroll
        for (int i = 0; i < 4; ++i) if (i != i1 && fv[i] > v2) { v2 = fv[i]; i2 = i; }
        const float w1 = pgrp / (1.0f + __expf(v2 - v1)), w2 = pgrp - w1;
        const int a = i1 < i2 ? i1 : i2, b = i1 < i2 ? i2 : i1;
        const int pidx = a == 0 ? b - 1 : (a == 1 ? b + 1 : 5);
        const int bucket = grp * 6 + pidx;
        const float wa = (i1 == a) ? w1 : w2, wb = (i1 == a) ? w2 : w1;
        const unsigned slot = __hip_atomic_fetch_add(cnt + bucket * 64, 1u, __ATOMIC_RELAXED, __HIP_MEMORY_SCOPE_AGENT);
        list[(unsigned)(bucket * LCAP) + slot] = R0 + lane;
        *(f32x2*)(wts + ((unsigned)(bucket * LCAP) + slot) * 2) = (f32x2){wa, wb};
    }
    f32x4 g4[4];
#pragma unroll
    for (int j = 0; j < 4; ++j) g4[j] = *(const f32x4*)(gain + 256 * j + 4 * lane);
#pragma unroll 4
    for (int rr = 0; rr < 16; ++rr) {
        const float rs = shfl_idx_f(rstd, rr);
        const float* xr = X + (unsigned)((R0 + rr) * 1024 + 4 * lane); bf16* hr = H + (unsigned)((R0 + rr) * 1024 + 4 * lane);
#pragma unroll
        for (int j = 0; j < 4; ++j) { const f32x4 v = *(const f32x4*)(xr + 256 * j) * rs * g4[j]; u32x2 w; w.x = cvt_pk_bf16(v[0], v[1]); w.y = cvt_pk_bf16(v[2], v[3]); *(u32x2*)(hr + 256 * j) = w; }
    }
}

__device__ __forceinline__ void final_norm_row(float* X, const float* gain, int row, int lane) {
    f32x4 x[4]; float ss = 0.f;
#pragma unroll
    for (int j = 0; j < 4; ++j) { x[j] = *(const f32x4*)(X + (size_t)row * 1024 + 256 * j + 4 * lane); ss += (x[j][0] * x[j][0] + x[j][1] * x[j][1]) + (x[j][2] * x[j][2] + x[j][3] * x[j][3]); }
    ss = wave_sum(ss, lane); const float rstd = 1.0f / sqrtf(ss * (1.0f / 1024.0f) + RMS_EPS);
#pragma unroll
    for (int j = 0; j < 4; ++j) { const f32x4 g4 = *(const f32x4*)(gain + 256 * j + 4 * lane); *(f32x4*)(X + (size_t)row * 1024 + 256 * j + 4 * lane) = x[j] * rstd * g4; }
}

__device__ __forceinline__ void s5_scan_item(int item, const float* ST, bf16* At, const f32x2* apow_l, LAS float* sc, int tid) {
    const int d = item & 1, bg = item >> 1, g = bg & 15, seg = tid >> 6, p = tid & 63;
    const f32x2 A32 = apow_l[((d * 16 + g) * 33 + 32) * 64 + p];
    const int chunk0 = d ? 255 - seg * 32 : seg * 32; const long cstep = d ? -1 : 1;
    const float* rp0 = ST + (size_t)(bg * 256 + chunk0) * 256 + d * 128 + p;
    float tr = 0.f, ti = 0.f;
#pragma unroll 8
    for (int j = 0; j < 32; ++j) { const float* rp = rp0 + cstep * j * 256; const float sr = rp[0], si = rp[64]; const float nr = A32.x * tr - A32.y * ti + sr, ni = A32.x * ti + A32.y * tr + si; tr = nr; ti = ni; }
    sc[(seg * 64 + p) * 2] = tr; sc[(seg * 64 + p) * 2 + 1] = ti;
    __syncthreads();
    float pr = A32.x, pi = A32.y;
#pragma unroll
    for (int k = 0; k < 5; ++k) { const float nr = pr * pr - pi * pi, ni = 2.f * pr * pi; pr = nr; pi = ni; }
    float er = 0.f, ei = 0.f;
    for (int s2 = 0; s2 < seg; ++s2) { const float qr = sc[(s2 * 64 + p) * 2], qi = sc[(s2 * 64 + p) * 2 + 1]; const float nr = pr * er - pi * ei + qr, ni = pr * ei + pi * er + qi; er = nr; ei = ni; }
    bf16* op0 = At + (size_t)(bg * 256 + chunk0) * ATK + 512 + d * 128 + p;
#pragma unroll 8
    for (int j = 0; j < 32; ++j) { const float* rp = rp0 + cstep * j * 256; const float sr = rp[0], si = rp[64]; bf16* op = op0 + cstep * j * ATK;
        op[0] = (bf16)(cvt_pk_bf16(er, er) & 0xffffu); op[64] = (bf16)(cvt_pk_bf16(ei, ei) & 0xffffu);
        const float nr = A32.x * er - A32.y * ei + sr, ni = A32.x * ei + A32.y * er + si; er = nr; ei = ni; }
    __syncthreads();
}

#define XA_ITEMS(first, last, stride) do { \
    const bf16* QX = WP(bf16, WS_QX); const bf16* KM = WP(bf16, WS_KM); const bf16* VM8 = WP(bf16, WS_VM8); bf16* Hx = WP(bf16, WS_H); \
    const int n_ = lane & 15, q_ = lane >> 4, kcol = tid >> 3, kdst = kcol * 128 + (((tid & 7) ^ kswz(kcol)) << 4); \
    for (int item = (first); item < (last); item += (stride)) { \
        const int b = item >> 6, h = (item >> 4) & 3, qc = item & 15; \
        const bf16* Kg = KM + ((size_t)(l * 4 + b) * 256) * 256 + h * 64 + (unsigned)(kcol * 256 + (tid & 7) * 8); \
        const bf16* Vg = VM8 + (size_t)((l * 4 + b) * 4 + h) * 32 * 512 + (unsigned)(tid * 8); \
        _Pragma("unroll") for (int j = 0; j < 4; ++j) { const u32x4 kv = *(const u32x4*)(Kg + j * 64 * 256), vv = *(const u32x4*)(Vg + j * 4096); \
            *(LAS u32x4*)(F.lds + j * AT_SLOT + kdst) = kv; *(LAS u32x4*)(F.lds + AT_VOFF + j * AT_SLOT + tid * 16) = vv; } \
        __syncthreads(); \
        _Pragma("unroll 1") for (int j = 0; j < 4; ++j) { \
            const int t0 = b * SEQ + qc * 512 + wave * 64 + j * 16; \
            bf16x8 qf[2]; { const bf16* qb = QX + (size_t)t0 * 256 + h * 64 + (unsigned)(n_ * 256 + 8 * q_); qf[0] = *(const bf16x8*)qb; qf[1] = *(const bf16x8*)(qb + 32); } \
            attn_core<false>(qf, F.lds, 0, 0, Hx + (size_t)t0 * 1024 + 768 + h * 64, nullptr, 0, 0, lane); } \
        __syncthreads(); \
    } } while (0)

#ifndef PHMASK
#define PHMASK 0xffffffffu
#endif
#define PH(k) ((PHMASK >> (k)) & 1u)
#ifndef REPMASK
#define REPMASK 0u
#endif
#define NREP(k) (1 + (int)((REPMASK >> (k)) & 1u))
constexpr int PTR_OFF = MISC_OFF + 1024;
__device__ __forceinline__ const float* inp(LAS unsigned char* lds, int i, int z) {
    const LAS unsigned* q = (const LAS unsigned*)(lds + PTR_OFF + 8 * i + z);
    const unsigned lo = __builtin_amdgcn_readfirstlane(q[0]), hi = __builtin_amdgcn_readfirstlane(q[1]);
    return (const float*)(((unsigned long long)hi << 32) | lo);
}
#define WSL() unsigned char* wsl = args.ws; int wave = F.wave, bid = blockIdx.x, G = gridDim.x, zz = 0; unsigned mm_ = ~0u; asm volatile("" : "+s"(mm_)); int lane = (int)__builtin_amdgcn_mbcnt_hi(mm_, __builtin_amdgcn_mbcnt_lo(mm_, 0u)); \
    asm volatile("" : "+s"(wsl), "+s"(wave), "+v"(lane), "+s"(bid), "+s"(G), "+s"(zz)); \
    const int tid = wave * 64 + lane, vcu = (G % 8 == 0) ? (bid % 8) * (G / 8) + bid / 8 : bid, gw = vcu * NWAVES + wave, NGW = G * NWAVES, NGT = G * NWAVES * 64; \
    (void)tid; (void)gw; (void)NGW; (void)NGT; (void)wsl
#define WP(T, off) ((T*)(wsl + (off)))
#define IN(i) inp(F.lds, (i), zz)

__global__ void __launch_bounds__(NWAVES * 64, 2) fwd_kernel(Args args) {
    extern __shared__ __attribute__((aligned(16))) unsigned char lds_raw[];
    Frame F;
    F.lds = (LAS unsigned char*)lds_raw;
    F.tid = threadIdx.x; F.lane = F.tid & 63; F.wave = __builtin_amdgcn_readfirstlane(F.tid >> 6);
    F.G = gridDim.x; { const int bx = blockIdx.x; F.vcu = (F.G % 8 == 0) ? (bx % 8) * (F.G / 8) + bx / 8 : bx; }
    for (int u = F.tid; u < (LDS_BYTES - MISC_OFF) / 4; u += NWAVES * 64) ((LAS unsigned*)(F.lds + MISC_OFF))[u] = 0u;
    __syncthreads();
    if (F.tid < 30) { const unsigned long long p = (unsigned long long)args.in[F.tid]; LAS unsigned* q = (LAS unsigned*)(F.lds + PTR_OFF + 8 * F.tid); q[0] = (unsigned)p; q[1] = (unsigned)(p >> 32); }
    __syncthreads();
    (void)xcd_barrier_post((unsigned*)(args.ws + WS_CTL) + CW_BAR, (volatile LAS unsigned*)(F.lds + MISC_OFF));
#define GRID_BAR() do { unsigned char* w_ = args.ws; asm volatile("" : "+s"(w_)); XcdBarrier b_; b_.bar = (unsigned*)(w_ + WS_CTL) + CW_BAR; b_.x = xb_xcc_id(); b_.st = (volatile LAS unsigned*)(F.lds + MISC_OFF); unsigned m_ = ~0u; int wv_ = F.wave; asm volatile("" : "+s"(m_), "+s"(wv_)); \
    xcd_barrier(b_, (wv_ == 0) && (__builtin_amdgcn_mbcnt_hi(m_, __builtin_amdgcn_mbcnt_lo(m_, 0u)) == 0u)); } while (0)
#define GT() (vcu * (NWAVES * 64) + tid)
#define SCR() ((LAS float*)(F.lds + wave * 16384))

    if (PH(0)) {
        WSL();
        f32x2* APOW = WP(f32x2, WS_APOW); f32x2* BBAR = WP(f32x2, WS_BBAR); bf16* WRT = WP(bf16, WS_WRT); bf16* MEMN = WP(bf16, WS_MEMN); bf16* WMKV = WP(bf16, WS_WMKV);
        for (int it = gw; it < 1024; it += NGW) { const int l = it >> 8, r = it & 255;
            transpose_job_item(IN(I_WMKV) + (size_t)l * 1024 * 512, 512, 512, r, WMKV + (size_t)l * 512 * 1024, 1024, 0, 0, 1, 0, 0, SCR(), lane); }
        for (int it = gw; it < 4096; it += NGW) { const int l = it >> 10, row = it & 1023;
            const float* xr = IN(I_MEM) + (size_t)row * 1024; const float* gn = IN(I_NMEM) + l * 1024;
            f32x4 x[4]; float ss = 0.f;
#pragma unroll
            for (int j = 0; j < 4; ++j) { x[j] = *(const f32x4*)(xr + 256 * j + 4 * lane); ss += (x[j][0] * x[j][0] + x[j][1] * x[j][1]) + (x[j][2] * x[j][2] + x[j][3] * x[j][3]); }
            ss = wave_sum(ss, lane); const float rstd = 1.0f / sqrtf(ss * (1.0f / 1024.0f) + RMS_EPS);
#pragma unroll
            for (int j = 0; j < 4; ++j) { const f32x4 v = x[j] * rstd * *(const f32x4*)(gn + 256 * j + 4 * lane); u32x2 w; w.x = cvt_pk_bf16(v[0], v[1]); w.y = cvt_pk_bf16(v[2], v[3]);
                *(u32x2*)(MEMN + (size_t)it * 1024 + 256 * j + 4 * lane) = w; } }
        for (int it = GT(); it < 8192; it += NGT) {
            const int p = it & 63, ldg = it >> 6;
            const double lr = fmin((double)IN(I_LRE)[it], -1e-4), li = (double)IN(I_LIM)[it];
            double dt, dum; cexp_d((double)IN(I_LDT)[ldg], 0.0, dt, dum);
            double ar, ai; cexp_d(lr * dt, li * dt, ar, ai);
            const double den = lr * lr + li * li, fr = ((ar - 1.0) * lr + ai * li) / den, fi = (ai * lr - (ar - 1.0) * li) / den;
            const float* bre = IN(I_BRE) + (size_t)it * 16; const float* bim = IN(I_BIM) + (size_t)it * 16;
#pragma unroll 4
            for (int c = 0; c < 16; ++c) { const double br = (double)bre[c], bi = (double)bim[c];
                BBAR[(size_t)it * 16 + c] = (f32x2){(float)(fr * br - fi * bi), (float)(fr * bi + fi * br)}; }
            double pr = 1.0, pi = 0.0;
            for (int n = 0; n <= 32; ++n) { APOW[((size_t)ldg * 33 + n) * 64 + p] = (f32x2){(float)pr, (float)pi}; const double nr = pr * ar - pi * ai, ni = pr * ai + pi * ar; pr = nr; pi = ni; }
        }
        { float* RPBP = WP(float, WS_RPBP); const float* rpb = IN(I_RPB);
          for (int it = GT(); it < 4 * 8 * 15 * 64; it += NGT) { const int j = it & 63; RPBP[it] = (j >= 16 && j < 47) ? rpb[(it >> 6) * 31 + (j - 16)] : 0.f; } }
        for (int it = GT(); it < 4 * 20480; it += NGT) { const int l = it / 20480, r = it % 20480, c = r >> 10, k = r & 1023;
            const float gk = IN(I_NFFN)[l * 1024 + k];
            const float v = gk * (c < 16 ? IN(I_WFI)[(size_t)(l * 1024 + k) * 16 + c] : IN(I_WCO)[(size_t)(l * 1024 + k) * 4 + (c - 16)]);
            const unsigned hw = cvt_pk_bf16(v, v) & 0xffffu; const float lo = v - bflo(hw);
            WRT[(size_t)(l * 2 + 0) * 20480 + r] = (bf16)hw; WRT[(size_t)(l * 2 + 1) * 20480 + r] = (bf16)(cvt_pk_bf16(lo, lo) & 0xffffu); }
    }
    GRID_BAR();

    if (PH(1)) {
        WSL();
        { pg8::Gemm g{WP(bf16, WS_MEMN), WP(bf16, WS_WMKV), 1024, 1024, 1024}; pg8::MemOrder S{G, bid}; EpiMemKV E{WP(bf16, WS_KM), WP(bf16, WS_VM8)};
          pg8::gemm_phase<EpiMemKV, pg8::MemOrder>(F.lds, g, S, E, tid); }
        const f32x2* APOW = WP(f32x2, WS_APOW); const f32x2* BBAR = WP(f32x2, WS_BBAR); float* KT = WP(float, WS_KT);
        const float* CRE = IN(I_CRE); const float* CIM = IN(I_CIM); const float* S5D = IN(I_S5D);
        for (int it = GT(); it < 4 * 16 * 63 * 64; it += NGT) {
            const int c2 = (it & 3) * 4, c = (it >> 2) & 15, rest = it >> 6, tp = rest % 63, lg = rest / 63, l = lg >> 4, g = lg & 15;
            f32x4 sum = (f32x4){0.f, 0.f, 0.f, 0.f};
#pragma unroll 1
            for (int d = 0; d < 2; ++d) {
                if (d == 0 ? (tp < 31) : (tp > 31)) continue;
                const int n = d == 0 ? tp - 31 : 31 - tp, base = (l * 2 + d) * 16 + g;
                const float* cre = CRE + ((size_t)base * 16 + c) * 64; const float* cim = CIM + ((size_t)base * 16 + c) * 64;
                const f32x2* ap = APOW + ((size_t)base * 33 + n) * 64; const f32x4* bb = (const f32x4*)(BBAR + (size_t)base * 64 * 16 + c2);
#pragma unroll 8
                for (int p = 0; p < 64; ++p) { const f32x2 a = ap[p]; const f32x4 b0 = bb[p * 8], b1 = bb[p * 8 + 1]; const float cr = cre[p], ci = cim[p];
                    const float er = cr * a.x - ci * a.y, ei = cr * a.y + ci * a.x;
                    sum[0] += er * b0[0] - ei * b0[1]; sum[1] += er * b0[2] - ei * b0[3]; sum[2] += er * b1[0] - ei * b1[1]; sum[3] += er * b1[2] - ei * b1[3]; }
            }
            if (tp == 31 && c >= c2 && c < c2 + 4) sum[c - c2] += S5D[l * 256 + g * 16 + c];
            *(f32x4*)(KT + (size_t)it * 4) = sum;
        }
    }
    GRID_BAR();

    const float* xcur = args.in[I_X];
    float* XO = args.out;
#pragma unroll 1
    for (int l = 0; l < DEPTH; ++l) {
        for (int rep_ = 0; rep_ < NREP(2); ++rep_) {
        if (PH(2)) {
            WSL();
            {
            bf16* WIN = WP(bf16, WS_WIN); bf16* WCAT = WP(bf16, WS_WCAT); bf16* WOUT = WP(bf16, WS_WOUT); bf16* WGLU = WP(bf16, WS_WGLU);
            for (int it = gw; it < 3648; it += NGW) {
                int r = it;
                if (r < 2560) { transpose_job_item(IN(I_WIN) + (size_t)l * 1024 * 5120, 5120, 5120, r, WIN, 1024, 0, 0, 1, 0, 1, SCR(), lane); continue; } r -= 2560;
                if (r < 256) { transpose_job_item(IN(I_WBNA) + (size_t)l * 512 * 1024, 1024, 1024, r, WCAT, 1024, 0, 0, 1, 0, 0, SCR(), lane); continue; } r -= 256;
                if (r < 128) { transpose_job_item(IN(I_WBS5) + (size_t)l * 256 * 1024, 1024, 1024, r, WCAT, 1024, 512, 0, 1, 0, 0, SCR(), lane); continue; } r -= 128;
                if (r < 128) { transpose_job_item(IN(I_WBXA) + (size_t)l * 256 * 1024, 1024, 1024, r, WCAT, 1024, 768, 0, 1, 0, 0, SCR(), lane); continue; } r -= 128;
                if (r < 512) { transpose_job_item(IN(I_WOUT) + (size_t)l * 1024 * 1024, 1024, 1024, r, WOUT, 1024, 0, 0, 1, 0, 0, SCR(), lane); continue; } r -= 512;
                if (r < 32) { transpose_job_item(IN(I_WGLU) + (size_t)l * 256 * 512, 512, 256, r, WGLU, 256, 0, 0, 2, 0, 0, SCR(), lane); continue; } r -= 32;
                transpose_job_item(IN(I_WGLU) + (size_t)l * 256 * 512 + 256, 512, 256, r, WGLU, 256, 0, 0, 2, 1, 0, SCR(), lane);
            }
            }
            {
            const f32x2* APOW = WP(f32x2, WS_APOW); const f32x2* BBAR = WP(f32x2, WS_BBAR); bf16* S5W = WP(bf16, WS_S5W);
            for (int it = GT(); it < 16 * 256 * 64; it += NGT) {
                const int k8 = it & 63, n = (it >> 6) & 255, g = it >> 14;
                const int s = k8 >> 1, c0 = (k8 & 1) * 8, d = n >> 7, ri = (n >> 6) & 1, p = n & 63, e = d == 0 ? 31 - s : s, base = (l * 2 + d) * 16 + g;
                const f32x2 a = APOW[((size_t)base * 33 + e) * 64 + p]; const f32x2* bb = BBAR + ((size_t)base * 64 + p) * 16 + c0;
                float v[8];
#pragma unroll
                for (int j = 0; j < 8; ++j) { const f32x2 b = bb[j]; v[j] = ri == 0 ? a.x * b.x - a.y * b.y : a.x * b.y + a.y * b.x; }
                u32x4 w; w.x = cvt_pk_bf16(v[0], v[1]); w.y = cvt_pk_bf16(v[2], v[3]); w.z = cvt_pk_bf16(v[4], v[5]); w.w = cvt_pk_bf16(v[6], v[7]);
                *(u32x4*)(S5W + ((size_t)(g * 256 + n) * 512 + k8 * 8)) = w;
            }
            const float* KT = WP(float, WS_KT); bf16* S5KV = WP(bf16, WS_S5KV); const float* CRE = IN(I_CRE); const float* CIM = IN(I_CIM);
            for (int it = GT(); it < 16 * 512 * 96; it += NGT) {
                const int k8 = it % 96, rest = it / 96, n = rest & 511, g = rest >> 9, t = n >> 4, c = n & 15;
                float v[8];
                if (k8 < 64) { const int s = k8 >> 1, c0 = (k8 & 1) * 8, tp = t - s + 31; const float* kp = KT + ((size_t)(((l * 16 + g) * 63 + tp) * 16 + c) * 16 + c0);
                    const f32x4 a = *(const f32x4*)kp, b = *(const f32x4*)(kp + 4); v[0] = a[0]; v[1] = a[1]; v[2] = a[2]; v[3] = a[3]; v[4] = b[0]; v[5] = b[1]; v[6] = b[2]; v[7] = b[3]; }
                else { const int jj = (k8 - 64) * 8, d = jj >> 7, ri = (jj >> 6) & 1, p0 = jj & 63, e = d == 0 ? t + 1 : 32 - t, base = (l * 2 + d) * 16 + g;
                    const float* cre = CRE + ((size_t)base * 16 + c) * 64 + p0; const float* cim = CIM + ((size_t)base * 16 + c) * 64 + p0; const f32x2* ap = APOW + ((size_t)base * 33 + e) * 64 + p0;
#pragma unroll
                    for (int j = 0; j < 8; ++j) { const f32x2 a = ap[j]; const float cr = cre[j], ci = cim[j]; v[j] = ri == 0 ? cr * a.x - ci * a.y : -(cr * a.y + ci * a.x); } }
                u32x4 w; w.x = cvt_pk_bf16(v[0], v[1]); w.y = cvt_pk_bf16(v[2], v[3]); w.z = cvt_pk_bf16(v[4], v[5]); w.w = cvt_pk_bf16(v[6], v[7]);
                *(u32x4*)(S5KV + ((size_t)(g * 512 + n) * ATK + k8 * 8)) = w;
            }
            }
            { bf16* H = WP(bf16, WS_H); const float* gn = IN(I_NMIX) + l * 1024;
              for (int grp = gw; grp < M / 4; grp += NGW) norm_rows4<false>(xcur, gn, H, grp * 4, lane, nullptr, nullptr, nullptr, nullptr, nullptr, nullptr); }
        }
        GRID_BAR();
        }

        for (int rep_ = 0; rep_ < NREP(3); ++rep_) {
        if (PH(3)) {
            WSL();
            pg8::Gemm g{WP(bf16, WS_H), WP(bf16, WS_WIN), 1024, 1024, 1024}; pg8::StaticOrder S; S.init(M / 256, INC / 256, G, bid);
            EpiProj E{WP(bf16, WS_QK), WP(bf16, WS_VT8), WP(bf16, WS_AT), WP(bf16, WS_QX), WP(bf16, WS_GATES), IN(I_BGATE) + l * 3072};
            pg8::gemm_phase<EpiProj, pg8::StaticOrder>(F.lds, g, S, E, tid);
        }
        GRID_BAR();
        }

        for (int rep_ = 0; rep_ < NREP(4); ++rep_) {
        if (PH(4)) {
            WSL();
            { pg8::Gemm g{WP(bf16, WS_AT), WP(bf16, WS_S5W), ATK, 512, 512}; pg8::S5Order S; S.init(64, 1, G, bid); EpiS5a E{WP(float, WS_ST)};
              pg8::gemm_phase<EpiS5a, pg8::S5Order>(F.lds, g, S, E, tid); }
            const int n = lane & 15, q = lane >> 4;
            {
            const bf16* QK = WP(bf16, WS_QK); const bf16* VT8 = WP(bf16, WS_VT8); bf16* H = WP(bf16, WS_H); const float* RPBP = WP(float, WS_RPBP);
            const int cb = wave & 3, qsel = wave >> 2, c_lo = cb == 0 ? 0 : (cb == 1 ? 8 : (cb == 2 ? 24 : 32));
            const int kcol = tid >> 3, kdst = kcol * 128 + (((tid & 7) ^ kswz(kcol)) << 4);
            for (int item = vcu; item < 256; item += G) {
                const int b = item >> 6, h = (item >> 3) & 7, r0 = (item & 7) * 16;
                const bf16* Kg = QK + (size_t)b * SEQ * 1024 + 512 + h * 64 + (unsigned)(kcol * 1024 + (tid & 7) * 8);
                const bf16* Vg = VT8 + (size_t)(b * 8 + h) * 1024 * 512 + (unsigned)(tid * 8);
                const float* rp = RPBP + (size_t)(l * 8 + h) * 15 * 64;
                int hi = min(max(r0 + 1 - 4, 0), 120) + 7;
                for (int kr = min(max(r0 - 4, 0), 120); kr <= hi; ++kr) {
                    const u32x4 kv = *(const u32x4*)(Kg + (size_t)kr * 65536), vv = *(const u32x4*)(Vg + (size_t)kr * 4096);
                    const int slot = kr % 9; *(LAS u32x4*)(F.lds + slot * AT_SLOT + kdst) = kv; *(LAS u32x4*)(F.lds + AT_VOFF + slot * AT_SLOT + tid * 16) = vv;
                }
                bf16x8 qf[2];
                { const bf16* qb = QK + (size_t)(b * SEQ + (r0 + qsel) * 64 + cb * 16) * 1024 + h * 64 + (unsigned)(n * 1024 + 8 * q); qf[0] = *(const bf16x8*)qb; qf[1] = *(const bf16x8*)(qb + 32); }
                __syncthreads();
#pragma unroll 1
                for (int st = 0; st < 8; ++st) {
                    const int r = r0 + 2 * st + qsel, rs = min(max(r - 4, 0), 120);
                    const bool more = st < 7;
                    const int hi_next = more ? min(max(r0 + 2 * st + 3 - 4, 0), 120) + 7 : hi;
                    const int kr1 = hi + 1, kr2 = hi + 2;
                    u32x4 k1 = (u32x4){0u, 0u, 0u, 0u}, v1 = k1, k2 = k1, v2 = k1; bf16x8 qn[2]; qn[0] = qf[0]; qn[1] = qf[1];
                    if (more) {
                        k1 = *(const u32x4*)(Kg + (size_t)min(kr1, 127) * 65536); v1 = *(const u32x4*)(Vg + (size_t)min(kr1, 127) * 4096);
                        k2 = *(const u32x4*)(Kg + (size_t)min(kr2, 127) * 65536); v2 = *(const u32x4*)(Vg + (size_t)min(kr2, 127) * 4096);
                        const bf16* qb = QK + (size_t)(b * SEQ + (r + 2) * 64 + cb * 16) * 1024 + h * 64 + (unsigned)(n * 1024 + 8 * q); qn[0] = *(const bf16x8*)qb; qn[1] = *(const bf16x8*)(qb + 32);
                    }
                    attn_core<true>(qf, F.lds, rs, c_lo, H + (size_t)(b * SEQ + r * 64 + cb * 16) * 1024 + h * 64, rp, rs - r + 7, cb * 16, lane);
                    __syncthreads();
                    if (more) {
                        if (kr1 <= hi_next) { const int slot = kr1 % 9; *(LAS u32x4*)(F.lds + slot * AT_SLOT + kdst) = k1; *(LAS u32x4*)(F.lds + AT_VOFF + slot * AT_SLOT + tid * 16) = v1; }
                        if (kr2 <= hi_next) { const int slot = kr2 % 9; *(LAS u32x4*)(F.lds + slot * AT_SLOT + kdst) = k2; *(LAS u32x4*)(F.lds + AT_VOFF + slot * AT_SLOT + tid * 16) = v2; }
                        hi = hi_next; qf[0] = qn[0]; qf[1] = qn[1];
                    }
                    __syncthreads();
                }
            }
            }
        }
        GRID_BAR();
        }

        for (int rep_ = 0; rep_ < NREP(5); ++rep_) {
        if (PH(5)) {
            WSL();
            for (int it = bid; it < 128; it += G) s5_scan_item(it, WP(float, WS_ST), WP(bf16, WS_AT), WP(f32x2, WS_APOW) + (size_t)l * 2 * 16 * 33 * 64, (LAS float*)F.lds, tid);
            if (G > 128) { if (bid >= 128) XA_ITEMS(bid - 128, 128, G - 128); } else XA_ITEMS(bid, 128, G);
        }
        GRID_BAR();
        }

        for (int rep_ = 0; rep_ < NREP(6); ++rep_) {
        if (PH(6)) {
            WSL();
            pg8::Gemm g{WP(bf16, WS_AT), WP(bf16, WS_S5KV), ATK, ATK, ATK}; pg8::S5Order S; S.init(64, 2, G, bid); EpiS5c E{WP(bf16, WS_Y)};
            pg8::gemm_phase<EpiS5c, pg8::S5Order>(F.lds, g, S, E, tid);
            if (G > 128) { if (bid >= 128) XA_ITEMS(128 + bid - 128, 256, G - 128); } else XA_ITEMS(128 + bid, 256, G);
        }
        GRID_BAR();
        }

        for (int rep_ = 0; rep_ < NREP(7); ++rep_) {
        if (PH(7)) {
            WSL();
            pg8::Gemm g{WP(bf16, WS_Y), WP(bf16, WS_WGLU), 256, 256, 256}; pg8::StaticOrder S; S.init(M / 256, 2, G, bid); EpiGlu E{WP(bf16, WS_H)};
            pg8::gemm_phase<EpiGlu, pg8::StaticOrder>(F.lds, g, S, E, tid);
        }
        GRID_BAR();
        }

        for (int rep_ = 0; rep_ < NREP(8); ++rep_) {
        if (PH(8)) {
            WSL();
            pg8::Gemm g{WP(bf16, WS_H), WP(bf16, WS_WCAT), 1024, 1024, 1024}; pg8::StaticOrder S; S.init(M / 256, 4, G, bid); EpiMerge E{WP(bf16, WS_GATES), WP(bf16, WS_QK)};
            pg8::gemm_phase<EpiMerge, pg8::StaticOrder, false, true>(F.lds, g, S, E, tid);
        }
        GRID_BAR();
        }

        for (int rep_ = 0; rep_ < NREP(9); ++rep_) {
        if (PH(9)) {
            WSL();
            pg8::Gemm g{WP(bf16, WS_QK), WP(bf16, WS_WOUT), 1024, 1024, 1024}; pg8::StaticOrder S; S.init(M / 256, 4, G, bid); EpiRes E{xcur, rep_ ? WP(float, WS_GATES) : XO};
            pg8::gemm_phase<EpiRes, pg8::StaticOrder>(F.lds, g, S, E, tid);
        }
        xcur = XO;
        GRID_BAR();
        }

        for (int rep_ = 0; rep_ < NREP(10); ++rep_) {
        if (PH(10)) {
            WSL();
            {
            unsigned* cnt = WP(unsigned, WS_CTL) + CW_CNT + (l + 4 * rep_) * NBUCKET * 64;
            bf16* H = WP(bf16, WS_H); const float* gn = IN(I_NFFN) + l * 1024; const float* bco = IN(I_BCO) + l * 4; const float* bfi = IN(I_BFI) + l * 16;
            int* LIST = rep_ ? WP(int, WS_GATES + 100 * MiB) : WP(int, WS_LIST); float* WTS = rep_ ? WP(float, WS_GATES + 104 * MiB) : WP(float, WS_WTS);
            { const u32x4* src = (const u32x4*)(WP(bf16, WS_WRT) + (size_t)l * 2 * 20480);
              for (int idx = tid; idx < 40 * 128; idx += NWAVES * 64) *(LAS u32x4*)(F.lds + (idx >> 7) * RT_STRIDE + (idx & 127) * 16) = src[idx]; }
            __syncthreads();
            for (int grp = gw; grp < M / 16; grp += NGW) router_rows16(XO, gn, H, grp * 16, lane, F.lds, wave, bco, bfi, cnt, LIST, WTS);
            __syncthreads();
            }
            bf16* WGU = WP(bf16, WS_WGU); bf16* WDP = WP(bf16, WS_WDP);
            for (int it = gw; it < 10240; it += NGW) {
                int r = it;
                if (r < 2048) { const int e = r >> 7; transpose_job_item(IN(I_WG) + (size_t)(l * 16 + e) * 1024 * 256, 256, 256, r & 127, WGU + (size_t)e * 512 * 1024, 1024, 0, 0, 2, 0, 0, SCR(), lane); continue; } r -= 2048;
                if (r < 2048) { const int e = r >> 7; transpose_job_item(IN(I_WU) + (size_t)(l * 16 + e) * 1024 * 256, 256, 256, r & 127, WGU + (size_t)e * 512 * 1024, 1024, 0, 0, 2, 1, 0, SCR(), lane); continue; } r -= 2048;
                const int ej = r >> 7, e = ej / 3, jj = ej % 3, i = e & 3, grpI = e >> 2, o = jj + (jj >= i ? 1 : 0), a = i < o ? i : o, b = i < o ? o : i;
                const int pair = grpI * 6 + (a == 0 ? b - 1 : (a == 1 ? b + 1 : 5)), slot = (i == a) ? 0 : 1;
                transpose_job_item(IN(I_WD) + (size_t)(l * 16 + e) * 256 * 1024, 1024, 1024, r & 127, WDP + (size_t)pair * 1024 * 512, 512, slot * 256, 0, 1, 0, 0, SCR(), lane);
            }
        }
        GRID_BAR();
        }

        LAS int* tab = (LAS int*)(F.lds + TAB_OFF);
        for (int rep_ = 0; rep_ < NREP(11); ++rep_) {
        if (PH(11)) {
            WSL();
            unsigned* cnt = WP(unsigned, WS_CTL) + CW_CNT + l * NBUCKET * 64;
            if (tid == 0) { int st = 0;
                for (int b = 0; b < NBUCKET; ++b) { const int c = (int)__hip_atomic_load(cnt + b * 64, __ATOMIC_RELAXED, __HIP_MEMORY_SCOPE_AGENT); tab[b] = c; tab[32 + b] = st; st += (c + 255) >> 8; }
                tab[32 + NBUCKET] = st; tab[64] = st; }
            __syncthreads();
            pg8::Gemm g{WP(bf16, WS_H), WP(bf16, WS_WGU), 1024, 1024, 1024}; pg8::MoeOrder S{tab, WP(int, WS_LIST), G, bid, 0}; EpiMoe1 E{WP(bf16, WS_ACT), WP(float, WS_WTS)};
            pg8::gemm_phase<EpiMoe1, pg8::MoeOrder, true>(F.lds, g, S, E, tid);
        }
        GRID_BAR();
        }

        for (int rep_ = 0; rep_ < NREP(12); ++rep_) {
        if (PH(12)) {
            WSL();
            pg8::Gemm g{WP(bf16, WS_ACT), WP(bf16, WS_WDP), 512, 512, 512}; pg8::MoeOrder S{tab, WP(int, WS_LIST), G, bid, 1}; EpiMoe2 E{rep_ ? WP(float, WS_QK) : XO, WP(int, WS_LIST)};
            pg8::gemm_phase<EpiMoe2, pg8::MoeOrder>(F.lds, g, S, E, tid);
        }
        GRID_BAR();
        }
    }
    { WSL(); (void)wsl; const float* gn = IN(I_FNORM);
      for (int row = gw; row < M; row += NGW) final_norm_row(XO, gn, row, lane); }
#undef GRID_BAR
}

extern "C" void kernel_launch(void* const* d_in, const int* in_sizes, int n_in, void* d_out, int out_size, void* d_ws, size_t ws_size, hipStream_t stream) {
    static int grid = 0;
    if (grid == 0) {
        if (n_in != 30 || out_size != M * D || ws_size < WS_END) { fprintf(stderr, "kernel_launch: unexpected shapes (n_in %d, out %d, ws %zu)\n", n_in, out_size, ws_size); grid = -1; return; }
        int dev = 0, cus = 0, per_cu = 0;
        if (hipGetDevice(&dev) != hipSuccess || hipDeviceGetAttribute(&cus, hipDeviceAttributeMultiprocessorCount, dev) != hipSuccess) { grid = -1; return; }
        if (hipFuncSetAttribute((const void*)fwd_kernel, hipFuncAttributeMaxDynamicSharedMemorySize, LDS_BYTES) != hipSuccess) { fprintf(stderr, "kernel_launch: hipFuncSetAttribute failed\n"); grid = -1; return; }
        if (hipOccupancyMaxActiveBlocksPerMultiprocessor(&per_cu, (const void*)fwd_kernel, NWAVES * 64, LDS_BYTES) != hipSuccess || per_cu < 1) { fprintf(stderr, "kernel_launch: occupancy query reports %d\n", per_cu); }
        (void)hipGetLastError();
        grid = cus;
    }
    if (grid < 0) return;
    (void)in_sizes;
    hipMemsetAsync((char*)d_ws + WS_CTL, 0, CTL_BYTES, stream);
    Args a{};
    for (int i = 0; i < 30; ++i) a.in[i] = (const float*)d_in[i];
    a.out = (float*)d_out; a.ws = (unsigned char*)d_ws;
    hipLaunchKernelGGL(fwd_kernel, dim3(grid), dim3(NWAVES * 64), LDS_BYTES, stream, a);
}
```

```cpp
#include <hip/hip_runtime.h>
#include <cstdio>
#include <cstdint>

#define LAS __attribute__((address_space(3)))
typedef unsigned short bf16;
typedef short bf16x8 __attribute__((ext_vector_type(8)));
typedef float f32x4 __attribute__((ext_vector_type(4)));
typedef float f32x2 __attribute__((ext_vector_type(2)));
typedef unsigned u32x4 __attribute__((ext_vector_type(4)));
typedef unsigned u32x2 __attribute__((ext_vector_type(2)));

constexpr int D = 1024, BATCH = 4, SEQ = 8192, M = BATCH * SEQ, DEPTH = 4;
constexpr int INC = 5120, NMEM = 256;
constexpr int NCHUNK = 256, TCH = 32;
constexpr int ATK = 768;
constexpr int LCAP = 32768;
constexpr int NBUCKET = 24;
constexpr float RMS_EPS = 1e-6f;

constexpr size_t MiB = 1u << 20;
constexpr size_t WS_CTL = 0, CTL_BYTES = 1 * MiB;
constexpr size_t WS_APOW = 1 * MiB;
constexpr size_t WS_BBAR = 4 * MiB;
constexpr size_t WS_KT = 5 * MiB;
constexpr size_t WS_WRT = 10 * MiB;
constexpr size_t WS_RPBP = 10 * MiB + 512 * 1024;
constexpr size_t WS_MEMN = 11 * MiB;
constexpr size_t WS_WMKV = 19 * MiB;
constexpr size_t WS_KM = 23 * MiB;
constexpr size_t WS_VM8 = 25 * MiB;
constexpr size_t WS_WIN = 27 * MiB;
constexpr size_t WS_WCAT = 37 * MiB;
constexpr size_t WS_WOUT = 39 * MiB;
constexpr size_t WS_WGLU = 41 * MiB;
constexpr size_t WS_S5W = 42 * MiB;
constexpr size_t WS_S5KV = 46 * MiB;
constexpr size_t WS_H = 58 * MiB;
constexpr size_t WS_QK = 122 * MiB;
constexpr size_t WS_VT8 = 186 * MiB;
constexpr size_t WS_AT = 218 * MiB;
constexpr size_t WS_QX = 242 * MiB;
constexpr size_t WS_ST = 258 * MiB;
constexpr size_t WS_Y = 274 * MiB;
constexpr size_t WS_GATES = 290 * MiB;
constexpr size_t WS_WGU = WS_GATES;
constexpr size_t WS_WDP = WS_GATES + 16 * MiB;
constexpr size_t WS_ACT = WS_GATES + 40 * MiB;
constexpr size_t WS_LIST = 482 * MiB;
constexpr size_t WS_WTS = 485 * MiB;
constexpr size_t WS_SS = 497 * MiB;
constexpr size_t WS_END = 505 * MiB;
constexpr int CW_BAR = 4096;
constexpr int CW_CNT = 16384;
constexpr int CW_Q = 32768;

__device__ __forceinline__ unsigned cvt_pk_bf16(float lo, float hi) { unsigned r; asm volatile("v_cvt_pk_bf16_f32 %0, %1, %2" : "=v"(r) : "v"(lo), "v"(hi)); return r; }
__device__ __forceinline__ float bf2f(unsigned short b) { return __uint_as_float(((unsigned)b) << 16); }
__device__ __forceinline__ float bflo(unsigned w) { return __uint_as_float(w << 16); }
__device__ __forceinline__ float bfhi(unsigned w) { return __uint_as_float(w & 0xffff0000u); }
__device__ __forceinline__ float fast_rcp(float x) { return __builtin_amdgcn_rcpf(x); }
__device__ __forceinline__ float fast_exp(float x) { return __builtin_amdgcn_exp2f(x * 1.4426950408889634f); }
__device__ __forceinline__ float sigmoid_f(float x) { return fast_rcp(1.0f + fast_exp(-x)); }
__device__ __forceinline__ float gelu_tanh_f(float x) { const float u = 1.5957691216057308f * (x + 0.044715f * x * x * x); return x * fast_rcp(1.0f + fast_exp(-u)); }
__device__ __forceinline__ float shfl_xor_f(float v, int o, int lane) { return __int_as_float(__builtin_amdgcn_ds_bpermute((lane ^ o) << 2, __float_as_int(v))); }
__device__ __forceinline__ float shfl_idx_f(float v, int src) { return __int_as_float(__builtin_amdgcn_ds_bpermute(src << 2, __float_as_int(v))); }
__device__ __forceinline__ float wave_sum(float v, int lane) {
#pragma unroll
    for (int o = 1; o < 64; o <<= 1) v += shfl_xor_f(v, o, lane);
    return v;
}
#define GASP __attribute__((address_space(1)))
template <class T> __device__ __forceinline__ T gld(const void* p) { return *(const GASP T*)p; }
template <class T> __device__ __forceinline__ void gst(void* p, const T& v) { *(GASP T*)p = v; }
__device__ __forceinline__ unsigned q8(float g) { return (unsigned)__builtin_fminf(__builtin_fmaxf(__builtin_rintf(g * 255.0f), 1.0f), 255.0f); }
__device__ __forceinline__ unsigned q8x4(float a, float b, float c, float d) { return q8(a) | (q8(b) << 8) | (q8(c) << 16) | (q8(d) << 24); }
#define LDS_WAIT() asm volatile("s_waitcnt lgkmcnt(0)" ::: "memory")
#define VM_WAIT() asm volatile("s_waitcnt vmcnt(0)" ::: "memory")

namespace pg8 {
constexpr int BM = 256, BK = 64, HALF = 128, HTB = HALF * BK * 2, STAGE_BYTES = 8 * HTB, NXCD = 8, WGM = 8;
__host__ __device__ __forceinline__ int lds_byte(int r, int c) { const int st = (r >> 4) * 2 + (c >> 5), rr = r & 15, cc = c & 31, ob = rr * 64 + cc * 2; return st * 1024 + (ob ^ (((ob >> 9) & 1) << 5)); }
__host__ __device__ __forceinline__ void stage_rc(int b, int& R, int& C) { const int st = b / 1024, sb = b % 1024, swz = sb ^ (((sb >> 9) & 1) << 5); R = (st >> 1) * 16 + swz / 64; C = (st & 1) * 32 + (swz % 64) / 2; }
__host__ __device__ __forceinline__ int perm32(int rho) { const int n = rho >> 4, i = rho & 15; return 8 * (i >> 2) + 4 * n + (i & 3); }

struct Unit { int pm, pn, am, bn, x0, x1, x2; };
struct Gemm { const bf16* A; const bf16* Bt; int lda, ldb, K; };

struct StaticOrder {
    int nM, nN, nwg, G, c;
    __device__ void init(int nM_, int nN_, int G_, int c_) { nM = nM_; nN = nN_; nwg = nM * nN; G = G_; c = c_; }
    __device__ bool next(int i, Unit& u) const {
        const long L = (long)i * G + c; if (L >= nwg) return false;
        int wgid = (int)L; { const int q = nwg / NXCD, r = nwg % NXCD, xcd = wgid % NXCD, off = wgid / NXCD; wgid = (xcd < r ? xcd * (q + 1) : r * (q + 1) + (xcd - r) * q) + off; }
        const int nig = WGM * nN, gid = wgid / nig, fm = gid * WGM, gsz = (nM - fm) < WGM ? (nM - fm) : WGM;
        u.pm = __builtin_amdgcn_readfirstlane(fm + ((wgid % nig) % gsz)); u.pn = __builtin_amdgcn_readfirstlane((wgid % nig) / gsz);
        u.am = u.pm; u.bn = u.pn; u.x0 = 0; u.x1 = 0; u.x2 = 0; return true;
    }
    __device__ __forceinline__ int a_row(const Unit&, int) const { return 0; }
};
struct S5Order : StaticOrder {
    __device__ bool next(int i, Unit& u) const { if (!StaticOrder::next(i, u)) return false; u.bn = (u.pm & 15) * nN + u.pn; return true; }
};
struct ListOrder {
    int pm, n, nN;
    __device__ bool next(int i, Unit& u) const { if (i >= n) return false; u.pm = pm; u.pn = i; u.am = pm; u.bn = (pm & 15) * nN + i; u.x0 = 0; u.x1 = 0; u.x2 = 0; return true; }
    __device__ __forceinline__ int a_row(const Unit&, int) const { return 0; }
};
struct MemOrder {
    int G, c;
    __device__ bool next(int i, Unit& u) const { const int L = i * G + c; if (L >= 32) return false; u.pm = L >> 1; u.pn = L & 1; u.am = u.pm; u.bn = (u.pm >> 2) * 2 + u.pn; u.x0 = 0; u.x1 = 0; u.x2 = 0; return true; }
    __device__ __forceinline__ int a_row(const Unit&, int) const { return 0; }
};
struct MoeOrder {
    const LAS int* tab; const int* list; int G, c, mode;
    __device__ bool next(int i, Unit& u) const {
        const int T = __builtin_amdgcn_readfirstlane(tab[64]); const int L = i * G + c; if (L >= T * 4) return false;
        const int tile = L >> 2, pn = L & 3; int b = 0;
#pragma unroll 1
        for (int j = 1; j < NBUCKET; ++j) if (__builtin_amdgcn_readfirstlane(tab[32 + j]) <= tile) b = j;
        u.pm = tile; u.pn = pn; u.am = tile; u.x0 = b; u.x1 = (tile - __builtin_amdgcn_readfirstlane(tab[32 + b])) * 256; u.x2 = __builtin_amdgcn_readfirstlane(tab[b]);
        const int grp = __builtin_amdgcn_readfirstlane(b / 6), pi = __builtin_amdgcn_readfirstlane(b % 6); const int ea = pi < 3 ? 0 : (pi < 5 ? 1 : 2), eb = pi < 3 ? pi + 1 : (pi < 5 ? pi - 1 : 3);
        if (mode == 0) { const int e = grp * 4 + ((pn >> 1) ? eb : ea); u.bn = e * 2 + (pn & 1); } else u.bn = b * 4 + pn;
        return true;
    }
    __device__ __forceinline__ int a_row(const Unit& u, int r) const { const int slot = u.x1 + r; return slot < u.x2 ? gld<int>(list + (unsigned)(u.x0 * LCAP + slot)) : 0; }
};

template <class Epi, class Sched, bool GATHER = false, bool KHOOK = false>
__device__ __forceinline__ void gemm_phase(LAS unsigned char* lds, const Gemm g, const Sched& S, const Epi& E, int tid_in) {
    int tid = tid_in; asm volatile("" : "+v"(tid));
    const int wid = __builtin_amdgcn_readfirstlane(tid >> 6), lane = tid & 63, wr = wid >> 2, wc = wid & 3, fr = lane & 15, fq = lane >> 4;
    int K = g.K, lda = g.lda, ldb = g.ldb;
    asm volatile("" : "+s"(K), "+s"(lda), "+s"(ldb));
    const int nt = K / BK;
    unsigned voffA[2], voffB[2]; int Rr[2], Cc[2];
#pragma unroll
    for (int i = 0; i < 2; ++i) { int R, C; stage_rc(tid * 16 + i * 8192, R, C); const int Rb = Epi::PERM ? ((R & ~31) + perm32(R & 31)) : R;
        voffA[i] = (unsigned)(R * lda + C) * 2u; voffB[i] = (unsigned)(Rb * ldb + C) * 2u; Rr[i] = R; Cc[i] = C; }
    const unsigned kstep = (unsigned)(BK * 2);
    const unsigned hstepA = (unsigned)(HALF * lda * 2), tstepA = 2u * hstepA, hstepB = (unsigned)(HALF * ldb * 2), tstepB = 2u * hstepB;
    const unsigned ldsw = (unsigned)wid * 1024u;
    const int aoff = lds_byte(wr * 64 + fr, fq * 8), boff = lds_byte(wc * 32 + fr, fq * 8);
    unsigned vC[2][2] = {{0u, 0u}, {0u, 0u}}, vN[2][2] = {{0u, 0u}, {0u, 0u}};
#define PG8_SA(b, h) (((b) * 2 + (h)) * HTB)
#define PG8_SB(b, h) ((4 + (b) * 2 + (h)) * HTB)
#define PG8_STAGE(bufoff, gbase, voff) do { _Pragma("unroll") for (int _i = 0; _i < 2; ++_i) \
        __builtin_amdgcn_global_load_lds((const unsigned*)((const char*)(gbase) + (voff)[_i]), (LAS unsigned*)(lds + (bufoff) + ldsw + _i * 8192), 16, 0, 0); } while (0)
#define PG8_STA(bufoff, ptr, h, nx) do { if constexpr (GATHER) { unsigned _v[2]; _v[0] = (nx) ? vN[h][0] : vC[h][0]; _v[1] = (nx) ? vN[h][1] : vC[h][1]; PG8_STAGE(bufoff, ptr, _v); } \
        else { PG8_STAGE(bufoff, (ptr) + (h) * hstepA, voffA); } } while (0)
#define PG8_STB(bufoff, ptr, h) PG8_STAGE(bufoff, (ptr) + (h) * hstepB, voffB)
#define PG8_LDA(dst, b, h) do { _Pragma("unroll") for (int m = 0; m < 4; ++m) _Pragma("unroll") for (int k = 0; k < 2; ++k) dst[m][k] = *(const LAS bf16x8*)(lds + PG8_SA(b, h) + aoff + m * 2048 + k * 1024); } while (0)
#define PG8_LDB(dst, b, h) do { _Pragma("unroll") for (int n = 0; n < 2; ++n) _Pragma("unroll") for (int k = 0; k < 2; ++k) dst[n][k] = *(const LAS bf16x8*)(lds + PG8_SB(b, h) + boff + n * 2048 + k * 1024); } while (0)
#define PG8_MMA(ai, bj, At, Bt) do { __builtin_amdgcn_s_setprio(1); _Pragma("unroll") for (int m = 0; m < 4; ++m) _Pragma("unroll") for (int n = 0; n < 2; ++n) _Pragma("unroll") for (int k = 0; k < 2; ++k) \
        acc[ai][bj][m][n] = __builtin_amdgcn_mfma_f32_16x16x32_bf16(Bt[n][k], At[m][k], acc[ai][bj][m][n], 0, 0, 0); __builtin_amdgcn_s_setprio(0); } while (0)
#define PG8_WAIT_V(n) asm volatile("s_waitcnt vmcnt(" #n ")" ::: "memory")
#define PG8_WAIT_L(n) asm volatile("s_waitcnt lgkmcnt(" #n ")" ::: "memory")
#define PG8_BAR __builtin_amdgcn_s_barrier()
#define PG8_SCHED __builtin_amdgcn_sched_barrier(0)
    Unit cur, nxt; int ui = 0;
    if (!S.next(0, cur)) return;
    f32x4 acc[2][2][4][2];
#pragma unroll
    for (int a = 0; a < 2; ++a)
#pragma unroll
        for (int b = 0; b < 2; ++b)
#pragma unroll
            for (int m = 0; m < 4; ++m)
#pragma unroll
                for (int n = 0; n < 2; ++n) acc[a][b][m][n] = (f32x4){0.f, 0.f, 0.f, 0.f};
    bf16x8 At[4][2], B0[2][2], B1[2][2];
    const char* cA = GATHER ? (const char*)g.A : (const char*)g.A + (unsigned)cur.am * tstepA;
    const char* cB = (const char*)g.Bt + (unsigned)cur.bn * tstepB;
    if constexpr (GATHER) {
#pragma unroll
        for (int h = 0; h < 2; ++h)
#pragma unroll
            for (int i = 0; i < 2; ++i) vC[h][i] = (unsigned)(S.a_row(cur, h * HALF + Rr[i]) * lda + Cc[i]) * 2u;
    }
    PG8_STB(PG8_SB(0, 0), cB, 0); PG8_STB(PG8_SB(0, 1), cB, 1); PG8_STA(PG8_SA(0, 0), cA, 0, false); PG8_STA(PG8_SA(0, 1), cA, 1, false);
    if (wr == 1) PG8_BAR;
    PG8_WAIT_V(2); PG8_BAR;
    PG8_STB(PG8_SB(1, 0), cB + kstep, 0); PG8_STA(PG8_SA(1, 0), cA + kstep, 0, false); PG8_STB(PG8_SB(1, 1), cB + kstep, 1);
    PG8_WAIT_V(6); PG8_BAR;
    for (;;) {
        const bool has_next = S.next(ui + 1, nxt);
        const char* nA = GATHER ? (const char*)g.A : (has_next ? (const char*)g.A + (unsigned)nxt.am * tstepA : cA);
        const char* nB = has_next ? (const char*)g.Bt + (unsigned)nxt.bn * tstepB : cB;
        if constexpr (GATHER) {
#pragma unroll
            for (int h = 0; h < 2; ++h)
#pragma unroll
                for (int i = 0; i < 2; ++i) vN[h][i] = has_next ? (unsigned)(S.a_row(nxt, h * HALF + Rr[i]) * lda + Cc[i]) * 2u : vC[h][i];
        }
        int tb = 0;
#pragma unroll 1
        for (int seg = 0; seg < (KHOOK ? 3 : 1); ++seg) {
        const int te = KHOOK ? (seg == 0 ? 8 : (seg == 1 ? 12 : nt)) : nt;
        for (int t = tb; t < te; t += 2) {
            const bool last = (t == nt - 2);
            const char* a1 = cA + (unsigned)(t + 1) * kstep;
            const char* a2 = last ? nA : cA + (unsigned)(t + 2) * kstep; const char* b2 = last ? nB : cB + (unsigned)(t + 2) * kstep;
            const char* a3 = a2 + kstep; const char* b3 = b2 + kstep;
            PG8_LDB(B0, 0, 0); PG8_LDB(B1, 0, 1); PG8_SCHED; PG8_LDA(At, 0, 0); PG8_STA(PG8_SA(1, 1), a1, 1, false);
            PG8_WAIT_V(8); PG8_WAIT_L(0); PG8_BAR; PG8_MMA(0, 0, At, B0); PG8_MMA(0, 1, At, B1); PG8_BAR; PG8_SCHED;
            PG8_LDA(At, 0, 1); PG8_STB(PG8_SB(0, 0), b2, 0); PG8_STB(PG8_SB(0, 1), b2, 1); PG8_STA(PG8_SA(0, 0), a2, 0, last);
            PG8_WAIT_V(8); PG8_WAIT_L(0); PG8_BAR; PG8_MMA(1, 0, At, B0); PG8_MMA(1, 1, At, B1); PG8_BAR; PG8_SCHED;
            PG8_LDB(B0, 1, 0); PG8_LDB(B1, 1, 1); PG8_SCHED; PG8_LDA(At, 1, 0); PG8_STA(PG8_SA(0, 1), a2, 1, last);
            PG8_WAIT_V(8); PG8_WAIT_L(0); PG8_BAR; PG8_MMA(0, 0, At, B0); PG8_MMA(0, 1, At, B1); PG8_BAR; PG8_SCHED;
            PG8_LDA(At, 1, 1); PG8_STB(PG8_SB(1, 0), b3, 0); PG8_STB(PG8_SB(1, 1), b3, 1); PG8_STA(PG8_SA(1, 0), a3, 0, last);
            PG8_WAIT_V(8); PG8_WAIT_L(0); PG8_BAR; PG8_MMA(1, 0, At, B0); PG8_MMA(1, 1, At, B1); PG8_BAR; PG8_SCHED;
        }
        if constexpr (KHOOK) { if (seg < 2) { unsigned mm_ = ~0u; asm volatile("" : "+s"(mm_)); const int ln_ = (int)__builtin_amdgcn_mbcnt_hi(mm_, __builtin_amdgcn_mbcnt_lo(mm_, 0u)); E.khook(acc, cur, te, wr, wc, ln_ & 15, ln_ >> 4); } }
        tb = te;
        }
        if (wr == 0) PG8_BAR;
        { unsigned mm_ = ~0u; asm volatile("" : "+s"(mm_)); const int ln_ = (int)__builtin_amdgcn_mbcnt_hi(mm_, __builtin_amdgcn_mbcnt_lo(mm_, 0u)); E(acc, cur, wr, wc, ln_ & 15, ln_ >> 4); }
        if (!has_next) break;
#pragma unroll
        for (int a = 0; a < 2; ++a)
#pragma unroll
            for (int b = 0; b < 2; ++b)
#pragma unroll
                for (int m = 0; m < 4; ++m)
#pragma unroll
                    for (int n = 0; n < 2; ++n) acc[a][b][m][n] = (f32x4){0.f, 0.f, 0.f, 0.f};
        cur = nxt; cA = nA; cB = nB; ++ui;
        if constexpr (GATHER) {
#pragma unroll
            for (int h = 0; h < 2; ++h)
#pragma unroll
                for (int i = 0; i < 2; ++i) vC[h][i] = vN[h][i];
        }
        if (wr == 1) PG8_BAR;
    }
    PG8_WAIT_V(0);
    PG8_BAR;
#undef PG8_SA
#undef PG8_SB
#undef PG8_STAGE
#undef PG8_STA
#undef PG8_STB
#undef PG8_LDA
#undef PG8_LDB
#undef PG8_MMA
#undef PG8_WAIT_V
#undef PG8_WAIT_L
#undef PG8_BAR
#undef PG8_SCHED
}
}

using pg8::Unit;
struct EpiProj {
    static constexpr bool PERM = true;
    bf16 *QK, *Vt8, *At, *QX, *GATES; const float* bgate; const float* ssq;
#define EP_LOOP_BEGIN _Pragma("unroll") for (int ai = 0; ai < 2; ++ai) _Pragma("unroll") for (int m = 0; m < 4; ++m) { const int row = row0 + ai * 128 + m * 16; const float rs = rstd[ai][m]; _Pragma("unroll") for (int bj = 0; bj < 2; ++bj) { \
        const f32x4 v0 = acc[ai][bj][m][0] * rs, v1 = acc[ai][bj][m][1] * rs; const int cl = cl0 + bj * 128;
#define EP_LOOP_END } asm volatile("" ::: "memory"); }
    __device__ __forceinline__ void operator()(const f32x4 (&acc)[2][2][4][2], const Unit& u, int wr, int wc, int fr, int fq) const {
        const int pn = u.pn, row0 = u.pm * 256 + wr * 64 + fr, cl0 = wc * 32 + 8 * fq;
        float rstd[2][4];
#pragma unroll
        for (int ai = 0; ai < 2; ++ai)
#pragma unroll
            for (int m = 0; m < 4; ++m) { if (!ssq) { rstd[ai][m] = -1.f; continue; } const float* sp = ssq + (unsigned)((row0 + ai * 128 + m * 16) * 16); const f32x4 a = gld<f32x4>(sp), b = gld<f32x4>(sp + 4), c = gld<f32x4>(sp + 8), d = gld<f32x4>(sp + 12);
                rstd[ai][m] = (((a[0] + a[1]) + (a[2] + a[3])) + ((b[0] + b[1]) + (b[2] + b[3]))) + (((c[0] + c[1]) + (c[2] + c[3])) + ((d[0] + d[1]) + (d[2] + d[3]))); }
#pragma unroll
        for (int ai = 0; ai < 2; ++ai)
#pragma unroll
            for (int m = 0; m < 4; ++m) rstd[ai][m] = rstd[ai][m] < 0.f ? 1.0f : 1.0f / sqrtf(rstd[ai][m] * (1.0f / 1024.0f) + RMS_EPS);
        if (pn < 4) {
            EP_LOOP_BEGIN
                u32x4 w; w.x = cvt_pk_bf16(v0[0], v0[1]); w.y = cvt_pk_bf16(v0[2], v0[3]); w.z = cvt_pk_bf16(v1[0], v1[1]); w.w = cvt_pk_bf16(v1[2], v1[3]);
                gst<u32x4>(QK + (unsigned)row * 1024 + pn * 256 + cl, w);
            EP_LOOP_END
        } else if (pn < 6) {
            EP_LOOP_BEGIN
                const int vc = (pn - 4) * 256 + cl, hh = vc >> 6, dh = vc & 63, b = row >> 13, s = row & 8191;
                bf16* p = Vt8 + ((unsigned)((b * 8 + hh) * 1024 + (s >> 3)) * 64 + dh) * 8 + (s & 7);
                const unsigned w0 = cvt_pk_bf16(v0[0], v0[1]), w1 = cvt_pk_bf16(v0[2], v0[3]), w2 = cvt_pk_bf16(v1[0], v1[1]), w3 = cvt_pk_bf16(v1[2], v1[3]);
                gst<bf16>(p, (bf16)w0); gst<bf16>(p + 8, (bf16)(w0 >> 16)); gst<bf16>(p + 16, (bf16)w1); gst<bf16>(p + 24, (bf16)(w1 >> 16)); gst<bf16>(p + 32, (bf16)w2); gst<bf16>(p + 40, (bf16)(w2 >> 16)); gst<bf16>(p + 48, (bf16)w3); gst<bf16>(p + 56, (bf16)(w3 >> 16));
            EP_LOOP_END
        } else if (pn == 6) {
            EP_LOOP_BEGIN
                const int g = cl >> 4, c0 = cl & 15, b = row >> 13, s = row & 8191;
                u32x4 w; w.x = cvt_pk_bf16(v0[0], v0[1]); w.y = cvt_pk_bf16(v0[2], v0[3]); w.z = cvt_pk_bf16(v1[0], v1[1]); w.w = cvt_pk_bf16(v1[2], v1[3]);
                gst<u32x4>(At + ((unsigned)((b * 16 + g) * 256 + (s >> 5))) * ATK + (s & 31) * 16 + c0, w);
            EP_LOOP_END
        } else if (pn == 7) {
            EP_LOOP_BEGIN
                u32x4 w; w.x = cvt_pk_bf16(v0[0], v0[1]); w.y = cvt_pk_bf16(v0[2], v0[3]); w.z = cvt_pk_bf16(v1[0], v1[1]); w.w = cvt_pk_bf16(v1[2], v1[3]);
                gst<u32x4>(QX + (unsigned)row * 256 + cl, w);
            EP_LOOP_END
        } else {
            EP_LOOP_BEGIN
                const int gc = (pn - 8) * 256 + cl;
                const f32x4 b0 = gld<f32x4>(bgate + gc), b1 = gld<f32x4>(bgate + gc + 4);
                u32x2 w; w.x = q8x4(sigmoid_f(v0[0] + b0[0]), sigmoid_f(v0[1] + b0[1]), sigmoid_f(v0[2] + b0[2]), sigmoid_f(v0[3] + b0[3]));
                w.y = q8x4(sigmoid_f(v1[0] + b1[0]), sigmoid_f(v1[1] + b1[1]), sigmoid_f(v1[2] + b1[2]), sigmoid_f(v1[3] + b1[3]));
                gst<u32x2>((unsigned char*)GATES + (unsigned)row * 3072 + gc, w);
            EP_LOOP_END
        }
    }
#undef EP_LOOP_BEGIN
#undef EP_LOOP_END
};
struct EpiMemKV {
    static constexpr bool PERM = true;
    bf16 *Km, *Vm8;
    __device__ __forceinline__ void operator()(const f32x4 (&acc)[2][2][4][2], const Unit& u, int wr, int wc, int fr, int fq) const {
        const int row0 = u.pm * 256 + wr * 64 + fr, cl0 = wc * 32 + 8 * fq;
#pragma unroll
        for (int ai = 0; ai < 2; ++ai)
#pragma unroll
            for (int m = 0; m < 4; ++m) {
                const int row = row0 + ai * 128 + m * 16;
#pragma unroll
                for (int bj = 0; bj < 2; ++bj) {
                    const f32x4 v0 = acc[ai][bj][m][0], v1 = acc[ai][bj][m][1];
                    const int cl = cl0 + bj * 128;
                    const unsigned w0 = cvt_pk_bf16(v0[0], v0[1]), w1 = cvt_pk_bf16(v0[2], v0[3]), w2 = cvt_pk_bf16(v1[0], v1[1]), w3 = cvt_pk_bf16(v1[2], v1[3]);
                    if (u.pn == 0) { u32x4 w; w.x = w0; w.y = w1; w.z = w2; w.w = w3; gst<u32x4>(Km + (unsigned)row * 256 + cl, w); }
                    else {
                        const int hh = cl >> 6, dh = cl & 63, lb = row >> 8, mm = row & 255;
                        bf16* p = Vm8 + ((unsigned)((lb * 4 + hh) * 32 + (mm >> 3)) * 64 + dh) * 8 + (mm & 7);
                        gst<bf16>(p, (bf16)w0); gst<bf16>(p + 8, (bf16)(w0 >> 16)); gst<bf16>(p + 16, (bf16)w1); gst<bf16>(p + 24, (bf16)(w1 >> 16)); gst<bf16>(p + 32, (bf16)w2); gst<bf16>(p + 40, (bf16)(w2 >> 16)); gst<bf16>(p + 48, (bf16)w3); gst<bf16>(p + 56, (bf16)(w3 >> 16));
                    }
                }
                asm volatile("" ::: "memory");
            }
    }
};
struct EpiS5a {
    static constexpr bool PERM = false;
    float* ST;
    __device__ __forceinline__ void operator()(const f32x4 (&acc)[2][2][4][2], const Unit& u, int wr, int wc, int fr, int fq) const {
        const int row0 = u.am * 256 + wr * 64 + fr, col0 = wc * 32 + 4 * fq;
#pragma unroll
        for (int ai = 0; ai < 2; ++ai)
#pragma unroll
            for (int m = 0; m < 4; ++m) { float* rowp = ST + (unsigned)(row0 + ai * 128 + m * 16) * 256 + col0;
#pragma unroll
                for (int bj = 0; bj < 2; ++bj)
#pragma unroll
                    for (int n = 0; n < 2; ++n) gst<f32x4>(rowp + bj * 128 + n * 16, acc[ai][bj][m][n]);
                asm volatile("" ::: "memory"); }
    }
};
struct EpiS5c {
    static constexpr bool PERM = true;
    bf16* Y;
    __device__ __forceinline__ void operator()(const f32x4 (&acc)[2][2][4][2], const Unit& u, int wr, int wc, int fr, int fq) const {
        const int b = u.am >> 4, g = u.am & 15, r0 = wr * 64 + fr, cl0 = u.pn * 256 + wc * 32 + 8 * fq;
#pragma unroll
        for (int ai = 0; ai < 2; ++ai)
#pragma unroll
            for (int m = 0; m < 4; ++m) {
                const int chunk = r0 + ai * 128 + m * 16;
#pragma unroll
                for (int bj = 0; bj < 2; ++bj) {
                    const f32x4 v0 = acc[ai][bj][m][0], v1 = acc[ai][bj][m][1];
                    const int col = cl0 + bj * 128, t = col >> 4, c0 = col & 15;
                    u32x4 w; w.x = cvt_pk_bf16(gelu_tanh_f(v0[0]), gelu_tanh_f(v0[1])); w.y = cvt_pk_bf16(gelu_tanh_f(v0[2]), gelu_tanh_f(v0[3]));
                    w.z = cvt_pk_bf16(gelu_tanh_f(v1[0]), gelu_tanh_f(v1[1])); w.w = cvt_pk_bf16(gelu_tanh_f(v1[2]), gelu_tanh_f(v1[3]));
                    gst<u32x4>(Y + (unsigned)(b * SEQ + chunk * 32 + t) * 256 + g * 16 + c0, w);
                }
                asm volatile("" ::: "memory");
            }
    }
};
struct EpiGlu {
    static constexpr bool PERM = true;
    bf16* CAT;
    __device__ __forceinline__ void operator()(const f32x4 (&acc)[2][2][4][2], const Unit& u, int wr, int wc, int fr, int fq) const {
        const int row0 = u.pm * 256 + wr * 64 + fr, cl0 = u.pn * 256 + wc * 32 + 8 * fq;
#pragma unroll
        for (int ai = 0; ai < 2; ++ai)
#pragma unroll
            for (int m = 0; m < 4; ++m) {
                const int row = row0 + ai * 128 + m * 16;
#pragma unroll
                for (int bj = 0; bj < 2; ++bj) {
                    const f32x4 v0 = acc[ai][bj][m][0], v1 = acc[ai][bj][m][1];
                    const int col = cl0 + bj * 128;
                    u32x2 w; w.x = cvt_pk_bf16(v0[0] * sigmoid_f(v0[1]), v0[2] * sigmoid_f(v0[3])); w.y = cvt_pk_bf16(v1[0] * sigmoid_f(v1[1]), v1[2] * sigmoid_f(v1[3]));
                    gst<u32x2>(CAT + (unsigned)row * 1024 + 512 + (col >> 1), w);
                }
                asm volatile("" ::: "memory");
            }
    }
};
struct EpiMerge {
    static constexpr bool PERM = true;
    const unsigned char* GATES; bf16* MG;
    static __device__ __forceinline__ float ub(unsigned w, int i) { return (float)((w >> (8 * i)) & 0xffu); }
    __device__ __forceinline__ void khook(f32x4 (&acc)[2][2][4][2], const Unit& u, int t, int wr, int wc, int fr, int fq) const {
        const int row0 = u.pm * 256 + wr * 64 + fr, cl0 = u.pn * 256 + wc * 32 + 8 * fq;
        const int ga = (t == 8) ? 0 : 1024;
#pragma unroll
        for (int ai = 0; ai < 2; ++ai) {
            u32x2 na[4][2], nb[4][2];
#pragma unroll
            for (int m = 0; m < 4; ++m)
#pragma unroll
                for (int bj = 0; bj < 2; ++bj) { const unsigned char* gp = GATES + (unsigned)((row0 + ai * 128 + m * 16) * 3072 + ga + cl0 + bj * 128); na[m][bj] = gld<u32x2>(gp); nb[m][bj] = gld<u32x2>(gp + 1024); }
#pragma unroll
            for (int m = 0; m < 4; ++m)
#pragma unroll
                for (int bj = 0; bj < 2; ++bj) {
                    const u32x2 a = na[m][bj], b = nb[m][bj];
                    f32x4 r0, r1;
#pragma unroll
                    for (int i = 0; i < 4; ++i) { r0[i] = ub(a.x, i) * fast_rcp(ub(b.x, i)); r1[i] = ub(a.y, i) * fast_rcp(ub(b.y, i)); }
                    acc[ai][bj][m][0] *= r0; acc[ai][bj][m][1] *= r1;
                }
            asm volatile("" ::: "memory");
        }
    }
    __device__ __forceinline__ void operator()(const f32x4 (&acc)[2][2][4][2], const Unit& u, int wr, int wc, int fr, int fq) const {
        const int row0 = u.pm * 256 + wr * 64 + fr, cl0 = u.pn * 256 + wc * 32 + 8 * fq;
#pragma unroll
        for (int ai = 0; ai < 2; ++ai) {
            u32x2 g2[4][2];
#pragma unroll
            for (int m = 0; m < 4; ++m)
#pragma unroll
                for (int bj = 0; bj < 2; ++bj) g2[m][bj] = gld<u32x2>(GATES + (unsigned)((row0 + ai * 128 + m * 16) * 3072 + 2048 + cl0 + bj * 128));
#pragma unroll
            for (int m = 0; m < 4; ++m)
#pragma unroll
                for (int bj = 0; bj < 2; ++bj) {
                    const u32x2 g = g2[m][bj]; const f32x4 v0 = acc[ai][bj][m][0] * (1.0f / 255.0f), v1 = acc[ai][bj][m][1] * (1.0f / 255.0f);
                    u32x4 w; w.x = cvt_pk_bf16(v0[0] * ub(g.x, 0), v0[1] * ub(g.x, 1)); w.y = cvt_pk_bf16(v0[2] * ub(g.x, 2), v0[3] * ub(g.x, 3));
                    w.z = cvt_pk_bf16(v1[0] * ub(g.y, 0), v1[1] * ub(g.y, 1)); w.w = cvt_pk_bf16(v1[2] * ub(g.y, 2), v1[3] * ub(g.y, 3));
                    gst<u32x4>(MG + (unsigned)((row0 + ai * 128 + m * 16) * 1024 + cl0 + bj * 128), w);
                }
            asm volatile("" ::: "memory");
        }
    }
};
struct EpiRes {
    static constexpr bool PERM = false;
    const float* base; float* out; bf16* XB;
    __device__ __forceinline__ void operator()(const f32x4 (&acc)[2][2][4][2], const Unit& u, int wr, int wc, int fr, int fq) const {
        const int row0 = u.pm * 256 + wr * 64 + fr, col0 = u.pn * 256 + wc * 32 + 4 * fq;
#pragma unroll
        for (int ai = 0; ai < 2; ++ai)
#pragma unroll
            for (int mh = 0; mh < 2; ++mh) {
                f32x4 bs[2][2][2];
#pragma unroll
                for (int mm = 0; mm < 2; ++mm)
#pragma unroll
                    for (int bj = 0; bj < 2; ++bj)
#pragma unroll
                        for (int n = 0; n < 2; ++n) bs[mm][bj][n] = gld<f32x4>(base + (unsigned)((row0 + ai * 128 + (mh * 2 + mm) * 16) * 1024 + col0 + bj * 128 + n * 16));
#pragma unroll
                for (int mm = 0; mm < 2; ++mm)
#pragma unroll
                    for (int bj = 0; bj < 2; ++bj)
#pragma unroll
                        for (int n = 0; n < 2; ++n) { const unsigned off = (unsigned)((row0 + ai * 128 + (mh * 2 + mm) * 16) * 1024 + col0 + bj * 128 + n * 16); const f32x4 v = bs[mm][bj][n] + acc[ai][bj][mh * 2 + mm][n];
                            gst<f32x4>(out + off, v); u32x2 w; w.x = cvt_pk_bf16(v[0], v[1]); w.y = cvt_pk_bf16(v[2], v[3]); gst<u32x2>(XB + off, w); }
                asm volatile("" ::: "memory");
            }
    }
};
struct EpiMoe1 {
    static constexpr bool PERM = true;
    bf16* ACT; const float* wts;
    __device__ __forceinline__ void operator()(const f32x4 (&acc)[2][2][4][2], const Unit& u, int wr, int wc, int fr, int fq) const {
        const int r0 = wr * 64 + fr, cl0 = wc * 32 + 8 * fq, es = u.pn >> 1;
        float wv[2][4], rv[2][4];
#pragma unroll
        for (int ai = 0; ai < 2; ++ai)
#pragma unroll
            for (int m = 0; m < 4; ++m) { const int slot = u.x1 + r0 + ai * 128 + m * 16; const f32x4 t = slot < u.x2 ? gld<f32x4>(wts + (unsigned)((u.x0 * LCAP + slot) * 4)) : (f32x4){0.f, 0.f, 0.f, 0.f}; wv[ai][m] = es ? t[1] : t[0]; rv[ai][m] = t[2]; }
#pragma unroll
        for (int ai = 0; ai < 2; ++ai)
#pragma unroll
            for (int m = 0; m < 4; ++m) {
                const int r = r0 + ai * 128 + m * 16; const float w = wv[ai][m], rs = rv[ai][m];
#pragma unroll
                for (int bj = 0; bj < 2; ++bj) {
                    const f32x4 v0 = acc[ai][bj][m][0] * rs, v1 = acc[ai][bj][m][1] * rs;
                    const int col = cl0 + bj * 128;
                    u32x2 o; o.x = cvt_pk_bf16(v0[0] * sigmoid_f(v0[0]) * v0[1] * w, v0[2] * sigmoid_f(v0[2]) * v0[3] * w); o.y = cvt_pk_bf16(v1[0] * sigmoid_f(v1[0]) * v1[1] * w, v1[2] * sigmoid_f(v1[2]) * v1[3] * w);
                    gst<u32x2>(ACT + (unsigned)((u.pm * 256 + r) * 512 + es * 256 + (u.pn & 1) * 128 + (col >> 1)), o);
                }
                asm volatile("" ::: "memory");
            }
    }
};
struct EpiMoe2 {
    static constexpr bool PERM = false;
    float* X; const int* list; bf16* XB; float* ssq;
    __device__ __forceinline__ void operator()(const f32x4 (&acc)[2][2][4][2], const Unit& u, int wr, int wc, int fr, int fq) const {
        const int r0 = wr * 64 + fr, col0 = u.pn * 256 + wc * 32 + 4 * fq, ln = fq * 16 + fr;
        int tok[2][4];
#pragma unroll
        for (int ai = 0; ai < 2; ++ai)
#pragma unroll
            for (int m = 0; m < 4; ++m) { const int slot = u.x1 + r0 + ai * 128 + m * 16; tok[ai][m] = slot < u.x2 ? gld<int>(list + (unsigned)(u.x0 * LCAP + slot)) : -1; }
#pragma unroll
        for (int ai = 0; ai < 2; ++ai)
#pragma unroll
            for (int mh = 0; mh < 2; ++mh) {
                f32x4 bs[2][2][2];
#pragma unroll
                for (int mm = 0; mm < 2; ++mm)
#pragma unroll
                    for (int bj = 0; bj < 2; ++bj)
#pragma unroll
                        for (int n = 0; n < 2; ++n) { const int t = tok[ai][mh * 2 + mm]; bs[mm][bj][n] = t >= 0 ? gld<f32x4>(X + (unsigned)(t * 1024 + col0 + bj * 128 + n * 16)) : (f32x4){0.f, 0.f, 0.f, 0.f}; }
#pragma unroll
                for (int mm = 0; mm < 2; ++mm) {
                    const int m = mh * 2 + mm, t = tok[ai][m]; float ssp = 0.f;
#pragma unroll
                    for (int bj = 0; bj < 2; ++bj)
#pragma unroll
                        for (int n = 0; n < 2; ++n) { const f32x4 v = bs[mm][bj][n] + acc[ai][bj][m][n]; ssp += (v[0] * v[0] + v[1] * v[1]) + (v[2] * v[2] + v[3] * v[3]);
                            if (t >= 0) { const unsigned off = (unsigned)(t * 1024 + col0 + bj * 128 + n * 16); gst<f32x4>(X + off, v); if (XB) { u32x2 w; w.x = cvt_pk_bf16(v[0], v[1]); w.y = cvt_pk_bf16(v[2], v[3]); gst<u32x2>(XB + off, w); } } }
                    if (ssq) { ssp += shfl_xor_f(ssp, 16, ln); ssp += shfl_xor_f(ssp, 32, ln);
                        if (fq == 0 && t >= 0) gst<float>(ssq + (unsigned)(t * 16 + u.pn * 4 + wc), ssp); }
                }
                asm volatile("" ::: "memory");
            }
    }
};
#define XB_TMO      128
#define XB_XCNT(j)  (256  + 64 * (j))
#define XB_XSUB(j)  (1280 + 64 * (j))
#define XB_XGEN(j)  (2304 + 64 * (j))
#define XB_TOP      3328
#define XB_TOPGEN   3392
#define XCD_BAR_WORDS 3456
#define XB_SPIN_CAP (1u << 18)
__device__ __forceinline__ unsigned xb_ld(unsigned* p)              { return __hip_atomic_load((__attribute__((address_space(1))) unsigned*)p, __ATOMIC_RELAXED, __HIP_MEMORY_SCOPE_AGENT); }
__device__ __forceinline__ unsigned xb_add(unsigned* p, unsigned v) { return __hip_atomic_fetch_add((__attribute__((address_space(1))) unsigned*)p, v, __ATOMIC_RELAXED, __HIP_MEMORY_SCOPE_AGENT); }
__device__ __forceinline__ unsigned xb_xcc_id() { return (unsigned)__builtin_amdgcn_s_getreg((3 << 11) | 20) & 0xFu; }
#define XB_SPIN(cond, bar) do { unsigned _sp = 0; while (cond) { __builtin_amdgcn_s_sleep(1); \
    if ((++_sp & 255u) == 0u) { if (xb_ld(&(bar)[XB_TMO])) break; if (_sp > XB_SPIN_CAP) { atomicAdd(&(bar)[XB_TMO], 1u); break; } } } } while (0)
struct XcdBarrier { unsigned* bar; unsigned x; volatile LAS unsigned* st; };
__device__ __forceinline__ XcdBarrier xcd_barrier_post(unsigned* bar, volatile LAS unsigned* st) {
    XcdBarrier b; b.bar = bar; b.x = xb_xcc_id(); b.st = st;
    if (threadIdx.x == 0) (void)xb_add(&bar[XB_XCNT(b.x)], 1u);
    return b;
}
__device__ __forceinline__ void xcd_barrier_complete(unsigned* bar, unsigned x, unsigned& nloc, unsigned& nx) {
    const unsigned G = gridDim.x * gridDim.y * gridDim.z;
    unsigned sum, cnt, mine, sp = 0u;
    for (;;) {
        sum = 0u; cnt = 0u; mine = 0u;
#pragma unroll
        for (unsigned j = 0; j < 16; ++j) { const unsigned c = xb_ld(&bar[XB_XCNT(j)]); sum += c; cnt += (c > 0u) ? 1u : 0u; mine = (j == x) ? c : mine; }
        if (sum == G) break;
        __builtin_amdgcn_s_sleep(1);
        if ((++sp & 255u) == 0u) { if (xb_ld(&bar[XB_TMO])) break; if (sp > XB_SPIN_CAP) { atomicAdd(&bar[XB_TMO], 1u); break; } }
    }
    nloc = mine > 0u ? mine : 1u; nx = cnt > 0u ? cnt : 1u;
}
__device__ __forceinline__ void xcd_barrier(const XcdBarrier& b, bool is_t0) {
    asm volatile("s_waitcnt vmcnt(0)" ::: "memory");
    __syncthreads();
    if (is_t0) {
        unsigned* bar = b.bar;
        __builtin_amdgcn_s_waitcnt(0);
        unsigned nloc = b.st[0], nx = b.st[1];
        if (nloc == 0u) { xcd_barrier_complete(bar, b.x, nloc, nx); b.st[0] = nloc; b.st[1] = nx; }
        const unsigned old = xb_add(&bar[XB_XSUB(b.x)], 1u);
        const unsigned gen = old / nloc;
        if (old + 1u == (gen + 1u) * nloc) {
            __builtin_amdgcn_fence(__ATOMIC_RELEASE, "agent");
            asm volatile("s_waitcnt vmcnt(0)" ::: "memory");
            const unsigned og = xb_add(&bar[XB_TOP], 1u);
            const unsigned tg = og / nx;
            if (og + 1u == (tg + 1u) * nx) xb_add(&bar[XB_TOPGEN], 1u);
            else XB_SPIN(xb_ld(&bar[XB_TOPGEN]) == tg, bar);
            __builtin_amdgcn_fence(__ATOMIC_ACQUIRE, "agent");
            xb_add(&bar[XB_XGEN(b.x)], 1u);
            asm volatile("s_waitcnt vmcnt(0)" ::: "memory");
        } else {
            XB_SPIN(xb_ld(&bar[XB_XGEN(b.x)]) == gen, bar);
            __builtin_amdgcn_fence(__ATOMIC_ACQUIRE, "agent");
            asm volatile("s_waitcnt vmcnt(0)" ::: "memory");
        }
    }
    __syncthreads();
}

constexpr int AT_SLOT = 8192, AT_VOFF = 9 * AT_SLOT;
__device__ __forceinline__ int kswz(int col) { return ((col >> 1) & 1) | (((col >> 3) & 3) << 1); }
template <bool NA>
__device__ __forceinline__ void attn_core(const bf16x8 (&qf)[2], const LAS unsigned char* lds, int rs, int c_lo, bf16* obase, const float* rpbp_h, int rbias0, int c0q, int lane) {
    const int n = lane & 15, q = lane >> 4, cq = c0q + n;
    f32x4 bias0[8], bias1[8];
    if (NA) {
        const float* bp = rpbp_h + (c_lo - c0q + 8 * q - n + 31);
#pragma unroll
        for (int kb = 0; kb < 8; ++kb) { bias0[kb] = gld<f32x4>(bp + (rbias0 + kb) * 64); bias1[kb] = gld<f32x4>(bp + (rbias0 + kb) * 64 + 4); }
    }
    f32x4 s[8][2];
#pragma unroll
    for (int kb = 0; kb < 8; ++kb) {
        const int slot = NA ? (rs + kb) % 9 : (kb >> 1); const int cb0 = NA ? c_lo : (kb & 1) * 32;
        const LAS unsigned char* kp = lds + slot * AT_SLOT;
#pragma unroll
        for (int blk = 0; blk < 2; ++blk) {
            const int col = cb0 + 8 * (n >> 2) + 4 * blk + (n & 3), f = kswz(col);
            const bf16x8 a0 = *(const LAS bf16x8*)(kp + col * 128 + ((q ^ f) << 4)), a1 = *(const LAS bf16x8*)(kp + col * 128 + (((4 + q) ^ f) << 4));
            f32x4 a = (f32x4){0.f, 0.f, 0.f, 0.f};
            a = __builtin_amdgcn_mfma_f32_16x16x32_bf16(a0, qf[0], a, 0, 0, 0);
            a = __builtin_amdgcn_mfma_f32_16x16x32_bf16(a1, qf[1], a, 0, 0, 0);
            s[kb][blk] = a;
        }
    }
    if (NA) {
        const int cs = min(max(cq - 8, 0), 48);
#pragma unroll
        for (int kb = 0; kb < 8; ++kb) {
            const f32x4 b0 = bias0[kb], b1 = bias1[kb];
#pragma unroll
            for (int i = 0; i < 4; ++i) {
                const int kc0 = c_lo + 8 * q + i, kc1 = kc0 + 4;
                s[kb][0][i] = (kc0 >= cs && kc0 < cs + 16) ? s[kb][0][i] + b0[i] : -1e30f;
                s[kb][1][i] = (kc1 >= cs && kc1 < cs + 16) ? s[kb][1][i] + b1[i] : -1e30f;
            }
        }
    }
    float mx = -1e30f;
#pragma unroll
    for (int kb = 0; kb < 8; ++kb)
#pragma unroll
        for (int blk = 0; blk < 2; ++blk)
#pragma unroll
            for (int i = 0; i < 4; ++i) mx = fmaxf(mx, s[kb][blk][i]);
    mx = fmaxf(mx, shfl_xor_f(mx, 16, lane)); mx = fmaxf(mx, shfl_xor_f(mx, 32, lane));
    float sum = 0.f; bf16x8 pf[8];
#pragma unroll
    for (int kb = 0; kb < 8; ++kb) {
        float p[8];
#pragma unroll
        for (int blk = 0; blk < 2; ++blk)
#pragma unroll
            for (int i = 0; i < 4; ++i) { const float e = fast_exp(s[kb][blk][i] - mx); p[blk * 4 + i] = e; sum += e; }
        u32x4 w; w.x = cvt_pk_bf16(p[0], p[1]); w.y = cvt_pk_bf16(p[2], p[3]); w.z = cvt_pk_bf16(p[4], p[5]); w.w = cvt_pk_bf16(p[6], p[7]);
        pf[kb] = __builtin_bit_cast(bf16x8, w);
    }
    sum += shfl_xor_f(sum, 16, lane); sum += shfl_xor_f(sum, 32, lane);
    const float inv = fast_rcp(sum);
#pragma unroll
    for (int db = 0; db < 4; ++db) {
        f32x4 o = (f32x4){0.f, 0.f, 0.f, 0.f};
#pragma unroll
        for (int kb = 0; kb < 8; ++kb) {
            const int slot = NA ? (rs + kb) % 9 : (kb >> 1); const int cb0 = NA ? c_lo : (kb & 1) * 32;
            const bf16x8 vf = *(const LAS bf16x8*)(lds + AT_VOFF + slot * AT_SLOT + ((((cb0 >> 3) + q) * 64 + db * 16 + n) << 4));
            o = __builtin_amdgcn_mfma_f32_16x16x32_bf16(vf, pf[kb], o, 0, 0, 0);
        }
        u32x2 w; w.x = cvt_pk_bf16(o[0] * inv, o[1] * inv); w.y = cvt_pk_bf16(o[2] * inv, o[3] * inv);
        gst<u32x2>(obase + (unsigned)(n * 1024 + 4 * q) + db * 16, w);
    }
}

constexpr int NWAVES = 8;
constexpr int RING_BYTES = 131072, ATT_BYTES = 147456, MISC_OFF = ATT_BYTES, TAB_OFF = MISC_OFF + 256, LDS_BYTES = 163840;
struct Args { const float* in[30]; float* out; unsigned char* ws; };
struct Frame { LAS unsigned char* lds; int tid, lane, wave, vcu, G; };
enum { I_X = 0, I_MEM, I_NMIX, I_NFFN, I_NMEM, I_WIN, I_BGATE, I_RPB, I_LRE, I_LIM, I_LDT, I_BRE, I_BIM, I_CRE, I_CIM, I_S5D, I_WGLU, I_WMKV, I_WBNA, I_WBS5, I_WBXA, I_WOUT,
       I_WCO, I_BCO, I_WFI, I_BFI, I_WG, I_WU, I_WD, I_FNORM };

__device__ __forceinline__ void transpose_item(const float* W, int ldn, int k0, int n0, bf16* WT, int ldk, int dk0, int row_off, int rmul, int radd, int qs, const float* kscale, LAS float* scr, int lane) {
    { float t[32]; const float* wp = W + (size_t)(k0 + (lane >> 5)) * ldn + n0 + (lane & 31);
#pragma unroll
      for (int i = 0; i < 32; ++i) t[i] = gld<float>(wp + (size_t)(2 * i) * ldn);
#pragma unroll
      for (int i = 0; i < 32; ++i) scr[(2 * i + (lane >> 5)) * 33 + (lane & 31)] = t[i]; }
    LDS_WAIT(); asm volatile("" ::: "memory");
    const int c = lane & 7;
    f32x4 ka = (f32x4){1.f, 1.f, 1.f, 1.f}, kb = ka;
    if (kscale) { ka = gld<f32x4>(kscale + k0 + 8 * c); kb = gld<f32x4>(kscale + k0 + 8 * c + 4); }
#pragma unroll
    for (int j = 0; j < 4; ++j) { const int n = (lane >> 3) + 8 * j, nn = n0 + n; const LAS float* s = scr + (8 * c) * 33 + n;
        const float sc = (qs && (nn < 512 || (nn >= 1792 && nn < 2048))) ? 0.125f : 1.0f;
        u32x4 o; o.x = cvt_pk_bf16(s[0 * 33] * sc * ka[0], s[1 * 33] * sc * ka[1]); o.y = cvt_pk_bf16(s[2 * 33] * sc * ka[2], s[3 * 33] * sc * ka[3]); o.z = cvt_pk_bf16(s[4 * 33] * sc * kb[0], s[5 * 33] * sc * kb[1]); o.w = cvt_pk_bf16(s[6 * 33] * sc * kb[2], s[7 * 33] * sc * kb[3]);
        gst<u32x4>(WT + (size_t)(row_off + nn * rmul + radd) * ldk + dk0 + k0 + 8 * c, o); }
    LDS_WAIT(); asm volatile("" ::: "memory");
}
__device__ __forceinline__ void transpose_job_item(const float* W, int ldn, int N, int it, bf16* WT, int ldk, int dk0, int row_off, int rmul, int radd, int qs, const float* kscale, LAS float* scr, int lane) {
    const int nblk = N / 32, kb = it / nblk, nb = it % nblk;
    transpose_item(W, ldn, 64 * kb, 32 * nb, WT, ldk, dk0, row_off, rmul, radd, qs, kscale, scr, lane);
}

__device__ __forceinline__ void cexp_d(double zr, double zi, double& er, double& ei) {
    const double wr_ = zr * (1.0 / 1024.0), wi_ = zi * (1.0 / 1024.0);
    double tr = 1.0, ti = 0.0;
#pragma unroll
    for (int n = 12; n >= 1; --n) { const double ar = wr_ * (1.0 / n), ai = wi_ * (1.0 / n); const double nr = 1.0 + (ar * tr - ai * ti), ni = ar * ti + ai * tr; tr = nr; ti = ni; }
#pragma unroll
    for (int k = 0; k < 10; ++k) { const double nr = tr * tr - ti * ti, ni = 2.0 * tr * ti; tr = nr; ti = ni; }
    er = tr; ei = ti;
}

template <bool ROUTER>
__device__ __forceinline__ void norm_rows4(const float* X, const float* gain, bf16* H, int row0, int lane,
                                           const float* wrt, const float* bco, const float* bfi, unsigned* cnt, int* list, float* wts) {
    f32x4 x[4][4]; float rstd[4];
#pragma unroll
    for (int r = 0; r < 4; ++r) { float ss = 0.f;
#pragma unroll
        for (int j = 0; j < 4; ++j) { x[r][j] = gld<f32x4>(X + (size_t)(row0 + r) * 1024 + 256 * j + 4 * lane); ss += (x[r][j][0] * x[r][j][0] + x[r][j][1] * x[r][j][1]) + (x[r][j][2] * x[r][j][2] + x[r][j][3] * x[r][j][3]); }
        ss = wave_sum(ss, lane); rstd[r] = 1.0f / sqrtf(ss * (1.0f / 1024.0f) + RMS_EPS); }
#pragma unroll
    for (int j = 0; j < 4; ++j) { const f32x4 g4 = gld<f32x4>(gain + 256 * j + 4 * lane);
#pragma unroll
        for (int r = 0; r < 4; ++r) { const f32x4 v = x[r][j] * rstd[r] * g4; u32x2 w; w.x = cvt_pk_bf16(v[0], v[1]); w.y = cvt_pk_bf16(v[2], v[3]);
            gst<u32x2>(H + (size_t)(row0 + r) * 1024 + 256 * j + 4 * lane, w); } }
    if constexpr (ROUTER) {
        float keep[4] = {0.f, 0.f, 0.f, 0.f};
#pragma unroll 2
        for (int c = 0; c < 20; ++c) {
            float a0 = 0.f, a1 = 0.f, a2 = 0.f, a3 = 0.f;
#pragma unroll
            for (int j = 0; j < 4; ++j) { const f32x4 w4 = gld<f32x4>(wrt + c * 1024 + 256 * j + 4 * lane);
                a0 += (x[0][j][0] * w4[0] + x[0][j][1] * w4[1]) + (x[0][j][2] * w4[2] + x[0][j][3] * w4[3]);
                a1 += (x[1][j][0] * w4[0] + x[1][j][1] * w4[1]) + (x[1][j][2] * w4[2] + x[1][j][3] * w4[3]);
                a2 += (x[2][j][0] * w4[0] + x[2][j][1] * w4[1]) + (x[2][j][2] * w4[2] + x[2][j][3] * w4[3]);
                a3 += (x[3][j][0] * w4[0] + x[3][j][1] * w4[1]) + (x[3][j][2] * w4[2] + x[3][j][3] * w4[3]); }
            a0 = wave_sum(a0, lane); a1 = wave_sum(a1, lane); a2 = wave_sum(a2, lane); a3 = wave_sum(a3, lane);
            if (lane == c) { keep[0] = a0 * rstd[0]; keep[1] = a1 * rstd[1]; keep[2] = a2 * rstd[2]; keep[3] = a3 * rstd[3]; }
        }
#pragma unroll
        for (int r = 0; r < 4; ++r) {
            float co[4];
#pragma unroll
            for (int i = 0; i < 4; ++i) co[i] = shfl_idx_f(keep[r], i) + bco[i];
            int grp = 0; float cm = co[0];
#pragma unroll
            for (int i = 1; i < 4; ++i) if (co[i] > cm) { cm = co[i]; grp = i; }
            float den = 0.f;
#pragma unroll
            for (int i = 0; i < 4; ++i) den += __expf(co[i] - cm);
            const float pgrp = 1.0f / den;
            float fv[4];
#pragma unroll
            for (int i = 0; i < 4; ++i) fv[i] = shfl_idx_f(keep[r], 4 + grp * 4 + i) + bfi[grp * 4 + i];
            int i1 = 0; float v1 = fv[0];
#pragma unroll
            for (int i = 1; i < 4; ++i) if (fv[i] > v1) { v1 = fv[i]; i1 = i; }
            int i2 = -1; float v2 = -3.0e38f;
#pragma unroll
            for (int i = 0; i < 4; ++i) if (i != i1 && fv[i] > v2) { v2 = fv[i]; i2 = i; }
            const float w1 = pgrp / (1.0f + __expf(v2 - v1)), w2 = pgrp - w1;
            const int a = i1 < i2 ? i1 : i2, b = i1 < i2 ? i2 : i1;
            const int pidx = a == 0 ? b - 1 : (a == 1 ? b + 1 : 5);
            const int bucket = grp * 6 + pidx;
            const float wa = (i1 == a) ? w1 : w2, wb = (i1 == a) ? w2 : w1;
            if (lane == 0) {
                const unsigned slot = __hip_atomic_fetch_add(cnt + bucket * 64, 1u, __ATOMIC_RELAXED, __HIP_MEMORY_SCOPE_AGENT);
                list[(size_t)bucket * LCAP + slot] = row0 + r;
                gst<f32x2>(wts + ((size_t)bucket * LCAP + slot) * 2, (f32x2){wa, wb});
            }
        }
    }
}

constexpr int RT_STRIDE = 2064;
constexpr int RT_BYTES = 40 * RT_STRIDE;
constexpr int RT_SCR = 98304;
__device__ __forceinline__ void router_rows16(const float* X, int R0, int lane, LAS unsigned char* lds, int wave,
                                              const float* bco, const float* bfi, unsigned* cnt, int* list, float* wts) {
    const int n = lane & 15, q = lane >> 4;
    f32x4 accF = (f32x4){0.f, 0.f, 0.f, 0.f}, accC = (f32x4){0.f, 0.f, 0.f, 0.f};
    float ss = 0.f;
    const float* xp = X + (unsigned)((R0 + n) * 1024 + 8 * q);
    const LAS unsigned char* tF = lds + n * RT_STRIDE + 16 * q; const LAS unsigned char* tC = lds + (16 + (n & 3)) * RT_STRIDE + 16 * q;
#pragma unroll 4
    for (int ks = 0; ks < 32; ++ks) {
        const f32x4 x0 = gld<f32x4>(xp + ks * 32), x1 = gld<f32x4>(xp + ks * 32 + 4);
        ss += (x0[0] * x0[0] + x0[1] * x0[1]) + (x0[2] * x0[2] + x0[3] * x0[3]) + (x1[0] * x1[0] + x1[1] * x1[1]) + (x1[2] * x1[2] + x1[3] * x1[3]);
        u32x4 hw; hw.x = cvt_pk_bf16(x0[0], x0[1]); hw.y = cvt_pk_bf16(x0[2], x0[3]); hw.z = cvt_pk_bf16(x1[0], x1[1]); hw.w = cvt_pk_bf16(x1[2], x1[3]);
        u32x4 lw; lw.x = cvt_pk_bf16(x0[0] - bflo(hw.x), x0[1] - bfhi(hw.x)); lw.y = cvt_pk_bf16(x0[2] - bflo(hw.y), x0[3] - bfhi(hw.y));
        lw.z = cvt_pk_bf16(x1[0] - bflo(hw.z), x1[1] - bfhi(hw.z)); lw.w = cvt_pk_bf16(x1[2] - bflo(hw.w), x1[3] - bfhi(hw.w));
        const bf16x8 ah = __builtin_bit_cast(bf16x8, hw), al = __builtin_bit_cast(bf16x8, lw);
        const bf16x8 fh = *(const LAS bf16x8*)(tF + ks * 64), fl = *(const LAS bf16x8*)(tF + 20 * RT_STRIDE + ks * 64);
        const bf16x8 ch = *(const LAS bf16x8*)(tC + ks * 64), cl = *(const LAS bf16x8*)(tC + 20 * RT_STRIDE + ks * 64);
        accF = __builtin_amdgcn_mfma_f32_16x16x32_bf16(ah, fh, accF, 0, 0, 0); accF = __builtin_amdgcn_mfma_f32_16x16x32_bf16(ah, fl, accF, 0, 0, 0); accF = __builtin_amdgcn_mfma_f32_16x16x32_bf16(al, fh, accF, 0, 0, 0);
        accC = __builtin_amdgcn_mfma_f32_16x16x32_bf16(ah, ch, accC, 0, 0, 0); accC = __builtin_amdgcn_mfma_f32_16x16x32_bf16(ah, cl, accC, 0, 0, 0); accC = __builtin_amdgcn_mfma_f32_16x16x32_bf16(al, ch, accC, 0, 0, 0);
    }
    ss += shfl_xor_f(ss, 16, lane); ss += shfl_xor_f(ss, 32, lane);
    const float rstd = 1.0f / sqrtf(ss * (1.0f / 1024.0f) + RMS_EPS);
    LAS float* sc = (LAS float*)(lds + RT_SCR + wave * 1536);
#pragma unroll
    for (int r = 0; r < 4; ++r) { const float rs = shfl_idx_f(rstd, 4 * q + r); sc[(4 * q + r) * 24 + n] = accF[r] * rs; if (n < 4) sc[(4 * q + r) * 24 + 16 + n] = accC[r] * rs; }
    LDS_WAIT(); asm volatile("" ::: "memory");
    if (lane < 16) {
        const LAS float* my = sc + lane * 24;
        float co[4];
#pragma unroll
        for (int i = 0; i < 4; ++i) co[i] = my[16 + i] + gld<float>(bco + i);
        int grp = 0; float cm = co[0];
#pragma unroll
        for (int i = 1; i < 4; ++i) if (co[i] > cm) { cm = co[i]; grp = i; }
        float den = 0.f;
#pragma unroll
        for (int i = 0; i < 4; ++i) den += __expf(co[i] - cm);
        const float pgrp = 1.0f / den;
        float fv[4];
#pragma unroll
        for (int i = 0; i < 4; ++i) fv[i] = my[grp * 4 + i] + gld<float>(bfi + grp * 4 + i);
        int i1 = 0; float v1 = fv[0];
#pragma unroll
        for (int i = 1; i < 4; ++i) if (fv[i] > v1) { v1 = fv[i]; i1 = i; }
        int i2 = -1; float v2 = -3.0e38f;
#pragma unroll
        for (int i = 0; i < 4; ++i) if (i != i1 && fv[i] > v2) { v2 = fv[i]; i2 = i; }
        const float w1 = pgrp / (1.0f + __expf(v2 - v1)), w2 = pgrp - w1;
        const int a = i1 < i2 ? i1 : i2, b = i1 < i2 ? i2 : i1;
        const int pidx = a == 0 ? b - 1 : (a == 1 ? b + 1 : 5);
        const int bucket = grp * 6 + pidx;
        const float wa = (i1 == a) ? w1 : w2, wb = (i1 == a) ? w2 : w1;
        const unsigned slot = __hip_atomic_fetch_add((GASP unsigned*)(cnt + bucket * 64), 1u, __ATOMIC_RELAXED, __HIP_MEMORY_SCOPE_AGENT);
        gst<int>(list + ((unsigned)(bucket * LCAP) + slot), R0 + lane);
        gst<f32x4>(wts + ((unsigned)(bucket * LCAP) + slot) * 4, (f32x4){wa, wb, rstd, 0.f});
    }
}

__device__ __forceinline__ void final_norm_row(float* X, const float* gain, int row, int lane) {
    f32x4 x[4]; float ss = 0.f;
#pragma unroll
    for (int j = 0; j < 4; ++j) { x[j] = gld<f32x4>(X + (size_t)row * 1024 + 256 * j + 4 * lane); ss += (x[j][0] * x[j][0] + x[j][1] * x[j][1]) + (x[j][2] * x[j][2] + x[j][3] * x[j][3]); }
    ss = wave_sum(ss, lane); const float rstd = 1.0f / sqrtf(ss * (1.0f / 1024.0f) + RMS_EPS);
#pragma unroll
    for (int j = 0; j < 4; ++j) { const f32x4 g4 = gld<f32x4>(gain + 256 * j + 4 * lane); gst<f32x4>(X + (size_t)row * 1024 + 256 * j + 4 * lane, x[j] * rstd * g4); }
}

__device__ __forceinline__ void s5_scan_item(int item, const float* ST, bf16* At, const f32x2* apow_l, LAS float* sc, int tid) {
    const int d = item & 1, bg = item >> 1, g = bg & 15, seg = tid >> 6, p = tid & 63;
    const f32x2 A32 = gld<f32x2>(apow_l + ((d * 16 + g) * 33 + 32) * 64 + p);
    const int chunk0 = d ? 255 - seg * 32 : seg * 32; const long cstep = d ? -1 : 1;
    const float* rp0 = ST + (size_t)(bg * 256 + chunk0) * 256 + d * 128 + p;
    float tr = 0.f, ti = 0.f;
#pragma unroll 8
    for (int j = 0; j < 32; ++j) { const float* rp = rp0 + cstep * j * 256; const float sr = gld<float>(rp), si = gld<float>(rp + 64); const float nr = A32.x * tr - A32.y * ti + sr, ni = A32.x * ti + A32.y * tr + si; tr = nr; ti = ni; }
    sc[(seg * 64 + p) * 2] = tr; sc[(seg * 64 + p) * 2 + 1] = ti;
    __syncthreads();
    float pr = A32.x, pi = A32.y;
#pragma unroll
    for (int k = 0; k < 5; ++k) { const float nr = pr * pr - pi * pi, ni = 2.f * pr * pi; pr = nr; pi = ni; }
    float er = 0.f, ei = 0.f;
    for (int s2 = 0; s2 < seg; ++s2) { const float qr = sc[(s2 * 64 + p) * 2], qi = sc[(s2 * 64 + p) * 2 + 1]; const float nr = pr * er - pi * ei + qr, ni = pr * ei + pi * er + qi; er = nr; ei = ni; }
    bf16* op0 = At + (size_t)(bg * 256 + chunk0) * ATK + 512 + d * 128 + p;
#pragma unroll 8
    for (int j = 0; j < 32; ++j) { const float* rp = rp0 + cstep * j * 256; const float sr = gld<float>(rp), si = gld<float>(rp + 64); bf16* op = op0 + cstep * j * ATK;
        gst<bf16>(op, (bf16)(cvt_pk_bf16(er, er) & 0xffffu)); gst<bf16>(op + 64, (bf16)(cvt_pk_bf16(ei, ei) & 0xffffu));
        const float nr = A32.x * er - A32.y * ei + sr, ni = A32.x * ei + A32.y * er + si; er = nr; ei = ni; }
    __syncthreads();
}

#define NA_ITEM(item) do { \
    const bf16* QK = WP(bf16, WS_QK); const bf16* VT8 = WP(bf16, WS_VT8); bf16* Hn = WP(bf16, WS_H); const float* RPBP = WP(float, WS_RPBP); \
    const int n = lane & 15, q = lane >> 4, cb = wave & 3, qsel = wave >> 2, c_lo = cb == 0 ? 0 : (cb == 1 ? 8 : (cb == 2 ? 24 : 32)); \
    const int kcol = tid >> 3, kdst = kcol * 128 + (((tid & 7) ^ kswz(kcol)) << 4); \
    const int b = (item) >> 6, h = ((item) >> 3) & 7, r0 = ((item) & 7) * 16; \
    const bf16* Kg = QK + (size_t)b * SEQ * 1024 + 512 + h * 64 + (unsigned)(kcol * 1024 + (tid & 7) * 8); \
    const bf16* Vg = VT8 + (size_t)(b * 8 + h) * 1024 * 512 + (unsigned)(tid * 8); \
    const float* rp = RPBP + (size_t)(l * 8 + h) * 15 * 64; \
    int hi = min(max(r0 + 1 - 4, 0), 120) + 7; \
    { const int lo = min(max(r0 - 4, 0), 120); \
      u32x4 kv[9], vv[9]; \
      _Pragma("unroll") for (int j = 0; j < 9; ++j) { const int kr = min(lo + j, 127); kv[j] = gld<u32x4>(Kg + (size_t)kr * 65536); vv[j] = gld<u32x4>(Vg + (size_t)kr * 4096); } \
      _Pragma("unroll") for (int j = 0; j < 9; ++j) { const int kr = lo + j; if (kr <= hi) { const int slot = kr % 9; *(LAS u32x4*)(F.lds + slot * AT_SLOT + kdst) = kv[j]; *(LAS u32x4*)(F.lds + AT_VOFF + slot * AT_SLOT + tid * 16) = vv[j]; } } \
    } \
    bf16x8 qf[2]; \
    { const bf16* qb = QK + (size_t)(b * SEQ + (r0 + qsel) * 64 + cb * 16) * 1024 + h * 64 + (unsigned)(n * 1024 + 8 * q); qf[0] = gld<bf16x8>(qb); qf[1] = gld<bf16x8>(qb + 32); } \
    __syncthreads(); \
    _Pragma("unroll 1") for (int st = 0; st < 8; ++st) { \
        const int r = r0 + 2 * st + qsel, rs = min(max(r - 4, 0), 120); \
        const bool more = st < 7; \
        const int hi_next = more ? min(max(r0 + 2 * st + 3 - 4, 0), 120) + 7 : hi; \
        const int kr1 = hi + 1, kr2 = hi + 2; \
        u32x4 k1 = (u32x4){0u, 0u, 0u, 0u}, v1 = k1, k2 = k1, v2 = k1; bf16x8 qn[2]; qn[0] = qf[0]; qn[1] = qf[1]; \
        if (more) { \
            k1 = gld<u32x4>(Kg + (size_t)min(kr1, 127) * 65536); v1 = gld<u32x4>(Vg + (size_t)min(kr1, 127) * 4096); \
            k2 = gld<u32x4>(Kg + (size_t)min(kr2, 127) * 65536); v2 = gld<u32x4>(Vg + (size_t)min(kr2, 127) * 4096); \
            const bf16* qb = QK + (size_t)(b * SEQ + (r + 2) * 64 + cb * 16) * 1024 + h * 64 + (unsigned)(n * 1024 + 8 * q); qn[0] = gld<bf16x8>(qb); qn[1] = gld<bf16x8>(qb + 32); \
        } \
        attn_core<true>(qf, F.lds, rs, c_lo, Hn + (size_t)(b * SEQ + r * 64 + cb * 16) * 1024 + h * 64, rp, rs - r + 7, cb * 16, lane); \
        __syncthreads(); \
        if (more) { \
            if (kr1 <= hi_next) { const int slot = kr1 % 9; *(LAS u32x4*)(F.lds + slot * AT_SLOT + kdst) = k1; *(LAS u32x4*)(F.lds + AT_VOFF + slot * AT_SLOT + tid * 16) = v1; } \
            if (kr2 <= hi_next) { const int slot = kr2 % 9; *(LAS u32x4*)(F.lds + slot * AT_SLOT + kdst) = k2; *(LAS u32x4*)(F.lds + AT_VOFF + slot * AT_SLOT + tid * 16) = v2; } \
            hi = hi_next; qf[0] = qn[0]; qf[1] = qn[1]; \
        } \
        __syncthreads(); \
    } } while (0)
#define WG_MEM_SYNC() do { asm volatile("s_waitcnt vmcnt(0)" ::: "memory"); __syncthreads(); __builtin_amdgcn_fence(__ATOMIC_ACQUIRE, "agent"); asm volatile("s_waitcnt vmcnt(0)" ::: "memory"); } while (0)

#define XA_ITEMS(first, last, stride) do { \
    const bf16* QX = WP(bf16, WS_QX); const bf16* KM = WP(bf16, WS_KM); const bf16* VM8 = WP(bf16, WS_VM8); bf16* Hx = WP(bf16, WS_H); \
    const int n_ = lane & 15, q_ = lane >> 4, kcol = tid >> 3, kdst = kcol * 128 + (((tid & 7) ^ kswz(kcol)) << 4); \
    for (int item = (first); item < (last); item += (stride)) { \
        const int b = item >> 6, h = (item >> 4) & 3, qc = item & 15; \
        const bf16* Kg = KM + ((size_t)(l * 4 + b) * 256) * 256 + h * 64 + (unsigned)(kcol * 256 + (tid & 7) * 8); \
        const bf16* Vg = VM8 + (size_t)((l * 4 + b) * 4 + h) * 32 * 512 + (unsigned)(tid * 8); \
        _Pragma("unroll") for (int j = 0; j < 4; ++j) { const u32x4 kv = gld<u32x4>(Kg + j * 64 * 256), vv = gld<u32x4>(Vg + j * 4096); \
            *(LAS u32x4*)(F.lds + j * AT_SLOT + kdst) = kv; *(LAS u32x4*)(F.lds + AT_VOFF + j * AT_SLOT + tid * 16) = vv; } \
        __syncthreads(); \
        _Pragma("unroll 1") for (int j = 0; j < 4; ++j) { \
            const int t0 = b * SEQ + qc * 512 + wave * 64 + j * 16; \
            bf16x8 qf[2]; { const bf16* qb = QX + (size_t)t0 * 256 + h * 64 + (unsigned)(n_ * 256 + 8 * q_); qf[0] = gld<bf16x8>(qb); qf[1] = gld<bf16x8>(qb + 32); } \
            attn_core<false>(qf, F.lds, 0, 0, Hx + (size_t)t0 * 1024 + 768 + h * 64, nullptr, 0, 0, lane); } \
        __syncthreads(); \
    } } while (0)

#ifndef PHMASK
#define PHMASK 0xffffffffu
#endif
#define PH(k) ((PHMASK >> (k)) & 1u)
#ifndef FUSE1
#define FUSE1 0
#endif
#ifndef REPMASK
#define REPMASK 0u
#endif
#define NREP(k) (1 + (int)((REPMASK >> (k)) & 1u))
constexpr int PTR_OFF = MISC_OFF + 1024;
__device__ __forceinline__ const float* inp(LAS unsigned char* lds, int i, int z) {
    const LAS unsigned* q = (const LAS unsigned*)(lds + PTR_OFF + 8 * i + z);
    const unsigned lo = __builtin_amdgcn_readfirstlane(q[0]), hi = __builtin_amdgcn_readfirstlane(q[1]);
    return (const float*)(((unsigned long long)hi << 32) | lo);
}
#define WSL() unsigned char* wsl = args.ws; int wave = F.wave, bid = blockIdx.x, G = gridDim.x, zz = 0; unsigned mm_ = ~0u; asm volatile("" : "+s"(mm_)); int lane = (int)__builtin_amdgcn_mbcnt_hi(mm_, __builtin_amdgcn_mbcnt_lo(mm_, 0u)); \
    asm volatile("" : "+s"(wsl), "+s"(wave), "+v"(lane), "+s"(bid), "+s"(G), "+s"(zz)); \
    const int tid = wave * 64 + lane, vcu = (G % 8 == 0) ? (bid % 8) * (G / 8) + bid / 8 : bid, gw = vcu * NWAVES + wave, NGW = G * NWAVES, NGT = G * NWAVES * 64; \
    (void)tid; (void)gw; (void)NGW; (void)NGT; (void)wsl
#define WP(T, off) ((T*)(wsl + (off)))
#define IN(i) inp(F.lds, (i), zz)

__global__ void __launch_bounds__(NWAVES * 64, 2) fwd_kernel(Args args) {
    extern __shared__ __attribute__((aligned(16))) unsigned char lds_raw[];
    Frame F;
    F.lds = (LAS unsigned char*)lds_raw;
    F.tid = threadIdx.x; F.lane = F.tid & 63; F.wave = __builtin_amdgcn_readfirstlane(F.tid >> 6);
    F.G = gridDim.x; { const int bx = blockIdx.x; F.vcu = (F.G % 8 == 0) ? (bx % 8) * (F.G / 8) + bx / 8 : bx; }
    for (int u = F.tid; u < (LDS_BYTES - MISC_OFF) / 4; u += NWAVES * 64) ((LAS unsigned*)(F.lds + MISC_OFF))[u] = 0u;
    __syncthreads();
    if (F.tid < 30) { const unsigned long long p = (unsigned long long)args.in[F.tid]; LAS unsigned* q = (LAS unsigned*)(F.lds + PTR_OFF + 8 * F.tid); q[0] = (unsigned)p; q[1] = (unsigned)(p >> 32); }
    __syncthreads();
    (void)xcd_barrier_post((unsigned*)(args.ws + WS_CTL) + CW_BAR, (volatile LAS unsigned*)(F.lds + MISC_OFF));
#define GRID_BAR() do { unsigned char* w_ = args.ws; asm volatile("" : "+s"(w_)); XcdBarrier b_; b_.bar = (unsigned*)(w_ + WS_CTL) + CW_BAR; b_.x = xb_xcc_id(); b_.st = (volatile LAS unsigned*)(F.lds + MISC_OFF); unsigned m_ = ~0u; int wv_ = F.wave; asm volatile("" : "+s"(m_), "+s"(wv_)); \
    xcd_barrier(b_, (wv_ == 0) && (__builtin_amdgcn_mbcnt_hi(m_, __builtin_amdgcn_mbcnt_lo(m_, 0u)) == 0u)); } while (0)
#define GT() (vcu * (NWAVES * 64) + tid)
#define SCR() ((LAS float*)(F.lds + wave * 16384))

    if (PH(0)) {
        WSL();
        f32x2* APOW = WP(f32x2, WS_APOW); f32x2* BBAR = WP(f32x2, WS_BBAR); bf16* WRT = WP(bf16, WS_WRT); bf16* MEMN = WP(bf16, WS_MEMN); bf16* WMKV = WP(bf16, WS_WMKV);
        for (int it = gw; it < 1024; it += NGW) { const int l = it >> 8, r = it & 255;
            transpose_job_item(IN(I_WMKV) + (size_t)l * 1024 * 512, 512, 512, r, WMKV + (size_t)l * 512 * 1024, 1024, 0, 0, 1, 0, 0, nullptr, SCR(), lane); }
        for (int it = gw; it < 4096; it += NGW) { const int l = it >> 10, row = it & 1023;
            const float* xr = IN(I_MEM) + (size_t)row * 1024; const float* gn = IN(I_NMEM) + l * 1024;
            f32x4 x[4]; float ss = 0.f;
#pragma unroll
            for (int j = 0; j < 4; ++j) { x[j] = gld<f32x4>(xr + 256 * j + 4 * lane); ss += (x[j][0] * x[j][0] + x[j][1] * x[j][1]) + (x[j][2] * x[j][2] + x[j][3] * x[j][3]); }
            ss = wave_sum(ss, lane); const float rstd = 1.0f / sqrtf(ss * (1.0f / 1024.0f) + RMS_EPS);
#pragma unroll
            for (int j = 0; j < 4; ++j) { const f32x4 v = x[j] * rstd * gld<f32x4>(gn + 256 * j + 4 * lane); u32x2 w; w.x = cvt_pk_bf16(v[0], v[1]); w.y = cvt_pk_bf16(v[2], v[3]);
                gst<u32x2>(MEMN + (size_t)it * 1024 + 256 * j + 4 * lane, w); } }
        for (int it = GT(); it < 8192; it += NGT) {
            const int p = it & 63, ldg = it >> 6;
            const double lr = fmin((double)IN(I_LRE)[it], -1e-4), li = (double)IN(I_LIM)[it];
            double dt, dum; cexp_d((double)IN(I_LDT)[ldg], 0.0, dt, dum);
            double ar, ai; cexp_d(lr * dt, li * dt, ar, ai);
            const double den = lr * lr + li * li, fr = ((ar - 1.0) * lr + ai * li) / den, fi = (ai * lr - (ar - 1.0) * li) / den;
            const float* bre = IN(I_BRE) + (size_t)it * 16; const float* bim = IN(I_BIM) + (size_t)it * 16;
#pragma unroll 4
            for (int c = 0; c < 16; ++c) { const double br = (double)bre[c], bi = (double)bim[c];
                BBAR[(size_t)it * 16 + c] = (f32x2){(float)(fr * br - fi * bi), (float)(fr * bi + fi * br)}; }
            double pr = 1.0, pi = 0.0;
            for (int n = 0; n <= 32; ++n) { APOW[((size_t)ldg * 33 + n) * 64 + p] = (f32x2){(float)pr, (float)pi}; const double nr = pr * ar - pi * ai, ni = pr * ai + pi * ar; pr = nr; pi = ni; }
        }
        { float* RPBP = WP(float, WS_RPBP); const float* rpb = IN(I_RPB);
          for (int it = GT(); it < 4 * 8 * 15 * 64; it += NGT) { const int j = it & 63; RPBP[it] = (j >= 16 && j < 47) ? rpb[(it >> 6) * 31 + (j - 16)] : 0.f; } }
        for (int it = GT(); it < 4 * 20480; it += NGT) { const int l = it / 20480, r = it % 20480, c = r >> 10, k = r & 1023;
            const float gk = IN(I_NFFN)[l * 1024 + k];
            const float v = gk * (c < 16 ? IN(I_WFI)[(size_t)(l * 1024 + k) * 16 + c] : IN(I_WCO)[(size_t)(l * 1024 + k) * 4 + (c - 16)]);
            const unsigned hw = cvt_pk_bf16(v, v) & 0xffffu; const float lo = v - bflo(hw);
            WRT[(size_t)(l * 2 + 0) * 20480 + r] = (bf16)hw; WRT[(size_t)(l * 2 + 1) * 20480 + r] = (bf16)(cvt_pk_bf16(lo, lo) & 0xffffu); }
    }
    GRID_BAR();

    if (PH(1)) {
        WSL();
        { pg8::Gemm g{WP(bf16, WS_MEMN), WP(bf16, WS_WMKV), 1024, 1024, 1024}; pg8::MemOrder S{G, bid}; EpiMemKV E{WP(bf16, WS_KM), WP(bf16, WS_VM8)};
          pg8::gemm_phase<EpiMemKV, pg8::MemOrder>(F.lds, g, S, E, tid); }
        const f32x2* APOW = WP(f32x2, WS_APOW); const f32x2* BBAR = WP(f32x2, WS_BBAR); float* KT = WP(float, WS_KT);
        const float* CRE = IN(I_CRE); const float* CIM = IN(I_CIM); const float* S5D = IN(I_S5D);
        for (int it = GT(); it < 4 * 16 * 63 * 64; it += NGT) {
            const int c2 = (it & 3) * 4, c = (it >> 2) & 15, rest = it >> 6, tp = rest % 63, lg = rest / 63, l = lg >> 4, g = lg & 15;
            f32x4 sum = (f32x4){0.f, 0.f, 0.f, 0.f};
#pragma unroll 1
            for (int d = 0; d < 2; ++d) {
                if (d == 0 ? (tp < 31) : (tp > 31)) continue;
                const int n = d == 0 ? tp - 31 : 31 - tp, base = (l * 2 + d) * 16 + g;
                const float* cre = CRE + ((size_t)base * 16 + c) * 64; const float* cim = CIM + ((size_t)base * 16 + c) * 64;
                const f32x2* ap = APOW + ((size_t)base * 33 + n) * 64; const f32x4* bb = (const f32x4*)(BBAR + (size_t)base * 64 * 16 + c2);
#pragma unroll 8
                for (int p = 0; p < 64; ++p) { const f32x2 a = ap[p]; const f32x4 b0 = bb[p * 8], b1 = bb[p * 8 + 1]; const float cr = cre[p], ci = cim[p];
                    const float er = cr * a.x - ci * a.y, ei = cr * a.y + ci * a.x;
                    sum[0] += er * b0[0] - ei * b0[1]; sum[1] += er * b0[2] - ei * b0[3]; sum[2] += er * b1[0] - ei * b1[1]; sum[3] += er * b1[2] - ei * b1[3]; }
            }
            if (tp == 31 && c >= c2 && c < c2 + 4) sum[c - c2] += S5D[l * 256 + g * 16 + c];
            gst<f32x4>(KT + (size_t)it * 4, sum);
        }
    }
    GRID_BAR();

    const float* xcur = (const float*)(GASP const float*)args.in[I_X];
    float* XO = (float*)(GASP float*)args.out;
#pragma unroll 1
    for (int l = 0; l < DEPTH; ++l) {
        for (int rep_ = 0; rep_ < NREP(2); ++rep_) {
        if (PH(2)) {
            WSL();
            {
            bf16* WIN = WP(bf16, WS_WIN); bf16* WCAT = WP(bf16, WS_WCAT); bf16* WOUT = WP(bf16, WS_WOUT); bf16* WGLU = WP(bf16, WS_WGLU);
            for (int it = gw; it < 3648; it += NGW) {
                int r = it;
                if (r < 2560) { transpose_job_item(IN(I_WIN) + (size_t)l * 1024 * 5120, 5120, 5120, r, WIN, 1024, 0, 0, 1, 0, 1, FUSE1 ? IN(I_NMIX) + l * 1024 : nullptr, SCR(), lane); continue; } r -= 2560;
                if (r < 256) { transpose_job_item(IN(I_WBNA) + (size_t)l * 512 * 1024, 1024, 1024, r, WCAT, 1024, 0, 0, 1, 0, 0, nullptr, SCR(), lane); continue; } r -= 256;
                if (r < 128) { transpose_job_item(IN(I_WBS5) + (size_t)l * 256 * 1024, 1024, 1024, r, WCAT, 1024, 512, 0, 1, 0, 0, nullptr, SCR(), lane); continue; } r -= 128;
                if (r < 128) { transpose_job_item(IN(I_WBXA) + (size_t)l * 256 * 1024, 1024, 1024, r, WCAT, 1024, 768, 0, 1, 0, 0, nullptr, SCR(), lane); continue; } r -= 128;
                if (r < 512) { transpose_job_item(IN(I_WOUT) + (size_t)l * 1024 * 1024, 1024, 1024, r, WOUT, 1024, 0, 0, 1, 0, 0, nullptr, SCR(), lane); continue; } r -= 512;
                if (r < 32) { transpose_job_item(IN(I_WGLU) + (size_t)l * 256 * 512, 512, 256, r, WGLU, 256, 0, 0, 2, 0, 0, nullptr, SCR(), lane); continue; } r -= 32;
                transpose_job_item(IN(I_WGLU) + (size_t)l * 256 * 512 + 256, 512, 256, r, WGLU, 256, 0, 0, 2, 1, 0, nullptr, SCR(), lane);
            }
            }
            {
            const f32x2* APOW = WP(f32x2, WS_APOW); const f32x2* BBAR = WP(f32x2, WS_BBAR); bf16* S5W = WP(bf16, WS_S5W);
            for (int it = GT(); it < 16 * 256 * 64; it += NGT) {
                const int k8 = it & 63, n = (it >> 6) & 255, g = it >> 14;
                const int s = k8 >> 1, c0 = (k8 & 1) * 8, d = n >> 7, ri = (n >> 6) & 1, p = n & 63, e = d == 0 ? 31 - s : s, base = (l * 2 + d) * 16 + g;
                const f32x2 a = APOW[((size_t)base * 33 + e) * 64 + p]; const f32x2* bb = BBAR + ((size_t)base * 64 + p) * 16 + c0;
                float v[8];
#pragma unroll
                for (int j = 0; j < 8; ++j) { const f32x2 b = bb[j]; v[j] = ri == 0 ? a.x * b.x - a.y * b.y : a.x * b.y + a.y * b.x; }
                u32x4 w; w.x = cvt_pk_bf16(v[0], v[1]); w.y = cvt_pk_bf16(v[2], v[3]); w.z = cvt_pk_bf16(v[4], v[5]); w.w = cvt_pk_bf16(v[6], v[7]);
                gst<u32x4>(S5W + ((size_t)(g * 256 + n) * 512 + k8 * 8), w);
            }
            const float* KT = WP(float, WS_KT); bf16* S5KV = WP(bf16, WS_S5KV); const float* CRE = IN(I_CRE); const float* CIM = IN(I_CIM);
            for (int it = GT(); it < 16 * 512 * 96; it += NGT) {
                const int k8 = it % 96, rest = it / 96, n = rest & 511, g = rest >> 9, t = n >> 4, c = n & 15;
                float v[8];
                if (k8 < 64) { const int s = k8 >> 1, c0 = (k8 & 1) * 8, tp = t - s + 31; const float* kp = KT + ((size_t)(((l * 16 + g) * 63 + tp) * 16 + c) * 16 + c0);
                    const f32x4 a = gld<f32x4>(kp), b = gld<f32x4>(kp + 4); v[0] = a[0]; v[1] = a[1]; v[2] = a[2]; v[3] = a[3]; v[4] = b[0]; v[5] = b[1]; v[6] = b[2]; v[7] = b[3]; }
                else { const int jj = (k8 - 64) * 8, d = jj >> 7, ri = (jj >> 6) & 1, p0 = jj & 63, e = d == 0 ? t + 1 : 32 - t, base = (l * 2 + d) * 16 + g;
                    const float* cre = CRE + ((size_t)base * 16 + c) * 64 + p0; const float* cim = CIM + ((size_t)base * 16 + c) * 64 + p0; const f32x2* ap = APOW + ((size_t)base * 33 + e) * 64 + p0;
#pragma unroll
                    for (int j = 0; j < 8; ++j) { const f32x2 a = ap[j]; const float cr = cre[j], ci = cim[j]; v[j] = ri == 0 ? cr * a.x - ci * a.y : -(cr * a.y + ci * a.x); } }
                u32x4 w; w.x = cvt_pk_bf16(v[0], v[1]); w.y = cvt_pk_bf16(v[2], v[3]); w.z = cvt_pk_bf16(v[4], v[5]); w.w = cvt_pk_bf16(v[6], v[7]);
                gst<u32x4>(S5KV + ((size_t)(g * 512 + n) * ATK + k8 * 8), w);
            }
            }
            if (!FUSE1) { bf16* H = WP(bf16, WS_H); const float* gn = IN(I_NMIX) + l * 1024;
              for (int grp = gw; grp < M / 4; grp += NGW) norm_rows4<false>(xcur, gn, H, grp * 4, lane, nullptr, nullptr, nullptr, nullptr, nullptr, nullptr); }
        }
        GRID_BAR();
        }

        for (int rep_ = 0; rep_ < NREP(3); ++rep_) {
        if (PH(3)) {
            WSL();
            pg8::Gemm g{WP(bf16, WS_H), WP(bf16, WS_WIN), 1024, 1024, 1024}; pg8::StaticOrder S; S.init(M / 256, INC / 256, G, bid);
            EpiProj E{WP(bf16, WS_QK), WP(bf16, WS_VT8), WP(bf16, WS_AT), WP(bf16, WS_QX), WP(bf16, WS_GATES), IN(I_BGATE) + l * 3072, FUSE1 ? WP(float, WS_SS) + (size_t)l * M * 16 : nullptr};
            pg8::gemm_phase<EpiProj, pg8::StaticOrder>(F.lds, g, S, E, tid);
        }
        GRID_BAR();
        }

        for (int rep_ = 0; rep_ < NREP(4); ++rep_) {
        if (PH(4)) {
            WSL();
            for (int bg = bid; bg < 64; bg += G) {
                { pg8::Gemm g{WP(bf16, WS_AT), WP(bf16, WS_S5W), ATK, 512, 512}; pg8::ListOrder S{bg, 1, 1}; EpiS5a E{WP(float, WS_ST)};
                  pg8::gemm_phase<EpiS5a, pg8::ListOrder>(F.lds, g, S, E, tid); }
                WG_MEM_SYNC();
                s5_scan_item(bg * 2, WP(float, WS_ST), WP(bf16, WS_AT), WP(f32x2, WS_APOW) + (size_t)l * 2 * 16 * 33 * 64, (LAS float*)F.lds, tid);
                s5_scan_item(bg * 2 + 1, WP(float, WS_ST), WP(bf16, WS_AT), WP(f32x2, WS_APOW) + (size_t)l * 2 * 16 * 33 * 64, (LAS float*)F.lds, tid);
                WG_MEM_SYNC();
                { pg8::Gemm g{WP(bf16, WS_AT), WP(bf16, WS_S5KV), ATK, ATK, ATK}; pg8::ListOrder S{bg, 2, 2}; EpiS5c E{WP(bf16, WS_Y)};
                  pg8::gemm_phase<EpiS5c, pg8::ListOrder>(F.lds, g, S, E, tid); }
            }
            unsigned* qhead = WP(unsigned, WS_CTL) + CW_Q + (l + 4 * rep_) * 64;
            volatile LAS int* qslot = (volatile LAS int*)(F.lds + MISC_OFF + 64);
            for (;;) {
                if (tid == 0) qslot[0] = (int)__hip_atomic_fetch_add((GASP unsigned*)qhead, 1u, __ATOMIC_RELAXED, __HIP_MEMORY_SCOPE_AGENT);
                __syncthreads();
                const int qi = __builtin_amdgcn_readfirstlane(qslot[0]);
                __syncthreads();
                if (qi >= 512) break;
                if (qi < 256) NA_ITEM(qi); else XA_ITEMS(qi - 256, qi - 255, 1);
            }
        }
        GRID_BAR();
        }

        for (int rep_ = 0; rep_ < NREP(7); ++rep_) {
        if (PH(7)) {
            WSL();
            pg8::Gemm g{WP(bf16, WS_Y), WP(bf16, WS_WGLU), 256, 256, 256}; pg8::StaticOrder S; S.init(M / 256, 2, G, bid); EpiGlu E{WP(bf16, WS_H)};
            pg8::gemm_phase<EpiGlu, pg8::StaticOrder>(F.lds, g, S, E, tid);
        }
        GRID_BAR();
        }

        for (int rep_ = 0; rep_ < NREP(8); ++rep_) {
        if (PH(8)) {
            WSL();
            pg8::Gemm g{WP(bf16, WS_H), WP(bf16, WS_WCAT), 1024, 1024, 1024}; pg8::StaticOrder S; S.init(M / 256, 4, G, bid); EpiMerge E{WP(unsigned char, WS_GATES), WP(bf16, WS_QK)};
            pg8::gemm_phase<EpiMerge, pg8::StaticOrder, false, true>(F.lds, g, S, E, tid);
        }
        GRID_BAR();
        }

        for (int rep_ = 0; rep_ < NREP(9); ++rep_) {
        if (PH(9)) {
            WSL();
            pg8::Gemm g{WP(bf16, WS_QK), WP(bf16, WS_WOUT), 1024, 1024, 1024}; pg8::StaticOrder S; S.init(M / 256, 4, G, bid); EpiRes E{xcur, rep_ ? WP(float, WS_GATES) : XO, WP(bf16, WS_H)};
            pg8::gemm_phase<EpiRes, pg8::StaticOrder>(F.lds, g, S, E, tid);
        }
        xcur = XO;
        GRID_BAR();
        }

        for (int rep_ = 0; rep_ < NREP(10); ++rep_) {
        if (PH(10)) {
            WSL();
            {
            unsigned* cnt = WP(unsigned, WS_CTL) + CW_CNT + (l + 4 * rep_) * NBUCKET * 64;
            const float* bco = IN(I_BCO) + l * 4; const float* bfi = IN(I_BFI) + l * 16;
            int* LIST = rep_ ? WP(int, WS_GATES + 100 * MiB) : WP(int, WS_LIST); float* WTS = rep_ ? WP(float, WS_GATES + 104 * MiB) : WP(float, WS_WTS);
            { const u32x4* src = (const u32x4*)(WP(bf16, WS_WRT) + (size_t)l * 2 * 20480);
              for (int idx = tid; idx < 40 * 128; idx += NWAVES * 64) *(LAS u32x4*)(F.lds + (idx >> 7) * RT_STRIDE + (idx & 127) * 16) = gld<u32x4>(src + idx); }
            __syncthreads();
            for (int grp = gw; grp < M / 16; grp += NGW) router_rows16(XO, grp * 16, lane, F.lds, wave, bco, bfi, cnt, LIST, WTS);
            __syncthreads();
            }
            bf16* WGU = WP(bf16, WS_WGU); bf16* WDP = WP(bf16, WS_WDP);
            for (int it = gw; it < 10240; it += NGW) {
                int r = it;
                if (r < 2048) { const int e = r >> 7; transpose_job_item(IN(I_WG) + (size_t)(l * 16 + e) * 1024 * 256, 256, 256, r & 127, WGU + (size_t)e * 512 * 1024, 1024, 0, 0, 2, 0, 0, IN(I_NFFN) + l * 1024, SCR(), lane); continue; } r -= 2048;
                if (r < 2048) { const int e = r >> 7; transpose_job_item(IN(I_WU) + (size_t)(l * 16 + e) * 1024 * 256, 256, 256, r & 127, WGU + (size_t)e * 512 * 1024, 1024, 0, 0, 2, 1, 0, IN(I_NFFN) + l * 1024, SCR(), lane); continue; } r -= 2048;
                const int ej = r >> 7, e = ej / 3, jj = ej % 3, i = e & 3, grpI = e >> 2, o = jj + (jj >= i ? 1 : 0), a = i < o ? i : o, b = i < o ? o : i;
                const int pair = grpI * 6 + (a == 0 ? b - 1 : (a == 1 ? b + 1 : 5)), slot = (i == a) ? 0 : 1;
                transpose_job_item(IN(I_WD) + (size_t)(l * 16 + e) * 256 * 1024, 1024, 1024, r & 127, WDP + (size_t)pair * 1024 * 512, 512, slot * 256, 0, 1, 0, 0, nullptr, SCR(), lane);
            }
        }
        GRID_BAR();
        }

        LAS int* tab = (LAS int*)(F.lds + TAB_OFF);
        for (int rep_ = 0; rep_ < NREP(11); ++rep_) {
        if (PH(11)) {
            WSL();
            unsigned* cnt = WP(unsigned, WS_CTL) + CW_CNT + l * NBUCKET * 64;
            if (tid == 0) { int st = 0;
                for (int b = 0; b < NBUCKET; ++b) { const int c = (int)__hip_atomic_load((GASP unsigned*)(cnt + b * 64), __ATOMIC_RELAXED, __HIP_MEMORY_SCOPE_AGENT); tab[b] = c; tab[32 + b] = st; st += (c + 255) >> 8; }
                tab[32 + NBUCKET] = st; tab[64] = st; }
            __syncthreads();
            pg8::Gemm g{WP(bf16, WS_H), WP(bf16, WS_WGU), 1024, 1024, 1024}; pg8::MoeOrder S{tab, WP(int, WS_LIST), G, bid, 0}; EpiMoe1 E{WP(bf16, WS_ACT), WP(float, WS_WTS)};
            pg8::gemm_phase<EpiMoe1, pg8::MoeOrder, true>(F.lds, g, S, E, tid);
        }
        GRID_BAR();
        }

        for (int rep_ = 0; rep_ < NREP(12); ++rep_) {
        if (PH(12)) {
            WSL();
            pg8::Gemm g{WP(bf16, WS_ACT), WP(bf16, WS_WDP), 512, 512, 512}; pg8::MoeOrder S{tab, WP(int, WS_LIST), G, bid, 1}; EpiMoe2 E{rep_ ? WP(float, WS_QK) : XO, WP(int, WS_LIST), nullptr, nullptr};
            pg8::gemm_phase<EpiMoe2, pg8::MoeOrder>(F.lds, g, S, E, tid);
        }
        GRID_BAR();
        }
    }
    { WSL(); (void)wsl; const float* gn = IN(I_FNORM);
      for (int row = gw; row < M; row += NGW) final_norm_row(XO, gn, row, lane); }
#undef GRID_BAR
}

extern "C" void kernel_launch(void* const* d_in, const int* in_sizes, int n_in, void* d_out, int out_size, void* d_ws, size_t ws_size, hipStream_t stream) {
    static int grid = 0;
    if (grid == 0) {
        if (n_in != 30 || out_size != M * D || ws_size < WS_END) { fprintf(stderr, "kernel_launch: unexpected shapes (n_in %d, out %d, ws %zu)\n", n_in, out_size, ws_size); grid = -1; return; }
        int dev = 0, cus = 0, per_cu = 0;
        if (hipGetDevice(&dev) != hipSuccess || hipDeviceGetAttribute(&cus, hipDeviceAttributeMultiprocessorCount, dev) != hipSuccess) { grid = -1; return; }
        if (hipFuncSetAttribute((const void*)fwd_kernel, hipFuncAttributeMaxDynamicSharedMemorySize, LDS_BYTES) != hipSuccess) { fprintf(stderr, "kernel_launch: hipFuncSetAttribute failed\n"); grid = -1; return; }
        if (hipOccupancyMaxActiveBlocksPerMultiprocessor(&per_cu, (const void*)fwd_kernel, NWAVES * 64, LDS_BYTES) != hipSuccess || per_cu < 1) { fprintf(stderr, "kernel_launch: occupancy query reports %d\n", per_cu); }
        (void)hipGetLastError();
        grid = cus;
    }
    if (grid < 0) return;
    (void)in_sizes;
    (void)hipMemsetAsync((char*)d_ws + WS_CTL, 0, CTL_BYTES, stream);
    Args a{};
    for (int i = 0; i < 30; ++i) a.in[i] = (const float*)d_in[i];
    a.out = (float*)d_out; a.ws = (unsigned char*)d_ws;
    hipLaunchKernelGGL(fwd_kernel, dim3(grid), dim3(NWAVES * 64), LDS_BYTES, stream, a);
}
```

```cpp
#include <hip/hip_runtime.h>
#include <cstdio>
#include <cstdint>

#define LAS __attribute__((address_space(3)))
typedef unsigned short bf16;
typedef short bf16x8 __attribute__((ext_vector_type(8)));
typedef float f32x4 __attribute__((ext_vector_type(4)));
typedef float f32x2 __attribute__((ext_vector_type(2)));
typedef unsigned u32x4 __attribute__((ext_vector_type(4)));
typedef unsigned u32x2 __attribute__((ext_vector_type(2)));

constexpr int D = 1024, BATCH = 4, SEQ = 8192, M = BATCH * SEQ, DEPTH = 4;
constexpr int INC = 5120, NMEM = 256;
constexpr int NCHUNK = 256, TCH = 32;
constexpr int ATK = 768;
constexpr int LCAP = 32768;
constexpr int NBUCKET = 24;
constexpr float RMS_EPS = 1e-6f;

constexpr size_t MiB = 1u << 20;
constexpr size_t WS_CTL = 0, CTL_BYTES = 1 * MiB;
constexpr size_t WS_APOW = 1 * MiB;
constexpr size_t WS_BBAR = 4 * MiB;
constexpr size_t WS_KT = 5 * MiB;
constexpr size_t WS_WRT = 10 * MiB;
constexpr size_t WS_RPBP = 10 * MiB + 512 * 1024;
constexpr size_t WS_MEMN = 11 * MiB;
constexpr size_t WS_WMKV = 19 * MiB;
constexpr size_t WS_KM = 23 * MiB;
constexpr size_t WS_VM8 = 25 * MiB;
constexpr size_t WS_WIN = 27 * MiB;
constexpr size_t WS_WCAT = 37 * MiB;
constexpr size_t WS_WOUT = 39 * MiB;
constexpr size_t WS_WGLU = 41 * MiB;
constexpr size_t WS_S5W = 42 * MiB;
constexpr size_t WS_S5KV = 46 * MiB;
constexpr size_t WS_H = 58 * MiB;
constexpr size_t WS_QK = 122 * MiB;
constexpr size_t WS_VT8 = 186 * MiB;
constexpr size_t WS_AT = 218 * MiB;
constexpr size_t WS_QX = 242 * MiB;
constexpr size_t WS_ST = 258 * MiB;
constexpr size_t WS_Y = 274 * MiB;
constexpr size_t WS_GATES = 290 * MiB;
constexpr size_t WS_WGU = WS_GATES;
constexpr size_t WS_WDP = WS_GATES + 16 * MiB;
constexpr size_t WS_ACT = WS_GATES + 40 * MiB;
constexpr size_t WS_LIST = 482 * MiB;
constexpr size_t WS_WTS = 485 * MiB;
constexpr size_t WS_SS = 497 * MiB;
constexpr size_t WS_END = 505 * MiB;
constexpr int CW_BAR = 4096;
constexpr int CW_CNT = 16384;
constexpr int CW_Q = 32768;

__device__ __forceinline__ unsigned cvt_pk_bf16(float lo, float hi) { unsigned r; asm volatile("v_cvt_pk_bf16_f32 %0, %1, %2" : "=v"(r) : "v"(lo), "v"(hi)); return r; }
__device__ __forceinline__ float bf2f(unsigned short b) { return __uint_as_float(((unsigned)b) << 16); }
__device__ __forceinline__ float bflo(unsigned w) { return __uint_as_float(w << 16); }
__device__ __forceinline__ float bfhi(unsigned w) { return __uint_as_float(w & 0xffff0000u); }
__device__ __forceinline__ float fast_rcp(float x) { return __builtin_amdgcn_rcpf(x); }
__device__ __forceinline__ float fast_exp(float x) { return __builtin_amdgcn_exp2f(x * 1.4426950408889634f); }
__device__ __forceinline__ float sigmoid_f(float x) { return fast_rcp(1.0f + fast_exp(-x)); }
__device__ __forceinline__ float gelu_tanh_f(float x) { const float u = 1.5957691216057308f * (x + 0.044715f * x * x * x); return x * fast_rcp(1.0f + fast_exp(-u)); }
__device__ __forceinline__ float shfl_xor_f(float v, int o, int lane) { return __int_as_float(__builtin_amdgcn_ds_bpermute((lane ^ o) << 2, __float_as_int(v))); }
__device__ __forceinline__ float shfl_idx_f(float v, int src) { return __int_as_float(__builtin_amdgcn_ds_bpermute(src << 2, __float_as_int(v))); }
__device__ __forceinline__ float wave_sum(float v, int lane) {
#pragma unroll
    for (int o = 1; o < 64; o <<= 1) v += shfl_xor_f(v, o, lane);
    return v;
}
#define GASP __attribute__((address_space(1)))
template <class T> __device__ __forceinline__ T gld(const void* p) { return *(const GASP T*)p; }
template <class T> __device__ __forceinline__ void gst(void* p, const T& v) { *(GASP T*)p = v; }
__device__ __forceinline__ unsigned q8(float g) { return (unsigned)__builtin_fminf(__builtin_fmaxf(__builtin_rintf(g * 255.0f), 1.0f), 255.0f); }
__device__ __forceinline__ unsigned q8x4(float a, float b, float c, float d) { return q8(a) | (q8(b) << 8) | (q8(c) << 16) | (q8(d) << 24); }
#define LDS_WAIT() asm volatile("s_waitcnt lgkmcnt(0)" ::: "memory")
#define VM_WAIT() asm volatile("s_waitcnt vmcnt(0)" ::: "memory")

namespace pg8 {
constexpr int BM = 256, BK = 64, HALF = 128, HTB = HALF * BK * 2, STAGE_BYTES = 8 * HTB, NXCD = 8, WGM = 8;
__host__ __device__ __forceinline__ int lds_byte(int r, int c) { const int st = (r >> 4) * 2 + (c >> 5), rr = r & 15, cc = c & 31, ob = rr * 64 + cc * 2; return st * 1024 + (ob ^ (((ob >> 9) & 1) << 5)); }
__host__ __device__ __forceinline__ void stage_rc(int b, int& R, int& C) { const int st = b / 1024, sb = b % 1024, swz = sb ^ (((sb >> 9) & 1) << 5); R = (st >> 1) * 16 + swz / 64; C = (st & 1) * 32 + (swz % 64) / 2; }
__host__ __device__ __forceinline__ int perm32(int rho) { const int n = rho >> 4, i = rho & 15; return 8 * (i >> 2) + 4 * n + (i & 3); }

struct Unit { int pm, pn, am, bn, x0, x1, x2; };
struct Gemm { const bf16* A; const bf16* Bt; int lda, ldb, K; };

struct StaticOrder {
    int nM, nN, nwg, G, c;
    __device__ void init(int nM_, int nN_, int G_, int c_) { nM = nM_; nN = nN_; nwg = nM * nN; G = G_; c = c_; }
    __device__ bool next(int i, Unit& u) const {
        const long L = (long)i * G + c; if (L >= nwg) return false;
        int wgid = (int)L; { const int q = nwg / NXCD, r = nwg % NXCD, xcd = wgid % NXCD, off = wgid / NXCD; wgid = (xcd < r ? xcd * (q + 1) : r * (q + 1) + (xcd - r) * q) + off; }
        const int nig = WGM * nN, gid = wgid / nig, fm = gid * WGM, gsz = (nM - fm) < WGM ? (nM - fm) : WGM;
        u.pm = __builtin_amdgcn_readfirstlane(fm + ((wgid % nig) % gsz)); u.pn = __builtin_amdgcn_readfirstlane((wgid % nig) / gsz);
        u.am = u.pm; u.bn = u.pn; u.x0 = 0; u.x1 = 0; u.x2 = 0; return true;
    }
    __device__ __forceinline__ int a_row(const Unit&, int) const { return 0; }
};
struct S5Order : StaticOrder {
    __device__ bool next(int i, Unit& u) const { if (!StaticOrder::next(i, u)) return false; u.bn = (u.pm & 15) * nN + u.pn; return true; }
};
struct ListOrder {
    int pm, n, nN;
    __device__ bool next(int i, Unit& u) const { if (i >= n) return false; u.pm = pm; u.pn = i; u.am = pm; u.bn = (pm & 15) * nN + i; u.x0 = 0; u.x1 = 0; u.x2 = 0; return true; }
    __device__ __forceinline__ int a_row(const Unit&, int) const { return 0; }
};
struct MemOrder {
    int G, c;
    __device__ bool next(int i, Unit& u) const { const int L = i * G + c; if (L >= 32) return false; u.pm = L >> 1; u.pn = L & 1; u.am = u.pm; u.bn = (u.pm >> 2) * 2 + u.pn; u.x0 = 0; u.x1 = 0; u.x2 = 0; return true; }
    __device__ __forceinline__ int a_row(const Unit&, int) const { return 0; }
};
struct MoeOrder {
    const LAS int* tab; const int* list; int G, c, mode;
    __device__ bool next(int i, Unit& u) const {
        const int T = __builtin_amdgcn_readfirstlane(tab[64]); const int L = i * G + c; if (L >= T * 4) return false;
        const int tile = L >> 2, pn = L & 3; int b = 0;
#pragma unroll 1
        for (int j = 1; j < NBUCKET; ++j) if (__builtin_amdgcn_readfirstlane(tab[32 + j]) <= tile) b = j;
        u.pm = tile; u.pn = pn; u.am = tile; u.x0 = b; u.x1 = (tile - __builtin_amdgcn_readfirstlane(tab[32 + b])) * 256; u.x2 = __builtin_amdgcn_readfirstlane(tab[b]);
        const int grp = __builtin_amdgcn_readfirstlane(b / 6), pi = __builtin_amdgcn_readfirstlane(b % 6); const int ea = pi < 3 ? 0 : (pi < 5 ? 1 : 2), eb = pi < 3 ? pi + 1 : (pi < 5 ? pi - 1 : 3);
        if (mode == 0) { const int e = grp * 4 + ((pn >> 1) ? eb : ea); u.bn = e * 2 + (pn & 1); } else u.bn = b * 4 + pn;
        return true;
    }
    __device__ __forceinline__ int a_row(const Unit& u, int r) const { const int slot = u.x1 + r; return slot < u.x2 ? gld<int>(list + (unsigned)(u.x0 * LCAP + slot)) : 0; }
};

template <class Epi, class Sched, bool GATHER = false, bool KHOOK = false>
__device__ __forceinline__ void gemm_phase(LAS unsigned char* lds, const Gemm g, const Sched& S, const Epi& E, int tid_in) {
    int tid = tid_in; asm volatile("" : "+v"(tid));
    const int wid = __builtin_amdgcn_readfirstlane(tid >> 6), lane = tid & 63, wr = wid >> 2, wc = wid & 3, fr = lane & 15, fq = lane >> 4;
    int K = g.K, lda = g.lda, ldb = g.ldb;
    asm volatile("" : "+s"(K), "+s"(lda), "+s"(ldb));
    const int nt = K / BK;
    unsigned voffA[2], voffB[2]; int Rr[2], Cc[2];
#pragma unroll
    for (int i = 0; i < 2; ++i) { int R, C; stage_rc(tid * 16 + i * 8192, R, C); const int Rb = Epi::PERM ? ((R & ~31) + perm32(R & 31)) : R;
        voffA[i] = (unsigned)(R * lda + C) * 2u; voffB[i] = (unsigned)(Rb * ldb + C) * 2u; Rr[i] = R; Cc[i] = C; }
    const unsigned kstep = (unsigned)(BK * 2);
    const unsigned hstepA = (unsigned)(HALF * lda * 2), tstepA = 2u * hstepA, hstepB = (unsigned)(HALF * ldb * 2), tstepB = 2u * hstepB;
    const unsigned ldsw = (unsigned)wid * 1024u;
    const int aoff = lds_byte(wr * 64 + fr, fq * 8), boff = lds_byte(wc * 32 + fr, fq * 8);
    unsigned vC[2][2] = {{0u, 0u}, {0u, 0u}}, vN[2][2] = {{0u, 0u}, {0u, 0u}};
#define PG8_SA(b, h) (((b) * 2 + (h)) * HTB)
#define PG8_SB(b, h) ((4 + (b) * 2 + (h)) * HTB)
#define PG8_STAGE(bufoff, gbase, voff) do { _Pragma("unroll") for (int _i = 0; _i < 2; ++_i) \
        __builtin_amdgcn_global_load_lds((const unsigned*)((const char*)(gbase) + (voff)[_i]), (LAS unsigned*)(lds + (bufoff) + ldsw + _i * 8192), 16, 0, 0); } while (0)
#define PG8_STA(bufoff, ptr, h, nx) do { if constexpr (GATHER) { unsigned _v[2]; _v[0] = (nx) ? vN[h][0] : vC[h][0]; _v[1] = (nx) ? vN[h][1] : vC[h][1]; PG8_STAGE(bufoff, ptr, _v); } \
        else { PG8_STAGE(bufoff, (ptr) + (h) * hstepA, voffA); } } while (0)
#define PG8_STB(bufoff, ptr, h) PG8_STAGE(bufoff, (ptr) + (h) * hstepB, voffB)
#define PG8_LDA(dst, b, h) do { _Pragma("unroll") for (int m = 0; m < 4; ++m) _Pragma("unroll") for (int k = 0; k < 2; ++k) dst[m][k] = *(const LAS bf16x8*)(lds + PG8_SA(b, h) + aoff + m * 2048 + k * 1024); } while (0)
#define PG8_LDB(dst, b, h) do { _Pragma("unroll") for (int n = 0; n < 2; ++n) _Pragma("unroll") for (int k = 0; k < 2; ++k) dst[n][k] = *(const LAS bf16x8*)(lds + PG8_SB(b, h) + boff + n * 2048 + k * 1024); } while (0)
#define PG8_MMA(ai, bj, At, Bt) do { __builtin_amdgcn_s_setprio(1); _Pragma("unroll") for (int m = 0; m < 4; ++m) _Pragma("unroll") for (int n = 0; n < 2; ++n) _Pragma("unroll") for (int k = 0; k < 2; ++k) \
        acc[ai][bj][m][n] = __builtin_amdgcn_mfma_f32_16x16x32_bf16(Bt[n][k], At[m][k], acc[ai][bj][m][n], 0, 0, 0); __builtin_amdgcn_s_setprio(0); } while (0)
#define PG8_WAIT_V(n) asm volatile("s_waitcnt vmcnt(" #n ")" ::: "memory")
#define PG8_WAIT_L(n) asm volatile("s_waitcnt lgkmcnt(" #n ")" ::: "memory")
#define PG8_BAR __builtin_amdgcn_s_barrier()
#define PG8_SCHED __builtin_amdgcn_sched_barrier(0)
    Unit cur, nxt; int ui = 0;
    if (!S.next(0, cur)) return;
    f32x4 acc[2][2][4][2];
#pragma unroll
    for (int a = 0; a < 2; ++a)
#pragma unroll
        for (int b = 0; b < 2; ++b)
#pragma unroll
            for (int m = 0; m < 4; ++m)
#pragma unroll
                for (int n = 0; n < 2; ++n) acc[a][b][m][n] = (f32x4){0.f, 0.f, 0.f, 0.f};
    bf16x8 At[4][2], B0[2][2], B1[2][2];
    const char* cA = GATHER ? (const char*)g.A : (const char*)g.A + (unsigned)cur.am * tstepA;
    const char* cB = (const char*)g.Bt + (unsigned)cur.bn * tstepB;
    if constexpr (GATHER) {
#pragma unroll
        for (int h = 0; h < 2; ++h)
#pragma unroll
            for (int i = 0; i < 2; ++i) vC[h][i] = (unsigned)(S.a_row(cur, h * HALF + Rr[i]) * lda + Cc[i]) * 2u;
    }
    PG8_STB(PG8_SB(0, 0), cB, 0); PG8_STB(PG8_SB(0, 1), cB, 1); PG8_STA(PG8_SA(0, 0), cA, 0, false); PG8_STA(PG8_SA(0, 1), cA, 1, false);
    if (wr == 1) PG8_BAR;
    PG8_WAIT_V(2); PG8_BAR;
    PG8_STB(PG8_SB(1, 0), cB + kstep, 0); PG8_STA(PG8_SA(1, 0), cA + kstep, 0, false); PG8_STB(PG8_SB(1, 1), cB + kstep, 1);
    PG8_WAIT_V(6); PG8_BAR;
    for (;;) {
        const bool has_next = S.next(ui + 1, nxt);
        const char* nA = GATHER ? (const char*)g.A : (has_next ? (const char*)g.A + (unsigned)nxt.am * tstepA : cA);
        const char* nB = has_next ? (const char*)g.Bt + (unsigned)nxt.bn * tstepB : cB;
        if constexpr (GATHER) {
#pragma unroll
            for (int h = 0; h < 2; ++h)
#pragma unroll
                for (int i = 0; i < 2; ++i) vN[h][i] = has_next ? (unsigned)(S.a_row(nxt, h * HALF + Rr[i]) * lda + Cc[i]) * 2u : vC[h][i];
        }
        int tb = 0;
#pragma unroll 1
        for (int seg = 0; seg < (KHOOK ? 3 : 1); ++seg) {
        const int te = KHOOK ? (seg == 0 ? 8 : (seg == 1 ? 12 : nt)) : nt;
        for (int t = tb; t < te; t += 2) {
            const bool last = (t == nt - 2);
            const char* a1 = cA + (unsigned)(t + 1) * kstep;
            const char* a2 = last ? nA : cA + (unsigned)(t + 2) * kstep; const char* b2 = last ? nB : cB + (unsigned)(t + 2) * kstep;
            const char* a3 = a2 + kstep; const char* b3 = b2 + kstep;
            PG8_LDB(B0, 0, 0); PG8_LDB(B1, 0, 1); PG8_SCHED; PG8_LDA(At, 0, 0); PG8_STA(PG8_SA(1, 1), a1, 1, false);
            PG8_WAIT_V(8); PG8_WAIT_L(0); PG8_BAR; PG8_MMA(0, 0, At, B0); PG8_MMA(0, 1, At, B1); PG8_BAR; PG8_SCHED;
            PG8_LDA(At, 0, 1); PG8_STB(PG8_SB(0, 0), b2, 0); PG8_STB(PG8_SB(0, 1), b2, 1); PG8_STA(PG8_SA(0, 0), a2, 0, last);
            PG8_WAIT_V(8); PG8_WAIT_L(0); PG8_BAR; PG8_MMA(1, 0, At, B0); PG8_MMA(1, 1, At, B1); PG8_BAR; PG8_SCHED;
            PG8_LDB(B0, 1, 0); PG8_LDB(B1, 1, 1); PG8_SCHED; PG8_LDA(At, 1, 0); PG8_STA(PG8_SA(0, 1), a2, 1, last);
            PG8_WAIT_V(8); PG8_WAIT_L(0); PG8_BAR; PG8_MMA(0, 0, At, B0); PG8_MMA(0, 1, At, B1); PG8_BAR; PG8_SCHED;
            PG8_LDA(At, 1, 1); PG8_STB(PG8_SB(1, 0), b3, 0); PG8_STB(PG8_SB(1, 1), b3, 1); PG8_STA(PG8_SA(1, 0), a3, 0, last);
            PG8_WAIT_V(8); PG8_WAIT_L(0); PG8_BAR; PG8_MMA(1, 0, At, B0); PG8_MMA(1, 1, At, B1); PG8_BAR; PG8_SCHED;
        }
        if constexpr (KHOOK) { if (seg < 2) { unsigned mm_ = ~0u; asm volatile("" : "+s"(mm_)); const int ln_ = (int)__builtin_amdgcn_mbcnt_hi(mm_, __builtin_amdgcn_mbcnt_lo(mm_, 0u)); E.khook(acc, cur, te, wr, wc, ln_ & 15, ln_ >> 4); } }
        tb = te;
        }
        if (wr == 0) PG8_BAR;
        { unsigned mm_ = ~0u; asm volatile("" : "+s"(mm_)); const int ln_ = (int)__builtin_amdgcn_mbcnt_hi(mm_, __builtin_amdgcn_mbcnt_lo(mm_, 0u)); E(acc, cur, wr, wc, ln_ & 15, ln_ >> 4); }
        if (!has_next) break;
#pragma unroll
        for (int a = 0; a < 2; ++a)
#pragma unroll
            for (int b = 0; b < 2; ++b)
#pragma unroll
                for (int m = 0; m < 4; ++m)
#pragma unroll
                    for (int n = 0; n < 2; ++n) acc[a][b][m][n] = (f32x4){0.f, 0.f, 0.f, 0.f};
        cur = nxt; cA = nA; cB = nB; ++ui;
        if constexpr (GATHER) {
#pragma unroll
            for (int h = 0; h < 2; ++h)
#pragma unroll
                for (int i = 0; i < 2; ++i) vC[h][i] = vN[h][i];
        }
        if (wr == 1) PG8_BAR;
    }
    PG8_WAIT_V(0);
    PG8_BAR;
#undef PG8_SA
#undef PG8_SB
#undef PG8_STAGE
#undef PG8_STA
#undef PG8_STB
#undef PG8_LDA
#undef PG8_LDB
#undef PG8_MMA
#undef PG8_WAIT_V
#undef PG8_WAIT_L
#undef PG8_BAR
#undef PG8_SCHED
}
}

using pg8::Unit;
struct EpiProj {
    static constexpr bool PERM = true;
    bf16 *QK, *Vt8, *At, *QX, *GATES; const float* bgate; const float* ssq;
#define EP_LOOP_BEGIN _Pragma("unroll") for (int ai = 0; ai < 2; ++ai) _Pragma("unroll") for (int m = 0; m < 4; ++m) { const int row = row0 + ai * 128 + m * 16; const float rs = rstd[ai][m]; _Pragma("unroll") for (int bj = 0; bj < 2; ++bj) { \
        const f32x4 v0 = acc[ai][bj][m][0] * rs, v1 = acc[ai][bj][m][1] * rs; const int cl = cl0 + bj * 128;
#define EP_LOOP_END } asm volatile("" ::: "memory"); }
    __device__ __forceinline__ void operator()(const f32x4 (&acc)[2][2][4][2], const Unit& u, int wr, int wc, int fr, int fq) const {
        const int pn = u.pn, row0 = u.pm * 256 + wr * 64 + fr, cl0 = wc * 32 + 8 * fq;
        float rstd[2][4];
#pragma unroll
        for (int ai = 0; ai < 2; ++ai)
#pragma unroll
            for (int m = 0; m < 4; ++m) { if (!ssq) { rstd[ai][m] = -1.f; continue; } const float* sp = ssq + (unsigned)((row0 + ai * 128 + m * 16) * 16); const f32x4 a = gld<f32x4>(sp), b = gld<f32x4>(sp + 4), c = gld<f32x4>(sp + 8), d = gld<f32x4>(sp + 12);
                rstd[ai][m] = (((a[0] + a[1]) + (a[2] + a[3])) + ((b[0] + b[1]) + (b[2] + b[3]))) + (((c[0] + c[1]) + (c[2] + c[3])) + ((d[0] + d[1]) + (d[2] + d[3]))); }
#pragma unroll
        for (int ai = 0; ai < 2; ++ai)
#pragma unroll
            for (int m = 0; m < 4; ++m) rstd[ai][m] = rstd[ai][m] < 0.f ? 1.0f : 1.0f / sqrtf(rstd[ai][m] * (1.0f / 1024.0f) + RMS_EPS);
        if (pn < 4) {
            EP_LOOP_BEGIN
                u32x4 w; w.x = cvt_pk_bf16(v0[0], v0[1]); w.y = cvt_pk_bf16(v0[2], v0[3]); w.z = cvt_pk_bf16(v1[0], v1[1]); w.w = cvt_pk_bf16(v1[2], v1[3]);
                gst<u32x4>(QK + (unsigned)row * 1024 + pn * 256 + cl, w);
            EP_LOOP_END
        } else if (pn < 6) {
            EP_LOOP_BEGIN
                const int vc = (pn - 4) * 256 + cl, hh = vc >> 6, dh = vc & 63, b = row >> 13, s = row & 8191;
                bf16* p = Vt8 + ((unsigned)((b * 8 + hh) * 1024 + (s >> 3)) * 64 + dh) * 8 + (s & 7);
                const unsigned w0 = cvt_pk_bf16(v0[0], v0[1]), w1 = cvt_pk_bf16(v0[2], v0[3]), w2 = cvt_pk_bf16(v1[0], v1[1]), w3 = cvt_pk_bf16(v1[2], v1[3]);
                gst<bf16>(p, (bf16)w0); gst<bf16>(p + 8, (bf16)(w0 >> 16)); gst<bf16>(p + 16, (bf16)w1); gst<bf16>(p + 24, (bf16)(w1 >> 16)); gst<bf16>(p + 32, (bf16)w2); gst<bf16>(p + 40, (bf16)(w2 >> 16)); gst<bf16>(p + 48, (bf16)w3); gst<bf16>(p + 56, (bf16)(w3 >> 16));
            EP_LOOP_END
        } else if (pn == 6) {
            EP_LOOP_BEGIN
                const int g = cl >> 4, c0 = cl & 15, b = row >> 13, s = row & 8191;
                u32x4 w; w.x = cvt_pk_bf16(v0[0], v0[1]); w.y = cvt_pk_bf16(v0[2], v0[3]); w.z = cvt_pk_bf16(v1[0], v1[1]); w.w = cvt_pk_bf16(v1[2], v1[3]);
                gst<u32x4>(At + ((unsigned)((b * 16 + g) * 256 + (s >> 5))) * ATK + (s & 31) * 16 + c0, w);
            EP_LOOP_END
        } else if (pn == 7) {
            EP_LOOP_BEGIN
                u32x4 w; w.x = cvt_pk_bf16(v0[0], v0[1]); w.y = cvt_pk_bf16(v0[2], v0[3]); w.z = cvt_pk_bf16(v1[0], v1[1]); w.w = cvt_pk_bf16(v1[2], v1[3]);
                gst<u32x4>(QX + (unsigned)row * 256 + cl, w);
            EP_LOOP_END
        } else {
            EP_LOOP_BEGIN
                const int gc = (pn - 8) * 256 + cl;
                const f32x4 b0 = gld<f32x4>(bgate + gc), b1 = gld<f32x4>(bgate + gc + 4);
                u32x2 w; w.x = q8x4(sigmoid_f(v0[0] + b0[0]), sigmoid_f(v0[1] + b0[1]), sigmoid_f(v0[2] + b0[2]), sigmoid_f(v0[3] + b0[3]));
                w.y = q8x4(sigmoid_f(v1[0] + b1[0]), sigmoid_f(v1[1] + b1[1]), sigmoid_f(v1[2] + b1[2]), sigmoid_f(v1[3] + b1[3]));
                gst<u32x2>((unsigned char*)GATES + (unsigned)row * 3072 + gc, w);
            EP_LOOP_END
        }
    }
#undef EP_LOOP_BEGIN
#undef EP_LOOP_END
};
struct EpiMemKV {
    static constexpr bool PERM = true;
    bf16 *Km, *Vm8;
    __device__ __forceinline__ void operator()(const f32x4 (&acc)[2][2][4][2], const Unit& u, int wr, int wc, int fr, int fq) const {
        const int row0 = u.pm * 256 + wr * 64 + fr, cl0 = wc * 32 + 8 * fq;
#pragma unroll
        for (int ai = 0; ai < 2; ++ai)
#pragma unroll
            for (int m = 0; m < 4; ++m) {
                const int row = row0 + ai * 128 + m * 16;
#pragma unroll
                for (int bj = 0; bj < 2; ++bj) {
                    const f32x4 v0 = acc[ai][bj][m][0], v1 = acc[ai][bj][m][1];
                    const int cl = cl0 + bj * 128;
                    const unsigned w0 = cvt_pk_bf16(v0[0], v0[1]), w1 = cvt_pk_bf16(v0[2], v0[3]), w2 = cvt_pk_bf16(v1[0], v1[1]), w3 = cvt_pk_bf16(v1[2], v1[3]);
                    if (u.pn == 0) { u32x4 w; w.x = w0; w.y = w1; w.z = w2; w.w = w3; gst<u32x4>(Km + (unsigned)row * 256 + cl, w); }
                    else {
                        const int hh = cl >> 6, dh = cl & 63, lb = row >> 8, mm = row & 255;
                        bf16* p = Vm8 + ((unsigned)((lb * 4 + hh) * 32 + (mm >> 3)) * 64 + dh) * 8 + (mm & 7);
                        gst<bf16>(p, (bf16)w0); gst<bf16>(p + 8, (bf16)(w0 >> 16)); gst<bf16>(p + 16, (bf16)w1); gst<bf16>(p + 24, (bf16)(w1 >> 16)); gst<bf16>(p + 32, (bf16)w2); gst<bf16>(p + 40, (bf16)(w2 >> 16)); gst<bf16>(p + 48, (bf16)w3); gst<bf16>(p + 56, (bf16)(w3 >> 16));
                    }
                }
                asm volatile("" ::: "memory");
            }
    }
};
struct EpiS5a {
    static constexpr bool PERM = false;
    float* ST;
    __device__ __forceinline__ void operator()(const f32x4 (&acc)[2][2][4][2], const Unit& u, int wr, int wc, int fr, int fq) const {
        const int row0 = u.am * 256 + wr * 64 + fr, col0 = wc * 32 + 4 * fq;
#pragma unroll
        for (int ai = 0; ai < 2; ++ai)
#pragma unroll
            for (int m = 0; m < 4; ++m) { float* rowp = ST + (unsigned)(row0 + ai * 128 + m * 16) * 256 + col0;
#pragma unroll
                for (int bj = 0; bj < 2; ++bj)
#pragma unroll
                    for (int n = 0; n < 2; ++n) gst<f32x4>(rowp + bj * 128 + n * 16, acc[ai][bj][m][n]);
                asm volatile("" ::: "memory"); }
    }
};
struct EpiS5c {
    static constexpr bool PERM = true;
    bf16* Y;
    __device__ __forceinline__ void operator()(const f32x4 (&acc)[2][2][4][2], const Unit& u, int wr, int wc, int fr, int fq) const {
        const int b = u.am >> 4, g = u.am & 15, r0 = wr * 64 + fr, cl0 = u.pn * 256 + wc * 32 + 8 * fq;
#pragma unroll
        for (int ai = 0; ai < 2; ++ai)
#pragma unroll
            for (int m = 0; m < 4; ++m) {
                const int chunk = r0 + ai * 128 + m * 16;
#pragma unroll
                for (int bj = 0; bj < 2; ++bj) {
                    const f32x4 v0 = acc[ai][bj][m][0], v1 = acc[ai][bj][m][1];
                    const int col = cl0 + bj * 128, t = col >> 4, c0 = col & 15;
                    u32x4 w; w.x = cvt_pk_bf16(gelu_tanh_f(v0[0]), gelu_tanh_f(v0[1])); w.y = cvt_pk_bf16(gelu_tanh_f(v0[2]), gelu_tanh_f(v0[3]));
                    w.z = cvt_pk_bf16(gelu_tanh_f(v1[0]), gelu_tanh_f(v1[1])); w.w = cvt_pk_bf16(gelu_tanh_f(v1[2]), gelu_tanh_f(v1[3]));
                    gst<u32x4>(Y + (unsigned)(b * SEQ + chunk * 32 + t) * 256 + g * 16 + c0, w);
                }
                asm volatile("" ::: "memory");
            }
    }
};
struct EpiGlu {
    static constexpr bool PERM = true;
    bf16* CAT;
    __device__ __forceinline__ void operator()(const f32x4 (&acc)[2][2][4][2], const Unit& u, int wr, int wc, int fr, int fq) const {
        const int row0 = u.pm * 256 + wr * 64 + fr, cl0 = u.pn * 256 + wc * 32 + 8 * fq;
#pragma unroll
        for (int ai = 0; ai < 2; ++ai)
#pragma unroll
            for (int m = 0; m < 4; ++m) {
                const int row = row0 + ai * 128 + m * 16;
#pragma unroll
                for (int bj = 0; bj < 2; ++bj) {
                    const f32x4 v0 = acc[ai][bj][m][0], v1 = acc[ai][bj][m][1];
                    const int col = cl0 + bj * 128;
                    u32x2 w; w.x = cvt_pk_bf16(v0[0] * sigmoid_f(v0[1]), v0[2] * sigmoid_f(v0[3])); w.y = cvt_pk_bf16(v1[0] * sigmoid_f(v1[1]), v1[2] * sigmoid_f(v1[3]));
                    gst<u32x2>(CAT + (unsigned)row * 1024 + 512 + (col >> 1), w);
                }
                asm volatile("" ::: "memory");
            }
    }
};
struct EpiMerge {
    static constexpr bool PERM = true;
    const unsigned char* GATES; bf16* MG;
    static __device__ __forceinline__ float ub(unsigned w, int i) { return (float)((w >> (8 * i)) & 0xffu); }
    __device__ __forceinline__ void khook(f32x4 (&acc)[2][2][4][2], const Unit& u, int t, int wr, int wc, int fr, int fq) const {
        const int row0 = u.pm * 256 + wr * 64 + fr, cl0 = u.pn * 256 + wc * 32 + 8 * fq;
        const int ga = (t == 8) ? 0 : 1024;
#pragma unroll
        for (int ai = 0; ai < 2; ++ai) {
            u32x2 na[4][2], nb[4][2];
#pragma unroll
            for (int m = 0; m < 4; ++m)
#pragma unroll
                for (int bj = 0; bj < 2; ++bj) { const unsigned char* gp = GATES + (unsigned)((row0 + ai * 128 + m * 16) * 3072 + ga + cl0 + bj * 128); na[m][bj] = gld<u32x2>(gp); nb[m][bj] = gld<u32x2>(gp + 1024); }
#pragma unroll
            for (int m = 0; m < 4; ++m)
#pragma unroll
                for (int bj = 0; bj < 2; ++bj) {
                    const u32x2 a = na[m][bj], b = nb[m][bj];
                    f32x4 r0, r1;
#pragma unroll
                    for (int i = 0; i < 4; ++i) { r0[i] = ub(a.x, i) * fast_rcp(ub(b.x, i)); r1[i] = ub(a.y, i) * fast_rcp(ub(b.y, i)); }
                    acc[ai][bj][m][0] *= r0; acc[ai][bj][m][1] *= r1;
                }
            asm volatile("" ::: "memory");
        }
    }
    __device__ __forceinline__ void operator()(const f32x4 (&acc)[2][2][4][2], const Unit& u, int wr, int wc, int fr, int fq) const {
        const int row0 = u.pm * 256 + wr * 64 + fr, cl0 = u.pn * 256 + wc * 32 + 8 * fq;
#pragma unroll
        for (int ai = 0; ai < 2; ++ai) {
            u32x2 g2[4][2];
#pragma unroll
            for (int m = 0; m < 4; ++m)
#pragma unroll
                for (int bj = 0; bj < 2; ++bj) g2[m][bj] = gld<u32x2>(GATES + (unsigned)((row0 + ai * 128 + m * 16) * 3072 + 2048 + cl0 + bj * 128));
#pragma unroll
            for (int m = 0; m < 4; ++m)
#pragma unroll
                for (int bj = 0; bj < 2; ++bj) {
                    const u32x2 g = g2[m][bj]; const f32x4 v0 = acc[ai][bj][m][0] * (1.0f / 255.0f), v1 = acc[ai][bj][m][1] * (1.0f / 255.0f);
                    u32x4 w; w.x = cvt_pk_bf16(v0[0] * ub(g.x, 0), v0[1] * ub(g.x, 1)); w.y = cvt_pk_bf16(v0[2] * ub(g.x, 2), v0[3] * ub(g.x, 3));
                    w.z = cvt_pk_bf16(v1[0] * ub(g.y, 0), v1[1] * ub(g.y, 1)); w.w = cvt_pk_bf16(v1[2] * ub(g.y, 2), v1[3] * ub(g.y, 3));
                    gst<u32x4>(MG + (unsigned)((row0 + ai * 128 + m * 16) * 1024 + cl0 + bj * 128), w);
                }
            asm volatile("" ::: "memory");
        }
    }
};
struct EpiDelta {
    static constexpr bool PERM = true;
    bf16* Dm;
    __device__ __forceinline__ void operator()(const f32x4 (&acc)[2][2][4][2], const Unit& u, int wr, int wc, int fr, int fq) const {
        const int row0 = u.pm * 256 + wr * 64 + fr, cl0 = u.pn * 256 + wc * 32 + 8 * fq;
#pragma unroll
        for (int ai = 0; ai < 2; ++ai)
#pragma unroll
            for (int m = 0; m < 4; ++m) {
#pragma unroll
                for (int bj = 0; bj < 2; ++bj) { const f32x4 v0 = acc[ai][bj][m][0], v1 = acc[ai][bj][m][1];
                    u32x4 w; w.x = cvt_pk_bf16(v0[0], v0[1]); w.y = cvt_pk_bf16(v0[2], v0[3]); w.z = cvt_pk_bf16(v1[0], v1[1]); w.w = cvt_pk_bf16(v1[2], v1[3]);
                    gst<u32x4>(Dm + (unsigned)((row0 + ai * 128 + m * 16) * 1024 + cl0 + bj * 128), w); }
                asm volatile("" ::: "memory");
            }
    }
};
struct EpiMoe1 {
    static constexpr bool PERM = true;
    bf16* ACT; const float* wts;
    __device__ __forceinline__ void operator()(const f32x4 (&acc)[2][2][4][2], const Unit& u, int wr, int wc, int fr, int fq) const {
        const int r0 = wr * 64 + fr, cl0 = wc * 32 + 8 * fq, es = u.pn >> 1;
        float wv[2][4], rv[2][4];
#pragma unroll
        for (int ai = 0; ai < 2; ++ai)
#pragma unroll
            for (int m = 0; m < 4; ++m) { const int slot = u.x1 + r0 + ai * 128 + m * 16; const f32x4 t = slot < u.x2 ? gld<f32x4>(wts + (unsigned)((u.x0 * LCAP + slot) * 4)) : (f32x4){0.f, 0.f, 0.f, 0.f}; wv[ai][m] = es ? t[1] : t[0]; rv[ai][m] = t[2]; }
#pragma unroll
        for (int ai = 0; ai < 2; ++ai)
#pragma unroll
            for (int m = 0; m < 4; ++m) {
                const int r = r0 + ai * 128 + m * 16; const float w = wv[ai][m], rs = rv[ai][m];
#pragma unroll
                for (int bj = 0; bj < 2; ++bj) {
                    const f32x4 v0 = acc[ai][bj][m][0] * rs, v1 = acc[ai][bj][m][1] * rs;
                    const int col = cl0 + bj * 128;
                    u32x2 o; o.x = cvt_pk_bf16(v0[0] * sigmoid_f(v0[0]) * v0[1] * w, v0[2] * sigmoid_f(v0[2]) * v0[3] * w); o.y = cvt_pk_bf16(v1[0] * sigmoid_f(v1[0]) * v1[1] * w, v1[2] * sigmoid_f(v1[2]) * v1[3] * w);
                    gst<u32x2>(ACT + (unsigned)((u.pm * 256 + r) * 512 + es * 256 + (u.pn & 1) * 128 + (col >> 1)), o);
                }
                asm volatile("" ::: "memory");
            }
    }
};
struct EpiMoe2 {
    static constexpr bool PERM = true;
    bf16* Dm; const int* list;
    __device__ __forceinline__ void operator()(const f32x4 (&acc)[2][2][4][2], const Unit& u, int wr, int wc, int fr, int fq) const {
        const int r0 = wr * 64 + fr, cl0 = u.pn * 256 + wc * 32 + 8 * fq;
        int tok[2][4];
#pragma unroll
        for (int ai = 0; ai < 2; ++ai)
#pragma unroll
            for (int m = 0; m < 4; ++m) { const int slot = u.x1 + r0 + ai * 128 + m * 16; tok[ai][m] = slot < u.x2 ? gld<int>(list + (unsigned)(u.x0 * LCAP + slot)) : -1; }
#pragma unroll
        for (int ai = 0; ai < 2; ++ai)
#pragma unroll
            for (int m = 0; m < 4; ++m) {
                const int t = tok[ai][m];
#pragma unroll
                for (int bj = 0; bj < 2; ++bj) { const f32x4 v0 = acc[ai][bj][m][0], v1 = acc[ai][bj][m][1];
                    u32x4 w; w.x = cvt_pk_bf16(v0[0], v0[1]); w.y = cvt_pk_bf16(v0[2], v0[3]); w.z = cvt_pk_bf16(v1[0], v1[1]); w.w = cvt_pk_bf16(v1[2], v1[3]);
                    if (t >= 0) gst<u32x4>(Dm + (unsigned)(t * 1024 + cl0 + bj * 128), w); }
                asm volatile("" ::: "memory");
            }
    }
};
#define XB_TMO      128
#define XB_XCNT(j)  (256  + 64 * (j))
#define XB_XSUB(j)  (1280 + 64 * (j))
#define XB_XGEN(j)  (2304 + 64 * (j))
#define XB_TOP      3328
#define XB_TOPGEN   3392
#define XCD_BAR_WORDS 3456
#define XB_SPIN_CAP (1u << 18)
__device__ __forceinline__ unsigned xb_ld(unsigned* p)              { return __hip_atomic_load((__attribute__((address_space(1))) unsigned*)p, __ATOMIC_RELAXED, __HIP_MEMORY_SCOPE_AGENT); }
__device__ __forceinline__ unsigned xb_add(unsigned* p, unsigned v) { return __hip_atomic_fetch_add((__attribute__((address_space(1))) unsigned*)p, v, __ATOMIC_RELAXED, __HIP_MEMORY_SCOPE_AGENT); }
__device__ __forceinline__ unsigned xb_xcc_id() { return (unsigned)__builtin_amdgcn_s_getreg((3 << 11) | 20) & 0xFu; }
#define XB_SPIN(cond, bar) do { unsigned _sp = 0; while (cond) { __builtin_amdgcn_s_sleep(1); \
    if ((++_sp & 255u) == 0u) { if (xb_ld(&(bar)[XB_TMO])) break; if (_sp > XB_SPIN_CAP) { atomicAdd(&(bar)[XB_TMO], 1u); break; } } } } while (0)
struct XcdBarrier { unsigned* bar; unsigned x; volatile LAS unsigned* st; };
__device__ __forceinline__ XcdBarrier xcd_barrier_post(unsigned* bar, volatile LAS unsigned* st) {
    XcdBarrier b; b.bar = bar; b.x = xb_xcc_id(); b.st = st;
    if (threadIdx.x == 0) (void)xb_add(&bar[XB_XCNT(b.x)], 1u);
    return b;
}
__device__ __forceinline__ void xcd_barrier_complete(unsigned* bar, unsigned x, unsigned& nloc, unsigned& nx) {
    const unsigned G = gridDim.x * gridDim.y * gridDim.z;
    unsigned sum, cnt, mine, sp = 0u;
    for (;;) {
        sum = 0u; cnt = 0u; mine = 0u;
#pragma unroll
        for (unsigned j = 0; j < 16; ++j) { const unsigned c = xb_ld(&bar[XB_XCNT(j)]); sum += c; cnt += (c > 0u) ? 1u : 0u; mine = (j == x) ? c : mine; }
        if (sum == G) break;
        __builtin_amdgcn_s_sleep(1);
        if ((++sp & 255u) == 0u) { if (xb_ld(&bar[XB_TMO])) break; if (sp > XB_SPIN_CAP) { atomicAdd(&bar[XB_TMO], 1u); break; } }
    }
    nloc = mine > 0u ? mine : 1u; nx = cnt > 0u ? cnt : 1u;
}
__device__ __forceinline__ void xcd_barrier(const XcdBarrier& b, bool is_t0) {
    asm volatile("s_waitcnt vmcnt(0)" ::: "memory");
    __syncthreads();
    if (is_t0) {
        unsigned* bar = b.bar;
        __builtin_amdgcn_s_waitcnt(0);
        unsigned nloc = b.st[0], nx = b.st[1];
        if (nloc == 0u) { xcd_barrier_complete(bar, b.x, nloc, nx); b.st[0] = nloc; b.st[1] = nx; }
        const unsigned old = xb_add(&bar[XB_XSUB(b.x)], 1u);
        const unsigned gen = old / nloc;
        if (old + 1u == (gen + 1u) * nloc) {
            __builtin_amdgcn_fence(__ATOMIC_RELEASE, "agent");
            asm volatile("s_waitcnt vmcnt(0)" ::: "memory");
            const unsigned og = xb_add(&bar[XB_TOP], 1u);
            const unsigned tg = og / nx;
            if (og + 1u == (tg + 1u) * nx) xb_add(&bar[XB_TOPGEN], 1u);
            else XB_SPIN(xb_ld(&bar[XB_TOPGEN]) == tg, bar);
            __builtin_amdgcn_fence(__ATOMIC_ACQUIRE, "agent");
            xb_add(&bar[XB_XGEN(b.x)], 1u);
            asm volatile("s_waitcnt vmcnt(0)" ::: "memory");
        } else {
            XB_SPIN(xb_ld(&bar[XB_XGEN(b.x)]) == gen, bar);
            __builtin_amdgcn_fence(__ATOMIC_ACQUIRE, "agent");
            asm volatile("s_waitcnt vmcnt(0)" ::: "memory");
        }
    }
    __syncthreads();
}

constexpr int AT_SLOT = 8192, AT_VOFF = 9 * AT_SLOT;
__device__ __forceinline__ int kswz(int col) { return ((col >> 1) & 1) | (((col >> 3) & 3) << 1); }
template <bool NA>
__device__ __forceinline__ void attn_core(const bf16x8 (&qf)[2], const LAS unsigned char* lds, int rs, int c_lo, bf16* obase, const float* rpbp_h, int rbias0, int c0q, int lane) {
    const int n = lane & 15, q = lane >> 4, cq = c0q + n;
    f32x4 bias0[8], bias1[8];
    if (NA) {
        const float* bp = rpbp_h + (c_lo - c0q + 8 * q - n + 31);
#pragma unroll
        for (int kb = 0; kb < 8; ++kb) { bias0[kb] = gld<f32x4>(bp + (rbias0 + kb) * 64); bias1[kb] = gld<f32x4>(bp + (rbias0 + kb) * 64 + 4); }
    }
    f32x4 s[8][2];
#pragma unroll
    for (int kb = 0; kb < 8; ++kb) {
        const int slot = NA ? (rs + kb) % 9 : (kb >> 1); const int cb0 = NA ? c_lo : (kb & 1) * 32;
        const LAS unsigned char* kp = lds + slot * AT_SLOT;
#pragma unroll
        for (int blk = 0; blk < 2; ++blk) {
            const int col = cb0 + 8 * (n >> 2) + 4 * blk + (n & 3), f = kswz(col);
            const bf16x8 a0 = *(const LAS bf16x8*)(kp + col * 128 + ((q ^ f) << 4)), a1 = *(const LAS bf16x8*)(kp + col * 128 + (((4 + q) ^ f) << 4));
            f32x4 a = (f32x4){0.f, 0.f, 0.f, 0.f};
            a = __builtin_amdgcn_mfma_f32_16x16x32_bf16(a0, qf[0], a, 0, 0, 0);
            a = __builtin_amdgcn_mfma_f32_16x16x32_bf16(a1, qf[1], a, 0, 0, 0);
            s[kb][blk] = a;
        }
    }
    if (NA) {
        const int cs = min(max(cq - 8, 0), 48);
#pragma unroll
        for (int kb = 0; kb < 8; ++kb) {
            const f32x4 b0 = bias0[kb], b1 = bias1[kb];
#pragma unroll
            for (int i = 0; i < 4; ++i) {
                const int kc0 = c_lo + 8 * q + i, kc1 = kc0 + 4;
                s[kb][0][i] = (kc0 >= cs && kc0 < cs + 16) ? s[kb][0][i] + b0[i] : -1e30f;
                s[kb][1][i] = (kc1 >= cs && kc1 < cs + 16) ? s[kb][1][i] + b1[i] : -1e30f;
            }
        }
    }
    float mx = -1e30f;
#pragma unroll
    for (int kb = 0; kb < 8; ++kb)
#pragma unroll
        for (int blk = 0; blk < 2; ++blk)
#pragma unroll
            for (int i = 0; i < 4; ++i) mx = fmaxf(mx, s[kb][blk][i]);
    mx = fmaxf(mx, shfl_xor_f(mx, 16, lane)); mx = fmaxf(mx, shfl_xor_f(mx, 32, lane));
    float sum = 0.f; bf16x8 pf[8];
#pragma unroll
    for (int kb = 0; kb < 8; ++kb) {
        float p[8];
#pragma unroll
        for (int blk = 0; blk < 2; ++blk)
#pragma unroll
            for (int i = 0; i < 4; ++i) { const float e = fast_exp(s[kb][blk][i] - mx); p[blk * 4 + i] = e; sum += e; }
        u32x4 w; w.x = cvt_pk_bf16(p[0], p[1]); w.y = cvt_pk_bf16(p[2], p[3]); w.z = cvt_pk_bf16(p[4], p[5]); w.w = cvt_pk_bf16(p[6], p[7]);
        pf[kb] = __builtin_bit_cast(bf16x8, w);
    }
    sum += shfl_xor_f(sum, 16, lane); sum += shfl_xor_f(sum, 32, lane);
    const float inv = fast_rcp(sum);
#pragma unroll
    for (int db = 0; db < 4; ++db) {
        f32x4 o = (f32x4){0.f, 0.f, 0.f, 0.f};
#pragma unroll
        for (int kb = 0; kb < 8; ++kb) {
            const int slot = NA ? (rs + kb) % 9 : (kb >> 1); const int cb0 = NA ? c_lo : (kb & 1) * 32;
            const bf16x8 vf = *(const LAS bf16x8*)(lds + AT_VOFF + slot * AT_SLOT + ((((cb0 >> 3) + q) * 64 + db * 16 + n) << 4));
            o = __builtin_amdgcn_mfma_f32_16x16x32_bf16(vf, pf[kb], o, 0, 0, 0);
        }
        u32x2 w; w.x = cvt_pk_bf16(o[0] * inv, o[1] * inv); w.y = cvt_pk_bf16(o[2] * inv, o[3] * inv);
        gst<u32x2>(obase + (unsigned)(n * 1024 + 4 * q) + db * 16, w);
    }
}

constexpr int NWAVES = 8;
constexpr int RING_BYTES = 131072, ATT_BYTES = 147456, MISC_OFF = ATT_BYTES, TAB_OFF = MISC_OFF + 256, LDS_BYTES = 163840;
struct Args { const float* in[30]; float* out; unsigned char* ws; };
struct Frame { LAS unsigned char* lds; int tid, lane, wave, vcu, G; };
enum { I_X = 0, I_MEM, I_NMIX, I_NFFN, I_NMEM, I_WIN, I_BGATE, I_RPB, I_LRE, I_LIM, I_LDT, I_BRE, I_BIM, I_CRE, I_CIM, I_S5D, I_WGLU, I_WMKV, I_WBNA, I_WBS5, I_WBXA, I_WOUT,
       I_WCO, I_BCO, I_WFI, I_BFI, I_WG, I_WU, I_WD, I_FNORM };

__device__ __forceinline__ void transpose_item(const float* W, int ldn, int k0, int n0, bf16* WT, int ldk, int dk0, int row_off, int rmul, int radd, int qs, const float* kscale, LAS float* scr, int lane) {
    { float t[32]; const float* wp = W + (size_t)(k0 + (lane >> 5)) * ldn + n0 + (lane & 31);
#pragma unroll
      for (int i = 0; i < 32; ++i) t[i] = gld<float>(wp + (size_t)(2 * i) * ldn);
#pragma unroll
      for (int i = 0; i < 32; ++i) scr[(2 * i + (lane >> 5)) * 33 + (lane & 31)] = t[i]; }
    LDS_WAIT(); asm volatile("" ::: "memory");
    const int c = lane & 7;
    f32x4 ka = (f32x4){1.f, 1.f, 1.f, 1.f}, kb = ka;
    if (kscale) { ka = gld<f32x4>(kscale + k0 + 8 * c); kb = gld<f32x4>(kscale + k0 + 8 * c + 4); }
#pragma unroll
    for (int j = 0; j < 4; ++j) { const int n = (lane >> 3) + 8 * j, nn = n0 + n; const LAS float* s = scr + (8 * c) * 33 + n;
        const float sc = (qs && (nn < 512 || (nn >= 1792 && nn < 2048))) ? 0.125f : 1.0f;
        u32x4 o; o.x = cvt_pk_bf16(s[0 * 33] * sc * ka[0], s[1 * 33] * sc * ka[1]); o.y = cvt_pk_bf16(s[2 * 33] * sc * ka[2], s[3 * 33] * sc * ka[3]); o.z = cvt_pk_bf16(s[4 * 33] * sc * kb[0], s[5 * 33] * sc * kb[1]); o.w = cvt_pk_bf16(s[6 * 33] * sc * kb[2], s[7 * 33] * sc * kb[3]);
        gst<u32x4>(WT + (size_t)(row_off + nn * rmul + radd) * ldk + dk0 + k0 + 8 * c, o); }
    LDS_WAIT(); asm volatile("" ::: "memory");
}
__device__ __forceinline__ void transpose_job_item(const float* W, int ldn, int N, int it, bf16* WT, int ldk, int dk0, int row_off, int rmul, int radd, int qs, const float* kscale, LAS float* scr, int lane) {
    const int nblk = N / 32, kb = it / nblk, nb = it % nblk;
    transpose_item(W, ldn, 64 * kb, 32 * nb, WT, ldk, dk0, row_off, rmul, radd, qs, kscale, scr, lane);
}

__device__ __forceinline__ void cexp_d(double zr, double zi, double& er, double& ei) {
    const double wr_ = zr * (1.0 / 1024.0), wi_ = zi * (1.0 / 1024.0);
    double tr = 1.0, ti = 0.0;
#pragma unroll
    for (int n = 12; n >= 1; --n) { const double ar = wr_ * (1.0 / n), ai = wi_ * (1.0 / n); const double nr = 1.0 + (ar * tr - ai * ti), ni = ar * ti + ai * tr; tr = nr; ti = ni; }
#pragma unroll
    for (int k = 0; k < 10; ++k) { const double nr = tr * tr - ti * ti, ni = 2.0 * tr * ti; tr = nr; ti = ni; }
    er = tr; ei = ti;
}

template <bool ROUTER>
__device__ __forceinline__ void norm_rows4(const float* X, const float* gain, bf16* H, int row0, int lane,
                                           const float* wrt, const float* bco, const float* bfi, unsigned* cnt, int* list, float* wts, float* Xout = nullptr) {
    f32x4 x[4][4]; float rstd[4];
#pragma unroll
    for (int r = 0; r < 4; ++r) { float ss = 0.f;
#pragma unroll
        for (int j = 0; j < 4; ++j) { x[r][j] = gld<f32x4>(X + (size_t)(row0 + r) * 1024 + 256 * j + 4 * lane);
            if (Xout) { const u32x2 d = gld<u32x2>(H + (size_t)(row0 + r) * 1024 + 256 * j + 4 * lane); x[r][j][0] += bflo(d.x); x[r][j][1] += bfhi(d.x); x[r][j][2] += bflo(d.y); x[r][j][3] += bfhi(d.y);
                gst<f32x4>(Xout + (size_t)(row0 + r) * 1024 + 256 * j + 4 * lane, x[r][j]); }
            ss += (x[r][j][0] * x[r][j][0] + x[r][j][1] * x[r][j][1]) + (x[r][j][2] * x[r][j][2] + x[r][j][3] * x[r][j][3]); }
        ss = wave_sum(ss, lane); rstd[r] = 1.0f / sqrtf(ss * (1.0f / 1024.0f) + RMS_EPS); }
#pragma unroll
    for (int j = 0; j < 4; ++j) { const f32x4 g4 = gld<f32x4>(gain + 256 * j + 4 * lane);
#pragma unroll
        for (int r = 0; r < 4; ++r) { const f32x4 v = x[r][j] * rstd[r] * g4; u32x2 w; w.x = cvt_pk_bf16(v[0], v[1]); w.y = cvt_pk_bf16(v[2], v[3]);
            gst<u32x2>(H + (size_t)(row0 + r) * 1024 + 256 * j + 4 * lane, w); } }
    if constexpr (ROUTER) {
        float keep[4] = {0.f, 0.f, 0.f, 0.f};
#pragma unroll 2
        for (int c = 0; c < 20; ++c) {
            float a0 = 0.f, a1 = 0.f, a2 = 0.f, a3 = 0.f;
#pragma unroll
            for (int j = 0; j < 4; ++j) { const f32x4 w4 = gld<f32x4>(wrt + c * 1024 + 256 * j + 4 * lane);
                a0 += (x[0][j][0] * w4[0] + x[0][j][1] * w4[1]) + (x[0][j][2] * w4[2] + x[0][j][3] * w4[3]);
                a1 += (x[1][j][0] * w4[0] + x[1][j][1] * w4[1]) + (x[1][j][2] * w4[2] + x[1][j][3] * w4[3]);
                a2 += (x[2][j][0] * w4[0] + x[2][j][1] * w4[1]) + (x[2][j][2] * w4[2] + x[2][j][3] * w4[3]);
                a3 += (x[3][j][0] * w4[0] + x[3][j][1] * w4[1]) + (x[3][j][2] * w4[2] + x[3][j][3] * w4[3]); }
            a0 = wave_sum(a0, lane); a1 = wave_sum(a1, lane); a2 = wave_sum(a2, lane); a3 = wave_sum(a3, lane);
            if (lane == c) { keep[0] = a0 * rstd[0]; keep[1] = a1 * rstd[1]; keep[2] = a2 * rstd[2]; keep[3] = a3 * rstd[3]; }
        }
#pragma unroll
        for (int r = 0; r < 4; ++r) {
            float co[4];
#pragma unroll
            for (int i = 0; i < 4; ++i) co[i] = shfl_idx_f(keep[r], i) + bco[i];
            int grp = 0; float cm = co[0];
#pragma unroll
            for (int i = 1; i < 4; ++i) if (co[i] > cm) { cm = co[i]; grp = i; }
            float den = 0.f;
#pragma unroll
            for (int i = 0; i < 4; ++i) den += __expf(co[i] - cm);
            const float pgrp = 1.0f / den;
            float fv[4];
#pragma unroll
            for (int i = 0; i < 4; ++i) fv[i] = shfl_idx_f(keep[r], 4 + grp * 4 + i) + bfi[grp * 4 + i];
            int i1 = 0; float v1 = fv[0];
#pragma unroll
            for (int i = 1; i < 4; ++i) if (fv[i] > v1) { v1 = fv[i]; i1 = i; }
            int i2 = -1; float v2 = -3.0e38f;
#pragma unroll
            for (int i = 0; i < 4; ++i) if (i != i1 && fv[i] > v2) { v2 = fv[i]; i2 = i; }
            const float w1 = pgrp / (1.0f + __expf(v2 - v1)), w2 = pgrp - w1;
            const int a = i1 < i2 ? i1 : i2, b = i1 < i2 ? i2 : i1;
            const int pidx = a == 0 ? b - 1 : (a == 1 ? b + 1 : 5);
            const int bucket = grp * 6 + pidx;
            const float wa = (i1 == a) ? w1 : w2, wb = (i1 == a) ? w2 : w1;
            if (lane == 0) {
                const unsigned slot = __hip_atomic_fetch_add(cnt + bucket * 64, 1u, __ATOMIC_RELAXED, __HIP_MEMORY_SCOPE_AGENT);
                list[(size_t)bucket * LCAP + slot] = row0 + r;
                gst<f32x2>(wts + ((size_t)bucket * LCAP + slot) * 2, (f32x2){wa, wb});
            }
        }
    }
}

constexpr int RT_STRIDE = 2064;
constexpr int RT_BYTES = 40 * RT_STRIDE;
constexpr int RT_SCR = 98304;
__device__ __forceinline__ void router_rows16(const float* X, float* Xout, const bf16* DH, bf16* XB, int R0, int lane, LAS unsigned char* lds, int wave,
                                              const float* bco, const float* bfi, unsigned* cnt, int* list, float* wts) {
    const int n = lane & 15, q = lane >> 4;
    f32x4 accF = (f32x4){0.f, 0.f, 0.f, 0.f}, accC = (f32x4){0.f, 0.f, 0.f, 0.f};
    float ss = 0.f;
    const unsigned xo = (unsigned)((R0 + n) * 1024 + 8 * q); const float* xp = X + xo;
    const LAS unsigned char* tF = lds + n * RT_STRIDE + 16 * q; const LAS unsigned char* tC = lds + (16 + (n & 3)) * RT_STRIDE + 16 * q;
#pragma unroll 4
    for (int ks = 0; ks < 32; ++ks) {
        f32x4 x0 = gld<f32x4>(xp + ks * 32), x1 = gld<f32x4>(xp + ks * 32 + 4);
        if (DH) { const u32x4 d = gld<u32x4>(DH + xo + ks * 32); x0[0] += bflo(d.x); x0[1] += bfhi(d.x); x0[2] += bflo(d.y); x0[3] += bfhi(d.y); x1[0] += bflo(d.z); x1[1] += bfhi(d.z); x1[2] += bflo(d.w); x1[3] += bfhi(d.w); }
        gst<f32x4>(Xout + xo + ks * 32, x0); gst<f32x4>(Xout + xo + ks * 32 + 4, x1);
        ss += (x0[0] * x0[0] + x0[1] * x0[1]) + (x0[2] * x0[2] + x0[3] * x0[3]) + (x1[0] * x1[0] + x1[1] * x1[1]) + (x1[2] * x1[2] + x1[3] * x1[3]);
        u32x4 hw; hw.x = cvt_pk_bf16(x0[0], x0[1]); hw.y = cvt_pk_bf16(x0[2], x0[3]); hw.z = cvt_pk_bf16(x1[0], x1[1]); hw.w = cvt_pk_bf16(x1[2], x1[3]);
        u32x4 lw; lw.x = cvt_pk_bf16(x0[0] - bflo(hw.x), x0[1] - bfhi(hw.x)); lw.y = cvt_pk_bf16(x0[2] - bflo(hw.y), x0[3] - bfhi(hw.y));
        lw.z = cvt_pk_bf16(x1[0] - bflo(hw.z), x1[1] - bfhi(hw.z)); lw.w = cvt_pk_bf16(x1[2] - bflo(hw.w), x1[3] - bfhi(hw.w));
        gst<u32x4>(XB + xo + ks * 32, hw);
        const bf16x8 ah = __builtin_bit_cast(bf16x8, hw), al = __builtin_bit_cast(bf16x8, lw);
        const bf16x8 fh = *(const LAS bf16x8*)(tF + ks * 64), fl = *(const LAS bf16x8*)(tF + 20 * RT_STRIDE + ks * 64);
        const bf16x8 ch = *(const LAS bf16x8*)(tC + ks * 64), cl = *(const LAS bf16x8*)(tC + 20 * RT_STRIDE + ks * 64);
        accF = __builtin_amdgcn_mfma_f32_16x16x32_bf16(ah, fh, accF, 0, 0, 0); accF = __builtin_amdgcn_mfma_f32_16x16x32_bf16(ah, fl, accF, 0, 0, 0); accF = __builtin_amdgcn_mfma_f32_16x16x32_bf16(al, fh, accF, 0, 0, 0);
        accC = __builtin_amdgcn_mfma_f32_16x16x32_bf16(ah, ch, accC, 0, 0, 0); accC = __builtin_amdgcn_mfma_f32_16x16x32_bf16(ah, cl, accC, 0, 0, 0); accC = __builtin_amdgcn_mfma_f32_16x16x32_bf16(al, ch, accC, 0, 0, 0);
    }
    ss += shfl_xor_f(ss, 16, lane); ss += shfl_xor_f(ss, 32, lane);
    const float rstd = 1.0f / sqrtf(ss * (1.0f / 1024.0f) + RMS_EPS);
    LAS float* sc = (LAS float*)(lds + RT_SCR + wave * 1536);
#pragma unroll
    for (int r = 0; r < 4; ++r) { const float rs = shfl_idx_f(rstd, 4 * q + r); sc[(4 * q + r) * 24 + n] = accF[r] * rs; if (n < 4) sc[(4 * q + r) * 24 + 16 + n] = accC[r] * rs; }
    LDS_WAIT(); asm volatile("" ::: "memory");
    if (lane < 16) {
        const LAS float* my = sc + lane * 24;
        float co[4];
#pragma unroll
        for (int i = 0; i < 4; ++i) co[i] = my[16 + i] + gld<float>(bco + i);
        int grp = 0; float cm = co[0];
#pragma unroll
        for (int i = 1; i < 4; ++i) if (co[i] > cm) { cm = co[i]; grp = i; }
        float den = 0.f;
#pragma unroll
        for (int i = 0; i < 4; ++i) den += __expf(co[i] - cm);
        const float pgrp = 1.0f / den;
        float fv[4];
#pragma unroll
        for (int i = 0; i < 4; ++i) fv[i] = my[grp * 4 + i] + gld<float>(bfi + grp * 4 + i);
        int i1 = 0; float v1 = fv[0];
#pragma unroll
        for (int i = 1; i < 4; ++i) if (fv[i] > v1) { v1 = fv[i]; i1 = i; }
        int i2 = -1; float v2 = -3.0e38f;
#pragma unroll
        for (int i = 0; i < 4; ++i) if (i != i1 && fv[i] > v2) { v2 = fv[i]; i2 = i; }
        const float w1 = pgrp / (1.0f + __expf(v2 - v1)), w2 = pgrp - w1;
        const int a = i1 < i2 ? i1 : i2, b = i1 < i2 ? i2 : i1;
        const int pidx = a == 0 ? b - 1 : (a == 1 ? b + 1 : 5);
        const int bucket = grp * 6 + pidx;
        const float wa = (i1 == a) ? w1 : w2, wb = (i1 == a) ? w2 : w1;
        const unsigned slot = __hip_atomic_fetch_add((GASP unsigned*)(cnt + bucket * 64), 1u, __ATOMIC_RELAXED, __HIP_MEMORY_SCOPE_AGENT);
        gst<int>(list + ((unsigned)(bucket * LCAP) + slot), R0 + lane);
        gst<f32x4>(wts + ((unsigned)(bucket * LCAP) + slot) * 4, (f32x4){wa, wb, rstd, 0.f});
    }
}

__device__ __forceinline__ void final_norm_row(float* X, const bf16* Dl, const float* gain, int row, int lane) {
    f32x4 x[4]; float ss = 0.f;
#pragma unroll
    for (int j = 0; j < 4; ++j) { x[j] = gld<f32x4>(X + (size_t)row * 1024 + 256 * j + 4 * lane);
        { const u32x2 d = gld<u32x2>(Dl + (size_t)row * 1024 + 256 * j + 4 * lane); x[j][0] += bflo(d.x); x[j][1] += bfhi(d.x); x[j][2] += bflo(d.y); x[j][3] += bfhi(d.y); }
        ss += (x[j][0] * x[j][0] + x[j][1] * x[j][1]) + (x[j][2] * x[j][2] + x[j][3] * x[j][3]); }
    ss = wave_sum(ss, lane); const float rstd = 1.0f / sqrtf(ss * (1.0f / 1024.0f) + RMS_EPS);
#pragma unroll
    for (int j = 0; j < 4; ++j) { const f32x4 g4 = gld<f32x4>(gain + 256 * j + 4 * lane); gst<f32x4>(X + (size_t)row * 1024 + 256 * j + 4 * lane, x[j] * rstd * g4); }
}

__device__ __forceinline__ void s5_scan_item(int item, const float* ST, bf16* At, const f32x2* apow_l, LAS float* sc, int tid) {
    const int d = item & 1, bg = item >> 1, g = bg & 15, seg = tid >> 6, p = tid & 63;
    const f32x2 A32 = gld<f32x2>(apow_l + ((d * 16 + g) * 33 + 32) * 64 + p);
    const int chunk0 = d ? 255 - seg * 32 : seg * 32; const long cstep = d ? -1 : 1;
    const float* rp0 = ST + (size_t)(bg * 256 + chunk0) * 256 + d * 128 + p;
    float tr = 0.f, ti = 0.f;
#pragma unroll 8
    for (int j = 0; j < 32; ++j) { const float* rp = rp0 + cstep * j * 256; const float sr = gld<float>(rp), si = gld<float>(rp + 64); const float nr = A32.x * tr - A32.y * ti + sr, ni = A32.x * ti + A32.y * tr + si; tr = nr; ti = ni; }
    sc[(seg * 64 + p) * 2] = tr; sc[(seg * 64 + p) * 2 + 1] = ti;
    __syncthreads();
    float pr = A32.x, pi = A32.y;
#pragma unroll
    for (int k = 0; k < 5; ++k) { const float nr = pr * pr - pi * pi, ni = 2.f * pr * pi; pr = nr; pi = ni; }
    float er = 0.f, ei = 0.f;
    for (int s2 = 0; s2 < seg; ++s2) { const float qr = sc[(s2 * 64 + p) * 2], qi = sc[(s2 * 64 + p) * 2 + 1]; const float nr = pr * er - pi * ei + qr, ni = pr * ei + pi * er + qi; er = nr; ei = ni; }
    bf16* op0 = At + (size_t)(bg * 256 + chunk0) * ATK + 512 + d * 128 + p;
#pragma unroll 8
    for (int j = 0; j < 32; ++j) { const float* rp = rp0 + cstep * j * 256; const float sr = gld<float>(rp), si = gld<float>(rp + 64); bf16* op = op0 + cstep * j * ATK;
        gst<bf16>(op, (bf16)(cvt_pk_bf16(er, er) & 0xffffu)); gst<bf16>(op + 64, (bf16)(cvt_pk_bf16(ei, ei) & 0xffffu));
        const float nr = A32.x * er - A32.y * ei + sr, ni = A32.x * ei + A32.y * er + si; er = nr; ei = ni; }
    __syncthreads();
}

#define NA_ITEM(item) do { \
    const bf16* QK = WP(bf16, WS_QK); const bf16* VT8 = WP(bf16, WS_VT8); bf16* Hn = WP(bf16, WS_H); const float* RPBP = WP(float, WS_RPBP); \
    const int n = lane & 15, q = lane >> 4, cb = wave & 3, qsel = wave >> 2, c_lo = cb == 0 ? 0 : (cb == 1 ? 8 : (cb == 2 ? 24 : 32)); \
    const int kcol = tid >> 3, kdst = kcol * 128 + (((tid & 7) ^ kswz(kcol)) << 4); \
    const int b = (item) >> 7, h = ((item) >> 4) & 7, r0 = ((item) & 15) * 8; \
    const bf16* Kg = QK + (size_t)b * SEQ * 1024 + 512 + h * 64 + (unsigned)(kcol * 1024 + (tid & 7) * 8); \
    const bf16* Vg = VT8 + (size_t)(b * 8 + h) * 1024 * 512 + (unsigned)(tid * 8); \
    const float* rp = RPBP + (size_t)(l * 8 + h) * 15 * 64; \
    int hi = min(max(r0 + 1 - 4, 0), 120) + 7; \
    { const int lo = min(max(r0 - 4, 0), 120); \
      u32x4 kv[9], vv[9]; \
      _Pragma("unroll") for (int j = 0; j < 9; ++j) { const int kr = min(lo + j, 127); kv[j] = gld<u32x4>(Kg + (size_t)kr * 65536); vv[j] = gld<u32x4>(Vg + (size_t)kr * 4096); } \
      _Pragma("unroll") for (int j = 0; j < 9; ++j) { const int kr = lo + j; if (kr <= hi) { const int slot = kr % 9; *(LAS u32x4*)(F.lds + slot * AT_SLOT + kdst) = kv[j]; *(LAS u32x4*)(F.lds + AT_VOFF + slot * AT_SLOT + tid * 16) = vv[j]; } } \
    } \
    bf16x8 qf[2]; \
    { const bf16* qb = QK + (size_t)(b * SEQ + (r0 + qsel) * 64 + cb * 16) * 1024 + h * 64 + (unsigned)(n * 1024 + 8 * q); qf[0] = gld<bf16x8>(qb); qf[1] = gld<bf16x8>(qb + 32); } \
    __syncthreads(); \
    _Pragma("unroll 1") for (int st = 0; st < 4; ++st) { \
        const int r = r0 + 2 * st + qsel, rs = min(max(r - 4, 0), 120); \
        const bool more = st < 3; \
        const int hi_next = more ? min(max(r0 + 2 * st + 3 - 4, 0), 120) + 7 : hi; \
        const int kr1 = hi + 1, kr2 = hi + 2; \
        u32x4 k1 = (u32x4){0u, 0u, 0u, 0u}, v1 = k1, k2 = k1, v2 = k1; bf16x8 qn[2]; qn[0] = qf[0]; qn[1] = qf[1]; \
        if (more) { \
            k1 = gld<u32x4>(Kg + (size_t)min(kr1, 127) * 65536); v1 = gld<u32x4>(Vg + (size_t)min(kr1, 127) * 4096); \
            k2 = gld<u32x4>(Kg + (size_t)min(kr2, 127) * 65536); v2 = gld<u32x4>(Vg + (size_t)min(kr2, 127) * 4096); \
            const bf16* qb = QK + (size_t)(b * SEQ + (r + 2) * 64 + cb * 16) * 1024 + h * 64 + (unsigned)(n * 1024 + 8 * q); qn[0] = gld<bf16x8>(qb); qn[1] = gld<bf16x8>(qb + 32); \
        } \
        attn_core<true>(qf, F.lds, rs, c_lo, Hn + (size_t)(b * SEQ + r * 64 + cb * 16) * 1024 + h * 64, rp, rs - r + 7, cb * 16, lane); \
        __syncthreads(); \
        if (more) { \
            if (kr1 <= hi_next) { const int slot = kr1 % 9; *(LAS u32x4*)(F.lds + slot * AT_SLOT + kdst) = k1; *(LAS u32x4*)(F.lds + AT_VOFF + slot * AT_SLOT + tid * 16) = v1; } \
            if (kr2 <= hi_next) { const int slot = kr2 % 9; *(LAS u32x4*)(F.lds + slot * AT_SLOT + kdst) = k2; *(LAS u32x4*)(F.lds + AT_VOFF + slot * AT_SLOT + tid * 16) = v2; } \
            hi = hi_next; qf[0] = qn[0]; qf[1] = qn[1]; \
        } \
        __syncthreads(); \
    } } while (0)
#define WG_MEM_SYNC() do { asm volatile("s_waitcnt vmcnt(0)" ::: "memory"); __syncthreads(); __builtin_amdgcn_fence(__ATOMIC_ACQUIRE, "agent"); asm volatile("s_waitcnt vmcnt(0)" ::: "memory"); } while (0)

#define XA_ITEMS(first, last, stride) do { \
    const bf16* QX = WP(bf16, WS_QX); const bf16* KM = WP(bf16, WS_KM); const bf16* VM8 = WP(bf16, WS_VM8); bf16* Hx = WP(bf16, WS_H); \
    const int n_ = lane & 15, q_ = lane >> 4, kcol = tid >> 3, kdst = kcol * 128 + (((tid & 7) ^ kswz(kcol)) << 4); \
    for (int item = (first); item < (last); item += (stride)) { \
        const int b = item >> 6, h = (item >> 4) & 3, qc = item & 15; \
        const bf16* Kg = KM + ((size_t)(l * 4 + b) * 256) * 256 + h * 64 + (unsigned)(kcol * 256 + (tid & 7) * 8); \
        const bf16* Vg = VM8 + (size_t)((l * 4 + b) * 4 + h) * 32 * 512 + (unsigned)(tid * 8); \
        _Pragma("unroll") for (int j = 0; j < 4; ++j) { const u32x4 kv = gld<u32x4>(Kg + j * 64 * 256), vv = gld<u32x4>(Vg + j * 4096); \
            *(LAS u32x4*)(F.lds + j * AT_SLOT + kdst) = kv; *(LAS u32x4*)(F.lds + AT_VOFF + j * AT_SLOT + tid * 16) = vv; } \
        __syncthreads(); \
        _Pragma("unroll 1") for (int j = 0; j < 4; ++j) { \
            const int t0 = b * SEQ + qc * 512 + wave * 64 + j * 16; \
            bf16x8 qf[2]; { const bf16* qb = QX + (size_t)t0 * 256 + h * 64 + (unsigned)(n_ * 256 + 8 * q_); qf[0] = gld<bf16x8>(qb); qf[1] = gld<bf16x8>(qb + 32); } \
            attn_core<false>(qf, F.lds, 0, 0, Hx + (size_t)t0 * 1024 + 768 + h * 64, nullptr, 0, 0, lane); } \
        __syncthreads(); \
    } } while (0)

#ifndef PHMASK
#define PHMASK 0xffffffffu
#endif
#define PH(k) ((PHMASK >> (k)) & 1u)
#ifndef FUSE1
#define FUSE1 0
#endif
#ifndef REPMASK
#define REPMASK 0u
#endif
#define NREP(k) (1 + (int)((REPMASK >> (k)) & 1u))
constexpr int PTR_OFF = MISC_OFF + 1024;
__device__ __forceinline__ const float* inp(LAS unsigned char* lds, int i, int z) {
    const LAS unsigned* q = (const LAS unsigned*)(lds + PTR_OFF + 8 * i + z);
    const unsigned lo = __builtin_amdgcn_readfirstlane(q[0]), hi = __builtin_amdgcn_readfirstlane(q[1]);
    return (const float*)(((unsigned long long)hi << 32) | lo);
}
#define WSL() unsigned char* wsl = args.ws; int wave = F.wave, bid = blockIdx.x, G = gridDim.x, zz = 0; unsigned mm_ = ~0u; asm volatile("" : "+s"(mm_)); int lane = (int)__builtin_amdgcn_mbcnt_hi(mm_, __builtin_amdgcn_mbcnt_lo(mm_, 0u)); \
    asm volatile("" : "+s"(wsl), "+s"(wave), "+v"(lane), "+s"(bid), "+s"(G), "+s"(zz)); \
    const int tid = wave * 64 + lane, vcu = (G % 8 == 0) ? (bid % 8) * (G / 8) + bid / 8 : bid, gw = vcu * NWAVES + wave, NGW = G * NWAVES, NGT = G * NWAVES * 64; \
    (void)tid; (void)gw; (void)NGW; (void)NGT; (void)wsl
#define WP(T, off) ((T*)(wsl + (off)))
#define IN(i) inp(F.lds, (i), zz)

__global__ void __launch_bounds__(NWAVES * 64, 2) fwd_kernel(Args args) {
    extern __shared__ __attribute__((aligned(16))) unsigned char lds_raw[];
    Frame F;
    F.lds = (LAS unsigned char*)lds_raw;
    F.tid = threadIdx.x; F.lane = F.tid & 63; F.wave = __builtin_amdgcn_readfirstlane(F.tid >> 6);
    F.G = gridDim.x; { const int bx = blockIdx.x; F.vcu = (F.G % 8 == 0) ? (bx % 8) * (F.G / 8) + bx / 8 : bx; }
    for (int u = F.tid; u < (LDS_BYTES - MISC_OFF) / 4; u += NWAVES * 64) ((LAS unsigned*)(F.lds + MISC_OFF))[u] = 0u;
    __syncthreads();
    if (F.tid < 30) { const unsigned long long p = (unsigned long long)args.in[F.tid]; LAS unsigned* q = (LAS unsigned*)(F.lds + PTR_OFF + 8 * F.tid); q[0] = (unsigned)p; q[1] = (unsigned)(p >> 32); }
    __syncthreads();
    (void)xcd_barrier_post((unsigned*)(args.ws + WS_CTL) + CW_BAR, (volatile LAS unsigned*)(F.lds + MISC_OFF));
#define GRID_BAR() do { unsigned char* w_ = args.ws; asm volatile("" : "+s"(w_)); XcdBarrier b_; b_.bar = (unsigned*)(w_ + WS_CTL) + CW_BAR; b_.x = xb_xcc_id(); b_.st = (volatile LAS unsigned*)(F.lds + MISC_OFF); unsigned m_ = ~0u; int wv_ = F.wave; asm volatile("" : "+s"(m_), "+s"(wv_)); \
    xcd_barrier(b_, (wv_ == 0) && (__builtin_amdgcn_mbcnt_hi(m_, __builtin_amdgcn_mbcnt_lo(m_, 0u)) == 0u)); } while (0)
#define GT() (vcu * (NWAVES * 64) + tid)
#define SCR() ((LAS float*)(F.lds + wave * 16384))

    if (PH(0)) {
        WSL();
        f32x2* APOW = WP(f32x2, WS_APOW); f32x2* BBAR = WP(f32x2, WS_BBAR); bf16* WRT = WP(bf16, WS_WRT); bf16* MEMN = WP(bf16, WS_MEMN); bf16* WMKV = WP(bf16, WS_WMKV);
        for (int it = gw; it < 1024; it += NGW) { const int l = it >> 8, r = it & 255;
            transpose_job_item(IN(I_WMKV) + (size_t)l * 1024 * 512, 512, 512, r, WMKV + (size_t)l * 512 * 1024, 1024, 0, 0, 1, 0, 0, nullptr, SCR(), lane); }
        for (int it = gw; it < 4096; it += NGW) { const int l = it >> 10, row = it & 1023;
            const float* xr = IN(I_MEM) + (size_t)row * 1024; const float* gn = IN(I_NMEM) + l * 1024;
            f32x4 x[4]; float ss = 0.f;
#pragma unroll
            for (int j = 0; j < 4; ++j) { x[j] = gld<f32x4>(xr + 256 * j + 4 * lane); ss += (x[j][0] * x[j][0] + x[j][1] * x[j][1]) + (x[j][2] * x[j][2] + x[j][3] * x[j][3]); }
            ss = wave_sum(ss, lane); const float rstd = 1.0f / sqrtf(ss * (1.0f / 1024.0f) + RMS_EPS);
#pragma unroll
            for (int j = 0; j < 4; ++j) { const f32x4 v = x[j] * rstd * gld<f32x4>(gn + 256 * j + 4 * lane); u32x2 w; w.x = cvt_pk_bf16(v[0], v[1]); w.y = cvt_pk_bf16(v[2], v[3]);
                gst<u32x2>(MEMN + (size_t)it * 1024 + 256 * j + 4 * lane, w); } }
        for (int it = GT(); it < 8192; it += NGT) {
            const int p = it & 63, ldg = it >> 6;
            const double lr = fmin((double)IN(I_LRE)[it], -1e-4), li = (double)IN(I_LIM)[it];
            double dt, dum; cexp_d((double)IN(I_LDT)[ldg], 0.0, dt, dum);
            double ar, ai; cexp_d(lr * dt, li * dt, ar, ai);
            const double den = lr * lr + li * li, fr = ((ar - 1.0) * lr + ai * li) / den, fi = (ai * lr - (ar - 1.0) * li) / den;
            const float* bre = IN(I_BRE) + (size_t)it * 16; const float* bim = IN(I_BIM) + (size_t)it * 16;
#pragma unroll 4
            for (int c = 0; c < 16; ++c) { const double br = (double)bre[c], bi = (double)bim[c];
                BBAR[(size_t)it * 16 + c] = (f32x2){(float)(fr * br - fi * bi), (float)(fr * bi + fi * br)}; }
            double pr = 1.0, pi = 0.0;
            for (int n = 0; n <= 32; ++n) { APOW[((size_t)ldg * 33 + n) * 64 + p] = (f32x2){(float)pr, (float)pi}; const double nr = pr * ar - pi * ai, ni = pr * ai + pi * ar; pr = nr; pi = ni; }
        }
        { float* RPBP = WP(float, WS_RPBP); const float* rpb = IN(I_RPB);
          for (int it = GT(); it < 4 * 8 * 15 * 64; it += NGT) { const int j = it & 63; RPBP[it] = (j >= 16 && j < 47) ? rpb[(it >> 6) * 31 + (j - 16)] : 0.f; } }
        for (int it = GT(); it < 4 * 20480; it += NGT) { const int l = it / 20480, r = it % 20480, c = r >> 10, k = r & 1023;
            const float gk = IN(I_NFFN)[l * 1024 + k];
            const float v = gk * (c < 16 ? IN(I_WFI)[(size_t)(l * 1024 + k) * 16 + c] : IN(I_WCO)[(size_t)(l * 1024 + k) * 4 + (c - 16)]);
            const unsigned hw = cvt_pk_bf16(v, v) & 0xffffu; const float lo = v - bflo(hw);
            WRT[(size_t)(l * 2 + 0) * 20480 + r] = (bf16)hw; WRT[(size_t)(l * 2 + 1) * 20480 + r] = (bf16)(cvt_pk_bf16(lo, lo) & 0xffffu); }
    }
    GRID_BAR();

    if (PH(1)) {
        WSL();
        { pg8::Gemm g{WP(bf16, WS_MEMN), WP(bf16, WS_WMKV), 1024, 1024, 1024}; pg8::MemOrder S{G, bid}; EpiMemKV E{WP(bf16, WS_KM), WP(bf16, WS_VM8)};
          pg8::gemm_phase<EpiMemKV, pg8::MemOrder>(F.lds, g, S, E, tid); }
        const f32x2* APOW = WP(f32x2, WS_APOW); const f32x2* BBAR = WP(f32x2, WS_BBAR); float* KT = WP(float, WS_KT);
        const float* CRE = IN(I_CRE); const float* CIM = IN(I_CIM); const float* S5D = IN(I_S5D);
        for (int it = GT(); it < 4 * 16 * 63 * 64; it += NGT) {
            const int c2 = (it & 3) * 4, c = (it >> 2) & 15, rest = it >> 6, tp = rest % 63, lg = rest / 63, l = lg >> 4, g = lg & 15;
            f32x4 sum = (f32x4){0.f, 0.f, 0.f, 0.f};
#pragma unroll 1
            for (int d = 0; d < 2; ++d) {
                if (d == 0 ? (tp < 31) : (tp > 31)) continue;
                const int n = d == 0 ? tp - 31 : 31 - tp, base = (l * 2 + d) * 16 + g;
                const float* cre = CRE + ((size_t)base * 16 + c) * 64; const float* cim = CIM + ((size_t)base * 16 + c) * 64;
                const f32x2* ap = APOW + ((size_t)base * 33 + n) * 64; const f32x4* bb = (const f32x4*)(BBAR + (size_t)base * 64 * 16 + c2);
#pragma unroll 8
                for (int p = 0; p < 64; ++p) { const f32x2 a = ap[p]; const f32x4 b0 = bb[p * 8], b1 = bb[p * 8 + 1]; const float cr = cre[p], ci = cim[p];
                    const float er = cr * a.x - ci * a.y, ei = cr * a.y + ci * a.x;
                    sum[0] += er * b0[0] - ei * b0[1]; sum[1] += er * b0[2] - ei * b0[3]; sum[2] += er * b1[0] - ei * b1[1]; sum[3] += er * b1[2] - ei * b1[3]; }
            }
            if (tp == 31 && c >= c2 && c < c2 + 4) sum[c - c2] += S5D[l * 256 + g * 16 + c];
            gst<f32x4>(KT + (size_t)it * 4, sum);
        }
    }
    GRID_BAR();

    const float* xin0 = (const float*)(GASP const float*)args.in[I_X];
    float* XO = (float*)(GASP float*)args.out;
#pragma unroll 1
    for (int l = 0; l < DEPTH; ++l) {
        for (int rep_ = 0; rep_ < NREP(2); ++rep_) {
        if (PH(2)) {
            WSL();
            {
            bf16* WIN = WP(bf16, WS_WIN); bf16* WCAT = WP(bf16, WS_WCAT); bf16* WOUT = WP(bf16, WS_WOUT); bf16* WGLU = WP(bf16, WS_WGLU);
            for (int it = gw; it < 3648; it += NGW) {
                int r = it;
                if (r < 2560) { transpose_job_item(IN(I_WIN) + (size_t)l * 1024 * 5120, 5120, 5120, r, WIN, 1024, 0, 0, 1, 0, 1, FUSE1 ? IN(I_NMIX) + l * 1024 : nullptr, SCR(), lane); continue; } r -= 2560;
                if (r < 256) { transpose_job_item(IN(I_WBNA) + (size_t)l * 512 * 1024, 1024, 1024, r, WCAT, 1024, 0, 0, 1, 0, 0, nullptr, SCR(), lane); continue; } r -= 256;
                if (r < 128) { transpose_job_item(IN(I_WBS5) + (size_t)l * 256 * 1024, 1024, 1024, r, WCAT, 1024, 512, 0, 1, 0, 0, nullptr, SCR(), lane); continue; } r -= 128;
                if (r < 128) { transpose_job_item(IN(I_WBXA) + (size_t)l * 256 * 1024, 1024, 1024, r, WCAT, 1024, 768, 0, 1, 0, 0, nullptr, SCR(), lane); continue; } r -= 128;
                if (r < 512) { transpose_job_item(IN(I_WOUT) + (size_t)l * 1024 * 1024, 1024, 1024, r, WOUT, 1024, 0, 0, 1, 0, 0, nullptr, SCR(), lane); continue; } r -= 512;
                if (r < 32) { transpose_job_item(IN(I_WGLU) + (size_t)l * 256 * 512, 512, 256, r, WGLU, 256, 0, 0, 2, 0, 0, nullptr, SCR(), lane); continue; } r -= 32;
                transpose_job_item(IN(I_WGLU) + (size_t)l * 256 * 512 + 256, 512, 256, r, WGLU, 256, 0, 0, 2, 1, 0, nullptr, SCR(), lane);
            }
            }
            {
            const f32x2* APOW = WP(f32x2, WS_APOW); const f32x2* BBAR = WP(f32x2, WS_BBAR); bf16* S5W = WP(bf16, WS_S5W);
            for (int it = GT(); it < 16 * 256 * 64; it += NGT) {
                const int k8 = it & 63, n = (it >> 6) & 255, g = it >> 14;
                const int s = k8 >> 1, c0 = (k8 & 1) * 8, d = n >> 7, ri = (n >> 6) & 1, p = n & 63, e = d == 0 ? 31 - s : s, base = (l * 2 + d) * 16 + g;
                const f32x2 a = APOW[((size_t)base * 33 + e) * 64 + p]; const f32x2* bb = BBAR + ((size_t)base * 64 + p) * 16 + c0;
                float v[8];
#pragma unroll
                for (int j = 0; j < 8; ++j) { const f32x2 b = bb[j]; v[j] = ri == 0 ? a.x * b.x - a.y * b.y : a.x * b.y + a.y * b.x; }
                u32x4 w; w.x = cvt_pk_bf16(v[0], v[1]); w.y = cvt_pk_bf16(v[2], v[3]); w.z = cvt_pk_bf16(v[4], v[5]); w.w = cvt_pk_bf16(v[6], v[7]);
                gst<u32x4>(S5W + ((size_t)(g * 256 + n) * 512 + k8 * 8), w);
            }
            const float* KT = WP(float, WS_KT); bf16* S5KV = WP(bf16, WS_S5KV); const float* CRE = IN(I_CRE); const float* CIM = IN(I_CIM);
            for (int it = GT(); it < 16 * 512 * 96; it += NGT) {
                const int k8 = it % 96, rest = it / 96, n = rest & 511, g = rest >> 9, t = n >> 4, c = n & 15;
                float v[8];
                if (k8 < 64) { const int s = k8 >> 1, c0 = (k8 & 1) * 8, tp = t - s + 31; const float* kp = KT + ((size_t)(((l * 16 + g) * 63 + tp) * 16 + c) * 16 + c0);
                    const f32x4 a = gld<f32x4>(kp), b = gld<f32x4>(kp + 4); v[0] = a[0]; v[1] = a[1]; v[2] = a[2]; v[3] = a[3]; v[4] = b[0]; v[5] = b[1]; v[6] = b[2]; v[7] = b[3]; }
                else { const int jj = (k8 - 64) * 8, d = jj >> 7, ri = (jj >> 6) & 1, p0 = jj & 63, e = d == 0 ? t + 1 : 32 - t, base = (l * 2 + d) * 16 + g;
                    const float* cre = CRE + ((size_t)base * 16 + c) * 64 + p0; const float* cim = CIM + ((size_t)base * 16 + c) * 64 + p0; const f32x2* ap = APOW + ((size_t)base * 33 + e) * 64 + p0;
#pragma unroll
                    for (int j = 0; j < 8; ++j) { const f32x2 a = ap[j]; const float cr = cre[j], ci = cim[j]; v[j] = ri == 0 ? cr * a.x - ci * a.y : -(cr * a.y + ci * a.x); } }
                u32x4 w; w.x = cvt_pk_bf16(v[0], v[1]); w.y = cvt_pk_bf16(v[2], v[3]); w.z = cvt_pk_bf16(v[4], v[5]); w.w = cvt_pk_bf16(v[6], v[7]);
                gst<u32x4>(S5KV + ((size_t)(g * 512 + n) * ATK + k8 * 8), w);
            }
            }
            if (!FUSE1) { bf16* H = WP(bf16, WS_H); const float* gn = IN(I_NMIX) + l * 1024;
              for (int grp = gw; grp < M / 4; grp += NGW) norm_rows4<false>(l == 0 ? xin0 : XO, gn, H, grp * 4, lane, nullptr, nullptr, nullptr, nullptr, nullptr, nullptr, l == 0 ? nullptr : XO); }
        }
        GRID_BAR();
        }

        for (int rep_ = 0; rep_ < NREP(3); ++rep_) {
        if (PH(3)) {
            WSL();
            pg8::Gemm g{WP(bf16, WS_H), WP(bf16, WS_WIN), 1024, 1024, 1024}; pg8::StaticOrder S; S.init(M / 256, INC / 256, G, bid);
            EpiProj E{WP(bf16, WS_QK), WP(bf16, WS_VT8), WP(bf16, WS_AT), WP(bf16, WS_QX), WP(bf16, WS_GATES), IN(I_BGATE) + l * 3072, FUSE1 ? WP(float, WS_SS) + (size_t)l * M * 16 : nullptr};
            pg8::gemm_phase<EpiProj, pg8::StaticOrder>(F.lds, g, S, E, tid);
        }
        GRID_BAR();
        }

        for (int rep_ = 0; rep_ < NREP(4); ++rep_) {
        if (PH(4)) {
            WSL();
            for (int bg = bid; bg < 64; bg += G) {
                { pg8::Gemm g{WP(bf16, WS_AT), WP(bf16, WS_S5W), ATK, 512, 512}; pg8::ListOrder S{bg, 1, 1}; EpiS5a E{WP(float, WS_ST)};
                  pg8::gemm_phase<EpiS5a, pg8::ListOrder>(F.lds, g, S, E, tid); }
                WG_MEM_SYNC();
                s5_scan_item(bg * 2, WP(float, WS_ST), WP(bf16, WS_AT), WP(f32x2, WS_APOW) + (size_t)l * 2 * 16 * 33 * 64, (LAS float*)F.lds, tid);
                s5_scan_item(bg * 2 + 1, WP(float, WS_ST), WP(bf16, WS_AT), WP(f32x2, WS_APOW) + (size_t)l * 2 * 16 * 33 * 64, (LAS float*)F.lds, tid);
                WG_MEM_SYNC();
                { pg8::Gemm g{WP(bf16, WS_AT), WP(bf16, WS_S5KV), ATK, ATK, ATK}; pg8::ListOrder S{bg, 2, 2}; EpiS5c E{WP(bf16, WS_Y)};
                  pg8::gemm_phase<EpiS5c, pg8::ListOrder>(F.lds, g, S, E, tid); }
            }
            unsigned* qhead = WP(unsigned, WS_CTL) + CW_Q + (l + 4 * rep_) * 64;
            volatile LAS int* qslot = (volatile LAS int*)(F.lds + MISC_OFF + 64);
            for (;;) {
                if (tid == 0) qslot[0] = (int)__hip_atomic_fetch_add((GASP unsigned*)qhead, 1u, __ATOMIC_RELAXED, __HIP_MEMORY_SCOPE_AGENT);
                __syncthreads();
                const int qi = __builtin_amdgcn_readfirstlane(qslot[0]);
                __syncthreads();
                if (qi >= 768) break;
                if (qi < 512) NA_ITEM(qi); else XA_ITEMS(qi - 512, qi - 511, 1);
            }
        }
        GRID_BAR();
        }

        for (int rep_ = 0; rep_ < NREP(7); ++rep_) {
        if (PH(7)) {
            WSL();
            pg8::Gemm g{WP(bf16, WS_Y), WP(bf16, WS_WGLU), 256, 256, 256}; pg8::StaticOrder S; S.init(M / 256, 2, G, bid); EpiGlu E{WP(bf16, WS_H)};
            pg8::gemm_phase<EpiGlu, pg8::StaticOrder>(F.lds, g, S, E, tid);
        }
        GRID_BAR();
        }

        for (int rep_ = 0; rep_ < NREP(8); ++rep_) {
        if (PH(8)) {
            WSL();
            pg8::Gemm g{WP(bf16, WS_H), WP(bf16, WS_WCAT), 1024, 1024, 1024}; pg8::StaticOrder S; S.init(M / 256, 4, G, bid); EpiMerge E{WP(unsigned char, WS_GATES), WP(bf16, WS_QK)};
            pg8::gemm_phase<EpiMerge, pg8::StaticOrder, false, true>(F.lds, g, S, E, tid);
        }
        GRID_BAR();
        }

        for (int rep_ = 0; rep_ < NREP(9); ++rep_) {
        if (PH(9)) {
            WSL();
            pg8::Gemm g{WP(bf16, WS_QK), WP(bf16, WS_WOUT), 1024, 1024, 1024}; pg8::StaticOrder S; S.init(M / 256, 4, G, bid); EpiDelta E{WP(bf16, WS_H)};
            pg8::gemm_phase<EpiDelta, pg8::StaticOrder>(F.lds, g, S, E, tid);
        }
        GRID_BAR();
        }

        for (int rep_ = 0; rep_ < NREP(10); ++rep_) {
        if (PH(10)) {
            WSL();
            {
            unsigned* cnt = WP(unsigned, WS_CTL) + CW_CNT + (l + 4 * rep_) * NBUCKET * 64;
            const float* bco = IN(I_BCO) + l * 4; const float* bfi = IN(I_BFI) + l * 16;
            int* LIST = rep_ ? WP(int, WS_GATES + 100 * MiB) : WP(int, WS_LIST); float* WTS = rep_ ? WP(float, WS_GATES + 104 * MiB) : WP(float, WS_WTS);
            { const u32x4* src = (const u32x4*)(WP(bf16, WS_WRT) + (size_t)l * 2 * 20480);
              for (int idx = tid; idx < 40 * 128; idx += NWAVES * 64) *(LAS u32x4*)(F.lds + (idx >> 7) * RT_STRIDE + (idx & 127) * 16) = gld<u32x4>(src + idx); }
            __syncthreads();
            for (int grp = gw; grp < M / 16; grp += NGW) router_rows16(l == 0 ? xin0 : XO, XO, rep_ ? nullptr : WP(bf16, WS_H), WP(bf16, WS_H), grp * 16, lane, F.lds, wave, bco, bfi, cnt, LIST, WTS);
            __syncthreads();
            }
            bf16* WGU = WP(bf16, WS_WGU); bf16* WDP = WP(bf16, WS_WDP);
            for (int it = gw; it < 10240; it += NGW) {
                int r = it;
                if (r < 2048) { const int e = r >> 7; transpose_job_item(IN(I_WG) + (size_t)(l * 16 + e) * 1024 * 256, 256, 256, r & 127, WGU + (size_t)e * 512 * 1024, 1024, 0, 0, 2, 0, 0, IN(I_NFFN) + l * 1024, SCR(), lane); continue; } r -= 2048;
                if (r < 2048) { const int e = r >> 7; transpose_job_item(IN(I_WU) + (size_t)(l * 16 + e) * 1024 * 256, 256, 256, r & 127, WGU + (size_t)e * 512 * 1024, 1024, 0, 0, 2, 1, 0, IN(I_NFFN) + l * 1024, SCR(), lane); continue; } r -= 2048;
                const int ej = r >> 7, e = ej / 3, jj = ej % 3, i = e & 3, grpI = e >> 2, o = jj + (jj >= i ? 1 : 0), a = i < o ? i : o, b = i < o ? o : i;
                const int pair = grpI * 6 + (a == 0 ? b - 1 : (a == 1 ? b + 1 : 5)), slot = (i == a) ? 0 : 1;
                transpose_job_item(IN(I_WD) + (size_t)(l * 16 + e) * 256 * 1024, 1024, 1024, r & 127, WDP + (size_t)pair * 1024 * 512, 512, slot * 256, 0, 1, 0, 0, nullptr, SCR(), lane);
            }
        }
        GRID_BAR();
        }

        LAS int* tab = (LAS int*)(F.lds + TAB_OFF);
        for (int rep_ = 0; rep_ < NREP(11); ++rep_) {
        if (PH(11)) {
            WSL();
            unsigned* cnt = WP(unsigned, WS_CTL) + CW_CNT + l * NBUCKET * 64;
            if (tid == 0) { int st = 0;
                for (int b = 0; b < NBUCKET; ++b) { const int c = (int)__hip_atomic_load((GASP unsigned*)(cnt + b * 64), __ATOMIC_RELAXED, __HIP_MEMORY_SCOPE_AGENT); tab[b] = c; tab[32 + b] = st; st += (c + 255) >> 8; }
                tab[32 + NBUCKET] = st; tab[64] = st; }
            __syncthreads();
            pg8::Gemm g{WP(bf16, WS_H), WP(bf16, WS_WGU), 1024, 1024, 1024}; pg8::MoeOrder S{tab, WP(int, WS_LIST), G, bid, 0}; EpiMoe1 E{WP(bf16, WS_ACT), WP(float, WS_WTS)};
            pg8::gemm_phase<EpiMoe1, pg8::MoeOrder, true>(F.lds, g, S, E, tid);
        }
        GRID_BAR();
        }

        for (int rep_ = 0; rep_ < NREP(12); ++rep_) {
        if (PH(12)) {
            WSL();
            pg8::Gemm g{WP(bf16, WS_ACT), WP(bf16, WS_WDP), 512, 512, 512}; pg8::MoeOrder S{tab, WP(int, WS_LIST), G, bid, 1}; EpiMoe2 E{WP(bf16, WS_H), WP(int, WS_LIST)};
            pg8::gemm_phase<EpiMoe2, pg8::MoeOrder>(F.lds, g, S, E, tid);
        }
        GRID_BAR();
        }
    }
    { WSL(); const float* gn = IN(I_FNORM);
      for (int row = gw; row < M; row += NGW) final_norm_row(XO, WP(bf16, WS_H), gn, row, lane); }
#undef GRID_BAR
}

extern "C" void kernel_launch(void* const* d_in, const int* in_sizes, int n_in, void* d_out, int out_size, void* d_ws, size_t ws_size, hipStream_t stream) {
    static int grid = 0;
    if (grid == 0) {
        if (n_in != 30 || out_size != M * D || ws_size < WS_END) { fprintf(stderr, "kernel_launch: unexpected shapes (n_in %d, out %d, ws %zu)\n", n_in, out_size, ws_size); grid = -1; return; }
        int dev = 0, cus = 0, per_cu = 0;
        if (hipGetDevice(&dev) != hipSuccess || hipDeviceGetAttribute(&cus, hipDeviceAttributeMultiprocessorCount, dev) != hipSuccess) { grid = -1; return; }
        if (hipFuncSetAttribute((const void*)fwd_kernel, hipFuncAttributeMaxDynamicSharedMemorySize, LDS_BYTES) != hipSuccess) { fprintf(stderr, "kernel_launch: hipFuncSetAttribute failed\n"); grid = -1; return; }
        if (hipOccupancyMaxActiveBlocksPerMultiprocessor(&per_cu, (const void*)fwd_kernel, NWAVES * 64, LDS_BYTES) != hipSuccess || per_cu < 1) { fprintf(stderr, "kernel_launch: occupancy query reports %d\n", per_cu); }
        (void)hipGetLastError();
        grid = cus;
    }
    if (grid < 0) return;
    (void)in_sizes;
    (void)hipMemsetAsync((char*)d_ws + WS_CTL, 0, CTL_BYTES, stream);
    Args a{};
    for (int i = 0; i < 30; ++i) a.in[i] = (const float*)d_in[i];
    a.out = (float*)d_out; a.ws = (unsigned char*)d_ws;
    hipLaunchKernelGGL(fwd_kernel, dim3(grid), dim3(NWAVES * 64), LDS_BYTES, stream, a);
}
```

```cpp
#include <hip/hip_runtime.h>
#include <cstdio>
#include <cstdint>

#define LAS __attribute__((address_space(3)))
typedef unsigned short bf16;
typedef short bf16x8 __attribute__((ext_vector_type(8)));
typedef float f32x4 __attribute__((ext_vector_type(4)));
typedef float f32x2 __attribute__((ext_vector_type(2)));
typedef unsigned u32x4 __attribute__((ext_vector_type(4)));
typedef unsigned u32x2 __attribute__((ext_vector_type(2)));

constexpr int D = 1024, BATCH = 4, SEQ = 8192, M = BATCH * SEQ, DEPTH = 4;
constexpr int INC = 5120, NMEM = 256;
constexpr int NCHUNK = 256, TCH = 32;
constexpr int ATK = 768;
constexpr int LCAP = 32768;
constexpr int NBUCKET = 24;
constexpr float RMS_EPS = 1e-6f;

constexpr size_t MiB = 1u << 20;
constexpr size_t WS_CTL = 0, CTL_BYTES = 1 * MiB;
constexpr size_t WS_APOW = 1 * MiB;
constexpr size_t WS_BBAR = 4 * MiB;
constexpr size_t WS_KT = 5 * MiB;
constexpr size_t WS_WRT = 10 * MiB;
constexpr size_t WS_RPBP = 10 * MiB + 512 * 1024;
constexpr size_t WS_MEMN = 11 * MiB;
constexpr size_t WS_WMKV = 19 * MiB;
constexpr size_t WS_KM = 23 * MiB;
constexpr size_t WS_VM8 = 25 * MiB;
constexpr size_t WS_WIN = 27 * MiB;
constexpr size_t WS_WCAT = 37 * MiB;
constexpr size_t WS_WOUT = 39 * MiB;
constexpr size_t WS_WGLU = 41 * MiB;
constexpr size_t WS_S5W = 42 * MiB;
constexpr size_t WS_S5KV = 46 * MiB;
constexpr size_t WS_H = 58 * MiB;
constexpr size_t WS_QK = 122 * MiB;
constexpr size_t WS_VT8 = 186 * MiB;
constexpr size_t WS_AT = 218 * MiB;
constexpr size_t WS_QX = 242 * MiB;
constexpr size_t WS_ST = 258 * MiB;
constexpr size_t WS_Y = 274 * MiB;
constexpr size_t WS_GATES = 290 * MiB;
constexpr size_t WS_WGU = WS_GATES;
constexpr size_t WS_WDP = WS_GATES + 16 * MiB;
constexpr size_t WS_ACT = WS_GATES + 40 * MiB;
constexpr size_t WS_LIST = 482 * MiB;
constexpr size_t WS_WTS = 485 * MiB;
constexpr size_t WS_SS = 497 * MiB;
constexpr size_t WS_END = 505 * MiB;
constexpr int CW_BAR = 4096;
constexpr int CW_CNT = 16384;
constexpr int CW_Q = 32768;

__device__ __forceinline__ unsigned cvt_pk_bf16(float lo, float hi) { unsigned r; asm volatile("v_cvt_pk_bf16_f32 %0, %1, %2" : "=v"(r) : "v"(lo), "v"(hi)); return r; }
__device__ __forceinline__ float bf2f(unsigned short b) { return __uint_as_float(((unsigned)b) << 16); }
__device__ __forceinline__ float bflo(unsigned w) { return __uint_as_float(w << 16); }
__device__ __forceinline__ float bfhi(unsigned w) { return __uint_as_float(w & 0xffff0000u); }
__device__ __forceinline__ float fast_rcp(float x) { return __builtin_amdgcn_rcpf(x); }
__device__ __forceinline__ float fast_exp(float x) { return __builtin_amdgcn_exp2f(x * 1.4426950408889634f); }
__device__ __forceinline__ float sigmoid_f(float x) { return fast_rcp(1.0f + fast_exp(-x)); }
__device__ __forceinline__ float gelu_tanh_f(float x) { const float u = 1.5957691216057308f * (x + 0.044715f * x * x * x); return x * fast_rcp(1.0f + fast_exp(-u)); }
__device__ __forceinline__ float shfl_xor_f(float v, int o, int lane) { return __int_as_float(__builtin_amdgcn_ds_bpermute((lane ^ o) << 2, __float_as_int(v))); }
__device__ __forceinline__ float shfl_idx_f(float v, int src) { return __int_as_float(__builtin_amdgcn_ds_bpermute(src << 2, __float_as_int(v))); }
__device__ __forceinline__ float wave_sum(float v, int lane) {
#pragma unroll
    for (int o = 1; o < 64; o <<= 1) v += shfl_xor_f(v, o, lane);
    return v;
}
#define GASP __attribute__((address_space(1)))
template <class T> __device__ __forceinline__ T gld(const void* p) { return *(const GASP T*)p; }
template <class T> __device__ __forceinline__ void gst(void* p, const T& v) { *(GASP T*)p = v; }
__device__ __forceinline__ unsigned q8(float g) { return (unsigned)__builtin_fminf(__builtin_fmaxf(__builtin_rintf(g * 255.0f), 1.0f), 255.0f); }
__device__ __forceinline__ unsigned q8x4(float a, float b, float c, float d) { return q8(a) | (q8(b) << 8) | (q8(c) << 16) | (q8(d) << 24); }
#define LDS_WAIT() asm volatile("s_waitcnt lgkmcnt(0)" ::: "memory")
#define VM_WAIT() asm volatile("s_waitcnt vmcnt(0)" ::: "memory")

namespace pg8 {
constexpr int BM = 256, BK = 64, HALF = 128, HTB = HALF * BK * 2, STAGE_BYTES = 8 * HTB, NXCD = 8, WGM = 8;
__host__ __device__ __forceinline__ int lds_byte(int r, int c) { const int st = (r >> 4) * 2 + (c >> 5), rr = r & 15, cc = c & 31, ob = rr * 64 + cc * 2; return st * 1024 + (ob ^ (((ob >> 9) & 1) << 5)); }
__host__ __device__ __forceinline__ void stage_rc(int b, int& R, int& C) { const int st = b / 1024, sb = b % 1024, swz = sb ^ (((sb >> 9) & 1) << 5); R = (st >> 1) * 16 + swz / 64; C = (st & 1) * 32 + (swz % 64) / 2; }
__host__ __device__ __forceinline__ int perm32(int rho) { const int n = rho >> 4, i = rho & 15; return 8 * (i >> 2) + 4 * n + (i & 3); }

struct Unit { int pm, pn, am, bn, x0, x1, x2; };
struct Gemm { const bf16* A; const bf16* Bt; int lda, ldb, K; };

struct StaticOrder {
    int nM, nN, nwg, G, c;
    __device__ void init(int nM_, int nN_, int G_, int c_) { nM = nM_; nN = nN_; nwg = nM * nN; G = G_; c = c_; }
    __device__ bool next(int i, Unit& u) const {
        const long L = (long)i * G + c; if (L >= nwg) return false;
        int wgid = (int)L; { const int q = nwg / NXCD, r = nwg % NXCD, xcd = wgid % NXCD, off = wgid / NXCD; wgid = (xcd < r ? xcd * (q + 1) : r * (q + 1) + (xcd - r) * q) + off; }
        const int nig = WGM * nN, gid = wgid / nig, fm = gid * WGM, gsz = (nM - fm) < WGM ? (nM - fm) : WGM;
        u.pm = __builtin_amdgcn_readfirstlane(fm + ((wgid % nig) % gsz)); u.pn = __builtin_amdgcn_readfirstlane((wgid % nig) / gsz);
        u.am = u.pm; u.bn = u.pn; u.x0 = 0; u.x1 = 0; u.x2 = 0; return true;
    }
    __device__ __forceinline__ int a_row(const Unit&, int) const { return 0; }
};
struct S5Order : StaticOrder {
    __device__ bool next(int i, Unit& u) const { if (!StaticOrder::next(i, u)) return false; u.bn = (u.pm & 15) * nN + u.pn; return true; }
};
struct ListOrder {
    int pm, n, nN;
    __device__ bool next(int i, Unit& u) const { if (i >= n) return false; u.pm = pm; u.pn = i; u.am = pm; u.bn = (pm & 15) * nN + i; u.x0 = 0; u.x1 = 0; u.x2 = 0; return true; }
    __device__ __forceinline__ int a_row(const Unit&, int) const { return 0; }
};
struct MemOrder {
    int G, c;
    __device__ bool next(int i, Unit& u) const { const int L = i * G + c; if (L >= 32) return false; u.pm = L >> 1; u.pn = L & 1; u.am = u.pm; u.bn = (u.pm >> 2) * 2 + u.pn; u.x0 = 0; u.x1 = 0; u.x2 = 0; return true; }
    __device__ __forceinline__ int a_row(const Unit&, int) const { return 0; }
};
struct MoeOrder {
    const LAS int* tab; const int* list; int G, c, mode;
    __device__ bool next(int i, Unit& u) const {
        const int T = __builtin_amdgcn_readfirstlane(tab[64]); const int L = i * G + c; if (L >= T * 4) return false;
        const int tile = L >> 2, pn = L & 3; int b = 0;
#pragma unroll 1
        for (int j = 1; j < NBUCKET; ++j) if (__builtin_amdgcn_readfirstlane(tab[32 + j]) <= tile) b = j;
        u.pm = tile; u.pn = pn; u.am = tile; u.x0 = b; u.x1 = (tile - __builtin_amdgcn_readfirstlane(tab[32 + b])) * 256; u.x2 = __builtin_amdgcn_readfirstlane(tab[b]);
        const int grp = __builtin_amdgcn_readfirstlane(b / 6), pi = __builtin_amdgcn_readfirstlane(b % 6); const int ea = pi < 3 ? 0 : (pi < 5 ? 1 : 2), eb = pi < 3 ? pi + 1 : (pi < 5 ? pi - 1 : 3);
        if (mode == 0) { const int e = grp * 4 + ((pn >> 1) ? eb : ea); u.bn = e * 2 + (pn & 1); } else u.bn = b * 4 + pn;
        return true;
    }
    __device__ __forceinline__ int a_row(const Unit& u, int r) const { const int slot = u.x1 + r; return slot < u.x2 ? gld<int>(list + (unsigned)(u.x0 * LCAP + slot)) : 0; }
};

template <class Epi, class Sched, bool GATHER = false, bool KHOOK = false>
__device__ __forceinline__ void gemm_phase(LAS unsigned char* lds, const Gemm g, const Sched& S, const Epi& E, int tid_in) {
    int tid = tid_in; asm volatile("" : "+v"(tid));
    const int wid = __builtin_amdgcn_readfirstlane(tid >> 6), lane = tid & 63, wr = wid >> 2, wc = wid & 3, fr = lane & 15, fq = lane >> 4;
    int K = g.K, lda = g.lda, ldb = g.ldb;
    asm volatile("" : "+s"(K), "+s"(lda), "+s"(ldb));
    const int nt = K / BK;
    unsigned voffA[2], voffB[2]; int Rr[2], Cc[2];
#pragma unroll
    for (int i = 0; i < 2; ++i) { int R, C; stage_rc(tid * 16 + i * 8192, R, C); const int Rb = Epi::PERM ? ((R & ~31) + perm32(R & 31)) : R;
        voffA[i] = (unsigned)(R * lda + C) * 2u; voffB[i] = (unsigned)(Rb * ldb + C) * 2u; Rr[i] = R; Cc[i] = C; }
    const unsigned kstep = (unsigned)(BK * 2);
    const unsigned hstepA = (unsigned)(HALF * lda * 2), tstepA = 2u * hstepA, hstepB = (unsigned)(HALF * ldb * 2), tstepB = 2u * hstepB;
    const unsigned ldsw = (unsigned)wid * 1024u;
    const int aoff = lds_byte(wr * 64 + fr, fq * 8), boff = lds_byte(wc * 32 + fr, fq * 8);
    unsigned vC[2][2] = {{0u, 0u}, {0u, 0u}}, vN[2][2] = {{0u, 0u}, {0u, 0u}};
#define PG8_SA(b, h) (((b) * 2 + (h)) * HTB)
#define PG8_SB(b, h) ((4 + (b) * 2 + (h)) * HTB)
#define PG8_STAGE(bufoff, gbase, voff) do { _Pragma("unroll") for (int _i = 0; _i < 2; ++_i) \
        __builtin_amdgcn_global_load_lds((const unsigned*)((const char*)(gbase) + (voff)[_i]), (LAS unsigned*)(lds + (bufoff) + ldsw + _i * 8192), 16, 0, 0); } while (0)
#define PG8_STA(bufoff, ptr, h, nx) do { if constexpr (GATHER) { unsigned _v[2]; _v[0] = (nx) ? vN[h][0] : vC[h][0]; _v[1] = (nx) ? vN[h][1] : vC[h][1]; PG8_STAGE(bufoff, ptr, _v); } \
        else { PG8_STAGE(bufoff, (ptr) + (h) * hstepA, voffA); } } while (0)
#define PG8_STB(bufoff, ptr, h) PG8_STAGE(bufoff, (ptr) + (h) * hstepB, voffB)
#define PG8_LDA(dst, b, h) do { _Pragma("unroll") for (int m = 0; m < 4; ++m) _Pragma("unroll") for (int k = 0; k < 2; ++k) dst[m][k] = *(const LAS bf16x8*)(lds + PG8_SA(b, h) + aoff + m * 2048 + k * 1024); } while (0)
#define PG8_LDB(dst, b, h) do { _Pragma("unroll") for (int n = 0; n < 2; ++n) _Pragma("unroll") for (int k = 0; k < 2; ++k) dst[n][k] = *(const LAS bf16x8*)(lds + PG8_SB(b, h) + boff + n * 2048 + k * 1024); } while (0)
#define PG8_MMA(ai, bj, At, Bt) do { __builtin_amdgcn_s_setprio(1); _Pragma("unroll") for (int m = 0; m < 4; ++m) _Pragma("unroll") for (int n = 0; n < 2; ++n) _Pragma("unroll") for (int k = 0; k < 2; ++k) \
        acc[ai][bj][m][n] = __builtin_amdgcn_mfma_f32_16x16x32_bf16(Bt[n][k], At[m][k], acc[ai][bj][m][n], 0, 0, 0); __builtin_amdgcn_s_setprio(0); } while (0)
#define PG8_WAIT_V(n) asm volatile("s_waitcnt vmcnt(" #n ")" ::: "memory")
#define PG8_WAIT_L(n) asm volatile("s_waitcnt lgkmcnt(" #n ")" ::: "memory")
#define PG8_BAR __builtin_amdgcn_s_barrier()
#define PG8_SCHED __builtin_amdgcn_sched_barrier(0)
    Unit cur, nxt; int ui = 0;
    if (!S.next(0, cur)) return;
    f32x4 acc[2][2][4][2];
#pragma unroll
    for (int a = 0; a < 2; ++a)
#pragma unroll
        for (int b = 0; b < 2; ++b)
#pragma unroll
            for (int m = 0; m < 4; ++m)
#pragma unroll
                for (int n = 0; n < 2; ++n) acc[a][b][m][n] = (f32x4){0.f, 0.f, 0.f, 0.f};
    bf16x8 At[4][2], B0[2][2], B1[2][2];
    const char* cA = GATHER ? (const char*)g.A : (const char*)g.A + (unsigned)cur.am * tstepA;
    const char* cB = (const char*)g.Bt + (unsigned)cur.bn * tstepB;
    if constexpr (GATHER) {
#pragma unroll
        for (int h = 0; h < 2; ++h)
#pragma unroll
            for (int i = 0; i < 2; ++i) vC[h][i] = (unsigned)(S.a_row(cur, h * HALF + Rr[i]) * lda + Cc[i]) * 2u;
    }
    PG8_STB(PG8_SB(0, 0), cB, 0); PG8_STB(PG8_SB(0, 1), cB, 1); PG8_STA(PG8_SA(0, 0), cA, 0, false); PG8_STA(PG8_SA(0, 1), cA, 1, false);
    if (wr == 1) PG8_BAR;
    PG8_WAIT_V(2); PG8_BAR;
    PG8_STB(PG8_SB(1, 0), cB + kstep, 0); PG8_STA(PG8_SA(1, 0), cA + kstep, 0, false); PG8_STB(PG8_SB(1, 1), cB + kstep, 1);
    PG8_WAIT_V(6); PG8_BAR;
    for (;;) {
        const bool has_next = S.next(ui + 1, nxt);
        const char* nA = GATHER ? (const char*)g.A : (has_next ? (const char*)g.A + (unsigned)nxt.am * tstepA : cA);
        const char* nB = has_next ? (const char*)g.Bt + (unsigned)nxt.bn * tstepB : cB;
        if constexpr (GATHER) {
#pragma unroll
            for (int h = 0; h < 2; ++h)
#pragma unroll
                for (int i = 0; i < 2; ++i) vN[h][i] = has_next ? (unsigned)(S.a_row(nxt, h * HALF + Rr[i]) * lda + Cc[i]) * 2u : vC[h][i];
        }
        int tb = 0;
#pragma unroll 1
        for (int seg = 0; seg < (KHOOK ? 3 : 1); ++seg) {
        const int te = KHOOK ? (seg == 0 ? 8 : (seg == 1 ? 12 : nt)) : nt;
        for (int t = tb; t < te; t += 2) {
            const bool last = (t == nt - 2);
            const char* a1 = cA + (unsigned)(t + 1) * kstep;
            const char* a2 = last ? nA : cA + (unsigned)(t + 2) * kstep; const char* b2 = last ? nB : cB + (unsigned)(t + 2) * kstep;
            const char* a3 = a2 + kstep; const char* b3 = b2 + kstep;
            PG8_LDB(B0, 0, 0); PG8_LDB(B1, 0, 1); PG8_SCHED; PG8_LDA(At, 0, 0); PG8_STA(PG8_SA(1, 1), a1, 1, false);
            PG8_WAIT_V(8); PG8_WAIT_L(0); PG8_BAR; PG8_MMA(0, 0, At, B0); PG8_MMA(0, 1, At, B1); PG8_BAR; PG8_SCHED;
            PG8_LDA(At, 0, 1); PG8_STB(PG8_SB(0, 0), b2, 0); PG8_STB(PG8_SB(0, 1), b2, 1); PG8_STA(PG8_SA(0, 0), a2, 0, last);
            PG8_WAIT_V(8); PG8_WAIT_L(0); PG8_BAR; PG8_MMA(1, 0, At, B0); PG8_MMA(1, 1, At, B1); PG8_BAR; PG8_SCHED;
            PG8_LDB(B0, 1, 0); PG8_LDB(B1, 1, 1); PG8_SCHED; PG8_LDA(At, 1, 0); PG8_STA(PG8_SA(0, 1), a2, 1, last);
            PG8_WAIT_V(8); PG8_WAIT_L(0); PG8_BAR; PG8_MMA(0, 0, At, B0); PG8_MMA(0, 1, At, B1); PG8_BAR; PG8_SCHED;
            PG8_LDA(At, 1, 1); PG8_STB(PG8_SB(1, 0), b3, 0); PG8_STB(PG8_SB(1, 1), b3, 1); PG8_STA(PG8_SA(1, 0), a3, 0, last);
            PG8_WAIT_V(8); PG8_WAIT_L(0); PG8_BAR; PG8_MMA(1, 0, At, B0); PG8_MMA(1, 1, At, B1); PG8_BAR; PG8_SCHED;
        }
        if constexpr (KHOOK) { if (seg < 2) { unsigned mm_ = ~0u; asm volatile("" : "+s"(mm_)); const int ln_ = (int)__builtin_amdgcn_mbcnt_hi(mm_, __builtin_amdgcn_mbcnt_lo(mm_, 0u)); E.khook(acc, cur, te, wr, wc, ln_ & 15, ln_ >> 4); } }
        tb = te;
        }
        if (wr == 0) PG8_BAR;
        { unsigned mm_ = ~0u; asm volatile("" : "+s"(mm_)); const int ln_ = (int)__builtin_amdgcn_mbcnt_hi(mm_, __builtin_amdgcn_mbcnt_lo(mm_, 0u)); E(acc, cur, wr, wc, ln_ & 15, ln_ >> 4); }
        if (!has_next) break;
#pragma unroll
        for (int a = 0; a < 2; ++a)
#pragma unroll
            for (int b = 0; b < 2; ++b)
#pragma unroll
                for (int m = 0; m < 4; ++m)
#pragma unroll
                    for (int n = 0; n < 2; ++n) acc[a][b][m][n] = (f32x4){0.f, 0.f, 0.f, 0.f};
        cur = nxt; cA = nA; cB = nB; ++ui;
        if constexpr (GATHER) {
#pragma unroll
            for (int h = 0; h < 2; ++h)
#pragma unroll
                for (int i = 0; i < 2; ++i) vC[h][i] = vN[h][i];
        }
        if (wr == 1) PG8_BAR;
    }
    PG8_WAIT_V(0);
    PG8_BAR;
#undef PG8_SA
#undef PG8_SB
#undef PG8_STAGE
#undef PG8_STA
#undef PG8_STB
#undef PG8_LDA
#undef PG8_LDB
#undef PG8_MMA
#undef PG8_WAIT_V
#undef PG8_WAIT_L
#undef PG8_BAR
#undef PG8_SCHED
}
}

using pg8::Unit;
struct EpiProj {
    static constexpr bool PERM = true;
    bf16 *QK, *Vt8, *At, *QX, *GATES; const float* bgate; const float* ssq;
#define EP_LOOP_BEGIN _Pragma("unroll") for (int ai = 0; ai < 2; ++ai) _Pragma("unroll") for (int m = 0; m < 4; ++m) { const int row = row0 + ai * 128 + m * 16; const float rs = rstd[ai][m]; _Pragma("unroll") for (int bj = 0; bj < 2; ++bj) { \
        const f32x4 v0 = acc[ai][bj][m][0] * rs, v1 = acc[ai][bj][m][1] * rs; const int cl = cl0 + bj * 128;
#define EP_LOOP_END } asm volatile("" ::: "memory"); }
    __device__ __forceinline__ void operator()(const f32x4 (&acc)[2][2][4][2], const Unit& u, int wr, int wc, int fr, int fq) const {
        const int pn = u.pn, row0 = u.pm * 256 + wr * 64 + fr, cl0 = wc * 32 + 8 * fq;
        float rstd[2][4];
#pragma unroll
        for (int ai = 0; ai < 2; ++ai)
#pragma unroll
            for (int m = 0; m < 4; ++m) { if (!ssq) { rstd[ai][m] = -1.f; continue; } const float* sp = ssq + (unsigned)((row0 + ai * 128 + m * 16) * 16); const f32x4 a = gld<f32x4>(sp), b = gld<f32x4>(sp + 4), c = gld<f32x4>(sp + 8), d = gld<f32x4>(sp + 12);
                rstd[ai][m] = (((a[0] + a[1]) + (a[2] + a[3])) + ((b[0] + b[1]) + (b[2] + b[3]))) + (((c[0] + c[1]) + (c[2] + c[3])) + ((d[0] + d[1]) + (d[2] + d[3]))); }
#pragma unroll
        for (int ai = 0; ai < 2; ++ai)
#pragma unroll
            for (int m = 0; m < 4; ++m) rstd[ai][m] = rstd[ai][m] < 0.f ? 1.0f : 1.0f / sqrtf(rstd[ai][m] * (1.0f / 1024.0f) + RMS_EPS);
        if (pn < 4) {
            EP_LOOP_BEGIN
                u32x4 w; w.x = cvt_pk_bf16(v0[0], v0[1]); w.y = cvt_pk_bf16(v0[2], v0[3]); w.z = cvt_pk_bf16(v1[0], v1[1]); w.w = cvt_pk_bf16(v1[2], v1[3]);
                gst<u32x4>(QK + (unsigned)row * 1024 + pn * 256 + cl, w);
            EP_LOOP_END
        } else if (pn < 6) {
            EP_LOOP_BEGIN
                const int vc = (pn - 4) * 256 + cl, hh = vc >> 6, dh = vc & 63, b = row >> 13, s = row & 8191;
                bf16* p = Vt8 + ((unsigned)((b * 8 + hh) * 1024 + (s >> 3)) * 64 + dh) * 8 + (s & 7);
                const unsigned w0 = cvt_pk_bf16(v0[0], v0[1]), w1 = cvt_pk_bf16(v0[2], v0[3]), w2 = cvt_pk_bf16(v1[0], v1[1]), w3 = cvt_pk_bf16(v1[2], v1[3]);
                gst<bf16>(p, (bf16)w0); gst<bf16>(p + 8, (bf16)(w0 >> 16)); gst<bf16>(p + 16, (bf16)w1); gst<bf16>(p + 24, (bf16)(w1 >> 16)); gst<bf16>(p + 32, (bf16)w2); gst<bf16>(p + 40, (bf16)(w2 >> 16)); gst<bf16>(p + 48, (bf16)w3); gst<bf16>(p + 56, (bf16)(w3 >> 16));
            EP_LOOP_END
        } else if (pn == 6) {
            EP_LOOP_BEGIN
                const int g = cl >> 4, c0 = cl & 15, b = row >> 13, s = row & 8191;
                u32x4 w; w.x = cvt_pk_bf16(v0[0], v0[1]); w.y = cvt_pk_bf16(v0[2], v0[3]); w.z = cvt_pk_bf16(v1[0], v1[1]); w.w = cvt_pk_bf16(v1[2], v1[3]);
                gst<u32x4>(At + ((unsigned)((b * 16 + g) * 256 + (s >> 5))) * ATK + (s & 31) * 16 + c0, w);
            EP_LOOP_END
        } else if (pn == 7) {
            EP_LOOP_BEGIN
                u32x4 w; w.x = cvt_pk_bf16(v0[0], v0[1]); w.y = cvt_pk_bf16(v0[2], v0[3]); w.z = cvt_pk_bf16(v1[0], v1[1]); w.w = cvt_pk_bf16(v1[2], v1[3]);
                gst<u32x4>(QX + (unsigned)row * 256 + cl, w);
            EP_LOOP_END
        } else {
            EP_LOOP_BEGIN
                const int gc = (pn - 8) * 256 + cl;
                const f32x4 b0 = gld<f32x4>(bgate + gc), b1 = gld<f32x4>(bgate + gc + 4);
                u32x2 w; w.x = q8x4(sigmoid_f(v0[0] + b0[0]), sigmoid_f(v0[1] + b0[1]), sigmoid_f(v0[2] + b0[2]), sigmoid_f(v0[3] + b0[3]));
                w.y = q8x4(sigmoid_f(v1[0] + b1[0]), sigmoid_f(v1[1] + b1[1]), sigmoid_f(v1[2] + b1[2]), sigmoid_f(v1[3] + b1[3]));
                gst<u32x2>((unsigned char*)GATES + (unsigned)row * 3072 + gc, w);
            EP_LOOP_END
        }
    }
#undef EP_LOOP_BEGIN
#undef EP_LOOP_END
};
struct EpiMemKV {
    static constexpr bool PERM = true;
    bf16 *Km, *Vm8;
    __device__ __forceinline__ void operator()(const f32x4 (&acc)[2][2][4][2], const Unit& u, int wr, int wc, int fr, int fq) const {
        const int row0 = u.pm * 256 + wr * 64 + fr, cl0 = wc * 32 + 8 * fq;
#pragma unroll
        for (int ai = 0; ai < 2; ++ai)
#pragma unroll
            for (int m = 0; m < 4; ++m) {
                const int row = row0 + ai * 128 + m * 16;
#pragma unroll
                for (int bj = 0; bj < 2; ++bj) {
                    const f32x4 v0 = acc[ai][bj][m][0], v1 = acc[ai][bj][m][1];
                    const int cl = cl0 + bj * 128;
                    const unsigned w0 = cvt_pk_bf16(v0[0], v0[1]), w1 = cvt_pk_bf16(v0[2], v0[3]), w2 = cvt_pk_bf16(v1[0], v1[1]), w3 = cvt_pk_bf16(v1[2], v1[3]);
                    if (u.pn == 0) { u32x4 w; w.x = w0; w.y = w1; w.z = w2; w.w = w3; gst<u32x4>(Km + (unsigned)row * 256 + cl, w); }
                    else {
                        const int hh = cl >> 6, dh = cl & 63, lb = row >> 8, mm = row & 255;
                        bf16* p = Vm8 + ((unsigned)((lb * 4 + hh) * 32 + (mm >> 3)) * 64 + dh) * 8 + (mm & 7);
                        gst<bf16>(p, (bf16)w0); gst<bf16>(p + 8, (bf16)(w0 >> 16)); gst<bf16>(p + 16, (bf16)w1); gst<bf16>(p + 24, (bf16)(w1 >> 16)); gst<bf16>(p + 32, (bf16)w2); gst<bf16>(p + 40, (bf16)(w2 >> 16)); gst<bf16>(p + 48, (bf16)w3); gst<bf16>(p + 56, (bf16)(w3 >> 16));
                    }
                }
                asm volatile("" ::: "memory");
            }
    }
};
struct EpiS5a {
    static constexpr bool PERM = false;
    float* ST;
    __device__ __forceinline__ void operator()(const f32x4 (&acc)[2][2][4][2], const Unit& u, int wr, int wc, int fr, int fq) const {
        const int row0 = u.am * 256 + wr * 64 + fr, col0 = wc * 32 + 4 * fq;
#pragma unroll
        for (int ai = 0; ai < 2; ++ai)
#pragma unroll
            for (int m = 0; m < 4; ++m) { float* rowp = ST + (unsigned)(row0 + ai * 128 + m * 16) * 256 + col0;
#pragma unroll
                for (int bj = 0; bj < 2; ++bj)
#pragma unroll
                    for (int n = 0; n < 2; ++n) gst<f32x4>(rowp + bj * 128 + n * 16, acc[ai][bj][m][n]);
                asm volatile("" ::: "memory"); }
    }
};
struct EpiS5c {
    static constexpr bool PERM = true;
    bf16* Y;
    __device__ __forceinline__ void operator()(const f32x4 (&acc)[2][2][4][2], const Unit& u, int wr, int wc, int fr, int fq) const {
        const int b = u.am >> 4, g = u.am & 15, r0 = wr * 64 + fr, cl0 = u.pn * 256 + wc * 32 + 8 * fq;
#pragma unroll
        for (int ai = 0; ai < 2; ++ai)
#pragma unroll
            for (int m = 0; m < 4; ++m) {
                const int chunk = r0 + ai * 128 + m * 16;
#pragma unroll
                for (int bj = 0; bj < 2; ++bj) {
                    const f32x4 v0 = acc[ai][bj][m][0], v1 = acc[ai][bj][m][1];
                    const int col = cl0 + bj * 128, t = col >> 4, c0 = col & 15;
                    u32x4 w; w.x = cvt_pk_bf16(gelu_tanh_f(v0[0]), gelu_tanh_f(v0[1])); w.y = cvt_pk_bf16(gelu_tanh_f(v0[2]), gelu_tanh_f(v0[3]));
                    w.z = cvt_pk_bf16(gelu_tanh_f(v1[0]), gelu_tanh_f(v1[1])); w.w = cvt_pk_bf16(gelu_tanh_f(v1[2]), gelu_tanh_f(v1[3]));
                    gst<u32x4>(Y + (unsigned)(b * SEQ + chunk * 32 + t) * 256 + g * 16 + c0, w);
                }
                asm volatile("" ::: "memory");
            }
    }
};
struct EpiGlu {
    static constexpr bool PERM = true;
    bf16* CAT;
    __device__ __forceinline__ void operator()(const f32x4 (&acc)[2][2][4][2], const Unit& u, int wr, int wc, int fr, int fq) const {
        const int row0 = u.pm * 256 + wr * 64 + fr, cl0 = u.pn * 256 + wc * 32 + 8 * fq;
#pragma unroll
        for (int ai = 0; ai < 2; ++ai)
#pragma unroll
            for (int m = 0; m < 4; ++m) {
                const int row = row0 + ai * 128 + m * 16;
#pragma unroll
                for (int bj = 0; bj < 2; ++bj) {
                    const f32x4 v0 = acc[ai][bj][m][0], v1 = acc[ai][bj][m][1];
                    const int col = cl0 + bj * 128;
                    u32x2 w; w.x = cvt_pk_bf16(v0[0] * sigmoid_f(v0[1]), v0[2] * sigmoid_f(v0[3])); w.y = cvt_pk_bf16(v1[0] * sigmoid_f(v1[1]), v1[2] * sigmoid_f(v1[3]));
                    gst<u32x2>(CAT + (unsigned)row * 1024 + 512 + (col >> 1), w);
                }
                asm volatile("" ::: "memory");
            }
    }
};
struct EpiMerge {
    static constexpr bool PERM = true;
    const unsigned char* GATES; bf16* MG;
    static __device__ __forceinline__ float ub(unsigned w, int i) { return (float)((w >> (8 * i)) & 0xffu); }
    __device__ __forceinline__ void khook(f32x4 (&acc)[2][2][4][2], const Unit& u, int t, int wr, int wc, int fr, int fq) const {
        const int row0 = u.pm * 256 + wr * 64 + fr, cl0 = u.pn * 256 + wc * 32 + 8 * fq;
        const int ga = (t == 8) ? 0 : 1024;
#pragma unroll
        for (int ai = 0; ai < 2; ++ai) {
            u32x2 na[4][2], nb[4][2];
#pragma unroll
            for (int m = 0; m < 4; ++m)
#pragma unroll
                for (int bj = 0; bj < 2; ++bj) { const unsigned char* gp = GATES + (unsigned)((row0 + ai * 128 + m * 16) * 3072 + ga + cl0 + bj * 128); na[m][bj] = gld<u32x2>(gp); nb[m][bj] = gld<u32x2>(gp + 1024); }
#pragma unroll
            for (int m = 0; m < 4; ++m)
#pragma unroll
                for (int bj = 0; bj < 2; ++bj) {
                    const u32x2 a = na[m][bj], b = nb[m][bj];
                    f32x4 r0, r1;
#pragma unroll
                    for (int i = 0; i < 4; ++i) { r0[i] = ub(a.x, i) * fast_rcp(ub(b.x, i)); r1[i] = ub(a.y, i) * fast_rcp(ub(b.y, i)); }
                    acc[ai][bj][m][0] *= r0; acc[ai][bj][m][1] *= r1;
                }
            asm volatile("" ::: "memory");
        }
    }
    __device__ __forceinline__ void operator()(const f32x4 (&acc)[2][2][4][2], const Unit& u, int wr, int wc, int fr, int fq) const {
        const int row0 = u.pm * 256 + wr * 64 + fr, cl0 = u.pn * 256 + wc * 32 + 8 * fq;
#pragma unroll
        for (int ai = 0; ai < 2; ++ai) {
            u32x2 g2[4][2];
#pragma unroll
            for (int m = 0; m < 4; ++m)
#pragma unroll
                for (int bj = 0; bj < 2; ++bj) g2[m][bj] = gld<u32x2>(GATES + (unsigned)((row0 + ai * 128 + m * 16) * 3072 + 2048 + cl0 + bj * 128));
#pragma unroll
            for (int m = 0; m < 4; ++m)
#pragma unroll
                for (int bj = 0; bj < 2; ++bj) {
                    const u32x2 g = g2[m][bj]; const f32x4 v0 = acc[ai][bj][m][0] * (1.0f / 255.0f), v1 = acc[ai][bj][m][1] * (1.0f / 255.0f);
                    u32x4 w; w.x = cvt_pk_bf16(v0[0] * ub(g.x, 0), v0[1] * ub(g.x, 1)); w.y = cvt_pk_bf16(v0[2] * ub(g.x, 2), v0[3] * ub(g.x, 3));
                    w.z = cvt_pk_bf16(v1[0] * ub(g.y, 0), v1[1] * ub(g.y, 1)); w.w = cvt_pk_bf16(v1[2] * ub(g.y, 2), v1[3] * ub(g.y, 3));
                    gst<u32x4>(MG + (unsigned)((row0 + ai * 128 + m * 16) * 1024 + cl0 + bj * 128), w);
                }
            asm volatile("" ::: "memory");
        }
    }
};
struct EpiDelta {
    static constexpr bool PERM = true;
    bf16* Dm;
    __device__ __forceinline__ void operator()(const f32x4 (&acc)[2][2][4][2], const Unit& u, int wr, int wc, int fr, int fq) const {
        const int row0 = u.pm * 256 + wr * 64 + fr, cl0 = u.pn * 256 + wc * 32 + 8 * fq;
#pragma unroll
        for (int ai = 0; ai < 2; ++ai)
#pragma unroll
            for (int m = 0; m < 4; ++m) {
#pragma unroll
                for (int bj = 0; bj < 2; ++bj) { const f32x4 v0 = acc[ai][bj][m][0], v1 = acc[ai][bj][m][1];
                    u32x4 w; w.x = cvt_pk_bf16(v0[0], v0[1]); w.y = cvt_pk_bf16(v0[2], v0[3]); w.z = cvt_pk_bf16(v1[0], v1[1]); w.w = cvt_pk_bf16(v1[2], v1[3]);
                    gst<u32x4>(Dm + (unsigned)((row0 + ai * 128 + m * 16) * 1024 + cl0 + bj * 128), w); }
                asm volatile("" ::: "memory");
            }
    }
};
struct EpiMoe1 {
    static constexpr bool PERM = true;
    bf16* ACT; const float* wts;
    __device__ __forceinline__ void operator()(const f32x4 (&acc)[2][2][4][2], const Unit& u, int wr, int wc, int fr, int fq) const {
        const int r0 = wr * 64 + fr, cl0 = wc * 32 + 8 * fq, es = u.pn >> 1;
        float wv[2][4], rv[2][4];
#pragma unroll
        for (int ai = 0; ai < 2; ++ai)
#pragma unroll
            for (int m = 0; m < 4; ++m) { const int slot = u.x1 + r0 + ai * 128 + m * 16; const f32x4 t = slot < u.x2 ? gld<f32x4>(wts + (unsigned)((u.x0 * LCAP + slot) * 4)) : (f32x4){0.f, 0.f, 0.f, 0.f}; wv[ai][m] = es ? t[1] : t[0]; rv[ai][m] = t[2]; }
#pragma unroll
        for (int ai = 0; ai < 2; ++ai)
#pragma unroll
            for (int m = 0; m < 4; ++m) {
                const int r = r0 + ai * 128 + m * 16; const float w = wv[ai][m], rs = rv[ai][m];
#pragma unroll
                for (int bj = 0; bj < 2; ++bj) {
                    const f32x4 v0 = acc[ai][bj][m][0] * rs, v1 = acc[ai][bj][m][1] * rs;
                    const int col = cl0 + bj * 128;
                    u32x2 o; o.x = cvt_pk_bf16(v0[0] * sigmoid_f(v0[0]) * v0[1] * w, v0[2] * sigmoid_f(v0[2]) * v0[3] * w); o.y = cvt_pk_bf16(v1[0] * sigmoid_f(v1[0]) * v1[1] * w, v1[2] * sigmoid_f(v1[2]) * v1[3] * w);
                    gst<u32x2>(ACT + (unsigned)((u.pm * 256 + r) * 512 + es * 256 + (u.pn & 1) * 128 + (col >> 1)), o);
                }
                asm volatile("" ::: "memory");
            }
    }
};
struct EpiMoe2 {
    static constexpr bool PERM = true;
    bf16* Dm; const int* list;
    __device__ __forceinline__ void operator()(const f32x4 (&acc)[2][2][4][2], const Unit& u, int wr, int wc, int fr, int fq) const {
        const int r0 = wr * 64 + fr, cl0 = u.pn * 256 + wc * 32 + 8 * fq;
        int tok[2][4];
#pragma unroll
        for (int ai = 0; ai < 2; ++ai)
#pragma unroll
            for (int m = 0; m < 4; ++m) { const int slot = u.x1 + r0 + ai * 128 + m * 16; tok[ai][m] = slot < u.x2 ? gld<int>(list + (unsigned)(u.x0 * LCAP + slot)) : -1; }
#pragma unroll
        for (int ai = 0; ai < 2; ++ai)
#pragma unroll
            for (int m = 0; m < 4; ++m) {
                const int t = tok[ai][m];
#pragma unroll
                for (int bj = 0; bj < 2; ++bj) { const f32x4 v0 = acc[ai][bj][m][0], v1 = acc[ai][bj][m][1];
                    u32x4 w; w.x = cvt_pk_bf16(v0[0], v0[1]); w.y = cvt_pk_bf16(v0[2], v0[3]); w.z = cvt_pk_bf16(v1[0], v1[1]); w.w = cvt_pk_bf16(v1[2], v1[3]);
                    if (t >= 0) gst<u32x4>(Dm + (unsigned)(t * 1024 + cl0 + bj * 128), w); }
                asm volatile("" ::: "memory");
            }
    }
};
#define XB_TMO      128
#define XB_XCNT(j)  (256  + 64 * (j))
#define XB_XSUB(j)  (1280 + 64 * (j))
#define XB_XGEN(j)  (2304 + 64 * (j))
#define XB_TOP      3328
#define XB_TOPGEN   3392
#define XCD_BAR_WORDS 3456
#define XB_SPIN_CAP (1u << 18)
__device__ __forceinline__ unsigned xb_ld(unsigned* p)              { return __hip_atomic_load((__attribute__((address_space(1))) unsigned*)p, __ATOMIC_RELAXED, __HIP_MEMORY_SCOPE_AGENT); }
__device__ __forceinline__ unsigned xb_add(unsigned* p, unsigned v) { return __hip_atomic_fetch_add((__attribute__((address_space(1))) unsigned*)p, v, __ATOMIC_RELAXED, __HIP_MEMORY_SCOPE_AGENT); }
__device__ __forceinline__ unsigned xb_xcc_id() { return (unsigned)__builtin_amdgcn_s_getreg((3 << 11) | 20) & 0xFu; }
#define XB_SPIN(cond, bar) do { unsigned _sp = 0; while (cond) { __builtin_amdgcn_s_sleep(1); \
    if ((++_sp & 255u) == 0u) { if (xb_ld(&(bar)[XB_TMO])) break; if (_sp > XB_SPIN_CAP) { atomicAdd(&(bar)[XB_TMO], 1u); break; } } } } while (0)
struct XcdBarrier { unsigned* bar; unsigned x; volatile LAS unsigned* st; };
__device__ __forceinline__ XcdBarrier xcd_barrier_post(unsigned* bar, volatile LAS unsigned* st) {
    XcdBarrier b; b.bar = bar; b.x = xb_xcc_id(); b.st = st;
    if (threadIdx.x == 0) (void)xb_add(&bar[XB_XCNT(b.x)], 1u);
    return b;
}
__device__ __forceinline__ void xcd_barrier_complete(unsigned* bar, unsigned x, unsigned& nloc, unsigned& nx) {
    const unsigned G = gridDim.x * gridDim.y * gridDim.z;
    unsigned sum, cnt, mine, sp = 0u;
    for (;;) {
        sum = 0u; cnt = 0u; mine = 0u;
#pragma unroll
        for (unsigned j = 0; j < 16; ++j) { const unsigned c = xb_ld(&bar[XB_XCNT(j)]); sum += c; cnt += (c > 0u) ? 1u : 0u; mine = (j == x) ? c : mine; }
        if (sum == G) break;
        __builtin_amdgcn_s_sleep(1);
        if ((++sp & 255u) == 0u) { if (xb_ld(&bar[XB_TMO])) break; if (sp > XB_SPIN_CAP) { atomicAdd(&bar[XB_TMO], 1u); break; } }
    }
    nloc = mine > 0u ? mine : 1u; nx = cnt > 0u ? cnt : 1u;
}
__device__ __forceinline__ void xcd_barrier(const XcdBarrier& b, bool is_t0) {
    asm volatile("s_waitcnt vmcnt(0)" ::: "memory");
    __syncthreads();
    if (is_t0) {
        unsigned* bar = b.bar;
        __builtin_amdgcn_s_waitcnt(0);
        unsigned nloc = b.st[0], nx = b.st[1];
        if (nloc == 0u) { xcd_barrier_complete(bar, b.x, nloc, nx); b.st[0] = nloc; b.st[1] = nx; }
        const unsigned old = xb_add(&bar[XB_XSUB(b.x)], 1u);
        const unsigned gen = old / nloc;
        if (old + 1u == (gen + 1u) * nloc) {
            __builtin_amdgcn_fence(__ATOMIC_RELEASE, "agent");
            asm volatile("s_waitcnt vmcnt(0)" ::: "memory");
            const unsigned og = xb_add(&bar[XB_TOP], 1u);
            const unsigned tg = og / nx;
            if (og + 1u == (tg + 1u) * nx) xb_add(&bar[XB_TOPGEN], 1u);
            else XB_SPIN(xb_ld(&bar[XB_TOPGEN]) == tg, bar);
            __builtin_amdgcn_fence(__ATOMIC_ACQUIRE, "agent");
            xb_add(&bar[XB_XGEN(b.x)], 1u);
            asm volatile("s_waitcnt vmcnt(0)" ::: "memory");
        } else {
            XB_SPIN(xb_ld(&bar[XB_XGEN(b.x)]) == gen, bar);
            __builtin_amdgcn_fence(__ATOMIC_ACQUIRE, "agent");
            asm volatile("s_waitcnt vmcnt(0)" ::: "memory");
        }
    }
    __syncthreads();
}

constexpr int AT_SLOT = 8192, AT_VOFF = 9 * AT_SLOT;
__device__ __forceinline__ int kswz(int col) { return ((col >> 1) & 1) | (((col >> 3) & 3) << 1); }
template <bool NA>
__device__ __forceinline__ void attn_core(const bf16x8 (&qf)[2], const LAS unsigned char* lds, int rs, int c_lo, bf16* obase, const float* rpbp_h, int rbias0, int c0q, int lane) {
    const int n = lane & 15, q = lane >> 4, cq = c0q + n;
    f32x4 bias0[8], bias1[8];
    if (NA) {
        const float* bp = rpbp_h + (c_lo - c0q + 8 * q - n + 31);
#pragma unroll
        for (int kb = 0; kb < 8; ++kb) { bias0[kb] = gld<f32x4>(bp + (rbias0 + kb) * 64); bias1[kb] = gld<f32x4>(bp + (rbias0 + kb) * 64 + 4); }
    }
    f32x4 s[8][2];
#pragma unroll
    for (int kb = 0; kb < 8; ++kb) {
        const int slot = NA ? (rs + kb) % 9 : (kb >> 1); const int cb0 = NA ? c_lo : (kb & 1) * 32;
        const LAS unsigned char* kp = lds + slot * AT_SLOT;
#pragma unroll
        for (int blk = 0; blk < 2; ++blk) {
            const int col = cb0 + 8 * (n >> 2) + 4 * blk + (n & 3), f = kswz(col);
            const bf16x8 a0 = *(const LAS bf16x8*)(kp + col * 128 + ((q ^ f) << 4)), a1 = *(const LAS bf16x8*)(kp + col * 128 + (((4 + q) ^ f) << 4));
            f32x4 a = (f32x4){0.f, 0.f, 0.f, 0.f};
            a = __builtin_amdgcn_mfma_f32_16x16x32_bf16(a0, qf[0], a, 0, 0, 0);
            a = __builtin_amdgcn_mfma_f32_16x16x32_bf16(a1, qf[1], a, 0, 0, 0);
            s[kb][blk] = a;
        }
    }
    if (NA) {
        const int cs = min(max(cq - 8, 0), 48);
#pragma unroll
        for (int kb = 0; kb < 8; ++kb) {
            const f32x4 b0 = bias0[kb], b1 = bias1[kb];
#pragma unroll
            for (int i = 0; i < 4; ++i) {
                const int kc0 = c_lo + 8 * q + i, kc1 = kc0 + 4;
                s[kb][0][i] = (kc0 >= cs && kc0 < cs + 16) ? s[kb][0][i] + b0[i] : -1e30f;
                s[kb][1][i] = (kc1 >= cs && kc1 < cs + 16) ? s[kb][1][i] + b1[i] : -1e30f;
            }
        }
    }
    float mx = -1e30f;
#pragma unroll
    for (int kb = 0; kb < 8; ++kb)
#pragma unroll
        for (int blk = 0; blk < 2; ++blk)
#pragma unroll
            for (int i = 0; i < 4; ++i) mx = fmaxf(mx, s[kb][blk][i]);
    mx = fmaxf(mx, shfl_xor_f(mx, 16, lane)); mx = fmaxf(mx, shfl_xor_f(mx, 32, lane));
    float sum = 0.f; bf16x8 pf[8];
#pragma unroll
    for (int kb = 0; kb < 8; ++kb) {
        float p[8];
#pragma unroll
        for (int blk = 0; blk < 2; ++blk)
#pragma unroll
            for (int i = 0; i < 4; ++i) { const float e = fast_exp(s[kb][blk][i] - mx); p[blk * 4 + i] = e; sum += e; }
        u32x4 w; w.x = cvt_pk_bf16(p[0], p[1]); w.y = cvt_pk_bf16(p[2], p[3]); w.z = cvt_pk_bf16(p[4], p[5]); w.w = cvt_pk_bf16(p[6], p[7]);
        pf[kb] = __builtin_bit_cast(bf16x8, w);
    }
    sum += shfl_xor_f(sum, 16, lane); sum += shfl_xor_f(sum, 32, lane);
    const float inv = fast_rcp(sum);
#pragma unroll
    for (int db = 0; db < 4; ++db) {
        f32x4 o = (f32x4){0.f, 0.f, 0.f, 0.f};
#pragma unroll
        for (int kb = 0; kb < 8; ++kb) {
            const int slot = NA ? (rs + kb) % 9 : (kb >> 1); const int cb0 = NA ? c_lo : (kb & 1) * 32;
            const bf16x8 vf = *(const LAS bf16x8*)(lds + AT_VOFF + slot * AT_SLOT + ((((cb0 >> 3) + q) * 64 + db * 16 + n) << 4));
            o = __builtin_amdgcn_mfma_f32_16x16x32_bf16(vf, pf[kb], o, 0, 0, 0);
        }
        u32x2 w; w.x = cvt_pk_bf16(o[0] * inv, o[1] * inv); w.y = cvt_pk_bf16(o[2] * inv, o[3] * inv);
        gst<u32x2>(obase + (unsigned)(n * 1024 + 4 * q) + db * 16, w);
    }
}

constexpr int NWAVES = 8;
constexpr int RING_BYTES = 131072, ATT_BYTES = 147456, MISC_OFF = ATT_BYTES, TAB_OFF = MISC_OFF + 256, LDS_BYTES = 163840;
struct Args { const float* in[30]; float* out; unsigned char* ws; };
struct Frame { LAS unsigned char* lds; int tid, lane, wave, vcu, G; };
enum { I_X = 0, I_MEM, I_NMIX, I_NFFN, I_NMEM, I_WIN, I_BGATE, I_RPB, I_LRE, I_LIM, I_LDT, I_BRE, I_BIM, I_CRE, I_CIM, I_S5D, I_WGLU, I_WMKV, I_WBNA, I_WBS5, I_WBXA, I_WOUT,
       I_WCO, I_BCO, I_WFI, I_BFI, I_WG, I_WU, I_WD, I_FNORM };

__device__ __forceinline__ void transpose_item(const float* W, int ldn, int k0, int n0, bf16* WT, int ldk, int dk0, int row_off, int rmul, int radd, int qs, const float* kscale, LAS float* scr, int lane) {
    { float t[32]; const float* wp = W + (size_t)(k0 + (lane >> 5)) * ldn + n0 + (lane & 31);
#pragma unroll
      for (int i = 0; i < 32; ++i) t[i] = gld<float>(wp + (size_t)(2 * i) * ldn);
#pragma unroll
      for (int i = 0; i < 32; ++i) scr[(2 * i + (lane >> 5)) * 33 + (lane & 31)] = t[i]; }
    LDS_WAIT(); asm volatile("" ::: "memory");
    const int c = lane & 7;
    f32x4 ka = (f32x4){1.f, 1.f, 1.f, 1.f}, kb = ka;
    if (kscale) { ka = gld<f32x4>(kscale + k0 + 8 * c); kb = gld<f32x4>(kscale + k0 + 8 * c + 4); }
#pragma unroll
    for (int j = 0; j < 4; ++j) { const int n = (lane >> 3) + 8 * j, nn = n0 + n; const LAS float* s = scr + (8 * c) * 33 + n;
        const float sc = (qs && (nn < 512 || (nn >= 1792 && nn < 2048))) ? 0.125f : 1.0f;
        u32x4 o; o.x = cvt_pk_bf16(s[0 * 33] * sc * ka[0], s[1 * 33] * sc * ka[1]); o.y = cvt_pk_bf16(s[2 * 33] * sc * ka[2], s[3 * 33] * sc * ka[3]); o.z = cvt_pk_bf16(s[4 * 33] * sc * kb[0], s[5 * 33] * sc * kb[1]); o.w = cvt_pk_bf16(s[6 * 33] * sc * kb[2], s[7 * 33] * sc * kb[3]);
        gst<u32x4>(WT + (size_t)(row_off + nn * rmul + radd) * ldk + dk0 + k0 + 8 * c, o); }
    LDS_WAIT(); asm volatile("" ::: "memory");
}
__device__ __forceinline__ void transpose_job_item(const float* W, int ldn, int N, int it, bf16* WT, int ldk, int dk0, int row_off, int rmul, int radd, int qs, const float* kscale, LAS float* scr, int lane) {
    const int nblk = N / 32, kb = it / nblk, nb = it % nblk;
    transpose_item(W, ldn, 64 * kb, 32 * nb, WT, ldk, dk0, row_off, rmul, radd, qs, kscale, scr, lane);
}

__device__ __forceinline__ void cexp_d(double zr, double zi, double& er, double& ei) {
    const double wr_ = zr * (1.0 / 1024.0), wi_ = zi * (1.0 / 1024.0);
    double tr = 1.0, ti = 0.0;
#pragma unroll
    for (int n = 12; n >= 1; --n) { const double ar = wr_ * (1.0 / n), ai = wi_ * (1.0 / n); const double nr = 1.0 + (ar * tr - ai * ti), ni = ar * ti + ai * tr; tr = nr; ti = ni; }
#pragma unroll
    for (int k = 0; k < 10; ++k) { const double nr = tr * tr - ti * ti, ni = 2.0 * tr * ti; tr = nr; ti = ni; }
    er = tr; ei = ti;
}

template <bool ROUTER>
__device__ __forceinline__ void norm_rows4(const float* X, const float* gain, bf16* H, int row0, int lane,
                                           const float* wrt, const float* bco, const float* bfi, unsigned* cnt, int* list, float* wts, float* Xout = nullptr) {
    f32x4 x[4][4]; float rstd[4];
#pragma unroll
    for (int r = 0; r < 4; ++r) { float ss = 0.f;
#pragma unroll
        for (int j = 0; j < 4; ++j) { x[r][j] = gld<f32x4>(X + (size_t)(row0 + r) * 1024 + 256 * j + 4 * lane);
            if (Xout) { const u32x2 d = gld<u32x2>(H + (size_t)(row0 + r) * 1024 + 256 * j + 4 * lane); x[r][j][0] += bflo(d.x); x[r][j][1] += bfhi(d.x); x[r][j][2] += bflo(d.y); x[r][j][3] += bfhi(d.y);
                gst<f32x4>(Xout + (size_t)(row0 + r) * 1024 + 256 * j + 4 * lane, x[r][j]); }
            ss += (x[r][j][0] * x[r][j][0] + x[r][j][1] * x[r][j][1]) + (x[r][j][2] * x[r][j][2] + x[r][j][3] * x[r][j][3]); }
        ss = wave_sum(ss, lane); rstd[r] = 1.0f / sqrtf(ss * (1.0f / 1024.0f) + RMS_EPS); }
#pragma unroll
    for (int j = 0; j < 4; ++j) { const f32x4 g4 = gld<f32x4>(gain + 256 * j + 4 * lane);
#pragma unroll
        for (int r = 0; r < 4; ++r) { const f32x4 v = x[r][j] * rstd[r] * g4; u32x2 w; w.x = cvt_pk_bf16(v[0], v[1]); w.y = cvt_pk_bf16(v[2], v[3]);
            gst<u32x2>(H + (size_t)(row0 + r) * 1024 + 256 * j + 4 * lane, w); } }
    if constexpr (ROUTER) {
        float keep[4] = {0.f, 0.f, 0.f, 0.f};
#pragma unroll 2
        for (int c = 0; c < 20; ++c) {
            float a0 = 0.f, a1 = 0.f, a2 = 0.f, a3 = 0.f;
#pragma unroll
            for (int j = 0; j < 4; ++j) { const f32x4 w4 = gld<f32x4>(wrt + c * 1024 + 256 * j + 4 * lane);
                a0 += (x[0][j][0] * w4[0] + x[0][j][1] * w4[1]) + (x[0][j][2] * w4[2] + x[0][j][3] * w4[3]);
                a1 += (x[1][j][0] * w4[0] + x[1][j][1] * w4[1]) + (x[1][j][2] * w4[2] + x[1][j][3] * w4[3]);
                a2 += (x[2][j][0] * w4[0] + x[2][j][1] * w4[1]) + (x[2][j][2] * w4[2] + x[2][j][3] * w4[3]);
                a3 += (x[3][j][0] * w4[0] + x[3][j][1] * w4[1]) + (x[3][j][2] * w4[2] + x[3][j][3] * w4[3]); }
            a0 = wave_sum(a0, lane); a1 = wave_sum(a1, lane); a2 = wave_sum(a2, lane); a3 = wave_sum(a3, lane);
            if (lane == c) { keep[0] = a0 * rstd[0]; keep[1] = a1 * rstd[1]; keep[2] = a2 * rstd[2]; keep[3] = a3 * rstd[3]; }
        }
#pragma unroll
        for (int r = 0; r < 4; ++r) {
            float co[4];
#pragma unroll
            for (int i = 0; i < 4; ++i) co[i] = shfl_idx_f(keep[r], i) + bco[i];
            int grp = 0; float cm = co[0];
#pragma unroll
            for (int i = 1; i < 4; ++i) if (co[i] > cm) { cm = co[i]; grp = i; }
            float den = 0.f;
#pragma unroll
            for (int i = 0; i < 4; ++i) den += __expf(co[i] - cm);
            const float pgrp = 1.0f / den;
            float fv[4];
#pragma unroll
            for (int i = 0; i < 4; ++i) fv[i] = shfl_idx_f(keep[r], 4 + grp * 4 + i) + bfi[grp * 4 + i];
            int i1 = 0; float v1 = fv[0];
#pragma unroll
            for (int i = 1; i < 4; ++i) if (fv[i] > v1) { v1 = fv[i]; i1 = i; }
            int i2 = -1; float v2 = -3.0e38f;
#pragma unroll
            for (int i = 0; i < 4; ++i) if (i != i1 && fv[i] > v2) { v2 = fv[i]; i2 = i; }
            const float w1 = pgrp / (1.0f + __expf(v2 - v1)), w2 = pgrp - w1;
            const int a = i1 < i2 ? i1 : i2, b = i1 < i2 ? i2 : i1;
            const int pidx = a == 0 ? b - 1 : (a == 1 ? b + 1 : 5);
            const int bucket = grp * 6 + pidx;
            const float wa = (i1 == a) ? w1 : w2, wb = (i1 == a) ? w2 : w1;
            if (lane == 0) {
                const unsigned slot = __hip_atomic_fetch_add(cnt + bucket * 64, 1u, __ATOMIC_RELAXED, __HIP_MEMORY_SCOPE_AGENT);
                list[(size_t)bucket * LCAP + slot] = row0 + r;
                gst<f32x2>(wts + ((size_t)bucket * LCAP + slot) * 2, (f32x2){wa, wb});
            }
        }
    }
}

constexpr int RT_STRIDE = 2064;
constexpr int RT_BYTES = 40 * RT_STRIDE;
constexpr int RT_SCR = 98304;
__device__ __forceinline__ void router_rows16(const float* X, const bf16* XBi, const bf16* DH, bf16* XB, int R0, int lane, LAS unsigned char* lds, int wave,
                                              const float* bco, const float* bfi, unsigned* cnt, int* list, float* wts) {
    const int n = lane & 15, q = lane >> 4;
    f32x4 accF = (f32x4){0.f, 0.f, 0.f, 0.f}, accC = (f32x4){0.f, 0.f, 0.f, 0.f};
    float ss = 0.f;
    const unsigned xo = (unsigned)((R0 + n) * 1024 + 8 * q);
    const LAS unsigned char* tF = lds + n * RT_STRIDE + 16 * q; const LAS unsigned char* tC = lds + (16 + (n & 3)) * RT_STRIDE + 16 * q;
#pragma unroll 4
    for (int ks = 0; ks < 32; ++ks) {
        f32x4 x0, x1;
        if (XBi) { const u32x4 xb = gld<u32x4>(XBi + xo + ks * 32); x0 = (f32x4){bflo(xb.x), bfhi(xb.x), bflo(xb.y), bfhi(xb.y)}; x1 = (f32x4){bflo(xb.z), bfhi(xb.z), bflo(xb.w), bfhi(xb.w)}; }
        else { x0 = gld<f32x4>(X + xo + ks * 32); x1 = gld<f32x4>(X + xo + ks * 32 + 4); }
        if (DH) { const u32x4 d = gld<u32x4>(DH + xo + ks * 32); x0[0] += bflo(d.x); x0[1] += bfhi(d.x); x0[2] += bflo(d.y); x0[3] += bfhi(d.y); x1[0] += bflo(d.z); x1[1] += bfhi(d.z); x1[2] += bflo(d.w); x1[3] += bfhi(d.w); }
        ss += (x0[0] * x0[0] + x0[1] * x0[1]) + (x0[2] * x0[2] + x0[3] * x0[3]) + (x1[0] * x1[0] + x1[1] * x1[1]) + (x1[2] * x1[2] + x1[3] * x1[3]);
        u32x4 hw; hw.x = cvt_pk_bf16(x0[0], x0[1]); hw.y = cvt_pk_bf16(x0[2], x0[3]); hw.z = cvt_pk_bf16(x1[0], x1[1]); hw.w = cvt_pk_bf16(x1[2], x1[3]);
        u32x4 lw; lw.x = cvt_pk_bf16(x0[0] - bflo(hw.x), x0[1] - bfhi(hw.x)); lw.y = cvt_pk_bf16(x0[2] - bflo(hw.y), x0[3] - bfhi(hw.y));
        lw.z = cvt_pk_bf16(x1[0] - bflo(hw.z), x1[1] - bfhi(hw.z)); lw.w = cvt_pk_bf16(x1[2] - bflo(hw.w), x1[3] - bfhi(hw.w));
        gst<u32x4>(XB + xo + ks * 32, hw);
        const bf16x8 ah = __builtin_bit_cast(bf16x8, hw), al = __builtin_bit_cast(bf16x8, lw);
        const bf16x8 fh = *(const LAS bf16x8*)(tF + ks * 64), fl = *(const LAS bf16x8*)(tF + 20 * RT_STRIDE + ks * 64);
        const bf16x8 ch = *(const LAS bf16x8*)(tC + ks * 64), cl = *(const LAS bf16x8*)(tC + 20 * RT_STRIDE + ks * 64);
        accF = __builtin_amdgcn_mfma_f32_16x16x32_bf16(ah, fh, accF, 0, 0, 0); accF = __builtin_amdgcn_mfma_f32_16x16x32_bf16(ah, fl, accF, 0, 0, 0); accF = __builtin_amdgcn_mfma_f32_16x16x32_bf16(al, fh, accF, 0, 0, 0);
        accC = __builtin_amdgcn_mfma_f32_16x16x32_bf16(ah, ch, accC, 0, 0, 0); accC = __builtin_amdgcn_mfma_f32_16x16x32_bf16(ah, cl, accC, 0, 0, 0); accC = __builtin_amdgcn_mfma_f32_16x16x32_bf16(al, ch, accC, 0, 0, 0);
    }
    ss += shfl_xor_f(ss, 16, lane); ss += shfl_xor_f(ss, 32, lane);
    const float rstd = 1.0f / sqrtf(ss * (1.0f / 1024.0f) + RMS_EPS);
    LAS float* sc = (LAS float*)(lds + RT_SCR + wave * 1536);
#pragma unroll
    for (int r = 0; r < 4; ++r) { const float rs = shfl_idx_f(rstd, 4 * q + r); sc[(4 * q + r) * 24 + n] = accF[r] * rs; if (n < 4) sc[(4 * q + r) * 24 + 16 + n] = accC[r] * rs; }
    LDS_WAIT(); asm volatile("" ::: "memory");
    if (lane < 16) {
        const LAS float* my = sc + lane * 24;
        float co[4];
#pragma unroll
        for (int i = 0; i < 4; ++i) co[i] = my[16 + i] + gld<float>(bco + i);
        int grp = 0; float cm = co[0];
#pragma unroll
        for (int i = 1; i < 4; ++i) if (co[i] > cm) { cm = co[i]; grp = i; }
        float den = 0.f;
#pragma unroll
        for (int i = 0; i < 4; ++i) den += __expf(co[i] - cm);
        const float pgrp = 1.0f / den;
        float fv[4];
#pragma unroll
        for (int i = 0; i < 4; ++i) fv[i] = my[grp * 4 + i] + gld<float>(bfi + grp * 4 + i);
        int i1 = 0; float v1 = fv[0];
#pragma unroll
        for (int i = 1; i < 4; ++i) if (fv[i] > v1) { v1 = fv[i]; i1 = i; }
        int i2 = -1; float v2 = -3.0e38f;
#pragma unroll
        for (int i = 0; i < 4; ++i) if (i != i1 && fv[i] > v2) { v2 = fv[i]; i2 = i; }
        const float w1 = pgrp / (1.0f + __expf(v2 - v1)), w2 = pgrp - w1;
        const int a = i1 < i2 ? i1 : i2, b = i1 < i2 ? i2 : i1;
        const int pidx = a == 0 ? b - 1 : (a == 1 ? b + 1 : 5);
        const int bucket = grp * 6 + pidx;
        const float wa = (i1 == a) ? w1 : w2, wb = (i1 == a) ? w2 : w1;
        const unsigned slot = __hip_atomic_fetch_add((GASP unsigned*)(cnt + bucket * 64), 1u, __ATOMIC_RELAXED, __HIP_MEMORY_SCOPE_AGENT);
        gst<int>(list + ((unsigned)(bucket * LCAP) + slot), R0 + lane);
        gst<f32x4>(wts + ((unsigned)(bucket * LCAP) + slot) * 4, (f32x4){wa, wb, rstd, 0.f});
    }
}

__device__ __forceinline__ void norm_rows4b(bf16* XB, const float* gain, bf16* H, int row0, int lane) {
    f32x4 x[4][4]; float rstd[4];
#pragma unroll
    for (int r = 0; r < 4; ++r) { float ss = 0.f;
#pragma unroll
        for (int j = 0; j < 4; ++j) { const unsigned off = (unsigned)((row0 + r) * 1024 + 256 * j + 4 * lane); const u32x2 a = gld<u32x2>(XB + off), d = gld<u32x2>(H + off);
            x[r][j] = (f32x4){bflo(a.x) + bflo(d.x), bfhi(a.x) + bfhi(d.x), bflo(a.y) + bflo(d.y), bfhi(a.y) + bfhi(d.y)};
            u32x2 w; w.x = cvt_pk_bf16(x[r][j][0], x[r][j][1]); w.y = cvt_pk_bf16(x[r][j][2], x[r][j][3]); gst<u32x2>(XB + off, w);
            ss += (x[r][j][0] * x[r][j][0] + x[r][j][1] * x[r][j][1]) + (x[r][j][2] * x[r][j][2] + x[r][j][3] * x[r][j][3]); }
        ss = wave_sum(ss, lane); rstd[r] = 1.0f / sqrtf(ss * (1.0f / 1024.0f) + RMS_EPS); }
#pragma unroll
    for (int j = 0; j < 4; ++j) { const f32x4 g4 = gld<f32x4>(gain + 256 * j + 4 * lane);
#pragma unroll
        for (int r = 0; r < 4; ++r) { const f32x4 v = x[r][j] * rstd[r] * g4; u32x2 w; w.x = cvt_pk_bf16(v[0], v[1]); w.y = cvt_pk_bf16(v[2], v[3]);
            gst<u32x2>(H + (unsigned)((row0 + r) * 1024 + 256 * j + 4 * lane), w); } }
}

__device__ __forceinline__ void final_norm_row(const bf16* XB, const bf16* Dl, float* out, const float* gain, int row, int lane) {
    f32x4 x[4]; float ss = 0.f;
#pragma unroll
    for (int j = 0; j < 4; ++j) { const unsigned off = (unsigned)(row * 1024 + 256 * j + 4 * lane); const u32x2 a = gld<u32x2>(XB + off), d = gld<u32x2>(Dl + off);
        x[j] = (f32x4){bflo(a.x) + bflo(d.x), bfhi(a.x) + bfhi(d.x), bflo(a.y) + bflo(d.y), bfhi(a.y) + bfhi(d.y)};
        ss += (x[j][0] * x[j][0] + x[j][1] * x[j][1]) + (x[j][2] * x[j][2] + x[j][3] * x[j][3]); }
    ss = wave_sum(ss, lane); const float rstd = 1.0f / sqrtf(ss * (1.0f / 1024.0f) + RMS_EPS);
#pragma unroll
    for (int j = 0; j < 4; ++j) { const f32x4 g4 = gld<f32x4>(gain + 256 * j + 4 * lane); gst<f32x4>(out + (size_t)row * 1024 + 256 * j + 4 * lane, x[j] * rstd * g4); }
}

__device__ __forceinline__ void s5_scan_item(int item, const float* ST, bf16* At, const f32x2* apow_l, LAS float* sc, int tid) {
    const int d = item & 1, bg = item >> 1, g = bg & 15, seg = tid >> 6, p = tid & 63;
    const f32x2 A32 = gld<f32x2>(apow_l + ((d * 16 + g) * 33 + 32) * 64 + p);
    const int chunk0 = d ? 255 - seg * 32 : seg * 32; const long cstep = d ? -1 : 1;
    const float* rp0 = ST + (size_t)(bg * 256 + chunk0) * 256 + d * 128 + p;
    float tr = 0.f, ti = 0.f;
#pragma unroll 8
    for (int j = 0; j < 32; ++j) { const float* rp = rp0 + cstep * j * 256; const float sr = gld<float>(rp), si = gld<float>(rp + 64); const float nr = A32.x * tr - A32.y * ti + sr, ni = A32.x * ti + A32.y * tr + si; tr = nr; ti = ni; }
    sc[(seg * 64 + p) * 2] = tr; sc[(seg * 64 + p) * 2 + 1] = ti;
    __syncthreads();
    float pr = A32.x, pi = A32.y;
#pragma unroll
    for (int k = 0; k < 5; ++k) { const float nr = pr * pr - pi * pi, ni = 2.f * pr * pi; pr = nr; pi = ni; }
    float er = 0.f, ei = 0.f;
    for (int s2 = 0; s2 < seg; ++s2) { const float qr = sc[(s2 * 64 + p) * 2], qi = sc[(s2 * 64 + p) * 2 + 1]; const float nr = pr * er - pi * ei + qr, ni = pr * ei + pi * er + qi; er = nr; ei = ni; }
    bf16* op0 = At + (size_t)(bg * 256 + chunk0) * ATK + 512 + d * 128 + p;
#pragma unroll 8
    for (int j = 0; j < 32; ++j) { const float* rp = rp0 + cstep * j * 256; const float sr = gld<float>(rp), si = gld<float>(rp + 64); bf16* op = op0 + cstep * j * ATK;
        gst<bf16>(op, (bf16)(cvt_pk_bf16(er, er) & 0xffffu)); gst<bf16>(op + 64, (bf16)(cvt_pk_bf16(ei, ei) & 0xffffu));
        const float nr = A32.x * er - A32.y * ei + sr, ni = A32.x * ei + A32.y * er + si; er = nr; ei = ni; }
    __syncthreads();
}

#define NA_ITEM(item) do { \
    const bf16* QK = WP(bf16, WS_QK); const bf16* VT8 = WP(bf16, WS_VT8); bf16* Hn = WP(bf16, WS_H); const float* RPBP = WP(float, WS_RPBP); \
    const int n = lane & 15, q = lane >> 4, cb = wave & 3, qsel = wave >> 2, c_lo = cb == 0 ? 0 : (cb == 1 ? 8 : (cb == 2 ? 24 : 32)); \
    const int kcol = tid >> 3, kdst = kcol * 128 + (((tid & 7) ^ kswz(kcol)) << 4); \
    const int b = (item) >> 7, h = ((item) >> 4) & 7, r0 = ((item) & 15) * 8; \
    const bf16* Kg = QK + (size_t)b * SEQ * 1024 + 512 + h * 64 + (unsigned)(kcol * 1024 + (tid & 7) * 8); \
    const bf16* Vg = VT8 + (size_t)(b * 8 + h) * 1024 * 512 + (unsigned)(tid * 8); \
    const float* rp = RPBP + (size_t)(l * 8 + h) * 15 * 64; \
    int hi = min(max(r0 + 1 - 4, 0), 120) + 7; \
    { const int lo = min(max(r0 - 4, 0), 120); \
      u32x4 kv[9], vv[9]; \
      _Pragma("unroll") for (int j = 0; j < 9; ++j) { const int kr = min(lo + j, 127); kv[j] = gld<u32x4>(Kg + (size_t)kr * 65536); vv[j] = gld<u32x4>(Vg + (size_t)kr * 4096); } \
      _Pragma("unroll") for (int j = 0; j < 9; ++j) { const int kr = lo + j; if (kr <= hi) { const int slot = kr % 9; *(LAS u32x4*)(F.lds + slot * AT_SLOT + kdst) = kv[j]; *(LAS u32x4*)(F.lds + AT_VOFF + slot * AT_SLOT + tid * 16) = vv[j]; } } \
    } \
    bf16x8 qf[2]; \
    { const bf16* qb = QK + (size_t)(b * SEQ + (r0 + qsel) * 64 + cb * 16) * 1024 + h * 64 + (unsigned)(n * 1024 + 8 * q); qf[0] = gld<bf16x8>(qb); qf[1] = gld<bf16x8>(qb + 32); } \
    __syncthreads(); \
    _Pragma("unroll 1") for (int st = 0; st < 4; ++st) { \
        const int r = r0 + 2 * st + qsel, rs = min(max(r - 4, 0), 120); \
        const bool more = st < 3; \
        const int hi_next = more ? min(max(r0 + 2 * st + 3 - 4, 0), 120) + 7 : hi; \
        const int kr1 = hi + 1, kr2 = hi + 2; \
        u32x4 k1 = (u32x4){0u, 0u, 0u, 0u}, v1 = k1, k2 = k1, v2 = k1; bf16x8 qn[2]; qn[0] = qf[0]; qn[1] = qf[1]; \
        if (more) { \
            k1 = gld<u32x4>(Kg + (size_t)min(kr1, 127) * 65536); v1 = gld<u32x4>(Vg + (size_t)min(kr1, 127) * 4096); \
            k2 = gld<u32x4>(Kg + (size_t)min(kr2, 127) * 65536); v2 = gld<u32x4>(Vg + (size_t)min(kr2, 127) * 4096); \
            const bf16* qb = QK + (size_t)(b * SEQ + (r + 2) * 64 + cb * 16) * 1024 + h * 64 + (unsigned)(n * 1024 + 8 * q); qn[0] = gld<bf16x8>(qb); qn[1] = gld<bf16x8>(qb + 32); \
        } \
        attn_core<true>(qf, F.lds, rs, c_lo, Hn + (size_t)(b * SEQ + r * 64 + cb * 16) * 1024 + h * 64, rp, rs - r + 7, cb * 16, lane); \
        __syncthreads(); \
        if (more) { \
            if (kr1 <= hi_next) { const int slot = kr1 % 9; *(LAS u32x4*)(F.lds + slot * AT_SLOT + kdst) = k1; *(LAS u32x4*)(F.lds + AT_VOFF + slot * AT_SLOT + tid * 16) = v1; } \
            if (kr2 <= hi_next) { const int slot = kr2 % 9; *(LAS u32x4*)(F.lds + slot * AT_SLOT + kdst) = k2; *(LAS u32x4*)(F.lds + AT_VOFF + slot * AT_SLOT + tid * 16) = v2; } \
            hi = hi_next; qf[0] = qn[0]; qf[1] = qn[1]; \
        } \
        __syncthreads(); \
    } } while (0)
#define WG_MEM_SYNC() do { asm volatile("s_waitcnt vmcnt(0)" ::: "memory"); __syncthreads(); __builtin_amdgcn_fence(__ATOMIC_ACQUIRE, "agent"); asm volatile("s_waitcnt vmcnt(0)" ::: "memory"); } while (0)

#define XA_ITEMS(first, last, stride) do { \
    const bf16* QX = WP(bf16, WS_QX); const bf16* KM = WP(bf16, WS_KM); const bf16* VM8 = WP(bf16, WS_VM8); bf16* Hx = WP(bf16, WS_H); \
    const int n_ = lane & 15, q_ = lane >> 4, kcol = tid >> 3, kdst = kcol * 128 + (((tid & 7) ^ kswz(kcol)) << 4); \
    for (int item = (first); item < (last); item += (stride)) { \
        const int b = item >> 6, h = (item >> 4) & 3, qc = item & 15; \
        const bf16* Kg = KM + ((size_t)(l * 4 + b) * 256) * 256 + h * 64 + (unsigned)(kcol * 256 + (tid & 7) * 8); \
        const bf16* Vg = VM8 + (size_t)((l * 4 + b) * 4 + h) * 32 * 512 + (unsigned)(tid * 8); \
        _Pragma("unroll") for (int j = 0; j < 4; ++j) { const u32x4 kv = gld<u32x4>(Kg + j * 64 * 256), vv = gld<u32x4>(Vg + j * 4096); \
            *(LAS u32x4*)(F.lds + j * AT_SLOT + kdst) = kv; *(LAS u32x4*)(F.lds + AT_VOFF + j * AT_SLOT + tid * 16) = vv; } \
        __syncthreads(); \
        _Pragma("unroll 1") for (int j = 0; j < 4; ++j) { \
            const int t0 = b * SEQ + qc * 512 + wave * 64 + j * 16; \
            bf16x8 qf[2]; { const bf16* qb = QX + (size_t)t0 * 256 + h * 64 + (unsigned)(n_ * 256 + 8 * q_); qf[0] = gld<bf16x8>(qb); qf[1] = gld<bf16x8>(qb + 32); } \
            attn_core<false>(qf, F.lds, 0, 0, Hx + (size_t)t0 * 1024 + 768 + h * 64, nullptr, 0, 0, lane); } \
        __syncthreads(); \
    } } while (0)

#ifndef PHMASK
#define PHMASK 0xffffffffu
#endif
#define PH(k) ((PHMASK >> (k)) & 1u)
#ifndef FUSE1
#define FUSE1 0
#endif
#ifndef REPMASK
#define REPMASK 0u
#endif
#define NREP(k) (1 + (int)((REPMASK >> (k)) & 1u))
constexpr int PTR_OFF = MISC_OFF + 1024;
__device__ __forceinline__ const float* inp(LAS unsigned char* lds, int i, int z) {
    const LAS unsigned* q = (const LAS unsigned*)(lds + PTR_OFF + 8 * i + z);
    const unsigned lo = __builtin_amdgcn_readfirstlane(q[0]), hi = __builtin_amdgcn_readfirstlane(q[1]);
    return (const float*)(((unsigned long long)hi << 32) | lo);
}
#define WSL() unsigned char* wsl = args.ws; int wave = F.wave, bid = blockIdx.x, G = gridDim.x, zz = 0; unsigned mm_ = ~0u; asm volatile("" : "+s"(mm_)); int lane = (int)__builtin_amdgcn_mbcnt_hi(mm_, __builtin_amdgcn_mbcnt_lo(mm_, 0u)); \
    asm volatile("" : "+s"(wsl), "+s"(wave), "+v"(lane), "+s"(bid), "+s"(G), "+s"(zz)); \
    const int tid = wave * 64 + lane, vcu = (G % 8 == 0) ? (bid % 8) * (G / 8) + bid / 8 : bid, gw = vcu * NWAVES + wave, NGW = G * NWAVES, NGT = G * NWAVES * 64; \
    (void)tid; (void)gw; (void)NGW; (void)NGT; (void)wsl
#define WP(T, off) ((T*)(wsl + (off)))
#define IN(i) inp(F.lds, (i), zz)

__global__ void __launch_bounds__(NWAVES * 64, 2) fwd_kernel(Args args) {
    extern __shared__ __attribute__((aligned(16))) unsigned char lds_raw[];
    Frame F;
    F.lds = (LAS unsigned char*)lds_raw;
    F.tid = threadIdx.x; F.lane = F.tid & 63; F.wave = __builtin_amdgcn_readfirstlane(F.tid >> 6);
    F.G = gridDim.x; { const int bx = blockIdx.x; F.vcu = (F.G % 8 == 0) ? (bx % 8) * (F.G / 8) + bx / 8 : bx; }
    for (int u = F.tid; u < (LDS_BYTES - MISC_OFF) / 4; u += NWAVES * 64) ((LAS unsigned*)(F.lds + MISC_OFF))[u] = 0u;
    __syncthreads();
    if (F.tid < 30) { const unsigned long long p = (unsigned long long)args.in[F.tid]; LAS unsigned* q = (LAS unsigned*)(F.lds + PTR_OFF + 8 * F.tid); q[0] = (unsigned)p; q[1] = (unsigned)(p >> 32); }
    __syncthreads();
    (void)xcd_barrier_post((unsigned*)(args.ws + WS_CTL) + CW_BAR, (volatile LAS unsigned*)(F.lds + MISC_OFF));
#define GRID_BAR() do { unsigned char* w_ = args.ws; asm volatile("" : "+s"(w_)); XcdBarrier b_; b_.bar = (unsigned*)(w_ + WS_CTL) + CW_BAR; b_.x = xb_xcc_id(); b_.st = (volatile LAS unsigned*)(F.lds + MISC_OFF); unsigned m_ = ~0u; int wv_ = F.wave; asm volatile("" : "+s"(m_), "+s"(wv_)); \
    xcd_barrier(b_, (wv_ == 0) && (__builtin_amdgcn_mbcnt_hi(m_, __builtin_amdgcn_mbcnt_lo(m_, 0u)) == 0u)); } while (0)
#define GT() (vcu * (NWAVES * 64) + tid)
#define SCR() ((LAS float*)(F.lds + wave * 16384))

    if (PH(0)) {
        WSL();
        f32x2* APOW = WP(f32x2, WS_APOW); f32x2* BBAR = WP(f32x2, WS_BBAR); bf16* WRT = WP(bf16, WS_WRT); bf16* MEMN = WP(bf16, WS_MEMN); bf16* WMKV = WP(bf16, WS_WMKV);
        for (int it = gw; it < 1024; it += NGW) { const int l = it >> 8, r = it & 255;
            transpose_job_item(IN(I_WMKV) + (size_t)l * 1024 * 512, 512, 512, r, WMKV + (size_t)l * 512 * 1024, 1024, 0, 0, 1, 0, 0, nullptr, SCR(), lane); }
        for (int it = gw; it < 4096; it += NGW) { const int l = it >> 10, row = it & 1023;
            const float* xr = IN(I_MEM) + (size_t)row * 1024; const float* gn = IN(I_NMEM) + l * 1024;
            f32x4 x[4]; float ss = 0.f;
#pragma unroll
            for (int j = 0; j < 4; ++j) { x[j] = gld<f32x4>(xr + 256 * j + 4 * lane); ss += (x[j][0] * x[j][0] + x[j][1] * x[j][1]) + (x[j][2] * x[j][2] + x[j][3] * x[j][3]); }
            ss = wave_sum(ss, lane); const float rstd = 1.0f / sqrtf(ss * (1.0f / 1024.0f) + RMS_EPS);
#pragma unroll
            for (int j = 0; j < 4; ++j) { const f32x4 v = x[j] * rstd * gld<f32x4>(gn + 256 * j + 4 * lane); u32x2 w; w.x = cvt_pk_bf16(v[0], v[1]); w.y = cvt_pk_bf16(v[2], v[3]);
                gst<u32x2>(MEMN + (size_t)it * 1024 + 256 * j + 4 * lane, w); } }
        for (int it = GT(); it < 8192; it += NGT) {
            const int p = it & 63, ldg = it >> 6;
            const double lr = fmin((double)IN(I_LRE)[it], -1e-4), li = (double)IN(I_LIM)[it];
            double dt, dum; cexp_d((double)IN(I_LDT)[ldg], 0.0, dt, dum);
            double ar, ai; cexp_d(lr * dt, li * dt, ar, ai);
            const double den = lr * lr + li * li, fr = ((ar - 1.0) * lr + ai * li) / den, fi = (ai * lr - (ar - 1.0) * li) / den;
            const float* bre = IN(I_BRE) + (size_t)it * 16; const float* bim = IN(I_BIM) + (size_t)it * 16;
#pragma unroll 4
            for (int c = 0; c < 16; ++c) { const double br = (double)bre[c], bi = (double)bim[c];
                BBAR[(size_t)it * 16 + c] = (f32x2){(float)(fr * br - fi * bi), (float)(fr * bi + fi * br)}; }
            double pr = 1.0, pi = 0.0;
            for (int n = 0; n <= 32; ++n) { APOW[((size_t)ldg * 33 + n) * 64 + p] = (f32x2){(float)pr, (float)pi}; const double nr = pr * ar - pi * ai, ni = pr * ai + pi * ar; pr = nr; pi = ni; }
        }
        { float* RPBP = WP(float, WS_RPBP); const float* rpb = IN(I_RPB);
          for (int it = GT(); it < 4 * 8 * 15 * 64; it += NGT) { const int j = it & 63; RPBP[it] = (j >= 16 && j < 47) ? rpb[(it >> 6) * 31 + (j - 16)] : 0.f; } }
        for (int it = GT(); it < 4 * 20480; it += NGT) { const int l = it / 20480, r = it % 20480, c = r >> 10, k = r & 1023;
            const float gk = IN(I_NFFN)[l * 1024 + k];
            const float v = gk * (c < 16 ? IN(I_WFI)[(size_t)(l * 1024 + k) * 16 + c] : IN(I_WCO)[(size_t)(l * 1024 + k) * 4 + (c - 16)]);
            const unsigned hw = cvt_pk_bf16(v, v) & 0xffffu; const float lo = v - bflo(hw);
            WRT[(size_t)(l * 2 + 0) * 20480 + r] = (bf16)hw; WRT[(size_t)(l * 2 + 1) * 20480 + r] = (bf16)(cvt_pk_bf16(lo, lo) & 0xffffu); }
    }
    GRID_BAR();

    if (PH(1)) {
        WSL();
        { pg8::Gemm g{WP(bf16, WS_MEMN), WP(bf16, WS_WMKV), 1024, 1024, 1024}; pg8::MemOrder S{G, bid}; EpiMemKV E{WP(bf16, WS_KM), WP(bf16, WS_VM8)};
          pg8::gemm_phase<EpiMemKV, pg8::MemOrder>(F.lds, g, S, E, tid); }
        const f32x2* APOW = WP(f32x2, WS_APOW); const f32x2* BBAR = WP(f32x2, WS_BBAR); float* KT = WP(float, WS_KT);
        const float* CRE = IN(I_CRE); const float* CIM = IN(I_CIM); const float* S5D = IN(I_S5D);
        for (int it = GT(); it < 4 * 16 * 63 * 64; it += NGT) {
            const int c2 = (it & 3) * 4, c = (it >> 2) & 15, rest = it >> 6, tp = rest % 63, lg = rest / 63, l = lg >> 4, g = lg & 15;
            f32x4 sum = (f32x4){0.f, 0.f, 0.f, 0.f};
#pragma unroll 1
            for (int d = 0; d < 2; ++d) {
                if (d == 0 ? (tp < 31) : (tp > 31)) continue;
                const int n = d == 0 ? tp - 31 : 31 - tp, base = (l * 2 + d) * 16 + g;
                const float* cre = CRE + ((size_t)base * 16 + c) * 64; const float* cim = CIM + ((size_t)base * 16 + c) * 64;
                const f32x2* ap = APOW + ((size_t)base * 33 + n) * 64; const f32x4* bb = (const f32x4*)(BBAR + (size_t)base * 64 * 16 + c2);
#pragma unroll 8
                for (int p = 0; p < 64; ++p) { const f32x2 a = ap[p]; const f32x4 b0 = bb[p * 8], b1 = bb[p * 8 + 1]; const float cr = cre[p], ci = cim[p];
                    const float er = cr * a.x - ci * a.y, ei = cr * a.y + ci * a.x;
                    sum[0] += er * b0[0] - ei * b0[1]; sum[1] += er * b0[2] - ei * b0[3]; sum[2] += er * b1[0] - ei * b1[1]; sum[3] += er * b1[2] - ei * b1[3]; }
            }
            if (tp == 31 && c >= c2 && c < c2 + 4) sum[c - c2] += S5D[l * 256 + g * 16 + c];
            gst<f32x4>(KT + (size_t)it * 4, sum);
        }
    }
    GRID_BAR();

    const float* xin0 = (const float*)(GASP const float*)args.in[I_X];
    float* XO = (float*)(GASP float*)args.out;
#pragma unroll 1
    for (int l = 0; l < DEPTH; ++l) {
        for (int rep_ = 0; rep_ < NREP(2); ++rep_) {
        if (PH(2)) {
            WSL();
            {
            bf16* WIN = WP(bf16, WS_WIN); bf16* WCAT = WP(bf16, WS_WCAT); bf16* WOUT = WP(bf16, WS_WOUT); bf16* WGLU = WP(bf16, WS_WGLU);
            for (int it = gw; it < 3648; it += NGW) {
                int r = it;
                if (r < 2560) { transpose_job_item(IN(I_WIN) + (size_t)l * 1024 * 5120, 5120, 5120, r, WIN, 1024, 0, 0, 1, 0, 1, FUSE1 ? IN(I_NMIX) + l * 1024 : nullptr, SCR(), lane); continue; } r -= 2560;
                if (r < 256) { transpose_job_item(IN(I_WBNA) + (size_t)l * 512 * 1024, 1024, 1024, r, WCAT, 1024, 0, 0, 1, 0, 0, nullptr, SCR(), lane); continue; } r -= 256;
                if (r < 128) { transpose_job_item(IN(I_WBS5) + (size_t)l * 256 * 1024, 1024, 1024, r, WCAT, 1024, 512, 0, 1, 0, 0, nullptr, SCR(), lane); continue; } r -= 128;
                if (r < 128) { transpose_job_item(IN(I_WBXA) + (size_t)l * 256 * 1024, 1024, 1024, r, WCAT, 1024, 768, 0, 1, 0, 0, nullptr, SCR(), lane); continue; } r -= 128;
                if (r < 512) { transpose_job_item(IN(I_WOUT) + (size_t)l * 1024 * 1024, 1024, 1024, r, WOUT, 1024, 0, 0, 1, 0, 0, nullptr, SCR(), lane); continue; } r -= 512;
                if (r < 32) { transpose_job_item(IN(I_WGLU) + (size_t)l * 256 * 512, 512, 256, r, WGLU, 256, 0, 0, 2, 0, 0, nullptr, SCR(), lane); continue; } r -= 32;
                transpose_job_item(IN(I_WGLU) + (size_t)l * 256 * 512 + 256, 512, 256, r, WGLU, 256, 0, 0, 2, 1, 0, nullptr, SCR(), lane);
            }
            }
            {
            const f32x2* APOW = WP(f32x2, WS_APOW); const f32x2* BBAR = WP(f32x2, WS_BBAR); bf16* S5W = WP(bf16, WS_S5W);
            for (int it = GT(); it < 16 * 256 * 64; it += NGT) {
                const int k8 = it & 63, n = (it >> 6) & 255, g = it >> 14;
                const int s = k8 >> 1, c0 = (k8 & 1) * 8, d = n >> 7, ri = (n >> 6) & 1, p = n & 63, e = d == 0 ? 31 - s : s, base = (l * 2 + d) * 16 + g;
                const f32x2 a = APOW[((size_t)base * 33 + e) * 64 + p]; const f32x2* bb = BBAR + ((size_t)base * 64 + p) * 16 + c0;
                float v[8];
#pragma unroll
                for (int j = 0; j < 8; ++j) { const f32x2 b = bb[j]; v[j] = ri == 0 ? a.x * b.x - a.y * b.y : a.x * b.y + a.y * b.x; }
                u32x4 w; w.x = cvt_pk_bf16(v[0], v[1]); w.y = cvt_pk_bf16(v[2], v[3]); w.z = cvt_pk_bf16(v[4], v[5]); w.w = cvt_pk_bf16(v[6], v[7]);
                gst<u32x4>(S5W + ((size_t)(g * 256 + n) * 512 + k8 * 8), w);
            }
            const float* KT = WP(float, WS_KT); bf16* S5KV = WP(bf16, WS_S5KV); const float* CRE = IN(I_CRE); const float* CIM = IN(I_CIM);
            for (int it = GT(); it < 16 * 512 * 96; it += NGT) {
                const int k8 = it % 96, rest = it / 96, n = rest & 511, g = rest >> 9, t = n >> 4, c = n & 15;
                float v[8];
                if (k8 < 64) { const int s = k8 >> 1, c0 = (k8 & 1) * 8, tp = t - s + 31; const float* kp = KT + ((size_t)(((l * 16 + g) * 63 + tp) * 16 + c) * 16 + c0);
                    const f32x4 a = gld<f32x4>(kp), b = gld<f32x4>(kp + 4); v[0] = a[0]; v[1] = a[1]; v[2] = a[2]; v[3] = a[3]; v[4] = b[0]; v[5] = b[1]; v[6] = b[2]; v[7] = b[3]; }
                else { const int jj = (k8 - 64) * 8, d = jj >> 7, ri = (jj >> 6) & 1, p0 = jj & 63, e = d == 0 ? t + 1 : 32 - t, base = (l * 2 + d) * 16 + g;
                    const float* cre = CRE + ((size_t)base * 16 + c) * 64 + p0; const float* cim = CIM + ((size_t)base * 16 + c) * 64 + p0; const f32x2* ap = APOW + ((size_t)base * 33 + e) * 64 + p0;
#pragma unroll
                    for (int j = 0; j < 8; ++j) { const f32x2 a = ap[j]; const float cr = cre[j], ci = cim[j]; v[j] = ri == 0 ? cr * a.x - ci * a.y : -(cr * a.y + ci * a.x); } }
                u32x4 w; w.x = cvt_pk_bf16(v[0], v[1]); w.y = cvt_pk_bf16(v[2], v[3]); w.z = cvt_pk_bf16(v[4], v[5]); w.w = cvt_pk_bf16(v[6], v[7]);
                gst<u32x4>(S5KV + ((size_t)(g * 512 + n) * ATK + k8 * 8), w);
            }
            }
            if (!FUSE1) { bf16* H = WP(bf16, WS_H); const float* gn = IN(I_NMIX) + l * 1024;
              if (l == 0) { for (int grp = gw; grp < M / 4; grp += NGW) norm_rows4<false>(xin0, gn, H, grp * 4, lane, nullptr, nullptr, nullptr, nullptr, nullptr, nullptr); }
              else { bf16* XB = (bf16*)XO; for (int grp = gw; grp < M / 4; grp += NGW) norm_rows4b(XB, gn, H, grp * 4, lane); } }
        }
        GRID_BAR();
        }

        for (int rep_ = 0; rep_ < NREP(3); ++rep_) {
        if (PH(3)) {
            WSL();
            pg8::Gemm g{WP(bf16, WS_H), WP(bf16, WS_WIN), 1024, 1024, 1024}; pg8::StaticOrder S; S.init(M / 256, INC / 256, G, bid);
            EpiProj E{WP(bf16, WS_QK), WP(bf16, WS_VT8), WP(bf16, WS_AT), WP(bf16, WS_QX), WP(bf16, WS_GATES), IN(I_BGATE) + l * 3072, FUSE1 ? WP(float, WS_SS) + (size_t)l * M * 16 : nullptr};
            pg8::gemm_phase<EpiProj, pg8::StaticOrder>(F.lds, g, S, E, tid);
        }
        GRID_BAR();
        }

        for (int rep_ = 0; rep_ < NREP(4); ++rep_) {
        if (PH(4)) {
            WSL();
            for (int bg = bid; bg < 64; bg += G) {
                { pg8::Gemm g{WP(bf16, WS_AT), WP(bf16, WS_S5W), ATK, 512, 512}; pg8::ListOrder S{bg, 1, 1}; EpiS5a E{WP(float, WS_ST)};
                  pg8::gemm_phase<EpiS5a, pg8::ListOrder>(F.lds, g, S, E, tid); }
                WG_MEM_SYNC();
                s5_scan_item(bg * 2, WP(float, WS_ST), WP(bf16, WS_AT), WP(f32x2, WS_APOW) + (size_t)l * 2 * 16 * 33 * 64, (LAS float*)F.lds, tid);
                s5_scan_item(bg * 2 + 1, WP(float, WS_ST), WP(bf16, WS_AT), WP(f32x2, WS_APOW) + (size_t)l * 2 * 16 * 33 * 64, (LAS float*)F.lds, tid);
                WG_MEM_SYNC();
                { pg8::Gemm g{WP(bf16, WS_AT), WP(bf16, WS_S5KV), ATK, ATK, ATK}; pg8::ListOrder S{bg, 2, 2}; EpiS5c E{WP(bf16, WS_Y)};
                  pg8::gemm_phase<EpiS5c, pg8::ListOrder>(F.lds, g, S, E, tid); }
            }
            unsigned* qhead = WP(unsigned, WS_CTL) + CW_Q + (l + 4 * rep_) * 64;
            volatile LAS int* qslot = (volatile LAS int*)(F.lds + MISC_OFF + 64);
            for (;;) {
                if (tid == 0) qslot[0] = (int)__hip_atomic_fetch_add((GASP unsigned*)qhead, 1u, __ATOMIC_RELAXED, __HIP_MEMORY_SCOPE_AGENT);
                __syncthreads();
                const int qi = __builtin_amdgcn_readfirstlane(qslot[0]);
                __syncthreads();
                if (qi >= 768) break;
                if (qi < 512) NA_ITEM(qi); else XA_ITEMS(qi - 512, qi - 511, 1);
            }
        }
        GRID_BAR();
        }

        for (int rep_ = 0; rep_ < NREP(7); ++rep_) {
        if (PH(7)) {
            WSL();
            pg8::Gemm g{WP(bf16, WS_Y), WP(bf16, WS_WGLU), 256, 256, 256}; pg8::StaticOrder S; S.init(M / 256, 2, G, bid); EpiGlu E{WP(bf16, WS_H)};
            pg8::gemm_phase<EpiGlu, pg8::StaticOrder>(F.lds, g, S, E, tid);
        }
        GRID_BAR();
        }

        for (int rep_ = 0; rep_ < NREP(8); ++rep_) {
        if (PH(8)) {
            WSL();
            pg8::Gemm g{WP(bf16, WS_H), WP(bf16, WS_WCAT), 1024, 1024, 1024}; pg8::StaticOrder S; S.init(M / 256, 4, G, bid); EpiMerge E{WP(unsigned char, WS_GATES), WP(bf16, WS_QK)};
            pg8::gemm_phase<EpiMerge, pg8::StaticOrder, false, true>(F.lds, g, S, E, tid);
        }
        GRID_BAR();
        }

        for (int rep_ = 0; rep_ < NREP(9); ++rep_) {
        if (PH(9)) {
            WSL();
            pg8::Gemm g{WP(bf16, WS_QK), WP(bf16, WS_WOUT), 1024, 1024, 1024}; pg8::StaticOrder S; S.init(M / 256, 4, G, bid); EpiDelta E{WP(bf16, WS_H)};
            pg8::gemm_phase<EpiDelta, pg8::StaticOrder>(F.lds, g, S, E, tid);
        }
        GRID_BAR();
        }

        for (int rep_ = 0; rep_ < NREP(10); ++rep_) {
        if (PH(10)) {
            WSL();
            {
            unsigned* cnt = WP(unsigned, WS_CTL) + CW_CNT + (l + 4 * rep_) * NBUCKET * 64;
            const float* bco = IN(I_BCO) + l * 4; const float* bfi = IN(I_BFI) + l * 16;
            int* LIST = rep_ ? WP(int, WS_GATES + 100 * MiB) : WP(int, WS_LIST); float* WTS = rep_ ? WP(float, WS_GATES + 104 * MiB) : WP(float, WS_WTS);
            { const u32x4* src = (const u32x4*)(WP(bf16, WS_WRT) + (size_t)l * 2 * 20480);
              for (int idx = tid; idx < 40 * 128; idx += NWAVES * 64) *(LAS u32x4*)(F.lds + (idx >> 7) * RT_STRIDE + (idx & 127) * 16) = gld<u32x4>(src + idx); }
            __syncthreads();
            for (int grp = gw; grp < M / 16; grp += NGW) router_rows16(xin0, (l == 0 || rep_) ? nullptr : (const bf16*)XO, rep_ ? nullptr : WP(bf16, WS_H), rep_ ? WP(bf16, WS_GATES + 120 * MiB) : (l == DEPTH - 1 ? WP(bf16, WS_QK) : (bf16*)XO), grp * 16, lane, F.lds, wave, bco, bfi, cnt, LIST, WTS);
            __syncthreads();
            }
            bf16* WGU = WP(bf16, WS_WGU); bf16* WDP = WP(bf16, WS_WDP);
            for (int it = gw; it < 10240; it += NGW) {
                int r = it;
                if (r < 2048) { const int e = r >> 7; transpose_job_item(IN(I_WG) + (size_t)(l * 16 + e) * 1024 * 256, 256, 256, r & 127, WGU + (size_t)e * 512 * 1024, 1024, 0, 0, 2, 0, 0, IN(I_NFFN) + l * 1024, SCR(), lane); continue; } r -= 2048;
                if (r < 2048) { const int e = r >> 7; transpose_job_item(IN(I_WU) + (size_t)(l * 16 + e) * 1024 * 256, 256, 256, r & 127, WGU + (size_t)e * 512 * 1024, 1024, 0, 0, 2, 1, 0, IN(I_NFFN) + l * 1024, SCR(), lane); continue; } r -= 2048;
                const int ej = r >> 7, e = ej / 3, jj = ej % 3, i = e & 3, grpI = e >> 2, o = jj + (jj >= i ? 1 : 0), a = i < o ? i : o, b = i < o ? o : i;
                const int pair = grpI * 6 + (a == 0 ? b - 1 : (a == 1 ? b + 1 : 5)), slot = (i == a) ? 0 : 1;
                transpose_job_item(IN(I_WD) + (size_t)(l * 16 + e) * 256 * 1024, 1024, 1024, r & 127, WDP + (size_t)pair * 1024 * 512, 512, slot * 256, 0, 1, 0, 0, nullptr, SCR(), lane);
            }
        }
        GRID_BAR();
        }

        LAS int* tab = (LAS int*)(F.lds + TAB_OFF);
        for (int rep_ = 0; rep_ < NREP(11); ++rep_) {
        if (PH(11)) {
            WSL();
            unsigned* cnt = WP(unsigned, WS_CTL) + CW_CNT + l * NBUCKET * 64;
            if (tid == 0) { int st = 0;
                for (int b = 0; b < NBUCKET; ++b) { const int c = (int)__hip_atomic_load((GASP unsigned*)(cnt + b * 64), __ATOMIC_RELAXED, __HIP_MEMORY_SCOPE_AGENT); tab[b] = c; tab[32 + b] = st; st += (c + 255) >> 8; }
                tab[32 + NBUCKET] = st; tab[64] = st; }
            __syncthreads();
            pg8::Gemm g{l == DEPTH - 1 ? WP(bf16, WS_QK) : (const bf16*)XO, WP(bf16, WS_WGU), 1024, 1024, 1024}; pg8::MoeOrder S{tab, WP(int, WS_LIST), G, bid, 0}; EpiMoe1 E{WP(bf16, WS_ACT), WP(float, WS_WTS)};
            pg8::gemm_phase<EpiMoe1, pg8::MoeOrder, true>(F.lds, g, S, E, tid);
        }
        GRID_BAR();
        }

        for (int rep_ = 0; rep_ < NREP(12); ++rep_) {
        if (PH(12)) {
            WSL();
            pg8::Gemm g{WP(bf16, WS_ACT), WP(bf16, WS_WDP), 512, 512, 512}; pg8::MoeOrder S{tab, WP(int, WS_LIST), G, bid, 1}; EpiMoe2 E{WP(bf16, WS_H), WP(int, WS_LIST)};
            pg8::gemm_phase<EpiMoe2, pg8::MoeOrder>(F.lds, g, S, E, tid);
        }
        GRID_BAR();
        }
    }
    { WSL(); const float* gn = IN(I_FNORM);
      for (int row = gw; row < M; row += NGW) final_norm_row(WP(bf16, WS_QK), WP(bf16, WS_H), XO, gn, row, lane); }
#undef GRID_BAR
}

extern "C" void kernel_launch(void* const* d_in, const int* in_sizes, int n_in, void* d_out, int out_size, void* d_ws, size_t ws_size, hipStream_t stream) {
    static int grid = 0;
    if (grid == 0) {
        if (n_in != 30 || out_size != M * D || ws_size < WS_END) { fprintf(stderr, "kernel_launch: unexpected shapes (n_in %d, out %d, ws %zu)\n", n_in, out_size, ws_size); grid = -1; return; }
        int dev = 0, cus = 0, per_cu = 0;
        if (hipGetDevice(&dev) != hipSuccess || hipDeviceGetAttribute(&cus, hipDeviceAttributeMultiprocessorCount, dev) != hipSuccess) { grid = -1; return; }
        if (hipFuncSetAttribute((const void*)fwd_kernel, hipFuncAttributeMaxDynamicSharedMemorySize, LDS_BYTES) != hipSuccess) { fprintf(stderr, "kernel_launch: hipFuncSetAttribute failed\n"); grid = -1; return; }
        if (hipOccupancyMaxActiveBlocksPerMultiprocessor(&per_cu, (const void*)fwd_kernel, NWAVES * 64, LDS_BYTES) != hipSuccess || per_cu < 1) { fprintf(stderr, "kernel_launch: occupancy query reports %d\n", per_cu); }
        (void)hipGetLastError();
        grid = cus;
    }
    if (grid < 0) return;
    (void)in_sizes;
    (void)hipMemsetAsync((char*)d_ws + WS_CTL, 0, CTL_BYTES, stream);
    Args a{};
    for (int i = 0; i < 30; ++i) a.in[i] = (const float*)d_in[i];
    a.out = (float*)d_out; a.ws = (unsigned char*)d_ws;
    hipLaunchKernelGGL(fwd_kernel, dim3(grid), dim3(NWAVES * 64), LDS_BYTES, stream, a);
}
```

```cpp
#include <hip/hip_runtime.h>
#include <cstdio>
#include <cstdint>

#define LAS __attribute__((address_space(3)))
typedef unsigned short bf16;
typedef short bf16x8 __attribute__((ext_vector_type(8)));
typedef float f32x4 __attribute__((ext_vector_type(4)));
typedef float f32x2 __attribute__((ext_vector_type(2)));
typedef unsigned u32x4 __attribute__((ext_vector_type(4)));
typedef unsigned u32x2 __attribute__((ext_vector_type(2)));

constexpr int D = 1024, BATCH = 4, SEQ = 8192, M = BATCH * SEQ, DEPTH = 4;
constexpr int INC = 5120, NMEM = 256;
constexpr int NCHUNK = 256, TCH = 32;
constexpr int ATK = 768;
constexpr int LCAP = 32768;
constexpr int NBUCKET = 24;
constexpr float RMS_EPS = 1e-6f;

constexpr size_t MiB = 1u << 20;
constexpr size_t WS_CTL = 0, CTL_BYTES = 1 * MiB;
constexpr size_t WS_APOW = 1 * MiB;
constexpr size_t WS_BBAR = 4 * MiB;
constexpr size_t WS_KT = 5 * MiB;
constexpr size_t WS_WRT = 10 * MiB;
constexpr size_t WS_RPBP = 10 * MiB + 512 * 1024;
constexpr size_t WS_MEMN = 11 * MiB;
constexpr size_t WS_WMKV = 19 * MiB;
constexpr size_t WS_KM = 23 * MiB;
constexpr size_t WS_VM8 = 25 * MiB;
constexpr size_t WS_WIN = 27 * MiB;
constexpr size_t WS_WCAT = 37 * MiB;
constexpr size_t WS_WOUT = 39 * MiB;
constexpr size_t WS_WGLU = 41 * MiB;
constexpr size_t WS_S5W = 42 * MiB;
constexpr size_t WS_S5KV = 46 * MiB;
constexpr size_t WS_H = 58 * MiB;
constexpr size_t WS_QK = 122 * MiB;
constexpr size_t WS_VT8 = 186 * MiB;
constexpr size_t WS_AT = 218 * MiB;
constexpr size_t WS_QX = 242 * MiB;
constexpr size_t WS_ST = 258 * MiB;
constexpr size_t WS_Y = 274 * MiB;
constexpr size_t WS_GATES = 290 * MiB;
constexpr size_t WS_WGU = WS_GATES;
constexpr size_t WS_WDP = WS_GATES + 16 * MiB;
constexpr size_t WS_ACT = WS_GATES + 40 * MiB;
constexpr size_t WS_LIST = 482 * MiB;
constexpr size_t WS_WTS = 485 * MiB;
constexpr size_t WS_SS = 497 * MiB;
constexpr size_t WS_END = 505 * MiB;
constexpr int CW_BAR = 4096;
constexpr int CW_CNT = 16384;
constexpr int CW_Q = 32768;

__device__ __forceinline__ unsigned cvt_pk_bf16(float lo, float hi) { unsigned r; asm volatile("v_cvt_pk_bf16_f32 %0, %1, %2" : "=v"(r) : "v"(lo), "v"(hi)); return r; }
__device__ __forceinline__ float bf2f(unsigned short b) { return __uint_as_float(((unsigned)b) << 16); }
__device__ __forceinline__ float bflo(unsigned w) { return __uint_as_float(w << 16); }
__device__ __forceinline__ float bfhi(unsigned w) { return __uint_as_float(w & 0xffff0000u); }
__device__ __forceinline__ float fast_rcp(float x) { return __builtin_amdgcn_rcpf(x); }
__device__ __forceinline__ float fast_exp(float x) { return __builtin_amdgcn_exp2f(x * 1.4426950408889634f); }
__device__ __forceinline__ float sigmoid_f(float x) { return fast_rcp(1.0f + fast_exp(-x)); }
__device__ __forceinline__ float gelu_tanh_f(float x) { const float u = 1.5957691216057308f * (x + 0.044715f * x * x * x); return x * fast_rcp(1.0f + fast_exp(-u)); }
__device__ __forceinline__ float shfl_xor_f(float v, int o, int lane) { return __int_as_float(__builtin_amdgcn_ds_bpermute((lane ^ o) << 2, __float_as_int(v))); }
__device__ __forceinline__ float shfl_idx_f(float v, int src) { return __int_as_float(__builtin_amdgcn_ds_bpermute(src << 2, __float_as_int(v))); }
__device__ __forceinline__ float wave_sum(float v, int lane) {
#pragma unroll
    for (int o = 1; o < 64; o <<= 1) v += shfl_xor_f(v, o, lane);
    return v;
}
#define GASP __attribute__((address_space(1)))
template <class T> __device__ __forceinline__ T gld(const void* p) { return *(const GASP T*)p; }
template <class T> __device__ __forceinline__ void gst(void* p, const T& v) { *(GASP T*)p = v; }
__device__ __forceinline__ unsigned q8(float g) { return (unsigned)__builtin_fminf(__builtin_fmaxf(__builtin_rintf(g * 255.0f), 1.0f), 255.0f); }
__device__ __forceinline__ unsigned q8x4(float a, float b, float c, float d) { return q8(a) | (q8(b) << 8) | (q8(c) << 16) | (q8(d) << 24); }
#define LDS_WAIT() asm volatile("s_waitcnt lgkmcnt(0)" ::: "memory")
#define VM_WAIT() asm volatile("s_waitcnt vmcnt(0)" ::: "memory")

namespace pg8 {
constexpr int BM = 256, BK = 64, HALF = 128, HTB = HALF * BK * 2, STAGE_BYTES = 8 * HTB, NXCD = 8, WGM = 8;
__host__ __device__ __forceinline__ int lds_byte(int r, int c) { const int st = (r >> 4) * 2 + (c >> 5), rr = r & 15, cc = c & 31, ob = rr * 64 + cc * 2; return st * 1024 + (ob ^ (((ob >> 9) & 1) << 5)); }
__host__ __device__ __forceinline__ void stage_rc(int b, int& R, int& C) { const int st = b / 1024, sb = b % 1024, swz = sb ^ (((sb >> 9) & 1) << 5); R = (st >> 1) * 16 + swz / 64; C = (st & 1) * 32 + (swz % 64) / 2; }
__host__ __device__ __forceinline__ int perm32(int rho) { const int n = rho >> 4, i = rho & 15; return 8 * (i >> 2) + 4 * n + (i & 3); }

struct Unit { int pm, pn, am, bn, x0, x1, x2; };
struct Gemm { const bf16* A; const bf16* Bt; int lda, ldb, K; };

struct StaticOrder {
    int nM, nN, nwg, G, c;
    __device__ void init(int nM_, int nN_, int G_, int c_) { nM = nM_; nN = nN_; nwg = nM * nN; G = G_; c = c_; }
    __device__ bool next(int i, Unit& u) const {
        const long L = (long)i * G + c; if (L >= nwg) return false;
        int wgid = (int)L; { const int q = nwg / NXCD, r = nwg % NXCD, xcd = wgid % NXCD, off = wgid / NXCD; wgid = (xcd < r ? xcd * (q + 1) : r * (q + 1) + (xcd - r) * q) + off; }
        const int nig = WGM * nN, gid = wgid / nig, fm = gid * WGM, gsz = (nM - fm) < WGM ? (nM - fm) : WGM;
        u.pm = __builtin_amdgcn_readfirstlane(fm + ((wgid % nig) % gsz)); u.pn = __builtin_amdgcn_readfirstlane((wgid % nig) / gsz);
        u.am = u.pm; u.bn = u.pn; u.x0 = 0; u.x1 = 0; u.x2 = 0; return true;
    }
    __device__ __forceinline__ int a_row(const Unit&, int) const { return 0; }
};
struct S5Order : StaticOrder {
    __device__ bool next(int i, Unit& u) const { if (!StaticOrder::next(i, u)) return false; u.bn = (u.pm & 15) * nN + u.pn; return true; }
};
struct ListOrder {
    int pm, n, nN;
    __device__ bool next(int i, Unit& u) const { if (i >= n) return false; u.pm = pm; u.pn = i; u.am = pm; u.bn = (pm & 15) * nN + i; u.x0 = 0; u.x1 = 0; u.x2 = 0; return true; }
    __device__ __forceinline__ int a_row(const Unit&, int) const { return 0; }
};
struct MemOrder {
    int G, c;
    __device__ bool next(int i, Unit& u) const { const int L = i * G + c; if (L >= 32) return false; u.pm = L >> 1; u.pn = L & 1; u.am = u.pm; u.bn = (u.pm >> 2) * 2 + u.pn; u.x0 = 0; u.x1 = 0; u.x2 = 0; return true; }
    __device__ __forceinline__ int a_row(const Unit&, int) const { return 0; }
};
struct MoeOrder {
    const LAS int* tab; const int* list; int G, c, mode;
    __device__ bool next(int i, Unit& u) const {
        const int T = __builtin_amdgcn_readfirstlane(tab[64]); const int L = i * G + c; if (L >= T * 4) return false;
        const int tile = L >> 2, pn = L & 3; int b = 0;
#pragma unroll 1
        for (int j = 1; j < NBUCKET; ++j) if (__builtin_amdgcn_readfirstlane(tab[32 + j]) <= tile) b = j;
        u.pm = tile; u.pn = pn; u.am = tile; u.x0 = b; u.x1 = (tile - __builtin_amdgcn_readfirstlane(tab[32 + b])) * 256; u.x2 = __builtin_amdgcn_readfirstlane(tab[b]);
        const int grp = __builtin_amdgcn_readfirstlane(b / 6), pi = __builtin_amdgcn_readfirstlane(b % 6); const int ea = pi < 3 ? 0 : (pi < 5 ? 1 : 2), eb = pi < 3 ? pi + 1 : (pi < 5 ? pi - 1 : 3);
        if (mode == 0) { const int e = grp * 4 + ((pn >> 1) ? eb : ea); u.bn = e * 2 + (pn & 1); } else u.bn = b * 4 + pn;
        return true;
    }
    __device__ __forceinline__ int a_row(const Unit& u, int r) const { const int slot = u.x1 + r; return slot < u.x2 ? gld<int>(list + (unsigned)(u.x0 * LCAP + slot)) : 0; }
};

template <class Epi, class Sched, bool GATHER = false, bool KHOOK = false>
__device__ __forceinline__ void gemm_phase(LAS unsigned char* lds, const Gemm g, const Sched& S, const Epi& E, int tid_in) {
    int tid = tid_in; asm volatile("" : "+v"(tid));
    const int wid = __builtin_amdgcn_readfirstlane(tid >> 6), lane = tid & 63, wr = wid >> 2, wc = wid & 3, fr = lane & 15, fq = lane >> 4;
    int K = g.K, lda = g.lda, ldb = g.ldb;
    asm volatile("" : "+s"(K), "+s"(lda), "+s"(ldb));
    const int nt = K / BK;
    unsigned voffA[2], voffB[2]; int Rr[2], Cc[2];
#pragma unroll
    for (int i = 0; i < 2; ++i) { int R, C; stage_rc(tid * 16 + i * 8192, R, C); const int Rb = Epi::PERM ? ((R & ~31) + perm32(R & 31)) : R;
        voffA[i] = (unsigned)(R * lda + C) * 2u; voffB[i] = (unsigned)(Rb * ldb + C) * 2u; Rr[i] = R; Cc[i] = C; }
    const unsigned kstep = (unsigned)(BK * 2);
    const unsigned hstepA = (unsigned)(HALF * lda * 2), tstepA = 2u * hstepA, hstepB = (unsigned)(HALF * ldb * 2), tstepB = 2u * hstepB;
    const unsigned ldsw = (unsigned)wid * 1024u;
    const int aoff = lds_byte(wr * 64 + fr, fq * 8), boff = lds_byte(wc * 32 + fr, fq * 8);
    unsigned vC[2][2] = {{0u, 0u}, {0u, 0u}}, vN[2][2] = {{0u, 0u}, {0u, 0u}};
#define PG8_SA(b, h) (((b) * 2 + (h)) * HTB)
#define PG8_SB(b, h) ((4 + (b) * 2 + (h)) * HTB)
#define PG8_STAGE(bufoff, gbase, voff) do { _Pragma("unroll") for (int _i = 0; _i < 2; ++_i) \
        __builtin_amdgcn_global_load_lds((const unsigned*)((const char*)(gbase) + (voff)[_i]), (LAS unsigned*)(lds + (bufoff) + ldsw + _i * 8192), 16, 0, 0); } while (0)
#define PG8_STA(bufoff, ptr, h, nx) do { if constexpr (GATHER) { unsigned _v[2]; _v[0] = (nx) ? vN[h][0] : vC[h][0]; _v[1] = (nx) ? vN[h][1] : vC[h][1]; PG8_STAGE(bufoff, ptr, _v); } \
        else { PG8_STAGE(bufoff, (ptr) + (h) * hstepA, voffA); } } while (0)
#define PG8_STB(bufoff, ptr, h) PG8_STAGE(bufoff, (ptr) + (h) * hstepB, voffB)
#define PG8_LDA(dst, b, h) do { _Pragma("unroll") for (int m = 0; m < 4; ++m) _Pragma("unroll") for (int k = 0; k < 2; ++k) dst[m][k] = *(const LAS bf16x8*)(lds + PG8_SA(b, h) + aoff + m * 2048 + k * 1024); } while (0)
#define PG8_LDB(dst, b, h) do { _Pragma("unroll") for (int n = 0; n < 2; ++n) _Pragma("unroll") for (int k = 0; k < 2; ++k) dst[n][k] = *(const LAS bf16x8*)(lds + PG8_SB(b, h) + boff + n * 2048 + k * 1024); } while (0)
#define PG8_MMA(ai, bj, At, Bt) do { __builtin_amdgcn_s_setprio(1); _Pragma("unroll") for (int m = 0; m < 4; ++m) _Pragma("unroll") for (int n = 0; n < 2; ++n) _Pragma("unroll") for (int k = 0; k < 2; ++k) \
        acc[ai][bj][m][n] = __builtin_amdgcn_mfma_f32_16x16x32_bf16(Bt[n][k], At[m][k], acc[ai][bj][m][n], 0, 0, 0); __builtin_amdgcn_s_setprio(0); } while (0)
#define PG8_WAIT_V(n) asm volatile("s_waitcnt vmcnt(" #n ")" ::: "memory")
#define PG8_WAIT_L(n) asm volatile("s_waitcnt lgkmcnt(" #n ")" ::: "memory")
#define PG8_BAR __builtin_amdgcn_s_barrier()
#define PG8_SCHED __builtin_amdgcn_sched_barrier(0)
    Unit cur, nxt; int ui = 0;
    if (!S.next(0, cur)) return;
    f32x4 acc[2][2][4][2];
#pragma unroll
    for (int a = 0; a < 2; ++a)
#pragma unroll
        for (int b = 0; b < 2; ++b)
#pragma unroll
            for (int m = 0; m < 4; ++m)
#pragma unroll
                for (int n = 0; n < 2; ++n) acc[a][b][m][n] = (f32x4){0.f, 0.f, 0.f, 0.f};
    bf16x8 At[4][2], B0[2][2], B1[2][2];
    const char* cA = GATHER ? (const char*)g.A : (const char*)g.A + (unsigned)cur.am * tstepA;
    const char* cB = (const char*)g.Bt + (unsigned)cur.bn * tstepB;
    if constexpr (GATHER) {
#pragma unroll
        for (int h = 0; h < 2; ++h)
#pragma unroll
            for (int i = 0; i < 2; ++i) vC[h][i] = (unsigned)(S.a_row(cur, h * HALF + Rr[i]) * lda + Cc[i]) * 2u;
    }
    PG8_STB(PG8_SB(0, 0), cB, 0); PG8_STB(PG8_SB(0, 1), cB, 1); PG8_STA(PG8_SA(0, 0), cA, 0, false); PG8_STA(PG8_SA(0, 1), cA, 1, false);
    if (wr == 1) PG8_BAR;
    PG8_WAIT_V(2); PG8_BAR;
    PG8_STB(PG8_SB(1, 0), cB + kstep, 0); PG8_STA(PG8_SA(1, 0), cA + kstep, 0, false); PG8_STB(PG8_SB(1, 1), cB + kstep, 1);
    PG8_WAIT_V(6); PG8_BAR;
    for (;;) {
        const bool has_next = S.next(ui + 1, nxt);
        const char* nA = GATHER ? (const char*)g.A : (has_next ? (const char*)g.A + (unsigned)nxt.am * tstepA : cA);
        const char* nB = has_next ? (const char*)g.Bt + (unsigned)nxt.bn * tstepB : cB;
        if constexpr (GATHER) {
#pragma unroll
            for (int h = 0; h < 2; ++h)
#pragma unroll
                for (int i = 0; i < 2; ++i) vN[h][i] = has_next ? (unsigned)(S.a_row(nxt, h * HALF + Rr[i]) * lda + Cc[i]) * 2u : vC[h][i];
        }
        int tb = 0;
#pragma unroll 1
        for (int seg = 0; seg < (KHOOK ? 3 : 1); ++seg) {
        const int te = KHOOK ? (seg == 0 ? 8 : (seg == 1 ? 12 : nt)) : nt;
        for (int t = tb; t < te; t += 2) {
            const bool last = (t == nt - 2);
            const char* a1 = cA + (unsigned)(t + 1) * kstep;
            const char* a2 = last ? nA : cA + (unsigned)(t + 2) * kstep; const char* b2 = last ? nB : cB + (unsigned)(t + 2) * kstep;
            const char* a3 = a2 + kstep; const char* b3 = b2 + kstep;
            PG8_LDB(B0, 0, 0); PG8_LDB(B1, 0, 1); PG8_SCHED; PG8_LDA(At, 0, 0); PG8_STA(PG8_SA(1, 1), a1, 1, false);
            PG8_WAIT_V(8); PG8_WAIT_L(0); PG8_BAR; PG8_MMA(0, 0, At, B0); PG8_MMA(0, 1, At, B1); PG8_BAR; PG8_SCHED;
            PG8_LDA(At, 0, 1); PG8_STB(PG8_SB(0, 0), b2, 0); PG8_STB(PG8_SB(0, 1), b2, 1); PG8_STA(PG8_SA(0, 0), a2, 0, last);
            PG8_WAIT_V(8); PG8_WAIT_L(0); PG8_BAR; PG8_MMA(1, 0, At, B0); PG8_MMA(1, 1, At, B1); PG8_BAR; PG8_SCHED;
            PG8_LDB(B0, 1, 0); PG8_LDB(B1, 1, 1); PG8_SCHED; PG8_LDA(At, 1, 0); PG8_STA(PG8_SA(0, 1), a2, 1, last);
            PG8_WAIT_V(8); PG8_WAIT_L(0); PG8_BAR; PG8_MMA(0, 0, At, B0); PG8_MMA(0, 1, At, B1); PG8_BAR; PG8_SCHED;
            PG8_LDA(At, 1, 1); PG8_STB(PG8_SB(1, 0), b3, 0); PG8_STB(PG8_SB(1, 1), b3, 1); PG8_STA(PG8_SA(1, 0), a3, 0, last);
            PG8_WAIT_V(8); PG8_WAIT_L(0); PG8_BAR; PG8_MMA(1, 0, At, B0); PG8_MMA(1, 1, At, B1); PG8_BAR; PG8_SCHED;
        }
        if constexpr (KHOOK) { if (seg < 2) { unsigned mm_ = ~0u; asm volatile("" : "+s"(mm_)); const int ln_ = (int)__builtin_amdgcn_mbcnt_hi(mm_, __builtin_amdgcn_mbcnt_lo(mm_, 0u)); E.khook(acc, cur, te, wr, wc, ln_ & 15, ln_ >> 4); } }
        tb = te;
        }
        if (wr == 0) PG8_BAR;
        { unsigned mm_ = ~0u; asm volatile("" : "+s"(mm_)); const int ln_ = (int)__builtin_amdgcn_mbcnt_hi(mm_, __builtin_amdgcn_mbcnt_lo(mm_, 0u)); E(acc, cur, wr, wc, ln_ & 15, ln_ >> 4); }
        if (!has_next) break;
#pragma unroll
        for (int a = 0; a < 2; ++a)
#pragma unroll
            for (int b = 0; b < 2; ++b)
#pragma unroll
                for (int m = 0; m < 4; ++m)
#pragma unroll
                    for (int n = 0; n < 2; ++n) acc[a][b][m][n] = (f32x4){0.f, 0.f, 0.f, 0.f};
        cur = nxt; cA = nA; cB = nB; ++ui;
        if constexpr (GATHER) {
#pragma unroll
            for (int h = 0; h < 2; ++h)
#pragma unroll
                for (int i = 0; i < 2; ++i) vC[h][i] = vN[h][i];
        }
        if (wr == 1) PG8_BAR;
    }
    PG8_WAIT_V(0);
    PG8_BAR;
#undef PG8_SA
#undef PG8_SB
#undef PG8_STAGE
#undef PG8_STA
#undef PG8_STB
#undef PG8_LDA
#undef PG8_LDB
#undef PG8_MMA
#undef PG8_WAIT_V
#undef PG8_WAIT_L
#undef PG8_BAR
#undef PG8_SCHED
}
}

using pg8::Unit;
struct EpiProj {
    static constexpr bool PERM = true;
    bf16 *QK, *Vt8, *At, *QX, *GATES; const float* bgate; const float* ssq;
#define EP_LOOP_BEGIN _Pragma("unroll") for (int ai = 0; ai < 2; ++ai) _Pragma("unroll") for (int m = 0; m < 4; ++m) { const int row = row0 + ai * 128 + m * 16; const float rs = rstd[ai][m]; _Pragma("unroll") for (int bj = 0; bj < 2; ++bj) { \
        const f32x4 v0 = acc[ai][bj][m][0] * rs, v1 = acc[ai][bj][m][1] * rs; const int cl = cl0 + bj * 128;
#define EP_LOOP_END } asm volatile("" ::: "memory"); }
    __device__ __forceinline__ void operator()(const f32x4 (&acc)[2][2][4][2], const Unit& u, int wr, int wc, int fr, int fq) const {
        const int pn = u.pn, row0 = u.pm * 256 + wr * 64 + fr, cl0 = wc * 32 + 8 * fq;
        float rstd[2][4];
#pragma unroll
        for (int ai = 0; ai < 2; ++ai)
#pragma unroll
            for (int m = 0; m < 4; ++m) rstd[ai][m] = ssq ? gld<float>(ssq + row0 + ai * 128 + m * 16) : 1.0f;
        if (pn < 4) {
            EP_LOOP_BEGIN
                u32x4 w; w.x = cvt_pk_bf16(v0[0], v0[1]); w.y = cvt_pk_bf16(v0[2], v0[3]); w.z = cvt_pk_bf16(v1[0], v1[1]); w.w = cvt_pk_bf16(v1[2], v1[3]);
                gst<u32x4>(QK + (unsigned)row * 1024 + pn * 256 + cl, w);
            EP_LOOP_END
        } else if (pn < 6) {
            EP_LOOP_BEGIN
                const int vc = (pn - 4) * 256 + cl, hh = vc >> 6, dh = vc & 63, b = row >> 13, s = row & 8191;
                bf16* p = Vt8 + ((unsigned)((b * 8 + hh) * 1024 + (s >> 3)) * 64 + dh) * 8 + (s & 7);
                const unsigned w0 = cvt_pk_bf16(v0[0], v0[1]), w1 = cvt_pk_bf16(v0[2], v0[3]), w2 = cvt_pk_bf16(v1[0], v1[1]), w3 = cvt_pk_bf16(v1[2], v1[3]);
                gst<bf16>(p, (bf16)w0); gst<bf16>(p + 8, (bf16)(w0 >> 16)); gst<bf16>(p + 16, (bf16)w1); gst<bf16>(p + 24, (bf16)(w1 >> 16)); gst<bf16>(p + 32, (bf16)w2); gst<bf16>(p + 40, (bf16)(w2 >> 16)); gst<bf16>(p + 48, (bf16)w3); gst<bf16>(p + 56, (bf16)(w3 >> 16));
            EP_LOOP_END
        } else if (pn == 6) {
            EP_LOOP_BEGIN
                const int g = cl >> 4, c0 = cl & 15, b = row >> 13, s = row & 8191;
                u32x4 w; w.x = cvt_pk_bf16(v0[0], v0[1]); w.y = cvt_pk_bf16(v0[2], v0[3]); w.z = cvt_pk_bf16(v1[0], v1[1]); w.w = cvt_pk_bf16(v1[2], v1[3]);
                gst<u32x4>(At + ((unsigned)((b * 16 + g) * 256 + (s >> 5))) * ATK + (s & 31) * 16 + c0, w);
            EP_LOOP_END
        } else if (pn == 7) {
            EP_LOOP_BEGIN
                u32x4 w; w.x = cvt_pk_bf16(v0[0], v0[1]); w.y = cvt_pk_bf16(v0[2], v0[3]); w.z = cvt_pk_bf16(v1[0], v1[1]); w.w = cvt_pk_bf16(v1[2], v1[3]);
                gst<u32x4>(QX + (unsigned)row * 256 + cl, w);
            EP_LOOP_END
        } else {
            EP_LOOP_BEGIN
                const int gc = (pn - 8) * 256 + cl;
                const f32x4 b0 = gld<f32x4>(bgate + gc), b1 = gld<f32x4>(bgate + gc + 4);
                u32x2 w; w.x = q8x4(sigmoid_f(v0[0] + b0[0]), sigmoid_f(v0[1] + b0[1]), sigmoid_f(v0[2] + b0[2]), sigmoid_f(v0[3] + b0[3]));
                w.y = q8x4(sigmoid_f(v1[0] + b1[0]), sigmoid_f(v1[1] + b1[1]), sigmoid_f(v1[2] + b1[2]), sigmoid_f(v1[3] + b1[3]));
                gst<u32x2>((unsigned char*)GATES + (unsigned)row * 3072 + gc, w);
            EP_LOOP_END
        }
    }
#undef EP_LOOP_BEGIN
#undef EP_LOOP_END
};
struct EpiMemKV {
    static constexpr bool PERM = true;
    bf16 *Km, *Vm8;
    __device__ __forceinline__ void operator()(const f32x4 (&acc)[2][2][4][2], const Unit& u, int wr, int wc, int fr, int fq) const {
        const int row0 = u.pm * 256 + wr * 64 + fr, cl0 = wc * 32 + 8 * fq;
#pragma unroll
        for (int ai = 0; ai < 2; ++ai)
#pragma unroll
            for (int m = 0; m < 4; ++m) {
                const int row = row0 + ai * 128 + m * 16;
#pragma unroll
                for (int bj = 0; bj < 2; ++bj) {
                    const f32x4 v0 = acc[ai][bj][m][0], v1 = acc[ai][bj][m][1];
                    const int cl = cl0 + bj * 128;
                    const unsigned w0 = cvt_pk_bf16(v0[0], v0[1]), w1 = cvt_pk_bf16(v0[2], v0[3]), w2 = cvt_pk_bf16(v1[0], v1[1]), w3 = cvt_pk_bf16(v1[2], v1[3]);
                    if (u.pn == 0) { u32x4 w; w.x = w0; w.y = w1; w.z = w2; w.w = w3; gst<u32x4>(Km + (unsigned)row * 256 + cl, w); }
                    else {
                        const int hh = cl >> 6, dh = cl & 63, lb = row >> 8, mm = row & 255;
                        bf16* p = Vm8 + ((unsigned)((lb * 4 + hh) * 32 + (mm >> 3)) * 64 + dh) * 8 + (mm & 7);
                        gst<bf16>(p, (bf16)w0); gst<bf16>(p + 8, (bf16)(w0 >> 16)); gst<bf16>(p + 16, (bf16)w1); gst<bf16>(p + 24, (bf16)(w1 >> 16)); gst<bf16>(p + 32, (bf16)w2); gst<bf16>(p + 40, (bf16)(w2 >> 16)); gst<bf16>(p + 48, (bf16)w3); gst<bf16>(p + 56, (bf16)(w3 >> 16));
                    }
                }
                asm volatile("" ::: "memory");
            }
    }
};
struct EpiS5a {
    static constexpr bool PERM = false;
    float* ST;
    __device__ __forceinline__ void operator()(const f32x4 (&acc)[2][2][4][2], const Unit& u, int wr, int wc, int fr, int fq) const {
        const int row0 = u.am * 256 + wr * 64 + fr, col0 = wc * 32 + 4 * fq;
#pragma unroll
        for (int ai = 0; ai < 2; ++ai)
#pragma unroll
            for (int m = 0; m < 4; ++m) { float* rowp = ST + (unsigned)(row0 + ai * 128 + m * 16) * 256 + col0;
#pragma unroll
                for (int bj = 0; bj < 2; ++bj)
#pragma unroll
                    for (int n = 0; n < 2; ++n) gst<f32x4>(rowp + bj * 128 + n * 16, acc[ai][bj][m][n]);
                asm volatile("" ::: "memory"); }
    }
};
struct EpiS5c {
    static constexpr bool PERM = true;
    bf16* Y;
    __device__ __forceinline__ void operator()(const f32x4 (&acc)[2][2][4][2], const Unit& u, int wr, int wc, int fr, int fq) const {
        const int b = u.am >> 4, g = u.am & 15, r0 = wr * 64 + fr, cl0 = u.pn * 256 + wc * 32 + 8 * fq;
#pragma unroll
        for (int ai = 0; ai < 2; ++ai)
#pragma unroll
            for (int m = 0; m < 4; ++m) {
                const int chunk = r0 + ai * 128 + m * 16;
#pragma unroll
                for (int bj = 0; bj < 2; ++bj) {
                    const f32x4 v0 = acc[ai][bj][m][0], v1 = acc[ai][bj][m][1];
                    const int col = cl0 + bj * 128, t = col >> 4, c0 = col & 15;
                    u32x4 w; w.x = cvt_pk_bf16(gelu_tanh_f(v0[0]), gelu_tanh_f(v0[1])); w.y = cvt_pk_bf16(gelu_tanh_f(v0[2]), gelu_tanh_f(v0[3]));
                    w.z = cvt_pk_bf16(gelu_tanh_f(v1[0]), gelu_tanh_f(v1[1])); w.w = cvt_pk_bf16(gelu_tanh_f(v1[2]), gelu_tanh_f(v1[3]));
                    gst<u32x4>(Y + (unsigned)(b * SEQ + chunk * 32 + t) * 256 + g * 16 + c0, w);
                }
                asm volatile("" ::: "memory");
            }
    }
};
struct EpiGlu {
    static constexpr bool PERM = true;
    bf16* CAT;
    __device__ __forceinline__ void operator()(const f32x4 (&acc)[2][2][4][2], const Unit& u, int wr, int wc, int fr, int fq) const {
        const int row0 = u.pm * 256 + wr * 64 + fr, cl0 = u.pn * 256 + wc * 32 + 8 * fq;
#pragma unroll
        for (int ai = 0; ai < 2; ++ai)
#pragma unroll
            for (int m = 0; m < 4; ++m) {
                const int row = row0 + ai * 128 + m * 16;
#pragma unroll
                for (int bj = 0; bj < 2; ++bj) {
                    const f32x4 v0 = acc[ai][bj][m][0], v1 = acc[ai][bj][m][1];
                    const int col = cl0 + bj * 128;
                    u32x2 w; w.x = cvt_pk_bf16(v0[0] * sigmoid_f(v0[1]), v0[2] * sigmoid_f(v0[3])); w.y = cvt_pk_bf16(v1[0] * sigmoid_f(v1[1]), v1[2] * sigmoid_f(v1[3]));
                    gst<u32x2>(CAT + (unsigned)row * 1024 + 512 + (col >> 1), w);
                }
                asm volatile("" ::: "memory");
            }
    }
};
struct EpiMerge {
    static constexpr bool PERM = true;
    const unsigned char* GATES; bf16* MG;
    static __device__ __forceinline__ float ub(unsigned w, int i) { return (float)((w >> (8 * i)) & 0xffu); }
    __device__ __forceinline__ void khook(f32x4 (&acc)[2][2][4][2], const Unit& u, int t, int wr, int wc, int fr, int fq) const {
        const int row0 = u.pm * 256 + wr * 64 + fr, cl0 = u.pn * 256 + wc * 32 + 8 * fq;
        const int ga = (t == 8) ? 0 : 1024;
        u32x2 na[2][4][2], nb[2][4][2];
#pragma unroll
        for (int ai = 0; ai < 2; ++ai)
#pragma unroll
            for (int m = 0; m < 4; ++m)
#pragma unroll
                for (int bj = 0; bj < 2; ++bj) { const unsigned char* gp = GATES + (unsigned)((row0 + ai * 128 + m * 16) * 3072 + ga + cl0 + bj * 128); na[ai][m][bj] = gld<u32x2>(gp); nb[ai][m][bj] = gld<u32x2>(gp + 1024); }
#pragma unroll
        for (int ai = 0; ai < 2; ++ai)
#pragma unroll
            for (int m = 0; m < 4; ++m)
#pragma unroll
                for (int bj = 0; bj < 2; ++bj) {
                    const u32x2 a = na[ai][m][bj], b = nb[ai][m][bj];
                    f32x4 r0, r1;
#pragma unroll
                    for (int i = 0; i < 4; ++i) { r0[i] = ub(a.x, i) * fast_rcp(ub(b.x, i)); r1[i] = ub(a.y, i) * fast_rcp(ub(b.y, i)); }
                    acc[ai][bj][m][0] *= r0; acc[ai][bj][m][1] *= r1;
                }
        asm volatile("" ::: "memory");
    }
    __device__ __forceinline__ void operator()(const f32x4 (&acc)[2][2][4][2], const Unit& u, int wr, int wc, int fr, int fq) const {
        const int row0 = u.pm * 256 + wr * 64 + fr, cl0 = u.pn * 256 + wc * 32 + 8 * fq;
#pragma unroll
        for (int ai = 0; ai < 2; ++ai) {
            u32x2 g2[4][2];
#pragma unroll
            for (int m = 0; m < 4; ++m)
#pragma unroll
                for (int bj = 0; bj < 2; ++bj) g2[m][bj] = gld<u32x2>(GATES + (unsigned)((row0 + ai * 128 + m * 16) * 3072 + 2048 + cl0 + bj * 128));
#pragma unroll
            for (int m = 0; m < 4; ++m)
#pragma unroll
                for (int bj = 0; bj < 2; ++bj) {
                    const u32x2 g = g2[m][bj]; const f32x4 v0 = acc[ai][bj][m][0] * (1.0f / 255.0f), v1 = acc[ai][bj][m][1] * (1.0f / 255.0f);
                    u32x4 w; w.x = cvt_pk_bf16(v0[0] * ub(g.x, 0), v0[1] * ub(g.x, 1)); w.y = cvt_pk_bf16(v0[2] * ub(g.x, 2), v0[3] * ub(g.x, 3));
                    w.z = cvt_pk_bf16(v1[0] * ub(g.y, 0), v1[1] * ub(g.y, 1)); w.w = cvt_pk_bf16(v1[2] * ub(g.y, 2), v1[3] * ub(g.y, 3));
                    gst<u32x4>(MG + (unsigned)((row0 + ai * 128 + m * 16) * 1024 + cl0 + bj * 128), w);
                }
            asm volatile("" ::: "memory");
        }
    }
};
struct EpiDelta {
    static constexpr bool PERM = true;
    bf16* Dm;
    __device__ __forceinline__ void operator()(const f32x4 (&acc)[2][2][4][2], const Unit& u, int wr, int wc, int fr, int fq) const {
        const int row0 = u.pm * 256 + wr * 64 + fr, cl0 = u.pn * 256 + wc * 32 + 8 * fq;
#pragma unroll
        for (int ai = 0; ai < 2; ++ai)
#pragma unroll
            for (int m = 0; m < 4; ++m) {
#pragma unroll
                for (int bj = 0; bj < 2; ++bj) { const f32x4 v0 = acc[ai][bj][m][0], v1 = acc[ai][bj][m][1];
                    u32x4 w; w.x = cvt_pk_bf16(v0[0], v0[1]); w.y = cvt_pk_bf16(v0[2], v0[3]); w.z = cvt_pk_bf16(v1[0], v1[1]); w.w = cvt_pk_bf16(v1[2], v1[3]);
                    gst<u32x4>(Dm + (unsigned)((row0 + ai * 128 + m * 16) * 1024 + cl0 + bj * 128), w); }
                asm volatile("" ::: "memory");
            }
    }
};
struct EpiMoe1 {
    static constexpr bool PERM = true;
    bf16* ACT; const float* wts;
    __device__ __forceinline__ void operator()(const f32x4 (&acc)[2][2][4][2], const Unit& u, int wr, int wc, int fr, int fq) const {
        const int r0 = wr * 64 + fr, cl0 = wc * 32 + 8 * fq, es = u.pn >> 1;
        float wv[2][4], rv[2][4];
#pragma unroll
        for (int ai = 0; ai < 2; ++ai)
#pragma unroll
            for (int m = 0; m < 4; ++m) { const int slot = u.x1 + r0 + ai * 128 + m * 16; const f32x4 t = slot < u.x2 ? gld<f32x4>(wts + (unsigned)((u.x0 * LCAP + slot) * 4)) : (f32x4){0.f, 0.f, 0.f, 0.f}; wv[ai][m] = es ? t[1] : t[0]; rv[ai][m] = t[2]; }
#pragma unroll
        for (int ai = 0; ai < 2; ++ai)
#pragma unroll
            for (int m = 0; m < 4; ++m) {
                const int r = r0 + ai * 128 + m * 16; const float w = wv[ai][m], rs = rv[ai][m];
#pragma unroll
                for (int bj = 0; bj < 2; ++bj) {
                    const f32x4 v0 = acc[ai][bj][m][0] * rs, v1 = acc[ai][bj][m][1] * rs;
                    const int col = cl0 + bj * 128;
                    u32x2 o; o.x = cvt_pk_bf16(v0[0] * sigmoid_f(v0[0]) * v0[1] * w, v0[2] * sigmoid_f(v0[2]) * v0[3] * w); o.y = cvt_pk_bf16(v1[0] * sigmoid_f(v1[0]) * v1[1] * w, v1[2] * sigmoid_f(v1[2]) * v1[3] * w);
                    gst<u32x2>(ACT + (unsigned)((u.pm * 256 + r) * 512 + es * 256 + (u.pn & 1) * 128 + (col >> 1)), o);
                }
                asm volatile("" ::: "memory");
            }
    }
};
struct EpiMoe2 {
    static constexpr bool PERM = true;
    bf16* Dm; const int* list;
    __device__ __forceinline__ void operator()(const f32x4 (&acc)[2][2][4][2], const Unit& u, int wr, int wc, int fr, int fq) const {
        const int r0 = wr * 64 + fr, cl0 = u.pn * 256 + wc * 32 + 8 * fq;
        int tok[2][4];
#pragma unroll
        for (int ai = 0; ai < 2; ++ai)
#pragma unroll
            for (int m = 0; m < 4; ++m) { const int slot = u.x1 + r0 + ai * 128 + m * 16; tok[ai][m] = slot < u.x2 ? gld<int>(list + (unsigned)(u.x0 * LCAP + slot)) : -1; }
#pragma unroll
        for (int ai = 0; ai < 2; ++ai)
#pragma unroll
            for (int m = 0; m < 4; ++m) {
                const int t = tok[ai][m];
#pragma unroll
                for (int bj = 0; bj < 2; ++bj) { const f32x4 v0 = acc[ai][bj][m][0], v1 = acc[ai][bj][m][1];
                    u32x4 w; w.x = cvt_pk_bf16(v0[0], v0[1]); w.y = cvt_pk_bf16(v0[2], v0[3]); w.z = cvt_pk_bf16(v1[0], v1[1]); w.w = cvt_pk_bf16(v1[2], v1[3]);
                    if (t >= 0) gst<u32x4>(Dm + (unsigned)(t * 1024 + cl0 + bj * 128), w); }
                asm volatile("" ::: "memory");
            }
    }
};
#define XB_TMO      128
#define XB_XCNT(j)  (256  + 64 * (j))
#define XB_XSUB(j)  (1280 + 64 * (j))
#define XB_XGEN(j)  (2304 + 64 * (j))
#define XB_TOP      3328
#define XB_TOPGEN   3392
#define XCD_BAR_WORDS 3456
#define XB_SPIN_CAP (1u << 18)
__device__ __forceinline__ unsigned xb_ld(unsigned* p)              { return __hip_atomic_load((__attribute__((address_space(1))) unsigned*)p, __ATOMIC_RELAXED, __HIP_MEMORY_SCOPE_AGENT); }
__device__ __forceinline__ unsigned xb_add(unsigned* p, unsigned v) { return __hip_atomic_fetch_add((__attribute__((address_space(1))) unsigned*)p, v, __ATOMIC_RELAXED, __HIP_MEMORY_SCOPE_AGENT); }
__device__ __forceinline__ unsigned xb_xcc_id() { return (unsigned)__builtin_amdgcn_s_getreg((3 << 11) | 20) & 0xFu; }
#define XB_SPIN(cond, bar) do { unsigned _sp = 0; while (cond) { __builtin_amdgcn_s_sleep(1); \
    if ((++_sp & 255u) == 0u) { if (xb_ld(&(bar)[XB_TMO])) break; if (_sp > XB_SPIN_CAP) { atomicAdd(&(bar)[XB_TMO], 1u); break; } } } } while (0)
struct XcdBarrier { unsigned* bar; unsigned x; volatile LAS unsigned* st; };
__device__ __forceinline__ XcdBarrier xcd_barrier_post(unsigned* bar, volatile LAS unsigned* st) {
    XcdBarrier b; b.bar = bar; b.x = xb_xcc_id(); b.st = st;
    if (threadIdx.x == 0) (void)xb_add(&bar[XB_XCNT(b.x)], 1u);
    return b;
}
__device__ __forceinline__ void xcd_barrier_complete(unsigned* bar, unsigned x, unsigned& nloc, unsigned& nx) {
    const unsigned G = gridDim.x * gridDim.y * gridDim.z;
    unsigned sum, cnt, mine, sp = 0u;
    for (;;) {
        sum = 0u; cnt = 0u; mine = 0u;
#pragma unroll
        for (unsigned j = 0; j < 16; ++j) { const unsigned c = xb_ld(&bar[XB_XCNT(j)]); sum += c; cnt += (c > 0u) ? 1u : 0u; mine = (j == x) ? c : mine; }
        if (sum == G) break;
        __builtin_amdgcn_s_sleep(1);
        if ((++sp & 255u) == 0u) { if (xb_ld(&bar[XB_TMO])) break; if (sp > XB_SPIN_CAP) { atomicAdd(&bar[XB_TMO], 1u); break; } }
    }
    nloc = mine > 0u ? mine : 1u; nx = cnt > 0u ? cnt : 1u;
}
__device__ __forceinline__ void xcd_barrier(const XcdBarrier& b, bool is_t0) {
    asm volatile("s_waitcnt vmcnt(0)" ::: "memory");
    __syncthreads();
    if (is_t0) {
        unsigned* bar = b.bar;
        __builtin_amdgcn_s_waitcnt(0);
        unsigned nloc = b.st[0], nx = b.st[1];
        if (nloc == 0u) { xcd_barrier_complete(bar, b.x, nloc, nx); b.st[0] = nloc; b.st[1] = nx; }
        const unsigned old = xb_add(&bar[XB_XSUB(b.x)], 1u);
        const unsigned gen = old / nloc;
        if (old + 1u == (gen + 1u) * nloc) {
            __builtin_amdgcn_fence(__ATOMIC_RELEASE, "agent");
            asm volatile("s_waitcnt vmcnt(0)" ::: "memory");
            const unsigned og = xb_add(&bar[XB_TOP], 1u);
            const unsigned tg = og / nx;
            if (og + 1u == (tg + 1u) * nx) xb_add(&bar[XB_TOPGEN], 1u);
            else XB_SPIN(xb_ld(&bar[XB_TOPGEN]) == tg, bar);
            __builtin_amdgcn_fence(__ATOMIC_ACQUIRE, "agent");
            xb_add(&bar[XB_XGEN(b.x)], 1u);
            asm volatile("s_waitcnt vmcnt(0)" ::: "memory");
        } else {
            XB_SPIN(xb_ld(&bar[XB_XGEN(b.x)]) == gen, bar);
            __builtin_amdgcn_fence(__ATOMIC_ACQUIRE, "agent");
            asm volatile("s_waitcnt vmcnt(0)" ::: "memory");
        }
    }
    __syncthreads();
}

constexpr int AT_SLOT = 8192, AT_VOFF = 9 * AT_SLOT;
__device__ __forceinline__ int kswz(int col) { return ((col >> 1) & 1) | (((col >> 3) & 3) << 1); }
template <bool NA>
__device__ __forceinline__ void attn_core(const bf16x8 (&qf)[2], const LAS unsigned char* lds, int rs, int c_lo, bf16* obase, const float* rpbp_h, int rbias0, int c0q, int lane) {
    const int n = lane & 15, q = lane >> 4, cq = c0q + n;
    f32x4 bias0[8], bias1[8];
    if (NA) {
        const float* bp = rpbp_h + (c_lo - c0q + 8 * q - n + 31);
#pragma unroll
        for (int kb = 0; kb < 8; ++kb) { bias0[kb] = gld<f32x4>(bp + (rbias0 + kb) * 64); bias1[kb] = gld<f32x4>(bp + (rbias0 + kb) * 64 + 4); }
    }
    f32x4 s[8][2];
#pragma unroll
    for (int kb = 0; kb < 8; ++kb) {
        const int slot = NA ? (rs + kb) % 9 : (kb >> 1); const int cb0 = NA ? c_lo : (kb & 1) * 32;
        const LAS unsigned char* kp = lds + slot * AT_SLOT;
#pragma unroll
        for (int blk = 0; blk < 2; ++blk) {
            const int col = cb0 + 8 * (n >> 2) + 4 * blk + (n & 3), f = kswz(col);
            const bf16x8 a0 = *(const LAS bf16x8*)(kp + col * 128 + ((q ^ f) << 4)), a1 = *(const LAS bf16x8*)(kp + col * 128 + (((4 + q) ^ f) << 4));
            f32x4 a = (f32x4){0.f, 0.f, 0.f, 0.f};
            a = __builtin_amdgcn_mfma_f32_16x16x32_bf16(a0, qf[0], a, 0, 0, 0);
            a = __builtin_amdgcn_mfma_f32_16x16x32_bf16(a1, qf[1], a, 0, 0, 0);
            s[kb][blk] = a;
        }
    }
    if (NA) {
        const int cs = min(max(cq - 8, 0), 48);
#pragma unroll
        for (int kb = 0; kb < 8; ++kb) {
            const f32x4 b0 = bias0[kb], b1 = bias1[kb];
#pragma unroll
            for (int i = 0; i < 4; ++i) {
                const int kc0 = c_lo + 8 * q + i, kc1 = kc0 + 4;
                s[kb][0][i] = (kc0 >= cs && kc0 < cs + 16) ? s[kb][0][i] + b0[i] : -1e30f;
                s[kb][1][i] = (kc1 >= cs && kc1 < cs + 16) ? s[kb][1][i] + b1[i] : -1e30f;
            }
        }
    }
    float mx = -1e30f;
#pragma unroll
    for (int kb = 0; kb < 8; ++kb)
#pragma unroll
        for (int blk = 0; blk < 2; ++blk)
#pragma unroll
            for (int i = 0; i < 4; ++i) mx = fmaxf(mx, s[kb][blk][i]);
    mx = fmaxf(mx, shfl_xor_f(mx, 16, lane)); mx = fmaxf(mx, shfl_xor_f(mx, 32, lane));
    float sum = 0.f; bf16x8 pf[8];
#pragma unroll
    for (int kb = 0; kb < 8; ++kb) {
        float p[8];
#pragma unroll
        for (int blk = 0; blk < 2; ++blk)
#pragma unroll
            for (int i = 0; i < 4; ++i) { const float e = fast_exp(s[kb][blk][i] - mx); p[blk * 4 + i] = e; sum += e; }
        u32x4 w; w.x = cvt_pk_bf16(p[0], p[1]); w.y = cvt_pk_bf16(p[2], p[3]); w.z = cvt_pk_bf16(p[4], p[5]); w.w = cvt_pk_bf16(p[6], p[7]);
        pf[kb] = __builtin_bit_cast(bf16x8, w);
    }
    sum += shfl_xor_f(sum, 16, lane); sum += shfl_xor_f(sum, 32, lane);
    const float inv = fast_rcp(sum);
#pragma unroll
    for (int db = 0; db < 4; ++db) {
        f32x4 o = (f32x4){0.f, 0.f, 0.f, 0.f};
#pragma unroll
        for (int kb = 0; kb < 8; ++kb) {
            const int slot = NA ? (rs + kb) % 9 : (kb >> 1); const int cb0 = NA ? c_lo : (kb & 1) * 32;
            const bf16x8 vf = *(const LAS bf16x8*)(lds + AT_VOFF + slot * AT_SLOT + ((((cb0 >> 3) + q) * 64 + db * 16 + n) << 4));
            o = __builtin_amdgcn_mfma_f32_16x16x32_bf16(vf, pf[kb], o, 0, 0, 0);
        }
        u32x2 w; w.x = cvt_pk_bf16(o[0] * inv, o[1] * inv); w.y = cvt_pk_bf16(o[2] * inv, o[3] * inv);
        gst<u32x2>(obase + (unsigned)(n * 1024 + 4 * q) + db * 16, w);
    }
}

constexpr int NWAVES = 8;
constexpr int RING_BYTES = 131072, ATT_BYTES = 147456, MISC_OFF = ATT_BYTES, TAB_OFF = MISC_OFF + 256, LDS_BYTES = 163840;
struct Args { const float* in[30]; float* out; unsigned char* ws; };
struct Frame { LAS unsigned char* lds; int tid, lane, wave, vcu, G; };
enum { I_X = 0, I_MEM, I_NMIX, I_NFFN, I_NMEM, I_WIN, I_BGATE, I_RPB, I_LRE, I_LIM, I_LDT, I_BRE, I_BIM, I_CRE, I_CIM, I_S5D, I_WGLU, I_WMKV, I_WBNA, I_WBS5, I_WBXA, I_WOUT,
       I_WCO, I_BCO, I_WFI, I_BFI, I_WG, I_WU, I_WD, I_FNORM };

__device__ __forceinline__ void transpose_item(const float* W, int ldn, int k0, int n0, bf16* WT, int ldk, int dk0, int row_off, int rmul, int radd, int qs, const float* kscale, LAS float* scr, int lane) {
    { float t[32]; const float* wp = W + (size_t)(k0 + (lane >> 5)) * ldn + n0 + (lane & 31);
#pragma unroll
      for (int i = 0; i < 32; ++i) t[i] = gld<float>(wp + (size_t)(2 * i) * ldn);
#pragma unroll
      for (int i = 0; i < 32; ++i) scr[(2 * i + (lane >> 5)) * 33 + (lane & 31)] = t[i]; }
    LDS_WAIT(); asm volatile("" ::: "memory");
    const int c = lane & 7;
    f32x4 ka = (f32x4){1.f, 1.f, 1.f, 1.f}, kb = ka;
    if (kscale) { ka = gld<f32x4>(kscale + k0 + 8 * c); kb = gld<f32x4>(kscale + k0 + 8 * c + 4); }
#pragma unroll
    for (int j = 0; j < 4; ++j) { const int n = (lane >> 3) + 8 * j, nn = n0 + n; const LAS float* s = scr + (8 * c) * 33 + n;
        const float sc = (qs && (nn < 512 || (nn >= 1792 && nn < 2048))) ? 0.125f : 1.0f;
        u32x4 o; o.x = cvt_pk_bf16(s[0 * 33] * sc * ka[0], s[1 * 33] * sc * ka[1]); o.y = cvt_pk_bf16(s[2 * 33] * sc * ka[2], s[3 * 33] * sc * ka[3]); o.z = cvt_pk_bf16(s[4 * 33] * sc * kb[0], s[5 * 33] * sc * kb[1]); o.w = cvt_pk_bf16(s[6 * 33] * sc * kb[2], s[7 * 33] * sc * kb[3]);
        gst<u32x4>(WT + (size_t)(row_off + nn * rmul + radd) * ldk + dk0 + k0 + 8 * c, o); }
    LDS_WAIT(); asm volatile("" ::: "memory");
}
__device__ __forceinline__ void transpose_job_item(const float* W, int ldn, int N, int it, bf16* WT, int ldk, int dk0, int row_off, int rmul, int radd, int qs, const float* kscale, LAS float* scr, int lane) {
    const int nblk = N / 32, kb = it / nblk, nb = it % nblk;
    transpose_item(W, ldn, 64 * kb, 32 * nb, WT, ldk, dk0, row_off, rmul, radd, qs, kscale, scr, lane);
}

__device__ __forceinline__ void cexp_d(double zr, double zi, double& er, double& ei) {
    const double wr_ = zr * (1.0 / 1024.0), wi_ = zi * (1.0 / 1024.0);
    double tr = 1.0, ti = 0.0;
#pragma unroll
    for (int n = 12; n >= 1; --n) { const double ar = wr_ * (1.0 / n), ai = wi_ * (1.0 / n); const double nr = 1.0 + (ar * tr - ai * ti), ni = ar * ti + ai * tr; tr = nr; ti = ni; }
#pragma unroll
    for (int k = 0; k < 10; ++k) { const double nr = tr * tr - ti * ti, ni = 2.0 * tr * ti; tr = nr; ti = ni; }
    er = tr; ei = ti;
}

template <bool ROUTER>
__device__ __forceinline__ void norm_rows4(const float* X, const float* gain, bf16* H, int row0, int lane,
                                           const float* wrt, const float* bco, const float* bfi, unsigned* cnt, int* list, float* wts, float* Xout = nullptr) {
    f32x4 x[4][4]; float rstd[4];
#pragma unroll
    for (int r = 0; r < 4; ++r) { float ss = 0.f;
#pragma unroll
        for (int j = 0; j < 4; ++j) { x[r][j] = gld<f32x4>(X + (size_t)(row0 + r) * 1024 + 256 * j + 4 * lane);
            if (Xout) { const u32x2 d = gld<u32x2>(H + (size_t)(row0 + r) * 1024 + 256 * j + 4 * lane); x[r][j][0] += bflo(d.x); x[r][j][1] += bfhi(d.x); x[r][j][2] += bflo(d.y); x[r][j][3] += bfhi(d.y);
                gst<f32x4>(Xout + (size_t)(row0 + r) * 1024 + 256 * j + 4 * lane, x[r][j]); }
            ss += (x[r][j][0] * x[r][j][0] + x[r][j][1] * x[r][j][1]) + (x[r][j][2] * x[r][j][2] + x[r][j][3] * x[r][j][3]); }
        ss = wave_sum(ss, lane); rstd[r] = 1.0f / sqrtf(ss * (1.0f / 1024.0f) + RMS_EPS); }
#pragma unroll
    for (int j = 0; j < 4; ++j) { const f32x4 g4 = gld<f32x4>(gain + 256 * j + 4 * lane);
#pragma unroll
        for (int r = 0; r < 4; ++r) { const f32x4 v = ROUTER ? x[r][j] * rstd[r] * g4 : x[r][j]; u32x2 w; w.x = cvt_pk_bf16(v[0], v[1]); w.y = cvt_pk_bf16(v[2], v[3]);
            gst<u32x2>(H + (size_t)(row0 + r) * 1024 + 256 * j + 4 * lane, w); } }
    if (!ROUTER && wts && lane < 4) { float rr = rstd[0]; rr = lane == 1 ? rstd[1] : rr; rr = lane == 2 ? rstd[2] : rr; rr = lane == 3 ? rstd[3] : rr; gst<float>(wts + row0 + lane, rr); }
    if constexpr (ROUTER) {
        float keep[4] = {0.f, 0.f, 0.f, 0.f};
#pragma unroll 2
        for (int c = 0; c < 20; ++c) {
            float a0 = 0.f, a1 = 0.f, a2 = 0.f, a3 = 0.f;
#pragma unroll
            for (int j = 0; j < 4; ++j) { const f32x4 w4 = gld<f32x4>(wrt + c * 1024 + 256 * j + 4 * lane);
                a0 += (x[0][j][0] * w4[0] + x[0][j][1] * w4[1]) + (x[0][j][2] * w4[2] + x[0][j][3] * w4[3]);
                a1 += (x[1][j][0] * w4[0] + x[1][j][1] * w4[1]) + (x[1][j][2] * w4[2] + x[1][j][3] * w4[3]);
                a2 += (x[2][j][0] * w4[0] + x[2][j][1] * w4[1]) + (x[2][j][2] * w4[2] + x[2][j][3] * w4[3]);
                a3 += (x[3][j][0] * w4[0] + x[3][j][1] * w4[1]) + (x[3][j][2] * w4[2] + x[3][j][3] * w4[3]); }
            a0 = wave_sum(a0, lane); a1 = wave_sum(a1, lane); a2 = wave_sum(a2, lane); a3 = wave_sum(a3, lane);
            if (lane == c) { keep[0] = a0 * rstd[0]; keep[1] = a1 * rstd[1]; keep[2] = a2 * rstd[2]; keep[3] = a3 * rstd[3]; }
        }
#pragma unroll
        for (int r = 0; r < 4; ++r) {
            float co[4];
#pragma unroll
            for (int i = 0; i < 4; ++i) co[i] = shfl_idx_f(keep[r], i) + bco[i];
            int grp = 0; float cm = co[0];
#pragma unroll
            for (int i = 1; i < 4; ++i) if (co[i] > cm) { cm = co[i]; grp = i; }
            float den = 0.f;
#pragma unroll
            for (int i = 0; i < 4; ++i) den += __expf(co[i] - cm);
            const float pgrp = 1.0f / den;
            float fv[4];
#pragma unroll
            for (int i = 0; i < 4; ++i) fv[i] = shfl_idx_f(keep[r], 4 + grp * 4 + i) + bfi[grp * 4 + i];
            int i1 = 0; float v1 = fv[0];
#pragma unroll
            for (int i = 1; i < 4; ++i) if (fv[i] > v1) { v1 = fv[i]; i1 = i; }
            int i2 = -1; float v2 = -3.0e38f;
#pragma unroll
            for (int i = 0; i < 4; ++i) if (i != i1 && fv[i] > v2) { v2 = fv[i]; i2 = i; }
            const float w1 = pgrp / (1.0f + __expf(v2 - v1)), w2 = pgrp - w1;
            const int a = i1 < i2 ? i1 : i2, b = i1 < i2 ? i2 : i1;
            const int pidx = a == 0 ? b - 1 : (a == 1 ? b + 1 : 5);
            const int bucket = grp * 6 + pidx;
            const float wa = (i1 == a) ? w1 : w2, wb = (i1 == a) ? w2 : w1;
            if (lane == 0) {
                const unsigned slot = __hip_atomic_fetch_add(cnt + bucket * 64, 1u, __ATOMIC_RELAXED, __HIP_MEMORY_SCOPE_AGENT);
                list[(size_t)bucket * LCAP + slot] = row0 + r;
                gst<f32x2>(wts + ((size_t)bucket * LCAP + slot) * 2, (f32x2){wa, wb});
            }
        }
    }
}

constexpr int RT_STRIDE = 2064;
constexpr int RT_BYTES = 40 * RT_STRIDE;
constexpr int RT_SCR = 98304;
__device__ __forceinline__ void router_rows16(const float* X, const bf16* XBi, const bf16* DH, bf16* XB, int R0, int lane, LAS unsigned char* lds, int wave,
                                              const float* bco, const float* bfi, unsigned* cnt, int* list, float* wts) {
    const int n = lane & 15, q = lane >> 4;
    f32x4 accF = (f32x4){0.f, 0.f, 0.f, 0.f}, accC = (f32x4){0.f, 0.f, 0.f, 0.f};
    float ss = 0.f;
    const unsigned xo = (unsigned)((R0 + n) * 1024 + 8 * q);
    const LAS unsigned char* tF = lds + n * RT_STRIDE + 16 * q; const LAS unsigned char* tC = lds + (16 + (n & 3)) * RT_STRIDE + 16 * q;
#pragma unroll 4
    for (int ks = 0; ks < 32; ++ks) {
        f32x4 x0, x1;
        if (XBi) { const u32x4 xb = gld<u32x4>(XBi + xo + ks * 32); x0 = (f32x4){bflo(xb.x), bfhi(xb.x), bflo(xb.y), bfhi(xb.y)}; x1 = (f32x4){bflo(xb.z), bfhi(xb.z), bflo(xb.w), bfhi(xb.w)}; }
        else { x0 = gld<f32x4>(X + xo + ks * 32); x1 = gld<f32x4>(X + xo + ks * 32 + 4); }
        if (DH) { const u32x4 d = gld<u32x4>(DH + xo + ks * 32); x0[0] += bflo(d.x); x0[1] += bfhi(d.x); x0[2] += bflo(d.y); x0[3] += bfhi(d.y); x1[0] += bflo(d.z); x1[1] += bfhi(d.z); x1[2] += bflo(d.w); x1[3] += bfhi(d.w); }
        ss += (x0[0] * x0[0] + x0[1] * x0[1]) + (x0[2] * x0[2] + x0[3] * x0[3]) + (x1[0] * x1[0] + x1[1] * x1[1]) + (x1[2] * x1[2] + x1[3] * x1[3]);
        u32x4 hw; hw.x = cvt_pk_bf16(x0[0], x0[1]); hw.y = cvt_pk_bf16(x0[2], x0[3]); hw.z = cvt_pk_bf16(x1[0], x1[1]); hw.w = cvt_pk_bf16(x1[2], x1[3]);
        u32x4 lw; lw.x = cvt_pk_bf16(x0[0] - bflo(hw.x), x0[1] - bfhi(hw.x)); lw.y = cvt_pk_bf16(x0[2] - bflo(hw.y), x0[3] - bfhi(hw.y));
        lw.z = cvt_pk_bf16(x1[0] - bflo(hw.z), x1[1] - bfhi(hw.z)); lw.w = cvt_pk_bf16(x1[2] - bflo(hw.w), x1[3] - bfhi(hw.w));
        gst<u32x4>(XB + xo + ks * 32, hw);
        const bf16x8 ah = __builtin_bit_cast(bf16x8, hw), al = __builtin_bit_cast(bf16x8, lw);
        const bf16x8 fh = *(const LAS bf16x8*)(tF + ks * 64), fl = *(const LAS bf16x8*)(tF + 20 * RT_STRIDE + ks * 64);
        const bf16x8 ch = *(const LAS bf16x8*)(tC + ks * 64), cl = *(const LAS bf16x8*)(tC + 20 * RT_STRIDE + ks * 64);
        accF = __builtin_amdgcn_mfma_f32_16x16x32_bf16(ah, fh, accF, 0, 0, 0); accF = __builtin_amdgcn_mfma_f32_16x16x32_bf16(ah, fl, accF, 0, 0, 0); accF = __builtin_amdgcn_mfma_f32_16x16x32_bf16(al, fh, accF, 0, 0, 0);
        accC = __builtin_amdgcn_mfma_f32_16x16x32_bf16(ah, ch, accC, 0, 0, 0); accC = __builtin_amdgcn_mfma_f32_16x16x32_bf16(ah, cl, accC, 0, 0, 0); accC = __builtin_amdgcn_mfma_f32_16x16x32_bf16(al, ch, accC, 0, 0, 0);
    }
    ss += shfl_xor_f(ss, 16, lane); ss += shfl_xor_f(ss, 32, lane);
    const float rstd = 1.0f / sqrtf(ss * (1.0f / 1024.0f) + RMS_EPS);
    LAS float* sc = (LAS float*)(lds + RT_SCR + wave * 1536);
#pragma unroll
    for (int r = 0; r < 4; ++r) { const float rs = shfl_idx_f(rstd, 4 * q + r); sc[(4 * q + r) * 24 + n] = accF[r] * rs; if (n < 4) sc[(4 * q + r) * 24 + 16 + n] = accC[r] * rs; }
    LDS_WAIT(); asm volatile("" ::: "memory");
    if (lane < 16) {
        const LAS float* my = sc + lane * 24;
        float co[4];
#pragma unroll
        for (int i = 0; i < 4; ++i) co[i] = my[16 + i] + gld<float>(bco + i);
        int grp = 0; float cm = co[0];
#pragma unroll
        for (int i = 1; i < 4; ++i) if (co[i] > cm) { cm = co[i]; grp = i; }
        float den = 0.f;
#pragma unroll
        for (int i = 0; i < 4; ++i) den += __expf(co[i] - cm);
        const float pgrp = 1.0f / den;
        float fv[4];
#pragma unroll
        for (int i = 0; i < 4; ++i) fv[i] = my[grp * 4 + i] + gld<float>(bfi + grp * 4 + i);
        int i1 = 0; float v1 = fv[0];
#pragma unroll
        for (int i = 1; i < 4; ++i) if (fv[i] > v1) { v1 = fv[i]; i1 = i; }
        int i2 = -1; float v2 = -3.0e38f;
#pragma unroll
        for (int i = 0; i < 4; ++i) if (i != i1 && fv[i] > v2) { v2 = fv[i]; i2 = i; }
        const float w1 = pgrp / (1.0f + __expf(v2 - v1)), w2 = pgrp - w1;
        const int a = i1 < i2 ? i1 : i2, b = i1 < i2 ? i2 : i1;
        const int pidx = a == 0 ? b - 1 : (a == 1 ? b + 1 : 5);
        const int bucket = grp * 6 + pidx;
        const float wa = (i1 == a) ? w1 : w2, wb = (i1 == a) ? w2 : w1;
        const unsigned slot = __hip_atomic_fetch_add((GASP unsigned*)(cnt + bucket * 64), 1u, __ATOMIC_RELAXED, __HIP_MEMORY_SCOPE_AGENT);
        gst<int>(list + ((unsigned)(bucket * LCAP) + slot), R0 + lane);
        gst<f32x4>(wts + ((unsigned)(bucket * LCAP) + slot) * 4, (f32x4){wa, wb, rstd, 0.f});
    }
}

__device__ __forceinline__ void norm_rows4b(bf16* XB, const float* gain, bf16* H, int row0, int lane, float* RSo) {
    f32x4 x[4][4]; float rstd[4];
#pragma unroll
    for (int r = 0; r < 4; ++r) { float ss = 0.f;
#pragma unroll
        for (int j = 0; j < 4; ++j) { const unsigned off = (unsigned)((row0 + r) * 1024 + 256 * j + 4 * lane); const u32x2 a = gld<u32x2>(XB + off), d = gld<u32x2>(H + off);
            x[r][j] = (f32x4){bflo(a.x) + bflo(d.x), bfhi(a.x) + bfhi(d.x), bflo(a.y) + bflo(d.y), bfhi(a.y) + bfhi(d.y)};
            u32x2 w; w.x = cvt_pk_bf16(x[r][j][0], x[r][j][1]); w.y = cvt_pk_bf16(x[r][j][2], x[r][j][3]); gst<u32x2>(XB + off, w);
            ss += (x[r][j][0] * x[r][j][0] + x[r][j][1] * x[r][j][1]) + (x[r][j][2] * x[r][j][2] + x[r][j][3] * x[r][j][3]); }
        ss = wave_sum(ss, lane); rstd[r] = 1.0f / sqrtf(ss * (1.0f / 1024.0f) + RMS_EPS); }
    if (lane < 4) { float rr = rstd[0]; rr = lane == 1 ? rstd[1] : rr; rr = lane == 2 ? rstd[2] : rr; rr = lane == 3 ? rstd[3] : rr; gst<float>(RSo + row0 + lane, rr); }
}

__device__ __forceinline__ void final_norm_row(const bf16* XB, const bf16* Dl, float* out, const float* gain, int row, int lane) {
    f32x4 x[4]; float ss = 0.f;
#pragma unroll
    for (int j = 0; j < 4; ++j) { const unsigned off = (unsigned)(row * 1024 + 256 * j + 4 * lane); const u32x2 a = gld<u32x2>(XB + off), d = gld<u32x2>(Dl + off);
        x[j] = (f32x4){bflo(a.x) + bflo(d.x), bfhi(a.x) + bfhi(d.x), bflo(a.y) + bflo(d.y), bfhi(a.y) + bfhi(d.y)};
        ss += (x[j][0] * x[j][0] + x[j][1] * x[j][1]) + (x[j][2] * x[j][2] + x[j][3] * x[j][3]); }
    ss = wave_sum(ss, lane); const float rstd = 1.0f / sqrtf(ss * (1.0f / 1024.0f) + RMS_EPS);
#pragma unroll
    for (int j = 0; j < 4; ++j) { const f32x4 g4 = gld<f32x4>(gain + 256 * j + 4 * lane); gst<f32x4>(out + (size_t)row * 1024 + 256 * j + 4 * lane, x[j] * rstd * g4); }
}

__device__ __forceinline__ void s5_scan_item(int item, const float* ST, bf16* At, const f32x2* apow_l, LAS float* sc, int tid) {
    const int d = item & 1, bg = item >> 1, g = bg & 15, seg = tid >> 6, p = tid & 63;
    const f32x2 A32 = gld<f32x2>(apow_l + ((d * 16 + g) * 33 + 32) * 64 + p);
    const int chunk0 = d ? 255 - seg * 32 : seg * 32; const long cstep = d ? -1 : 1;
    const float* rp0 = ST + (size_t)(bg * 256 + chunk0) * 256 + d * 128 + p;
    float tr = 0.f, ti = 0.f;
#pragma unroll 8
    for (int j = 0; j < 32; ++j) { const float* rp = rp0 + cstep * j * 256; const float sr = gld<float>(rp), si = gld<float>(rp + 64); const float nr = A32.x * tr - A32.y * ti + sr, ni = A32.x * ti + A32.y * tr + si; tr = nr; ti = ni; }
    sc[(seg * 64 + p) * 2] = tr; sc[(seg * 64 + p) * 2 + 1] = ti;
    __syncthreads();
    float pr = A32.x, pi = A32.y;
#pragma unroll
    for (int k = 0; k < 5; ++k) { const float nr = pr * pr - pi * pi, ni = 2.f * pr * pi; pr = nr; pi = ni; }
    float er = 0.f, ei = 0.f;
    for (int s2 = 0; s2 < seg; ++s2) { const float qr = sc[(s2 * 64 + p) * 2], qi = sc[(s2 * 64 + p) * 2 + 1]; const float nr = pr * er - pi * ei + qr, ni = pr * ei + pi * er + qi; er = nr; ei = ni; }
    bf16* op0 = At + (size_t)(bg * 256 + chunk0) * ATK + 512 + d * 128 + p;
#pragma unroll 8
    for (int j = 0; j < 32; ++j) { const float* rp = rp0 + cstep * j * 256; const float sr = gld<float>(rp), si = gld<float>(rp + 64); bf16* op = op0 + cstep * j * ATK;
        gst<bf16>(op, (bf16)(cvt_pk_bf16(er, er) & 0xffffu)); gst<bf16>(op + 64, (bf16)(cvt_pk_bf16(ei, ei) & 0xffffu));
        const float nr = A32.x * er - A32.y * ei + sr, ni = A32.x * ei + A32.y * er + si; er = nr; ei = ni; }
    __syncthreads();
}

#define NA_ITEM(item) do { \
    const bf16* QK = WP(bf16, WS_QK); const bf16* VT8 = WP(bf16, WS_VT8); bf16* Hn = WP(bf16, WS_H); const float* RPBP = WP(float, WS_RPBP); \
    const int n = lane & 15, q = lane >> 4, cb = wave & 3, qsel = wave >> 2, c_lo = cb == 0 ? 0 : (cb == 1 ? 8 : (cb == 2 ? 24 : 32)); \
    const int kcol = tid >> 3, kdst = kcol * 128 + (((tid & 7) ^ kswz(kcol)) << 4); \
    const int b = (item) >> 7, h = ((item) >> 4) & 7, r0 = ((item) & 15) * 8; \
    const bf16* Kg = QK + (size_t)b * SEQ * 1024 + 512 + h * 64 + (unsigned)(kcol * 1024 + (tid & 7) * 8); \
    const bf16* Vg = VT8 + (size_t)(b * 8 + h) * 1024 * 512 + (unsigned)(tid * 8); \
    const float* rp = RPBP + (size_t)(l * 8 + h) * 15 * 64; \
    int hi = min(max(r0 + 1 - 4, 0), 120) + 7; \
    { const int lo = min(max(r0 - 4, 0), 120); \
      u32x4 kv[9], vv[9]; \
      _Pragma("unroll") for (int j = 0; j < 9; ++j) { const int kr = min(lo + j, 127); kv[j] = gld<u32x4>(Kg + (size_t)kr * 65536); vv[j] = gld<u32x4>(Vg + (size_t)kr * 4096); } \
      _Pragma("unroll") for (int j = 0; j < 9; ++j) { const int kr = lo + j; if (kr <= hi) { const int slot = kr % 9; *(LAS u32x4*)(F.lds + slot * AT_SLOT + kdst) = kv[j]; *(LAS u32x4*)(F.lds + AT_VOFF + slot * AT_SLOT + tid * 16) = vv[j]; } } \
    } \
    bf16x8 qf[2]; \
    { const bf16* qb = QK + (size_t)(b * SEQ + (r0 + qsel) * 64 + cb * 16) * 1024 + h * 64 + (unsigned)(n * 1024 + 8 * q); qf[0] = gld<bf16x8>(qb); qf[1] = gld<bf16x8>(qb + 32); } \
    __syncthreads(); \
    _Pragma("unroll 1") for (int st = 0; st < 4; ++st) { \
        const int r = r0 + 2 * st + qsel, rs = min(max(r - 4, 0), 120); \
        const bool more = st < 3; \
        const int hi_next = more ? min(max(r0 + 2 * st + 3 - 4, 0), 120) + 7 : hi; \
        const int kr1 = hi + 1, kr2 = hi + 2; \
        u32x4 k1 = (u32x4){0u, 0u, 0u, 0u}, v1 = k1, k2 = k1, v2 = k1; bf16x8 qn[2]; qn[0] = qf[0]; qn[1] = qf[1]; \
        if (more) { \
            k1 = gld<u32x4>(Kg + (size_t)min(kr1, 127) * 65536); v1 = gld<u32x4>(Vg + (size_t)min(kr1, 127) * 4096); \
            k2 = gld<u32x4>(Kg + (size_t)min(kr2, 127) * 65536); v2 = gld<u32x4>(Vg + (size_t)min(kr2, 127) * 4096); \
            const bf16* qb = QK + (size_t)(b * SEQ + (r + 2) * 64 + cb * 16) * 1024 + h * 64 + (unsigned)(n * 1024 + 8 * q); qn[0] = gld<bf16x8>(qb); qn[1] = gld<bf16x8>(qb + 32); \
        } \
        attn_core<true>(qf, F.lds, rs, c_lo, Hn + (size_t)(b * SEQ + r * 64 + cb * 16) * 1024 + h * 64, rp, rs - r + 7, cb * 16, lane); \
        __syncthreads(); \
        if (more) { \
            if (kr1 <= hi_next) { const int slot = kr1 % 9; *(LAS u32x4*)(F.lds + slot * AT_SLOT + kdst) = k1; *(LAS u32x4*)(F.lds + AT_VOFF + slot * AT_SLOT + tid * 16) = v1; } \
            if (kr2 <= hi_next) { const int slot = kr2 % 9; *(LAS u32x4*)(F.lds + slot * AT_SLOT + kdst) = k2; *(LAS u32x4*)(F.lds + AT_VOFF + slot * AT_SLOT + tid * 16) = v2; } \
            hi = hi_next; qf[0] = qn[0]; qf[1] = qn[1]; \
        } \
        __syncthreads(); \
    } } while (0)
#define WG_MEM_SYNC() do { asm volatile("s_waitcnt vmcnt(0)" ::: "memory"); __syncthreads(); __builtin_amdgcn_fence(__ATOMIC_ACQUIRE, "agent"); asm volatile("s_waitcnt vmcnt(0)" ::: "memory"); } while (0)

#define XA_ITEMS(first, last, stride) do { \
    const bf16* QX = WP(bf16, WS_QX); const bf16* KM = WP(bf16, WS_KM); const bf16* VM8 = WP(bf16, WS_VM8); bf16* Hx = WP(bf16, WS_H); \
    const int n_ = lane & 15, q_ = lane >> 4, kcol = tid >> 3, kdst = kcol * 128 + (((tid & 7) ^ kswz(kcol)) << 4); \
    for (int item = (first); item < (last); item += (stride)) { \
        const int b = item >> 6, h = (item >> 4) & 3, qc = item & 15; \
        const bf16* Kg = KM + ((size_t)(l * 4 + b) * 256) * 256 + h * 64 + (unsigned)(kcol * 256 + (tid & 7) * 8); \
        const bf16* Vg = VM8 + (size_t)((l * 4 + b) * 4 + h) * 32 * 512 + (unsigned)(tid * 8); \
        _Pragma("unroll") for (int j = 0; j < 4; ++j) { const u32x4 kv = gld<u32x4>(Kg + j * 64 * 256), vv = gld<u32x4>(Vg + j * 4096); \
            *(LAS u32x4*)(F.lds + j * AT_SLOT + kdst) = kv; *(LAS u32x4*)(F.lds + AT_VOFF + j * AT_SLOT + tid * 16) = vv; } \
        __syncthreads(); \
        _Pragma("unroll 1") for (int j = 0; j < 4; ++j) { \
            const int t0 = b * SEQ + qc * 512 + wave * 64 + j * 16; \
            bf16x8 qf[2]; { const bf16* qb = QX + (size_t)t0 * 256 + h * 64 + (unsigned)(n_ * 256 + 8 * q_); qf[0] = gld<bf16x8>(qb); qf[1] = gld<bf16x8>(qb + 32); } \
            attn_core<false>(qf, F.lds, 0, 0, Hx + (size_t)t0 * 1024 + 768 + h * 64, nullptr, 0, 0, lane); } \
        __syncthreads(); \
    } } while (0)

#ifndef PHMASK
#define PHMASK 0xffffffffu
#endif
#define PH(k) ((PHMASK >> (k)) & 1u)
#ifndef FUSE1
#define FUSE1 0
#endif
#ifndef REPMASK
#define REPMASK 0u
#endif
#define NREP(k) (1 + (int)((REPMASK >> (k)) & 1u))
constexpr int PTR_OFF = MISC_OFF + 1024;
__device__ __forceinline__ const float* inp(LAS unsigned char* lds, int i, int z) {
    const LAS unsigned* q = (const LAS unsigned*)(lds + PTR_OFF + 8 * i + z);
    const unsigned lo = __builtin_amdgcn_readfirstlane(q[0]), hi = __builtin_amdgcn_readfirstlane(q[1]);
    return (const float*)(((unsigned long long)hi << 32) | lo);
}
#define WSL() unsigned char* wsl = args.ws; int wave = F.wave, bid = blockIdx.x, G = gridDim.x, zz = 0; unsigned mm_ = ~0u; asm volatile("" : "+s"(mm_)); int lane = (int)__builtin_amdgcn_mbcnt_hi(mm_, __builtin_amdgcn_mbcnt_lo(mm_, 0u)); \
    asm volatile("" : "+s"(wsl), "+s"(wave), "+v"(lane), "+s"(bid), "+s"(G), "+s"(zz)); \
    const int tid = wave * 64 + lane, vcu = (G % 8 == 0) ? (bid % 8) * (G / 8) + bid / 8 : bid, gw = vcu * NWAVES + wave, NGW = G * NWAVES, NGT = G * NWAVES * 64; \
    (void)tid; (void)gw; (void)NGW; (void)NGT; (void)wsl
#define WP(T, off) ((T*)(wsl + (off)))
#define IN(i) inp(F.lds, (i), zz)

__global__ void __launch_bounds__(NWAVES * 64, 2) fwd_kernel(Args args) {
    extern __shared__ __attribute__((aligned(16))) unsigned char lds_raw[];
    Frame F;
    F.lds = (LAS unsigned char*)lds_raw;
    F.tid = threadIdx.x; F.lane = F.tid & 63; F.wave = __builtin_amdgcn_readfirstlane(F.tid >> 6);
    F.G = gridDim.x; { const int bx = blockIdx.x; F.vcu = (F.G % 8 == 0) ? (bx % 8) * (F.G / 8) + bx / 8 : bx; }
    for (int u = F.tid; u < (LDS_BYTES - MISC_OFF) / 4; u += NWAVES * 64) ((LAS unsigned*)(F.lds + MISC_OFF))[u] = 0u;
    __syncthreads();
    if (F.tid < 30) { const unsigned long long p = (unsigned long long)args.in[F.tid]; LAS unsigned* q = (LAS unsigned*)(F.lds + PTR_OFF + 8 * F.tid); q[0] = (unsigned)p; q[1] = (unsigned)(p >> 32); }
    __syncthreads();
    (void)xcd_barrier_post((unsigned*)(args.ws + WS_CTL) + CW_BAR, (volatile LAS unsigned*)(F.lds + MISC_OFF));
#define GRID_BAR() do { unsigned char* w_ = args.ws; asm volatile("" : "+s"(w_)); XcdBarrier b_; b_.bar = (unsigned*)(w_ + WS_CTL) + CW_BAR; b_.x = xb_xcc_id(); b_.st = (volatile LAS unsigned*)(F.lds + MISC_OFF); unsigned m_ = ~0u; int wv_ = F.wave; asm volatile("" : "+s"(m_), "+s"(wv_)); \
    xcd_barrier(b_, (wv_ == 0) && (__builtin_amdgcn_mbcnt_hi(m_, __builtin_amdgcn_mbcnt_lo(m_, 0u)) == 0u)); } while (0)
#define GT() (vcu * (NWAVES * 64) + tid)
#define SCR() ((LAS float*)(F.lds + wave * 16384))

    if (PH(0)) {
        WSL();
        f32x2* APOW = WP(f32x2, WS_APOW); f32x2* BBAR = WP(f32x2, WS_BBAR); bf16* WRT = WP(bf16, WS_WRT); bf16* MEMN = WP(bf16, WS_MEMN); bf16* WMKV = WP(bf16, WS_WMKV);
        for (int it = gw; it < 1024; it += NGW) { const int l = it >> 8, r = it & 255;
            transpose_job_item(IN(I_WMKV) + (size_t)l * 1024 * 512, 512, 512, r, WMKV + (size_t)l * 512 * 1024, 1024, 0, 0, 1, 0, 0, nullptr, SCR(), lane); }
        for (int it = gw; it < 4096; it += NGW) { const int l = it >> 10, row = it & 1023;
            const float* xr = IN(I_MEM) + (size_t)row * 1024; const float* gn = IN(I_NMEM) + l * 1024;
            f32x4 x[4]; float ss = 0.f;
#pragma unroll
            for (int j = 0; j < 4; ++j) { x[j] = gld<f32x4>(xr + 256 * j + 4 * lane); ss += (x[j][0] * x[j][0] + x[j][1] * x[j][1]) + (x[j][2] * x[j][2] + x[j][3] * x[j][3]); }
            ss = wave_sum(ss, lane); const float rstd = 1.0f / sqrtf(ss * (1.0f / 1024.0f) + RMS_EPS);
#pragma unroll
            for (int j = 0; j < 4; ++j) { const f32x4 v = x[j] * rstd * gld<f32x4>(gn + 256 * j + 4 * lane); u32x2 w; w.x = cvt_pk_bf16(v[0], v[1]); w.y = cvt_pk_bf16(v[2], v[3]);
                gst<u32x2>(MEMN + (size_t)it * 1024 + 256 * j + 4 * lane, w); } }
        for (int it = GT(); it < 8192; it += NGT) {
            const int p = it & 63, ldg = it >> 6;
            const double lr = fmin((double)IN(I_LRE)[it], -1e-4), li = (double)IN(I_LIM)[it];
            double dt, dum; cexp_d((double)IN(I_LDT)[ldg], 0.0, dt, dum);
            double ar, ai; cexp_d(lr * dt, li * dt, ar, ai);
            const double den = lr * lr + li * li, fr = ((ar - 1.0) * lr + ai * li) / den, fi = (ai * lr - (ar - 1.0) * li) / den;
            const float* bre = IN(I_BRE) + (size_t)it * 16; const float* bim = IN(I_BIM) + (size_t)it * 16;
#pragma unroll 4
            for (int c = 0; c < 16; ++c) { const double br = (double)bre[c], bi = (double)bim[c];
                BBAR[(size_t)it * 16 + c] = (f32x2){(float)(fr * br - fi * bi), (float)(fr * bi + fi * br)}; }
            double pr = 1.0, pi = 0.0;
            for (int n = 0; n <= 32; ++n) { APOW[((size_t)ldg * 33 + n) * 64 + p] = (f32x2){(float)pr, (float)pi}; const double nr = pr * ar - pi * ai, ni = pr * ai + pi * ar; pr = nr; pi = ni; }
        }
        { float* RPBP = WP(float, WS_RPBP); const float* rpb = IN(I_RPB);
          for (int it = GT(); it < 4 * 8 * 15 * 64; it += NGT) { const int j = it & 63; RPBP[it] = (j >= 16 && j < 47) ? rpb[(it >> 6) * 31 + (j - 16)] : 0.f; } }
        for (int it = GT(); it < 4 * 20480; it += NGT) { const int l = it / 20480, r = it % 20480, c = r >> 10, k = r & 1023;
            const float gk = IN(I_NFFN)[l * 1024 + k];
            const float v = gk * (c < 16 ? IN(I_WFI)[(size_t)(l * 1024 + k) * 16 + c] : IN(I_WCO)[(size_t)(l * 1024 + k) * 4 + (c - 16)]);
            const unsigned hw = cvt_pk_bf16(v, v) & 0xffffu; const float lo = v - bflo(hw);
            WRT[(size_t)(l * 2 + 0) * 20480 + r] = (bf16)hw; WRT[(size_t)(l * 2 + 1) * 20480 + r] = (bf16)(cvt_pk_bf16(lo, lo) & 0xffffu); }
    }
    GRID_BAR();

    if (PH(1)) {
        WSL();
        { pg8::Gemm g{WP(bf16, WS_MEMN), WP(bf16, WS_WMKV), 1024, 1024, 1024}; pg8::MemOrder S{G, bid}; EpiMemKV E{WP(bf16, WS_KM), WP(bf16, WS_VM8)};
          pg8::gemm_phase<EpiMemKV, pg8::MemOrder>(F.lds, g, S, E, tid); }
        const f32x2* APOW = WP(f32x2, WS_APOW); const f32x2* BBAR = WP(f32x2, WS_BBAR); float* KT = WP(float, WS_KT);
        const float* CRE = IN(I_CRE); const float* CIM = IN(I_CIM); const float* S5D = IN(I_S5D);
        for (int it = GT(); it < 4 * 16 * 63 * 64; it += NGT) {
            const int c2 = (it & 3) * 4, c = (it >> 2) & 15, rest = it >> 6, tp = rest % 63, lg = rest / 63, l = lg >> 4, g = lg & 15;
            f32x4 sum = (f32x4){0.f, 0.f, 0.f, 0.f};
#pragma unroll 1
            for (int d = 0; d < 2; ++d) {
                if (d == 0 ? (tp < 31) : (tp > 31)) continue;
                const int n = d == 0 ? tp - 31 : 31 - tp, base = (l * 2 + d) * 16 + g;
                const float* cre = CRE + ((size_t)base * 16 + c) * 64; const float* cim = CIM + ((size_t)base * 16 + c) * 64;
                const f32x2* ap = APOW + ((size_t)base * 33 + n) * 64; const f32x4* bb = (const f32x4*)(BBAR + (size_t)base * 64 * 16 + c2);
#pragma unroll 8
                for (int p = 0; p < 64; ++p) { const f32x2 a = ap[p]; const f32x4 b0 = bb[p * 8], b1 = bb[p * 8 + 1]; const float cr = cre[p], ci = cim[p];
                    const float er = cr * a.x - ci * a.y, ei = cr * a.y + ci * a.x;
                    sum[0] += er * b0[0] - ei * b0[1]; sum[1] += er * b0[2] - ei * b0[3]; sum[2] += er * b1[0] - ei * b1[1]; sum[3] += er * b1[2] - ei * b1[3]; }
            }
            if (tp == 31 && c >= c2 && c < c2 + 4) sum[c - c2] += S5D[l * 256 + g * 16 + c];
            gst<f32x4>(KT + (size_t)it * 4, sum);
        }
    }
    GRID_BAR();

    const float* xin0 = (const float*)(GASP const float*)args.in[I_X];
    float* XO = (float*)(GASP float*)args.out;
#pragma unroll 1
    for (int l = 0; l < DEPTH; ++l) {
        for (int rep_ = 0; rep_ < NREP(2); ++rep_) {
        if (PH(2)) {
            WSL();
            {
            bf16* WIN = WP(bf16, WS_WIN); bf16* WCAT = WP(bf16, WS_WCAT); bf16* WOUT = WP(bf16, WS_WOUT); bf16* WGLU = WP(bf16, WS_WGLU);
            for (int it = gw; it < 3648; it += NGW) {
                int r = it;
                if (r < 2560) { transpose_job_item(IN(I_WIN) + (size_t)l * 1024 * 5120, 5120, 5120, r, WIN, 1024, 0, 0, 1, 0, 1, IN(I_NMIX) + l * 1024, SCR(), lane); continue; } r -= 2560;
                if (r < 256) { transpose_job_item(IN(I_WBNA) + (size_t)l * 512 * 1024, 1024, 1024, r, WCAT, 1024, 0, 0, 1, 0, 0, nullptr, SCR(), lane); continue; } r -= 256;
                if (r < 128) { transpose_job_item(IN(I_WBS5) + (size_t)l * 256 * 1024, 1024, 1024, r, WCAT, 1024, 512, 0, 1, 0, 0, nullptr, SCR(), lane); continue; } r -= 128;
                if (r < 128) { transpose_job_item(IN(I_WBXA) + (size_t)l * 256 * 1024, 1024, 1024, r, WCAT, 1024, 768, 0, 1, 0, 0, nullptr, SCR(), lane); continue; } r -= 128;
                if (r < 512) { transpose_job_item(IN(I_WOUT) + (size_t)l * 1024 * 1024, 1024, 1024, r, WOUT, 1024, 0, 0, 1, 0, 0, nullptr, SCR(), lane); continue; } r -= 512;
                if (r < 32) { transpose_job_item(IN(I_WGLU) + (size_t)l * 256 * 512, 512, 256, r, WGLU, 256, 0, 0, 2, 0, 0, nullptr, SCR(), lane); continue; } r -= 32;
                transpose_job_item(IN(I_WGLU) + (size_t)l * 256 * 512 + 256, 512, 256, r, WGLU, 256, 0, 0, 2, 1, 0, nullptr, SCR(), lane);
            }
            }
            {
            const f32x2* APOW = WP(f32x2, WS_APOW); const f32x2* BBAR = WP(f32x2, WS_BBAR); bf16* S5W = WP(bf16, WS_S5W);
            for (int it = GT(); it < 16 * 256 * 64; it += NGT) {
                const int k8 = it & 63, n = (it >> 6) & 255, g = it >> 14;
                const int s = k8 >> 1, c0 = (k8 & 1) * 8, d = n >> 7, ri = (n >> 6) & 1, p = n & 63, e = d == 0 ? 31 - s : s, base = (l * 2 + d) * 16 + g;
                const f32x2 a = APOW[((size_t)base * 33 + e) * 64 + p]; const f32x2* bb = BBAR + ((size_t)base * 64 + p) * 16 + c0;
                float v[8];
#pragma unroll
                for (int j = 0; j < 8; ++j) { const f32x2 b = bb[j]; v[j] = ri == 0 ? a.x * b.x - a.y * b.y : a.x * b.y + a.y * b.x; }
                u32x4 w; w.x = cvt_pk_bf16(v[0], v[1]); w.y = cvt_pk_bf16(v[2], v[3]); w.z = cvt_pk_bf16(v[4], v[5]); w.w = cvt_pk_bf16(v[6], v[7]);
                gst<u32x4>(S5W + ((size_t)(g * 256 + n) * 512 + k8 * 8), w);
            }
            const float* KT = WP(float, WS_KT); bf16* S5KV = WP(bf16, WS_S5KV); const float* CRE = IN(I_CRE); const float* CIM = IN(I_CIM);
            for (int it = GT(); it < 16 * 512 * 96; it += NGT) {
                const int k8 = it % 96, rest = it / 96, n = rest & 511, g = rest >> 9, t = n >> 4, c = n & 15;
                float v[8];
                if (k8 < 64) { const int s = k8 >> 1, c0 = (k8 & 1) * 8, tp = t - s + 31; const float* kp = KT + ((size_t)(((l * 16 + g) * 63 + tp) * 16 + c) * 16 + c0);
                    const f32x4 a = gld<f32x4>(kp), b = gld<f32x4>(kp + 4); v[0] = a[0]; v[1] = a[1]; v[2] = a[2]; v[3] = a[3]; v[4] = b[0]; v[5] = b[1]; v[6] = b[2]; v[7] = b[3]; }
                else { const int jj = (k8 - 64) * 8, d = jj >> 7, ri = (jj >> 6) & 1, p0 = jj & 63, e = d == 0 ? t + 1 : 32 - t, base = (l * 2 + d) * 16 + g;
                    const float* cre = CRE + ((size_t)base * 16 + c) * 64 + p0; const float* cim = CIM + ((size_t)base * 16 + c) * 64 + p0; const f32x2* ap = APOW + ((size_t)base * 33 + e) * 64 + p0;
#pragma unroll
                    for (int j = 0; j < 8; ++j) { const f32x2 a = ap[j]; const float cr = cre[j], ci = cim[j]; v[j] = ri == 0 ? cr * a.x - ci * a.y : -(cr * a.y + ci * a.x); } }
                u32x4 w; w.x = cvt_pk_bf16(v[0], v[1]); w.y = cvt_pk_bf16(v[2], v[3]); w.z = cvt_pk_bf16(v[4], v[5]); w.w = cvt_pk_bf16(v[6], v[7]);
                gst<u32x4>(S5KV + ((size_t)(g * 512 + n) * ATK + k8 * 8), w);
            }
            }
            if (!FUSE1) { bf16* H = WP(bf16, WS_H); const float* gn = IN(I_NMIX) + l * 1024;
              if (l == 0) { for (int grp = gw; grp < M / 4; grp += NGW) norm_rows4<false>(xin0, gn, H, grp * 4, lane, nullptr, nullptr, nullptr, nullptr, nullptr, WP(float, WS_SS)); }
              else { bf16* XB = (bf16*)XO; for (int grp = gw; grp < M / 4; grp += NGW) norm_rows4b(XB, gn, H, grp * 4, lane, WP(float, WS_SS)); } }
        }
        GRID_BAR();
        }

        for (int rep_ = 0; rep_ < NREP(3); ++rep_) {
        if (PH(3)) {
            WSL();
            pg8::Gemm g{l == 0 ? WP(bf16, WS_H) : (const bf16*)XO, WP(bf16, WS_WIN), 1024, 1024, 1024}; pg8::StaticOrder S; S.init(M / 256, INC / 256, G, bid);
            EpiProj E{WP(bf16, WS_QK), WP(bf16, WS_VT8), WP(bf16, WS_AT), WP(bf16, WS_QX), WP(bf16, WS_GATES), IN(I_BGATE) + l * 3072, WP(float, WS_SS)};
            pg8::gemm_phase<EpiProj, pg8::StaticOrder>(F.lds, g, S, E, tid);
        }
        GRID_BAR();
        }

        for (int rep_ = 0; rep_ < NREP(4); ++rep_) {
        if (PH(4)) {
            WSL();
            for (int bg = bid; bg < 64; bg += G) {
                { pg8::Gemm g{WP(bf16, WS_AT), WP(bf16, WS_S5W), ATK, 512, 512}; pg8::ListOrder S{bg, 1, 1}; EpiS5a E{WP(float, WS_ST)};
                  pg8::gemm_phase<EpiS5a, pg8::ListOrder>(F.lds, g, S, E, tid); }
                WG_MEM_SYNC();
                s5_scan_item(bg * 2, WP(float, WS_ST), WP(bf16, WS_AT), WP(f32x2, WS_APOW) + (size_t)l * 2 * 16 * 33 * 64, (LAS float*)F.lds, tid);
                s5_scan_item(bg * 2 + 1, WP(float, WS_ST), WP(bf16, WS_AT), WP(f32x2, WS_APOW) + (size_t)l * 2 * 16 * 33 * 64, (LAS float*)F.lds, tid);
                WG_MEM_SYNC();
                { pg8::Gemm g{WP(bf16, WS_AT), WP(bf16, WS_S5KV), ATK, ATK, ATK}; pg8::ListOrder S{bg, 2, 2}; EpiS5c E{WP(bf16, WS_Y)};
                  pg8::gemm_phase<EpiS5c, pg8::ListOrder>(F.lds, g, S, E, tid); }
            }
            unsigned* qhead = WP(unsigned, WS_CTL) + CW_Q + (l + 4 * rep_) * 64;
            volatile LAS int* qslot = (volatile LAS int*)(F.lds + MISC_OFF + 64);
            for (;;) {
                if (tid == 0) qslot[0] = (int)__hip_atomic_fetch_add((GASP unsigned*)qhead, 1u, __ATOMIC_RELAXED, __HIP_MEMORY_SCOPE_AGENT);
                __syncthreads();
                const int qi = __builtin_amdgcn_readfirstlane(qslot[0]);
                __syncthreads();
                if (qi >= 768) break;
                if (qi < 512) NA_ITEM(qi); else XA_ITEMS(qi - 512, qi - 511, 1);
            }
        }
        GRID_BAR();
        }

        for (int rep_ = 0; rep_ < NREP(7); ++rep_) {
        if (PH(7)) {
            WSL();
            pg8::Gemm g{WP(bf16, WS_Y), WP(bf16, WS_WGLU), 256, 256, 256}; pg8::StaticOrder S; S.init(M / 256, 2, G, bid); EpiGlu E{WP(bf16, WS_H)};
            pg8::gemm_phase<EpiGlu, pg8::StaticOrder>(F.lds, g, S, E, tid);
        }
        GRID_BAR();
        }

        for (int rep_ = 0; rep_ < NREP(8); ++rep_) {
        if (PH(8)) {
            WSL();
            pg8::Gemm g{WP(bf16, WS_H), WP(bf16, WS_WCAT), 1024, 1024, 1024}; pg8::StaticOrder S; S.init(M / 256, 4, G, bid); EpiMerge E{WP(unsigned char, WS_GATES), WP(bf16, WS_QK)};
            pg8::gemm_phase<EpiMerge, pg8::StaticOrder, false, true>(F.lds, g, S, E, tid);
        }
        GRID_BAR();
        }

        for (int rep_ = 0; rep_ < NREP(9); ++rep_) {
        if (PH(9)) {
            WSL();
            pg8::Gemm g{WP(bf16, WS_QK), WP(bf16, WS_WOUT), 1024, 1024, 1024}; pg8::StaticOrder S; S.init(M / 256, 4, G, bid); EpiDelta E{WP(bf16, WS_H)};
            pg8::gemm_phase<EpiDelta, pg8::StaticOrder>(F.lds, g, S, E, tid);
        }
        GRID_BAR();
        }

        for (int rep_ = 0; rep_ < NREP(10); ++rep_) {
        if (PH(10)) {
            WSL();
            {
            unsigned* cnt = WP(unsigned, WS_CTL) + CW_CNT + (l + 4 * rep_) * NBUCKET * 64;
            const float* bco = IN(I_BCO) + l * 4; const float* bfi = IN(I_BFI) + l * 16;
            int* LIST = rep_ ? WP(int, WS_GATES + 100 * MiB) : WP(int, WS_LIST); float* WTS = rep_ ? WP(float, WS_GATES + 104 * MiB) : WP(float, WS_WTS);
            { const u32x4* src = (const u32x4*)(WP(bf16, WS_WRT) + (size_t)l * 2 * 20480);
              for (int idx = tid; idx < 40 * 128; idx += NWAVES * 64) *(LAS u32x4*)(F.lds + (idx >> 7) * RT_STRIDE + (idx & 127) * 16) = gld<u32x4>(src + idx); }
            __syncthreads();
            for (int grp = gw; grp < M / 16; grp += NGW) router_rows16(xin0, (l == 0 || rep_) ? nullptr : (const bf16*)XO, rep_ ? nullptr : WP(bf16, WS_H), rep_ ? WP(bf16, WS_GATES + 120 * MiB) : (l == DEPTH - 1 ? WP(bf16, WS_QK) : (bf16*)XO), grp * 16, lane, F.lds, wave, bco, bfi, cnt, LIST, WTS);
            __syncthreads();
            }
            bf16* WGU = WP(bf16, WS_WGU); bf16* WDP = WP(bf16, WS_WDP);
            for (int it = gw; it < 10240; it += NGW) {
                int r = it;
                if (r < 2048) { const int e = r >> 7; transpose_job_item(IN(I_WG) + (size_t)(l * 16 + e) * 1024 * 256, 256, 256, r & 127, WGU + (size_t)e * 512 * 1024, 1024, 0, 0, 2, 0, 0, IN(I_NFFN) + l * 1024, SCR(), lane); continue; } r -= 2048;
                if (r < 2048) { const int e = r >> 7; transpose_job_item(IN(I_WU) + (size_t)(l * 16 + e) * 1024 * 256, 256, 256, r & 127, WGU + (size_t)e * 512 * 1024, 1024, 0, 0, 2, 1, 0, IN(I_NFFN) + l * 1024, SCR(), lane); continue; } r -= 2048;
                const int ej = r >> 7, e = ej / 3, jj = ej % 3, i = e & 3, grpI = e >> 2, o = jj + (jj >= i ? 1 : 0), a = i < o ? i : o, b = i < o ? o : i;
                const int pair = grpI * 6 + (a == 0 ? b - 1 : (a == 1 ? b + 1 : 5)), slot = (i == a) ? 0 : 1;
                transpose_job_item(IN(I_WD) + (size_t)(l * 16 + e) * 256 * 1024, 1024, 1024, r & 127, WDP + (size_t)pair * 1024 * 512, 512, slot * 256, 0, 1, 0, 0, nullptr, SCR(), lane);
            }
        }
        GRID_BAR();
        }

        LAS int* tab = (LAS int*)(F.lds + TAB_OFF);
        for (int rep_ = 0; rep_ < NREP(11); ++rep_) {
        if (PH(11)) {
            WSL();
            unsigned* cnt = WP(unsigned, WS_CTL) + CW_CNT + l * NBUCKET * 64;
            if (tid == 0) { int st = 0;
                for (int b = 0; b < NBUCKET; ++b) { const int c = (int)__hip_atomic_load((GASP unsigned*)(cnt + b * 64), __ATOMIC_RELAXED, __HIP_MEMORY_SCOPE_AGENT); tab[b] = c; tab[32 + b] = st; st += (c + 255) >> 8; }
                tab[32 + NBUCKET] = st; tab[64] = st; }
            __syncthreads();
            pg8::Gemm g{l == DEPTH - 1 ? WP(bf16, WS_QK) : (const bf16*)XO, WP(bf16, WS_WGU), 1024, 1024, 1024}; pg8::MoeOrder S{tab, WP(int, WS_LIST), G, bid, 0}; EpiMoe1 E{WP(bf16, WS_ACT), WP(float, WS_WTS)};
            pg8::gemm_phase<EpiMoe1, pg8::MoeOrder, true>(F.lds, g, S, E, tid);
        }
        GRID_BAR();
        }

        for (int rep_ = 0; rep_ < NREP(12); ++rep_) {
        if (PH(12)) {
            WSL();
            pg8::Gemm g{WP(bf16, WS_ACT), WP(bf16, WS_WDP), 512, 512, 512}; pg8::MoeOrder S{tab, WP(int, WS_LIST), G, bid, 1}; EpiMoe2 E{WP(bf16, WS_H), WP(int, WS_LIST)};
            pg8::gemm_phase<EpiMoe2, pg8::MoeOrder>(F.lds, g, S, E, tid);
        }
        GRID_BAR();
        }
    }
    { WSL(); const float* gn = IN(I_FNORM);
      for (int row = gw; row < M; row += NGW) final_norm_row(WP(bf16, WS_QK), WP(bf16, WS_H), XO, gn, row, lane); }
#undef GRID_BAR
}

extern "C" void kernel_launch(void* const* d_in, const int* in_sizes, int n_in, void* d_out, int out_size, void* d_ws, size_t ws_size, hipStream_t stream) {
    static int grid = 0;
    if (grid == 0) {
        if (n_in != 30 || out_size != M * D || ws_size < WS_END) { fprintf(stderr, "kernel_launch: unexpected shapes (n_in %d, out %d, ws %zu)\n", n_in, out_size, ws_size); grid = -1; return; }
        int dev = 0, cus = 0, per_cu = 0;
        if (hipGetDevice(&dev) != hipSuccess || hipDeviceGetAttribute(&cus, hipDeviceAttributeMultiprocessorCount, dev) != hipSuccess) { grid = -1; return; }
        if (hipFuncSetAttribute((const void*)fwd_kernel, hipFuncAttributeMaxDynamicSharedMemorySize, LDS_BYTES) != hipSuccess) { fprintf(stderr, "kernel_launch: hipFuncSetAttribute failed\n"); grid = -1; return; }
        if (hipOccupancyMaxActiveBlocksPerMultiprocessor(&per_cu, (const void*)fwd_kernel, NWAVES * 64, LDS_BYTES) != hipSuccess || per_cu < 1) { fprintf(stderr, "kernel_launch: occupancy query reports %d\n", per_cu); }
        (void)hipGetLastError();
        grid = cus;
    }
    if (grid < 0) return;
    (void)in_sizes;
    (void)hipMemsetAsync((char*)d_ws + WS_CTL, 0, CTL_BYTES, stream);
    Args a{};
    for (int i = 0; i < 30; ++i) a.in[i] = (const float*)d_in[i];
    a.out = (float*)d_out; a.ws = (unsigned char*)d_ws;
    hipLaunchKernelGGL(fwd_kernel, dim3(grid), dim3(NWAVES * 64), LDS_BYTES, stream, a);
}
```

```cpp
#include <hip/hip_runtime.h>
#include <cstdio>
#include <cstdint>

#define LAS __attribute__((address_space(3)))
typedef unsigned short bf16;
typedef short bf16x8 __attribute__((ext_vector_type(8)));
typedef float f32x4 __attribute__((ext_vector_type(4)));
typedef float f32x2 __attribute__((ext_vector_type(2)));
typedef unsigned u32x4 __attribute__((ext_vector_type(4)));
typedef unsigned u32x2 __attribute__((ext_vector_type(2)));

constexpr int D = 1024, BATCH = 4, SEQ = 8192, M = BATCH * SEQ, DEPTH = 4;
constexpr int INC = 5120, NMEM = 256;
constexpr int NCHUNK = 256, TCH = 32;
constexpr int ATK = 768;
constexpr int LCAP = 32768;
constexpr int NBUCKET = 24;
constexpr float RMS_EPS = 1e-6f;

constexpr size_t MiB = 1u << 20;
constexpr size_t WS_CTL = 0, CTL_BYTES = 1 * MiB;
constexpr size_t WS_APOW = 1 * MiB;
constexpr size_t WS_BBAR = 4 * MiB;
constexpr size_t WS_KT = 5 * MiB;
constexpr size_t WS_WRT = 10 * MiB;
constexpr size_t WS_RPBP = 10 * MiB + 512 * 1024;
constexpr size_t WS_MEMN = 11 * MiB;
constexpr size_t WS_WMKV = 19 * MiB;
constexpr size_t WS_KM = 23 * MiB;
constexpr size_t WS_VM8 = 25 * MiB;
constexpr size_t WS_WIN = 27 * MiB;
constexpr size_t WS_WCAT = 37 * MiB;
constexpr size_t WS_WOUT = 39 * MiB;
constexpr size_t WS_WGLU = 41 * MiB;
constexpr size_t WS_S5W = 42 * MiB;
constexpr size_t WS_S5KV = 46 * MiB;
constexpr size_t WS_H = 58 * MiB;
constexpr size_t WS_QK = 122 * MiB;
constexpr size_t WS_VT8 = 186 * MiB;
constexpr size_t WS_AT = 218 * MiB;
constexpr size_t WS_QX = 242 * MiB;
constexpr size_t WS_ST = 258 * MiB;
constexpr size_t WS_Y = 274 * MiB;
constexpr size_t WS_GATES = 290 * MiB;
constexpr size_t WS_WGU = WS_GATES;
constexpr size_t WS_WDP = WS_GATES + 16 * MiB;
constexpr size_t WS_ACT = WS_GATES + 40 * MiB;
constexpr size_t WS_LIST = 482 * MiB;
constexpr size_t WS_WTS = 485 * MiB;
constexpr size_t WS_SS = 497 * MiB;
constexpr size_t WS_END = 505 * MiB;
constexpr int CW_BAR = 4096;
constexpr int CW_CNT = 16384;
constexpr int CW_Q = 32768;

__device__ __forceinline__ unsigned cvt_pk_bf16(float lo, float hi) { unsigned r; asm volatile("v_cvt_pk_bf16_f32 %0, %1, %2" : "=v"(r) : "v"(lo), "v"(hi)); return r; }
__device__ __forceinline__ float bf2f(unsigned short b) { return __uint_as_float(((unsigned)b) << 16); }
__device__ __forceinline__ float bflo(unsigned w) { return __uint_as_float(w << 16); }
__device__ __forceinline__ float bfhi(unsigned w) { return __uint_as_float(w & 0xffff0000u); }
__device__ __forceinline__ float fast_rcp(float x) { return __builtin_amdgcn_rcpf(x); }
__device__ __forceinline__ float fast_exp(float x) { return __builtin_amdgcn_exp2f(x * 1.4426950408889634f); }
__device__ __forceinline__ float sigmoid_f(float x) { return fast_rcp(1.0f + fast_exp(-x)); }
__device__ __forceinline__ float gelu_tanh_f(float x) { const float u = 1.5957691216057308f * (x + 0.044715f * x * x * x); return x * fast_rcp(1.0f + fast_exp(-u)); }
__device__ __forceinline__ float shfl_xor_f(float v, int o, int lane) { return __int_as_float(__builtin_amdgcn_ds_bpermute((lane ^ o) << 2, __float_as_int(v))); }
__device__ __forceinline__ float shfl_idx_f(float v, int src) { return __int_as_float(__builtin_amdgcn_ds_bpermute(src << 2, __float_as_int(v))); }
__device__ __forceinline__ float wave_sum(float v, int lane) {
#pragma unroll
    for (int o = 1; o < 64; o <<= 1) v += shfl_xor_f(v, o, lane);
    return v;
}
#define GASP __attribute__((address_space(1)))
template <class T> __device__ __forceinline__ T gld(const void* p) { return *(const GASP T*)p; }
template <class T> __device__ __forceinline__ void gst(void* p, const T& v) { *(GASP T*)p = v; }
__device__ __forceinline__ unsigned q8(float g) { return (unsigned)__builtin_fminf(__builtin_fmaxf(__builtin_rintf(g * 255.0f), 1.0f), 255.0f); }
__device__ __forceinline__ unsigned q8x4(float a, float b, float c, float d) { return q8(a) | (q8(b) << 8) | (q8(c) << 16) | (q8(d) << 24); }
#define LDS_WAIT() asm volatile("s_waitcnt lgkmcnt(0)" ::: "memory")
#define VM_WAIT() asm volatile("s_waitcnt vmcnt(0)" ::: "memory")

namespace pg8 {
constexpr int BM = 256, BK = 64, HALF = 128, HTB = HALF * BK * 2, STAGE_BYTES = 8 * HTB, NXCD = 8, WGM = 8;
__host__ __device__ __forceinline__ int lds_byte(int r, int c) { const int st = (r >> 4) * 2 + (c >> 5), rr = r & 15, cc = c & 31, ob = rr * 64 + cc * 2; return st * 1024 + (ob ^ (((ob >> 9) & 1) << 5)); }
__host__ __device__ __forceinline__ void stage_rc(int b, int& R, int& C) { const int st = b / 1024, sb = b % 1024, swz = sb ^ (((sb >> 9) & 1) << 5); R = (st >> 1) * 16 + swz / 64; C = (st & 1) * 32 + (swz % 64) / 2; }
__host__ __device__ __forceinline__ int perm32(int rho) { const int n = rho >> 4, i = rho & 15; return 8 * (i >> 2) + 4 * n + (i & 3); }

struct Unit { int pm, pn, am, bn, x0, x1, x2; };
struct Gemm { const bf16* A; const bf16* Bt; int lda, ldb, K; };

struct StaticOrder {
    int nM, nN, nwg, G, c;
    __device__ void init(int nM_, int nN_, int G_, int c_) { nM = nM_; nN = nN_; nwg = nM * nN; G = G_; c = c_; }
    __device__ bool next(int i, Unit& u) const {
        const long L = (long)i * G + c; if (L >= nwg) return false;
        int wgid = (int)L; { const int q = nwg / NXCD, r = nwg % NXCD, xcd = wgid % NXCD, off = wgid / NXCD; wgid = (xcd < r ? xcd * (q + 1) : r * (q + 1) + (xcd - r) * q) + off; }
        const int nig = WGM * nN, gid = wgid / nig, fm = gid * WGM, gsz = (nM - fm) < WGM ? (nM - fm) : WGM;
        u.pm = __builtin_amdgcn_readfirstlane(fm + ((wgid % nig) % gsz)); u.pn = __builtin_amdgcn_readfirstlane((wgid % nig) / gsz);
        u.am = u.pm; u.bn = u.pn; u.x0 = 0; u.x1 = 0; u.x2 = 0; return true;
    }
    __device__ __forceinline__ int a_row(const Unit&, int) const { return 0; }
};
struct S5Order : StaticOrder {
    __device__ bool next(int i, Unit& u) const { if (!StaticOrder::next(i, u)) return false; u.bn = (u.pm & 15) * nN + u.pn; return true; }
};
struct ListOrder {
    int pm, n, nN;
    __device__ bool next(int i, Unit& u) const { if (i >= n) return false; u.pm = pm; u.pn = i; u.am = pm; u.bn = (pm & 15) * nN + i; u.x0 = 0; u.x1 = 0; u.x2 = 0; return true; }
    __device__ __forceinline__ int a_row(const Unit&, int) const { return 0; }
};
struct MemOrder {
    int G, c;
    __device__ bool next(int i, Unit& u) const { const int L = i * G + c; if (L >= 32) return false; u.pm = L >> 1; u.pn = L & 1; u.am = u.pm; u.bn = (u.pm >> 2) * 2 + u.pn; u.x0 = 0; u.x1 = 0; u.x2 = 0; return true; }
    __device__ __forceinline__ int a_row(const Unit&, int) const { return 0; }
};
struct MoeOrder {
    const LAS int* tab; const int* list; int G, c, mode;
    __device__ bool next(int i, Unit& u) const {
        const int T = __builtin_amdgcn_readfirstlane(tab[64]); const int L = i * G + c; if (L >= T * 4) return false;
        const int tile = L >> 2, pn = L & 3; int b = 0;
#pragma unroll 1
        for (int j = 1; j < NBUCKET; ++j) if (__builtin_amdgcn_readfirstlane(tab[32 + j]) <= tile) b = j;
        u.pm = tile; u.pn = pn; u.am = tile; u.x0 = b; u.x1 = (tile - __builtin_amdgcn_readfirstlane(tab[32 + b])) * 256; u.x2 = __builtin_amdgcn_readfirstlane(tab[b]);
        const int grp = __builtin_amdgcn_readfirstlane(b / 6), pi = __builtin_amdgcn_readfirstlane(b % 6); const int ea = pi < 3 ? 0 : (pi < 5 ? 1 : 2), eb = pi < 3 ? pi + 1 : (pi < 5 ? pi - 1 : 3);
        if (mode == 0) { const int e = grp * 4 + ((pn >> 1) ? eb : ea); u.bn = e * 2 + (pn & 1); } else u.bn = b * 4 + pn;
        return true;
    }
    __device__ __forceinline__ int a_row(const Unit& u, int r) const { const int slot = u.x1 + r; return slot < u.x2 ? gld<int>(list + (unsigned)(u.x0 * LCAP + slot)) : 0; }
};

template <class Epi, class Sched, bool GATHER = false, bool KHOOK = false>
__device__ __forceinline__ void gemm_phase(LAS unsigned char* lds, const Gemm g, const Sched& S, const Epi& E, int tid_in) {
    int tid = tid_in; asm volatile("" : "+v"(tid));
    const int wid = __builtin_amdgcn_readfirstlane(tid >> 6), lane = tid & 63, wr = wid >> 2, wc = wid & 3, fr = lane & 15, fq = lane >> 4;
    int K = g.K, lda = g.lda, ldb = g.ldb;
    asm volatile("" : "+s"(K), "+s"(lda), "+s"(ldb));
    const int nt = K / BK;
    unsigned voffA[2], voffB[2]; int Rr[2], Cc[2];
#pragma unroll
    for (int i = 0; i < 2; ++i) { int R, C; stage_rc(tid * 16 + i * 8192, R, C); const int Rb = Epi::PERM ? ((R & ~31) + perm32(R & 31)) : R;
        voffA[i] = (unsigned)(R * lda + C) * 2u; voffB[i] = (unsigned)(Rb * ldb + C) * 2u; Rr[i] = R; Cc[i] = C; }
    const unsigned kstep = (unsigned)(BK * 2);
    const unsigned hstepA = (unsigned)(HALF * lda * 2), tstepA = 2u * hstepA, hstepB = (unsigned)(HALF * ldb * 2), tstepB = 2u * hstepB;
    const unsigned ldsw = (unsigned)wid * 1024u;
    const int aoff = lds_byte(wr * 64 + fr, fq * 8), boff = lds_byte(wc * 32 + fr, fq * 8);
    unsigned vC[2][2] = {{0u, 0u}, {0u, 0u}}, vN[2][2] = {{0u, 0u}, {0u, 0u}};
#define PG8_SA(b, h) (((b) * 2 + (h)) * HTB)
#define PG8_SB(b, h) ((4 + (b) * 2 + (h)) * HTB)
#define PG8_STAGE(bufoff, gbase, voff) do { _Pragma("unroll") for (int _i = 0; _i < 2; ++_i) \
        __builtin_amdgcn_global_load_lds((const unsigned*)((const char*)(gbase) + (voff)[_i]), (LAS unsigned*)(lds + (bufoff) + ldsw + _i * 8192), 16, 0, 0); } while (0)
#define PG8_STA(bufoff, ptr, h, nx) do { if constexpr (GATHER) { unsigned _v[2]; _v[0] = (nx) ? vN[h][0] : vC[h][0]; _v[1] = (nx) ? vN[h][1] : vC[h][1]; PG8_STAGE(bufoff, ptr, _v); } \
        else { PG8_STAGE(bufoff, (ptr) + (h) * hstepA, voffA); } } while (0)
#define PG8_STB(bufoff, ptr, h) PG8_STAGE(bufoff, (ptr) + (h) * hstepB, voffB)
#define PG8_LDA(dst, b, h) do { _Pragma("unroll") for (int m = 0; m < 4; ++m) _Pragma("unroll") for (int k = 0; k < 2; ++k) dst[m][k] = *(const LAS bf16x8*)(lds + PG8_SA(b, h) + aoff + m * 2048 + k * 1024); } while (0)
#define PG8_LDB(dst, b, h) do { _Pragma("unroll") for (int n = 0; n < 2; ++n) _Pragma("unroll") for (int k = 0; k < 2; ++k) dst[n][k] = *(const LAS bf16x8*)(lds + PG8_SB(b, h) + boff + n * 2048 + k * 1024); } while (0)
#define PG8_MMA(ai, bj, At, Bt) do { __builtin_amdgcn_s_setprio(1); _Pragma("unroll") for (int m = 0; m < 4; ++m) _Pragma("unroll") for (int n = 0; n < 2; ++n) _Pragma("unroll") for (int k = 0; k < 2; ++k) \
        acc[ai][bj][m][n] = __builtin_amdgcn_mfma_f32_16x16x32_bf16(Bt[n][k], At[m][k], acc[ai][bj][m][n], 0, 0, 0); __builtin_amdgcn_s_setprio(0); } while (0)
#define PG8_WAIT_V(n) asm volatile("s_waitcnt vmcnt(" #n ")" ::: "memory")
#define PG8_WAIT_L(n) asm volatile("s_waitcnt lgkmcnt(" #n ")" ::: "memory")
#define PG8_BAR __builtin_amdgcn_s_barrier()
#define PG8_SCHED __builtin_amdgcn_sched_barrier(0)
    Unit cur, nxt; int ui = 0;
    if (!S.next(0, cur)) return;
    f32x4 acc[2][2][4][2];
#pragma unroll
    for (int a = 0; a < 2; ++a)
#pragma unroll
        for (int b = 0; b < 2; ++b)
#pragma unroll
            for (int m = 0; m < 4; ++m)
#pragma unroll
                for (int n = 0; n < 2; ++n) acc[a][b][m][n] = (f32x4){0.f, 0.f, 0.f, 0.f};
    bf16x8 At[4][2], B0[2][2], B1[2][2];
    const char* cA = GATHER ? (const char*)g.A : (const char*)g.A + (unsigned)cur.am * tstepA;
    const char* cB = (const char*)g.Bt + (unsigned)cur.bn * tstepB;
    if constexpr (GATHER) {
#pragma unroll
        for (int h = 0; h < 2; ++h)
#pragma unroll
            for (int i = 0; i < 2; ++i) vC[h][i] = (unsigned)(S.a_row(cur, h * HALF + Rr[i]) * lda + Cc[i]) * 2u;
    }
    PG8_STB(PG8_SB(0, 0), cB, 0); PG8_STB(PG8_SB(0, 1), cB, 1); PG8_STA(PG8_SA(0, 0), cA, 0, false); PG8_STA(PG8_SA(0, 1), cA, 1, false);
    if (wr == 1) PG8_BAR;
    PG8_WAIT_V(2); PG8_BAR;
    PG8_STB(PG8_SB(1, 0), cB + kstep, 0); PG8_STA(PG8_SA(1, 0), cA + kstep, 0, false); PG8_STB(PG8_SB(1, 1), cB + kstep, 1);
    PG8_WAIT_V(6); PG8_BAR;
    for (;;) {
        const bool has_next = S.next(ui + 1, nxt);
        const char* nA = GATHER ? (const char*)g.A : (has_next ? (const char*)g.A + (unsigned)nxt.am * tstepA : cA);
        const char* nB = has_next ? (const char*)g.Bt + (unsigned)nxt.bn * tstepB : cB;
        if constexpr (GATHER) {
#pragma unroll
            for (int h = 0; h < 2; ++h)
#pragma unroll
                for (int i = 0; i < 2; ++i) vN[h][i] = has_next ? (unsigned)(S.a_row(nxt, h * HALF + Rr[i]) * lda + Cc[i]) * 2u : vC[h][i];
        }
        int tb = 0;
#pragma unroll 1
        for (int seg = 0; seg < (KHOOK ? 3 : 1); ++seg) {
        const int te = KHOOK ? (seg == 0 ? 8 : (seg == 1 ? 12 : nt)) : nt;
        for (int t = tb; t < te; t += 2) {
            const bool last = (t == nt - 2);
            const char* a1 = cA + (unsigned)(t + 1) * kstep;
            const char* a2 = last ? nA : cA + (unsigned)(t + 2) * kstep; const char* b2 = last ? nB : cB + (unsigned)(t + 2) * kstep;
            const char* a3 = a2 + kstep; const char* b3 = b2 + kstep;
            PG8_LDB(B0, 0, 0); PG8_LDB(B1, 0, 1); PG8_SCHED; PG8_LDA(At, 0, 0); PG8_STA(PG8_SA(1, 1), a1, 1, false);
            PG8_WAIT_V(8); PG8_WAIT_L(0); PG8_BAR; PG8_MMA(0, 0, At, B0); PG8_MMA(0, 1, At, B1); PG8_BAR; PG8_SCHED;
            PG8_LDA(At, 0, 1); PG8_STB(PG8_SB(0, 0), b2, 0); PG8_STB(PG8_SB(0, 1), b2, 1); PG8_STA(PG8_SA(0, 0), a2, 0, last);
            PG8_WAIT_V(8); PG8_WAIT_L(0); PG8_BAR; PG8_MMA(1, 0, At, B0); PG8_MMA(1, 1, At, B1); PG8_BAR; PG8_SCHED;
            PG8_LDB(B0, 1, 0); PG8_LDB(B1, 1, 1); PG8_SCHED; PG8_LDA(At, 1, 0); PG8_STA(PG8_SA(0, 1), a2, 1, last);
            PG8_WAIT_V(8); PG8_WAIT_L(0); PG8_BAR; PG8_MMA(0, 0, At, B0); PG8_MMA(0, 1, At, B1); PG8_BAR; PG8_SCHED;
            PG8_LDA(At, 1, 1); PG8_STB(PG8_SB(1, 0), b3, 0); PG8_STB(PG8_SB(1, 1), b3, 1); PG8_STA(PG8_SA(1, 0), a3, 0, last);
            PG8_WAIT_V(8); PG8_WAIT_L(0); PG8_BAR; PG8_MMA(1, 0, At, B0); PG8_MMA(1, 1, At, B1); PG8_BAR; PG8_SCHED;
        }
        if constexpr (KHOOK) { if (seg < 2) { unsigned mm_ = ~0u; asm volatile("" : "+s"(mm_)); const int ln_ = (int)__builtin_amdgcn_mbcnt_hi(mm_, __builtin_amdgcn_mbcnt_lo(mm_, 0u)); E.khook(acc, cur, te, wr, wc, ln_ & 15, ln_ >> 4); } }
        tb = te;
        }
        if (wr == 0) PG8_BAR;
        { unsigned mm_ = ~0u; asm volatile("" : "+s"(mm_)); const int ln_ = (int)__builtin_amdgcn_mbcnt_hi(mm_, __builtin_amdgcn_mbcnt_lo(mm_, 0u)); E(acc, cur, wr, wc, ln_ & 15, ln_ >> 4); }
        if (!has_next) break;
#pragma unroll
        for (int a = 0; a < 2; ++a)
#pragma unroll
            for (int b = 0; b < 2; ++b)
#pragma unroll
                for (int m = 0; m < 4; ++m)
#pragma unroll
                    for (int n = 0; n < 2; ++n) acc[a][b][m][n] = (f32x4){0.f, 0.f, 0.f, 0.f};
        cur = nxt; cA = nA; cB = nB; ++ui;
        if constexpr (GATHER) {
#pragma unroll
            for (int h = 0; h < 2; ++h)
#pragma unroll
                for (int i = 0; i < 2; ++i) vC[h][i] = vN[h][i];
        }
        if (wr == 1) PG8_BAR;
    }
    PG8_WAIT_V(0);
    PG8_BAR;
#undef PG8_SA
#undef PG8_SB
#undef PG8_STAGE
#undef PG8_STA
#undef PG8_STB
#undef PG8_LDA
#undef PG8_LDB
#undef PG8_MMA
#undef PG8_WAIT_V
#undef PG8_WAIT_L
#undef PG8_BAR
#undef PG8_SCHED
}
}

using pg8::Unit;
struct EpiProj {
    static constexpr bool PERM = true;
    bf16 *QK, *Vt8, *At, *QX, *GATES; const float* bgate; const float* ssq;
#define EP_LOOP_BEGIN _Pragma("unroll") for (int ai = 0; ai < 2; ++ai) _Pragma("unroll") for (int m = 0; m < 4; ++m) { const int row = row0 + ai * 128 + m * 16; const float rs = rstd[ai][m]; _Pragma("unroll") for (int bj = 0; bj < 2; ++bj) { \
        const f32x4 v0 = acc[ai][bj][m][0] * rs, v1 = acc[ai][bj][m][1] * rs; const int cl = cl0 + bj * 128;
#define EP_LOOP_END } asm volatile("" ::: "memory"); }
    __device__ __forceinline__ void operator()(const f32x4 (&acc)[2][2][4][2], const Unit& u, int wr, int wc, int fr, int fq) const {
        const int pn = u.pn, row0 = u.pm * 256 + wr * 64 + fr, cl0 = wc * 32 + 8 * fq;
        float rstd[2][4];
#pragma unroll
        for (int ai = 0; ai < 2; ++ai)
#pragma unroll
            for (int m = 0; m < 4; ++m) rstd[ai][m] = ssq ? gld<float>(ssq + row0 + ai * 128 + m * 16) : 1.0f;
        if (pn < 4) {
            EP_LOOP_BEGIN
                u32x4 w; w.x = cvt_pk_bf16(v0[0], v0[1]); w.y = cvt_pk_bf16(v0[2], v0[3]); w.z = cvt_pk_bf16(v1[0], v1[1]); w.w = cvt_pk_bf16(v1[2], v1[3]);
                gst<u32x4>(QK + (unsigned)row * 1024 + pn * 256 + cl, w);
            EP_LOOP_END
        } else if (pn < 6) {
            EP_LOOP_BEGIN
                const int vc = (pn - 4) * 256 + cl, hh = vc >> 6, dh = vc & 63, b = row >> 13, s = row & 8191;
                bf16* p = Vt8 + ((unsigned)((b * 8 + hh) * 1024 + (s >> 3)) * 64 + dh) * 8 + (s & 7);
                const unsigned w0 = cvt_pk_bf16(v0[0], v0[1]), w1 = cvt_pk_bf16(v0[2], v0[3]), w2 = cvt_pk_bf16(v1[0], v1[1]), w3 = cvt_pk_bf16(v1[2], v1[3]);
                gst<bf16>(p, (bf16)w0); gst<bf16>(p + 8, (bf16)(w0 >> 16)); gst<bf16>(p + 16, (bf16)w1); gst<bf16>(p + 24, (bf16)(w1 >> 16)); gst<bf16>(p + 32, (bf16)w2); gst<bf16>(p + 40, (bf16)(w2 >> 16)); gst<bf16>(p + 48, (bf16)w3); gst<bf16>(p + 56, (bf16)(w3 >> 16));
            EP_LOOP_END
        } else if (pn == 6) {
            EP_LOOP_BEGIN
                const int g = cl >> 4, c0 = cl & 15, b = row >> 13, s = row & 8191;
                u32x4 w; w.x = cvt_pk_bf16(v0[0], v0[1]); w.y = cvt_pk_bf16(v0[2], v0[3]); w.z = cvt_pk_bf16(v1[0], v1[1]); w.w = cvt_pk_bf16(v1[2], v1[3]);
                gst<u32x4>(At + ((unsigned)((b * 16 + g) * 256 + (s >> 5))) * ATK + (s & 31) * 16 + c0, w);
            EP_LOOP_END
        } else if (pn == 7) {
            EP_LOOP_BEGIN
                u32x4 w; w.x = cvt_pk_bf16(v0[0], v0[1]); w.y = cvt_pk_bf16(v0[2], v0[3]); w.z = cvt_pk_bf16(v1[0], v1[1]); w.w = cvt_pk_bf16(v1[2], v1[3]);
                gst<u32x4>(QX + (unsigned)row * 256 + cl, w);
            EP_LOOP_END
        } else {
            EP_LOOP_BEGIN
                const int gc = (pn - 8) * 256 + cl;
                const f32x4 b0 = gld<f32x4>(bgate + gc), b1 = gld<f32x4>(bgate + gc + 4);
                u32x2 w; w.x = q8x4(sigmoid_f(v0[0] + b0[0]), sigmoid_f(v0[1] + b0[1]), sigmoid_f(v0[2] + b0[2]), sigmoid_f(v0[3] + b0[3]));
                w.y = q8x4(sigmoid_f(v1[0] + b1[0]), sigmoid_f(v1[1] + b1[1]), sigmoid_f(v1[2] + b1[2]), sigmoid_f(v1[3] + b1[3]));
                gst<u32x2>((unsigned char*)GATES + (unsigned)row * 3072 + gc, w);
            EP_LOOP_END
        }
    }
#undef EP_LOOP_BEGIN
#undef EP_LOOP_END
};
struct EpiMemKV {
    static constexpr bool PERM = true;
    bf16 *Km, *Vm8;
    __device__ __forceinline__ void operator()(const f32x4 (&acc)[2][2][4][2], const Unit& u, int wr, int wc, int fr, int fq) const {
        const int row0 = u.pm * 256 + wr * 64 + fr, cl0 = wc * 32 + 8 * fq;
#pragma unroll
        for (int ai = 0; ai < 2; ++ai)
#pragma unroll
            for (int m = 0; m < 4; ++m) {
                const int row = row0 + ai * 128 + m * 16;
#pragma unroll
                for (int bj = 0; bj < 2; ++bj) {
                    const f32x4 v0 = acc[ai][bj][m][0], v1 = acc[ai][bj][m][1];
                    const int cl = cl0 + bj * 128;
                    const unsigned w0 = cvt_pk_bf16(v0[0], v0[1]), w1 = cvt_pk_bf16(v0[2], v0[3]), w2 = cvt_pk_bf16(v1[0], v1[1]), w3 = cvt_pk_bf16(v1[2], v1[3]);
                    if (u.pn == 0) { u32x4 w; w.x = w0; w.y = w1; w.z = w2; w.w = w3; gst<u32x4>(Km + (unsigned)row * 256 + cl, w); }
                    else {
                        const int hh = cl >> 6, dh = cl & 63, lb = row >> 8, mm = row & 255;
                        bf16* p = Vm8 + ((unsigned)((lb * 4 + hh) * 32 + (mm >> 3)) * 64 + dh) * 8 + (mm & 7);
                        gst<bf16>(p, (bf16)w0); gst<bf16>(p + 8, (bf16)(w0 >> 16)); gst<bf16>(p + 16, (bf16)w1); gst<bf16>(p + 24, (bf16)(w1 >> 16)); gst<bf16>(p + 32, (bf16)w2); gst<bf16>(p + 40, (bf16)(w2 >> 16)); gst<bf16>(p + 48, (bf16)w3); gst<bf16>(p + 56, (bf16)(w3 >> 16));
                    }
                }
                asm volatile("" ::: "memory");
            }
    }
};
struct EpiS5a {
    static constexpr bool PERM = false;
    float* ST;
    __device__ __forceinline__ void operator()(const f32x4 (&acc)[2][2][4][2], const Unit& u, int wr, int wc, int fr, int fq) const {
        const int row0 = u.am * 256 + wr * 64 + fr, col0 = wc * 32 + 4 * fq;
#pragma unroll
        for (int ai = 0; ai < 2; ++ai)
#pragma unroll
            for (int m = 0; m < 4; ++m) { float* rowp = ST + (unsigned)(row0 + ai * 128 + m * 16) * 256 + col0;
#pragma unroll
                for (int bj = 0; bj < 2; ++bj)
#pragma unroll
                    for (int n = 0; n < 2; ++n) gst<f32x4>(rowp + bj * 128 + n * 16, acc[ai][bj][m][n]);
                asm volatile("" ::: "memory"); }
    }
};
struct EpiS5c {
    static constexpr bool PERM = true;
    bf16* Y;
    __device__ __forceinline__ void operator()(const f32x4 (&acc)[2][2][4][2], const Unit& u, int wr, int wc, int fr, int fq) const {
        const int b = u.am >> 4, g = u.am & 15, r0 = wr * 64 + fr, cl0 = u.pn * 256 + wc * 32 + 8 * fq;
#pragma unroll
        for (int ai = 0; ai < 2; ++ai)
#pragma unroll
            for (int m = 0; m < 4; ++m) {
                const int chunk = r0 + ai * 128 + m * 16;
#pragma unroll
                for (int bj = 0; bj < 2; ++bj) {
                    const f32x4 v0 = acc[ai][bj][m][0], v1 = acc[ai][bj][m][1];
                    const int col = cl0 + bj * 128, t = col >> 4, c0 = col & 15;
                    u32x4 w; w.x = cvt_pk_bf16(gelu_tanh_f(v0[0]), gelu_tanh_f(v0[1])); w.y = cvt_pk_bf16(gelu_tanh_f(v0[2]), gelu_tanh_f(v0[3]));
                    w.z = cvt_pk_bf16(gelu_tanh_f(v1[0]), gelu_tanh_f(v1[1])); w.w = cvt_pk_bf16(gelu_tanh_f(v1[2]), gelu_tanh_f(v1[3]));
                    gst<u32x4>(Y + (unsigned)(b * SEQ + chunk * 32 + t) * 256 + g * 16 + c0, w);
                }
                asm volatile("" ::: "memory");
            }
    }
};
struct EpiGlu {
    static constexpr bool PERM = true;
    bf16* CAT;
    __device__ __forceinline__ void operator()(const f32x4 (&acc)[2][2][4][2], const Unit& u, int wr, int wc, int fr, int fq) const {
        const int row0 = u.pm * 256 + wr * 64 + fr, cl0 = u.pn * 256 + wc * 32 + 8 * fq;
#pragma unroll
        for (int ai = 0; ai < 2; ++ai)
#pragma unroll
            for (int m = 0; m < 4; ++m) {
                const int row = row0 + ai * 128 + m * 16;
#pragma unroll
                for (int bj = 0; bj < 2; ++bj) {
                    const f32x4 v0 = acc[ai][bj][m][0], v1 = acc[ai][bj][m][1];
                    const int col = cl0 + bj * 128;
                    u32x2 w; w.x = cvt_pk_bf16(v0[0] * sigmoid_f(v0[1]), v0[2] * sigmoid_f(v0[3])); w.y = cvt_pk_bf16(v1[0] * sigmoid_f(v1[1]), v1[2] * sigmoid_f(v1[3]));
                    gst<u32x2>(CAT + (unsigned)row * 1024 + 512 + (col >> 1), w);
                }
                asm volatile("" ::: "memory");
            }
    }
};
struct EpiMerge {
    static constexpr bool PERM = true;
    const unsigned char* GATES; bf16* MG;
    static __device__ __forceinline__ float ub(unsigned w, int i) { return (float)((w >> (8 * i)) & 0xffu); }
    __device__ __forceinline__ void khook(f32x4 (&acc)[2][2][4][2], const Unit& u, int t, int wr, int wc, int fr, int fq) const {
        const int row0 = u.pm * 256 + wr * 64 + fr, cl0 = u.pn * 256 + wc * 32 + 8 * fq;
        const int ga = (t == 8) ? 0 : 1024;
        u32x2 na[2][4][2], nb[2][4][2];
#pragma unroll
        for (int ai = 0; ai < 2; ++ai)
#pragma unroll
            for (int m = 0; m < 4; ++m)
#pragma unroll
                for (int bj = 0; bj < 2; ++bj) { const unsigned char* gp = GATES + (unsigned)((row0 + ai * 128 + m * 16) * 3072 + ga + cl0 + bj * 128); na[ai][m][bj] = gld<u32x2>(gp); nb[ai][m][bj] = gld<u32x2>(gp + 1024); }
#pragma unroll
        for (int ai = 0; ai < 2; ++ai)
#pragma unroll
            for (int m = 0; m < 4; ++m)
#pragma unroll
                for (int bj = 0; bj < 2; ++bj) {
                    const u32x2 a = na[ai][m][bj], b = nb[ai][m][bj];
                    f32x4 r0, r1;
#pragma unroll
                    for (int i = 0; i < 4; ++i) { r0[i] = ub(a.x, i) * fast_rcp(ub(b.x, i)); r1[i] = ub(a.y, i) * fast_rcp(ub(b.y, i)); }
                    acc[ai][bj][m][0] *= r0; acc[ai][bj][m][1] *= r1;
                }
        asm volatile("" ::: "memory");
    }
    __device__ __forceinline__ void operator()(const f32x4 (&acc)[2][2][4][2], const Unit& u, int wr, int wc, int fr, int fq) const {
        const int row0 = u.pm * 256 + wr * 64 + fr, cl0 = u.pn * 256 + wc * 32 + 8 * fq;
#pragma unroll
        for (int ai = 0; ai < 2; ++ai) {
            u32x2 g2[4][2];
#pragma unroll
            for (int m = 0; m < 4; ++m)
#pragma unroll
                for (int bj = 0; bj < 2; ++bj) g2[m][bj] = gld<u32x2>(GATES + (unsigned)((row0 + ai * 128 + m * 16) * 3072 + 2048 + cl0 + bj * 128));
#pragma unroll
            for (int m = 0; m < 4; ++m)
#pragma unroll
                for (int bj = 0; bj < 2; ++bj) {
                    const u32x2 g = g2[m][bj]; const f32x4 v0 = acc[ai][bj][m][0] * (1.0f / 255.0f), v1 = acc[ai][bj][m][1] * (1.0f / 255.0f);
                    u32x4 w; w.x = cvt_pk_bf16(v0[0] * ub(g.x, 0), v0[1] * ub(g.x, 1)); w.y = cvt_pk_bf16(v0[2] * ub(g.x, 2), v0[3] * ub(g.x, 3));
                    w.z = cvt_pk_bf16(v1[0] * ub(g.y, 0), v1[1] * ub(g.y, 1)); w.w = cvt_pk_bf16(v1[2] * ub(g.y, 2), v1[3] * ub(g.y, 3));
                    gst<u32x4>(MG + (unsigned)((row0 + ai * 128 + m * 16) * 1024 + cl0 + bj * 128), w);
                }
            asm volatile("" ::: "memory");
        }
    }
};
struct EpiResB {
    static constexpr bool PERM = true;
    const float* Xf; bf16* XB;
    __device__ __forceinline__ void operator()(const f32x4 (&acc)[2][2][4][2], const Unit& u, int wr, int wc, int fr, int fq) const {
        const int row0 = u.pm * 256 + wr * 64 + fr, cl0 = u.pn * 256 + wc * 32 + 8 * fq;
#pragma unroll
        for (int ai = 0; ai < 2; ++ai)
#pragma unroll
            for (int mh = 0; mh < 2; ++mh) {
                f32x4 b0[2][2], b1[2][2];
#pragma unroll
                for (int mm = 0; mm < 2; ++mm)
#pragma unroll
                    for (int bj = 0; bj < 2; ++bj) { const unsigned off = (unsigned)((row0 + ai * 128 + (mh * 2 + mm) * 16) * 1024 + cl0 + bj * 128);
                        if (Xf) { b0[mm][bj] = gld<f32x4>(Xf + off); b1[mm][bj] = gld<f32x4>(Xf + off + 4); }
                        else { const u32x4 a = gld<u32x4>(XB + off); b0[mm][bj] = (f32x4){bflo(a.x), bfhi(a.x), bflo(a.y), bfhi(a.y)}; b1[mm][bj] = (f32x4){bflo(a.z), bfhi(a.z), bflo(a.w), bfhi(a.w)}; } }
#pragma unroll
                for (int mm = 0; mm < 2; ++mm)
#pragma unroll
                    for (int bj = 0; bj < 2; ++bj) { const unsigned off = (unsigned)((row0 + ai * 128 + (mh * 2 + mm) * 16) * 1024 + cl0 + bj * 128);
                        const f32x4 v0 = b0[mm][bj] + acc[ai][bj][mh * 2 + mm][0], v1 = b1[mm][bj] + acc[ai][bj][mh * 2 + mm][1];
                        u32x4 w; w.x = cvt_pk_bf16(v0[0], v0[1]); w.y = cvt_pk_bf16(v0[2], v0[3]); w.z = cvt_pk_bf16(v1[0], v1[1]); w.w = cvt_pk_bf16(v1[2], v1[3]);
                        gst<u32x4>(XB + off, w); }
                asm volatile("" ::: "memory");
            }
    }
};
struct EpiMoe1 {
    static constexpr bool PERM = true;
    bf16* ACT; const float* wts;
    __device__ __forceinline__ void operator()(const f32x4 (&acc)[2][2][4][2], const Unit& u, int wr, int wc, int fr, int fq) const {
        const int r0 = wr * 64 + fr, cl0 = wc * 32 + 8 * fq, es = u.pn >> 1;
        float wv[2][4], rv[2][4];
#pragma unroll
        for (int ai = 0; ai < 2; ++ai)
#pragma unroll
            for (int m = 0; m < 4; ++m) { const int slot = u.x1 + r0 + ai * 128 + m * 16; const f32x4 t = slot < u.x2 ? gld<f32x4>(wts + (unsigned)((u.x0 * LCAP + slot) * 4)) : (f32x4){0.f, 0.f, 0.f, 0.f}; wv[ai][m] = es ? t[1] : t[0]; rv[ai][m] = t[2]; }
#pragma unroll
        for (int ai = 0; ai < 2; ++ai)
#pragma unroll
            for (int m = 0; m < 4; ++m) {
                const int r = r0 + ai * 128 + m * 16; const float w = wv[ai][m], rs = rv[ai][m];
#pragma unroll
                for (int bj = 0; bj < 2; ++bj) {
                    const f32x4 v0 = acc[ai][bj][m][0] * rs, v1 = acc[ai][bj][m][1] * rs;
                    const int col = cl0 + bj * 128;
                    u32x2 o; o.x = cvt_pk_bf16(v0[0] * sigmoid_f(v0[0]) * v0[1] * w, v0[2] * sigmoid_f(v0[2]) * v0[3] * w); o.y = cvt_pk_bf16(v1[0] * sigmoid_f(v1[0]) * v1[1] * w, v1[2] * sigmoid_f(v1[2]) * v1[3] * w);
                    gst<u32x2>(ACT + (unsigned)((u.pm * 256 + r) * 512 + es * 256 + (u.pn & 1) * 128 + (col >> 1)), o);
                }
                asm volatile("" ::: "memory");
            }
    }
};
struct EpiMoe2 {
    static constexpr bool PERM = true;
    bf16* XBo; const int* list; bf16* XB; float* SSP;
    __device__ __forceinline__ void operator()(const f32x4 (&acc)[2][2][4][2], const Unit& u, int wr, int wc, int fr, int fq) const {
        const int r0 = wr * 64 + fr, cl0 = u.pn * 256 + wc * 32 + 8 * fq, ln = fq * 16 + fr;
        int tok[2][4];
#pragma unroll
        for (int ai = 0; ai < 2; ++ai)
#pragma unroll
            for (int m = 0; m < 4; ++m) { const int slot = u.x1 + r0 + ai * 128 + m * 16; tok[ai][m] = slot < u.x2 ? gld<int>(list + (unsigned)(u.x0 * LCAP + slot)) : -1; }
        {
#pragma unroll
            for (int ai = 0; ai < 2; ++ai) {
                u32x4 xb[4][2];
#pragma unroll
                for (int m = 0; m < 4; ++m)
#pragma unroll
                    for (int bj = 0; bj < 2; ++bj) xb[m][bj] = tok[ai][m] >= 0 ? gld<u32x4>(XB + (unsigned)(tok[ai][m] * 1024 + cl0 + bj * 128)) : (u32x4){0u, 0u, 0u, 0u};
#pragma unroll
                for (int m = 0; m < 4; ++m) {
                    const int t = tok[ai][m]; float ssp = 0.f;
#pragma unroll
                    for (int bj = 0; bj < 2; ++bj) { const u32x4 a = xb[m][bj]; f32x4 v0 = acc[ai][bj][m][0], v1 = acc[ai][bj][m][1];
                        v0[0] += bflo(a.x); v0[1] += bfhi(a.x); v0[2] += bflo(a.y); v0[3] += bfhi(a.y); v1[0] += bflo(a.z); v1[1] += bfhi(a.z); v1[2] += bflo(a.w); v1[3] += bfhi(a.w);
                        ssp += ((v0[0] * v0[0] + v0[1] * v0[1]) + (v0[2] * v0[2] + v0[3] * v0[3])) + ((v1[0] * v1[0] + v1[1] * v1[1]) + (v1[2] * v1[2] + v1[3] * v1[3]));
                        u32x4 w; w.x = cvt_pk_bf16(v0[0], v0[1]); w.y = cvt_pk_bf16(v0[2], v0[3]); w.z = cvt_pk_bf16(v1[0], v1[1]); w.w = cvt_pk_bf16(v1[2], v1[3]);
                        if (t >= 0) gst<u32x4>(XBo + (unsigned)(t * 1024 + cl0 + bj * 128), w); }
                    ssp += shfl_xor_f(ssp, 16, ln); ssp += shfl_xor_f(ssp, 32, ln);
                    if (SSP && fq == 0 && t >= 0) __hip_atomic_store((GASP float*)(SSP + (unsigned)(t * 16 + u.pn * 4 + wc)), ssp, __ATOMIC_RELAXED, __HIP_MEMORY_SCOPE_AGENT);
                }
                asm volatile("" ::: "memory");
            }
        }
    }
};
#define XB_TMO      128
#define XB_XCNT(j)  (256  + 64 * (j))
#define XB_XSUB(j)  (1280 + 64 * (j))
#define XB_XGEN(j)  (2304 + 64 * (j))
#define XB_TOP      3328
#define XB_TOPGEN   3392
#define XCD_BAR_WORDS 3456
#define XB_SPIN_CAP (1u << 18)
__device__ __forceinline__ unsigned xb_ld(unsigned* p)              { return __hip_atomic_load((__attribute__((address_space(1))) unsigned*)p, __ATOMIC_RELAXED, __HIP_MEMORY_SCOPE_AGENT); }
__device__ __forceinline__ unsigned xb_add(unsigned* p, unsigned v) { return __hip_atomic_fetch_add((__attribute__((address_space(1))) unsigned*)p, v, __ATOMIC_RELAXED, __HIP_MEMORY_SCOPE_AGENT); }
__device__ __forceinline__ unsigned xb_xcc_id() { return (unsigned)__builtin_amdgcn_s_getreg((3 << 11) | 20) & 0xFu; }
#define XB_SPIN(cond, bar) do { unsigned _sp = 0; while (cond) { __builtin_amdgcn_s_sleep(1); \
    if ((++_sp & 255u) == 0u) { if (xb_ld(&(bar)[XB_TMO])) break; if (_sp > XB_SPIN_CAP) { atomicAdd(&(bar)[XB_TMO], 1u); break; } } } } while (0)
struct XcdBarrier { unsigned* bar; unsigned x; volatile LAS unsigned* st; };
__device__ __forceinline__ XcdBarrier xcd_barrier_post(unsigned* bar, volatile LAS unsigned* st) {
    XcdBarrier b; b.bar = bar; b.x = xb_xcc_id(); b.st = st;
    if (threadIdx.x == 0) (void)xb_add(&bar[XB_XCNT(b.x)], 1u);
    return b;
}
__device__ __forceinline__ void xcd_barrier_complete(unsigned* bar, unsigned x, unsigned& nloc, unsigned& nx) {
    const unsigned G = gridDim.x * gridDim.y * gridDim.z;
    unsigned sum, cnt, mine, sp = 0u;
    for (;;) {
        sum = 0u; cnt = 0u; mine = 0u;
#pragma unroll
        for (unsigned j = 0; j < 16; ++j) { const unsigned c = xb_ld(&bar[XB_XCNT(j)]); sum += c; cnt += (c > 0u) ? 1u : 0u; mine = (j == x) ? c : mine; }
        if (sum == G) break;
        __builtin_amdgcn_s_sleep(1);
        if ((++sp & 255u) == 0u) { if (xb_ld(&bar[XB_TMO])) break; if (sp > XB_SPIN_CAP) { atomicAdd(&bar[XB_TMO], 1u); break; } }
    }
    nloc = mine > 0u ? mine : 1u; nx = cnt > 0u ? cnt : 1u;
}
__device__ __forceinline__ void xcd_barrier(const XcdBarrier& b, bool is_t0) {
    asm volatile("s_waitcnt vmcnt(0)" ::: "memory");
    __syncthreads();
    if (is_t0) {
        unsigned* bar = b.bar;
        __builtin_amdgcn_s_waitcnt(0);
        unsigned nloc = b.st[0], nx = b.st[1];
        if (nloc == 0u) { xcd_barrier_complete(bar, b.x, nloc, nx); b.st[0] = nloc; b.st[1] = nx; }
        const unsigned old = xb_add(&bar[XB_XSUB(b.x)], 1u);
        const unsigned gen = old / nloc;
        if (old + 1u == (gen + 1u) * nloc) {
            __builtin_amdgcn_fence(__ATOMIC_RELEASE, "agent");
            asm volatile("s_waitcnt vmcnt(0)" ::: "memory");
            const unsigned og = xb_add(&bar[XB_TOP], 1u);
            const unsigned tg = og / nx;
            if (og + 1u == (tg + 1u) * nx) xb_add(&bar[XB_TOPGEN], 1u);
            else XB_SPIN(xb_ld(&bar[XB_TOPGEN]) == tg, bar);
            __builtin_amdgcn_fence(__ATOMIC_ACQUIRE, "agent");
            xb_add(&bar[XB_XGEN(b.x)], 1u);
            asm volatile("s_waitcnt vmcnt(0)" ::: "memory");
        } else {
            XB_SPIN(xb_ld(&bar[XB_XGEN(b.x)]) == gen, bar);
            __builtin_amdgcn_fence(__ATOMIC_ACQUIRE, "agent");
            asm volatile("s_waitcnt vmcnt(0)" ::: "memory");
        }
    }
    __syncthreads();
}

constexpr int AT_SLOT = 8192, AT_VOFF = 9 * AT_SLOT;
__device__ __forceinline__ int kswz(int col) { return ((col >> 1) & 1) | (((col >> 3) & 3) << 1); }
template <bool NA>
__device__ __forceinline__ void attn_core(const bf16x8 (&qf)[2], const LAS unsigned char* lds, int rs, int c_lo, bf16* obase, const float* rpbp_h, int rbias0, int c0q, int lane) {
    const int n = lane & 15, q = lane >> 4, cq = c0q + n;
    f32x4 bias0[8], bias1[8];
    if (NA) {
        const float* bp = rpbp_h + (c_lo - c0q + 8 * q - n + 31);
#pragma unroll
        for (int kb = 0; kb < 8; ++kb) { bias0[kb] = gld<f32x4>(bp + (rbias0 + kb) * 64); bias1[kb] = gld<f32x4>(bp + (rbias0 + kb) * 64 + 4); }
    }
    f32x4 s[8][2];
#pragma unroll
    for (int kb = 0; kb < 8; ++kb) {
        const int slot = NA ? (rs + kb) % 9 : (kb >> 1); const int cb0 = NA ? c_lo : (kb & 1) * 32;
        const LAS unsigned char* kp = lds + slot * AT_SLOT;
#pragma unroll
        for (int blk = 0; blk < 2; ++blk) {
            const int col = cb0 + 8 * (n >> 2) + 4 * blk + (n & 3), f = kswz(col);
            const bf16x8 a0 = *(const LAS bf16x8*)(kp + col * 128 + ((q ^ f) << 4)), a1 = *(const LAS bf16x8*)(kp + col * 128 + (((4 + q) ^ f) << 4));
            f32x4 a = (f32x4){0.f, 0.f, 0.f, 0.f};
            a = __builtin_amdgcn_mfma_f32_16x16x32_bf16(a0, qf[0], a, 0, 0, 0);
            a = __builtin_amdgcn_mfma_f32_16x16x32_bf16(a1, qf[1], a, 0, 0, 0);
            s[kb][blk] = a;
        }
    }
    if (NA) {
        const int cs = min(max(cq - 8, 0), 48);
#pragma unroll
        for (int kb = 0; kb < 8; ++kb) {
            const f32x4 b0 = bias0[kb], b1 = bias1[kb];
#pragma unroll
            for (int i = 0; i < 4; ++i) {
                const int kc0 = c_lo + 8 * q + i, kc1 = kc0 + 4;
                s[kb][0][i] = (kc0 >= cs && kc0 < cs + 16) ? s[kb][0][i] + b0[i] : -1e30f;
                s[kb][1][i] = (kc1 >= cs && kc1 < cs + 16) ? s[kb][1][i] + b1[i] : -1e30f;
            }
        }
    }
    float mx = -1e30f;
#pragma unroll
    for (int kb = 0; kb < 8; ++kb)
#pragma unroll
        for (int blk = 0; blk < 2; ++blk)
#pragma unroll
            for (int i = 0; i < 4; ++i) mx = fmaxf(mx, s[kb][blk][i]);
    mx = fmaxf(mx, shfl_xor_f(mx, 16, lane)); mx = fmaxf(mx, shfl_xor_f(mx, 32, lane));
    float sum = 0.f; bf16x8 pf[8];
#pragma unroll
    for (int kb = 0; kb < 8; ++kb) {
        float p[8];
#pragma unroll
        for (int blk = 0; blk < 2; ++blk)
#pragma unroll
            for (int i = 0; i < 4; ++i) { const float e = fast_exp(s[kb][blk][i] - mx); p[blk * 4 + i] = e; sum += e; }
        u32x4 w; w.x = cvt_pk_bf16(p[0], p[1]); w.y = cvt_pk_bf16(p[2], p[3]); w.z = cvt_pk_bf16(p[4], p[5]); w.w = cvt_pk_bf16(p[6], p[7]);
        pf[kb] = __builtin_bit_cast(bf16x8, w);
    }
    sum += shfl_xor_f(sum, 16, lane); sum += shfl_xor_f(sum, 32, lane);
    const float inv = fast_rcp(sum);
#pragma unroll
    for (int db = 0; db < 4; ++db) {
        f32x4 o = (f32x4){0.f, 0.f, 0.f, 0.f};
#pragma unroll
        for (int kb = 0; kb < 8; ++kb) {
            const int slot = NA ? (rs + kb) % 9 : (kb >> 1); const int cb0 = NA ? c_lo : (kb & 1) * 32;
            const bf16x8 vf = *(const LAS bf16x8*)(lds + AT_VOFF + slot * AT_SLOT + ((((cb0 >> 3) + q) * 64 + db * 16 + n) << 4));
            o = __builtin_amdgcn_mfma_f32_16x16x32_bf16(vf, pf[kb], o, 0, 0, 0);
        }
        u32x2 w; w.x = cvt_pk_bf16(o[0] * inv, o[1] * inv); w.y = cvt_pk_bf16(o[2] * inv, o[3] * inv);
        gst<u32x2>(obase + (unsigned)(n * 1024 + 4 * q) + db * 16, w);
    }
}

constexpr int NWAVES = 8;
constexpr int RING_BYTES = 131072, ATT_BYTES = 147456, MISC_OFF = ATT_BYTES, TAB_OFF = MISC_OFF + 256, LDS_BYTES = 163840;
struct Args { const float* in[30]; float* out; unsigned char* ws; };
struct Frame { LAS unsigned char* lds; int tid, lane, wave, vcu, G; };
enum { I_X = 0, I_MEM, I_NMIX, I_NFFN, I_NMEM, I_WIN, I_BGATE, I_RPB, I_LRE, I_LIM, I_LDT, I_BRE, I_BIM, I_CRE, I_CIM, I_S5D, I_WGLU, I_WMKV, I_WBNA, I_WBS5, I_WBXA, I_WOUT,
       I_WCO, I_BCO, I_WFI, I_BFI, I_WG, I_WU, I_WD, I_FNORM };

__device__ __forceinline__ void transpose_item(const float* W, int ldn, int k0, int n0, bf16* WT, int ldk, int dk0, int row_off, int rmul, int radd, int qs, const float* kscale, LAS float* scr, int lane) {
    { float t[32]; const float* wp = W + (size_t)(k0 + (lane >> 5)) * ldn + n0 + (lane & 31);
#pragma unroll
      for (int i = 0; i < 32; ++i) t[i] = gld<float>(wp + (size_t)(2 * i) * ldn);
#pragma unroll
      for (int i = 0; i < 32; ++i) scr[(2 * i + (lane >> 5)) * 33 + (lane & 31)] = t[i]; }
    LDS_WAIT(); asm volatile("" ::: "memory");
    const int c = lane & 7;
    f32x4 ka = (f32x4){1.f, 1.f, 1.f, 1.f}, kb = ka;
    if (kscale) { ka = gld<f32x4>(kscale + k0 + 8 * c); kb = gld<f32x4>(kscale + k0 + 8 * c + 4); }
#pragma unroll
    for (int j = 0; j < 4; ++j) { const int n = (lane >> 3) + 8 * j, nn = n0 + n; const LAS float* s = scr + (8 * c) * 33 + n;
        const float sc = (qs && (nn < 512 || (nn >= 1792 && nn < 2048))) ? 0.125f : 1.0f;
        u32x4 o; o.x = cvt_pk_bf16(s[0 * 33] * sc * ka[0], s[1 * 33] * sc * ka[1]); o.y = cvt_pk_bf16(s[2 * 33] * sc * ka[2], s[3 * 33] * sc * ka[3]); o.z = cvt_pk_bf16(s[4 * 33] * sc * kb[0], s[5 * 33] * sc * kb[1]); o.w = cvt_pk_bf16(s[6 * 33] * sc * kb[2], s[7 * 33] * sc * kb[3]);
        gst<u32x4>(WT + (size_t)(row_off + nn * rmul + radd) * ldk + dk0 + k0 + 8 * c, o); }
    LDS_WAIT(); asm volatile("" ::: "memory");
}
__device__ __forceinline__ void transpose_job_item(const float* W, int ldn, int N, int it, bf16* WT, int ldk, int dk0, int row_off, int rmul, int radd, int qs, const float* kscale, LAS float* scr, int lane) {
    const int nblk = N / 32, kb = it / nblk, nb = it % nblk;
    transpose_item(W, ldn, 64 * kb, 32 * nb, WT, ldk, dk0, row_off, rmul, radd, qs, kscale, scr, lane);
}

__device__ __forceinline__ void cexp_d(double zr, double zi, double& er, double& ei) {
    const double wr_ = zr * (1.0 / 1024.0), wi_ = zi * (1.0 / 1024.0);
    double tr = 1.0, ti = 0.0;
#pragma unroll
    for (int n = 12; n >= 1; --n) { const double ar = wr_ * (1.0 / n), ai = wi_ * (1.0 / n); const double nr = 1.0 + (ar * tr - ai * ti), ni = ar * ti + ai * tr; tr = nr; ti = ni; }
#pragma unroll
    for (int k = 0; k < 10; ++k) { const double nr = tr * tr - ti * ti, ni = 2.0 * tr * ti; tr = nr; ti = ni; }
    er = tr; ei = ti;
}

template <bool ROUTER>
__device__ __forceinline__ void norm_rows4(const float* X, const float* gain, bf16* H, int row0, int lane,
                                           const float* wrt, const float* bco, const float* bfi, unsigned* cnt, int* list, float* wts, float* Xout = nullptr) {
    f32x4 x[4][4]; float rstd[4];
#pragma unroll
    for (int r = 0; r < 4; ++r) { float ss = 0.f;
#pragma unroll
        for (int j = 0; j < 4; ++j) { x[r][j] = gld<f32x4>(X + (size_t)(row0 + r) * 1024 + 256 * j + 4 * lane);
            if (Xout) { const u32x2 d = gld<u32x2>(H + (size_t)(row0 + r) * 1024 + 256 * j + 4 * lane); x[r][j][0] += bflo(d.x); x[r][j][1] += bfhi(d.x); x[r][j][2] += bflo(d.y); x[r][j][3] += bfhi(d.y);
                gst<f32x4>(Xout + (size_t)(row0 + r) * 1024 + 256 * j + 4 * lane, x[r][j]); }
            ss += (x[r][j][0] * x[r][j][0] + x[r][j][1] * x[r][j][1]) + (x[r][j][2] * x[r][j][2] + x[r][j][3] * x[r][j][3]); }
        ss = wave_sum(ss, lane); rstd[r] = 1.0f / sqrtf(ss * (1.0f / 1024.0f) + RMS_EPS); }
#pragma unroll
    for (int j = 0; j < 4; ++j) { const f32x4 g4 = gld<f32x4>(gain + 256 * j + 4 * lane);
#pragma unroll
        for (int r = 0; r < 4; ++r) { const f32x4 v = ROUTER ? x[r][j] * rstd[r] * g4 : x[r][j]; u32x2 w; w.x = cvt_pk_bf16(v[0], v[1]); w.y = cvt_pk_bf16(v[2], v[3]);
            gst<u32x2>(H + (size_t)(row0 + r) * 1024 + 256 * j + 4 * lane, w); } }
    if (!ROUTER && wts && lane < 4) { float rr = rstd[0]; rr = lane == 1 ? rstd[1] : rr; rr = lane == 2 ? rstd[2] : rr; rr = lane == 3 ? rstd[3] : rr; gst<float>(wts + row0 + lane, rr); }
    if constexpr (ROUTER) {
        float keep[4] = {0.f, 0.f, 0.f, 0.f};
#pragma unroll 2
        for (int c = 0; c < 20; ++c) {
            float a0 = 0.f, a1 = 0.f, a2 = 0.f, a3 = 0.f;
#pragma unroll
            for (int j = 0; j < 4; ++j) { const f32x4 w4 = gld<f32x4>(wrt + c * 1024 + 256 * j + 4 * lane);
                a0 += (x[0][j][0] * w4[0] + x[0][j][1] * w4[1]) + (x[0][j][2] * w4[2] + x[0][j][3] * w4[3]);
                a1 += (x[1][j][0] * w4[0] + x[1][j][1] * w4[1]) + (x[1][j][2] * w4[2] + x[1][j][3] * w4[3]);
                a2 += (x[2][j][0] * w4[0] + x[2][j][1] * w4[1]) + (x[2][j][2] * w4[2] + x[2][j][3] * w4[3]);
                a3 += (x[3][j][0] * w4[0] + x[3][j][1] * w4[1]) + (x[3][j][2] * w4[2] + x[3][j][3] * w4[3]); }
            a0 = wave_sum(a0, lane); a1 = wave_sum(a1, lane); a2 = wave_sum(a2, lane); a3 = wave_sum(a3, lane);
            if (lane == c) { keep[0] = a0 * rstd[0]; keep[1] = a1 * rstd[1]; keep[2] = a2 * rstd[2]; keep[3] = a3 * rstd[3]; }
        }
#pragma unroll
        for (int r = 0; r < 4; ++r) {
            float co[4];
#pragma unroll
            for (int i = 0; i < 4; ++i) co[i] = shfl_idx_f(keep[r], i) + bco[i];
            int grp = 0; float cm = co[0];
#pragma unroll
            for (int i = 1; i < 4; ++i) if (co[i] > cm) { cm = co[i]; grp = i; }
            float den = 0.f;
#pragma unroll
            for (int i = 0; i < 4; ++i) den += __expf(co[i] - cm);
            const float pgrp = 1.0f / den;
            float fv[4];
#pragma unroll
            for (int i = 0; i < 4; ++i) fv[i] = shfl_idx_f(keep[r], 4 + grp * 4 + i) + bfi[grp * 4 + i];
            int i1 = 0; float v1 = fv[0];
#pragma unroll
            for (int i = 1; i < 4; ++i) if (fv[i] > v1) { v1 = fv[i]; i1 = i; }
            int i2 = -1; float v2 = -3.0e38f;
#pragma unroll
            for (int i = 0; i < 4; ++i) if (i != i1 && fv[i] > v2) { v2 = fv[i]; i2 = i; }
            const float w1 = pgrp / (1.0f + __expf(v2 - v1)), w2 = pgrp - w1;
            const int a = i1 < i2 ? i1 : i2, b = i1 < i2 ? i2 : i1;
            const int pidx = a == 0 ? b - 1 : (a == 1 ? b + 1 : 5);
            const int bucket = grp * 6 + pidx;
            const float wa = (i1 == a) ? w1 : w2, wb = (i1 == a) ? w2 : w1;
            if (lane == 0) {
                const unsigned slot = __hip_atomic_fetch_add(cnt + bucket * 64, 1u, __ATOMIC_RELAXED, __HIP_MEMORY_SCOPE_AGENT);
                list[(size_t)bucket * LCAP + slot] = row0 + r;
                gst<f32x2>(wts + ((size_t)bucket * LCAP + slot) * 2, (f32x2){wa, wb});
            }
        }
    }
}

constexpr int RT_STRIDE = 2064;
constexpr int RT_BYTES = 40 * RT_STRIDE;
constexpr int RT_SCR = 98304;
__device__ __forceinline__ void router_rows16(const float* X, const bf16* XBi, const bf16* DH, bf16* XB, int R0, int lane, LAS unsigned char* lds, int wave,
                                              const float* bco, const float* bfi, unsigned* cnt, int* list, float* wts) {
    const int n = lane & 15, q = lane >> 4;
    f32x4 accF = (f32x4){0.f, 0.f, 0.f, 0.f}, accC = (f32x4){0.f, 0.f, 0.f, 0.f};
    float ss = 0.f;
    const unsigned xo = (unsigned)((R0 + n) * 1024 + 8 * q);
    const LAS unsigned char* tF = lds + n * RT_STRIDE + 16 * q; const LAS unsigned char* tC = lds + (16 + (n & 3)) * RT_STRIDE + 16 * q;
#pragma unroll 4
    for (int ks = 0; ks < 32; ++ks) {
        f32x4 x0, x1;
        if (XBi) { const u32x4 xb = gld<u32x4>(XBi + xo + ks * 32); x0 = (f32x4){bflo(xb.x), bfhi(xb.x), bflo(xb.y), bfhi(xb.y)}; x1 = (f32x4){bflo(xb.z), bfhi(xb.z), bflo(xb.w), bfhi(xb.w)}; }
        else { x0 = gld<f32x4>(X + xo + ks * 32); x1 = gld<f32x4>(X + xo + ks * 32 + 4); }
        if (DH) { const u32x4 d = gld<u32x4>(DH + xo + ks * 32); x0[0] += bflo(d.x); x0[1] += bfhi(d.x); x0[2] += bflo(d.y); x0[3] += bfhi(d.y); x1[0] += bflo(d.z); x1[1] += bfhi(d.z); x1[2] += bflo(d.w); x1[3] += bfhi(d.w); }
        ss += (x0[0] * x0[0] + x0[1] * x0[1]) + (x0[2] * x0[2] + x0[3] * x0[3]) + (x1[0] * x1[0] + x1[1] * x1[1]) + (x1[2] * x1[2] + x1[3] * x1[3]);
        u32x4 hw; hw.x = cvt_pk_bf16(x0[0], x0[1]); hw.y = cvt_pk_bf16(x0[2], x0[3]); hw.z = cvt_pk_bf16(x1[0], x1[1]); hw.w = cvt_pk_bf16(x1[2], x1[3]);
        u32x4 lw; lw.x = cvt_pk_bf16(x0[0] - bflo(hw.x), x0[1] - bfhi(hw.x)); lw.y = cvt_pk_bf16(x0[2] - bflo(hw.y), x0[3] - bfhi(hw.y));
        lw.z = cvt_pk_bf16(x1[0] - bflo(hw.z), x1[1] - bfhi(hw.z)); lw.w = cvt_pk_bf16(x1[2] - bflo(hw.w), x1[3] - bfhi(hw.w));
        if (XB) gst<u32x4>(XB + xo + ks * 32, hw);
        const bf16x8 ah = __builtin_bit_cast(bf16x8, hw), al = __builtin_bit_cast(bf16x8, lw);
        const bf16x8 fh = *(const LAS bf16x8*)(tF + ks * 64), fl = *(const LAS bf16x8*)(tF + 20 * RT_STRIDE + ks * 64);
        const bf16x8 ch = *(const LAS bf16x8*)(tC + ks * 64), cl = *(const LAS bf16x8*)(tC + 20 * RT_STRIDE + ks * 64);
        accF = __builtin_amdgcn_mfma_f32_16x16x32_bf16(ah, fh, accF, 0, 0, 0); accF = __builtin_amdgcn_mfma_f32_16x16x32_bf16(ah, fl, accF, 0, 0, 0); accF = __builtin_amdgcn_mfma_f32_16x16x32_bf16(al, fh, accF, 0, 0, 0);
        accC = __builtin_amdgcn_mfma_f32_16x16x32_bf16(ah, ch, accC, 0, 0, 0); accC = __builtin_amdgcn_mfma_f32_16x16x32_bf16(ah, cl, accC, 0, 0, 0); accC = __builtin_amdgcn_mfma_f32_16x16x32_bf16(al, ch, accC, 0, 0, 0);
    }
    ss += shfl_xor_f(ss, 16, lane); ss += shfl_xor_f(ss, 32, lane);
    const float rstd = 1.0f / sqrtf(ss * (1.0f / 1024.0f) + RMS_EPS);
    LAS float* sc = (LAS float*)(lds + RT_SCR + wave * 1536);
#pragma unroll
    for (int r = 0; r < 4; ++r) { const float rs = shfl_idx_f(rstd, 4 * q + r); sc[(4 * q + r) * 24 + n] = accF[r] * rs; if (n < 4) sc[(4 * q + r) * 24 + 16 + n] = accC[r] * rs; }
    LDS_WAIT(); asm volatile("" ::: "memory");
    if (lane < 16) {
        const LAS float* my = sc + lane * 24;
        float co[4];
#pragma unroll
        for (int i = 0; i < 4; ++i) co[i] = my[16 + i] + gld<float>(bco + i);
        int grp = 0; float cm = co[0];
#pragma unroll
        for (int i = 1; i < 4; ++i) if (co[i] > cm) { cm = co[i]; grp = i; }
        float den = 0.f;
#pragma unroll
        for (int i = 0; i < 4; ++i) den += __expf(co[i] - cm);
        const float pgrp = 1.0f / den;
        float fv[4];
#pragma unroll
        for (int i = 0; i < 4; ++i) fv[i] = my[grp * 4 + i] + gld<float>(bfi + grp * 4 + i);
        int i1 = 0; float v1 = fv[0];
#pragma unroll
        for (int i = 1; i < 4; ++i) if (fv[i] > v1) { v1 = fv[i]; i1 = i; }
        int i2 = -1; float v2 = -3.0e38f;
#pragma unroll
        for (int i = 0; i < 4; ++i) if (i != i1 && fv[i] > v2) { v2 = fv[i]; i2 = i; }
        const float w1 = pgrp / (1.0f + __expf(v2 - v1)), w2 = pgrp - w1;
        const int a = i1 < i2 ? i1 : i2, b = i1 < i2 ? i2 : i1;
        const int pidx = a == 0 ? b - 1 : (a == 1 ? b + 1 : 5);
        const int bucket = grp * 6 + pidx;
        const float wa = (i1 == a) ? w1 : w2, wb = (i1 == a) ? w2 : w1;
        const unsigned slot = __hip_atomic_fetch_add((GASP unsigned*)(cnt + bucket * 64), 1u, __ATOMIC_RELAXED, __HIP_MEMORY_SCOPE_AGENT);
        gst<int>(list + ((unsigned)(bucket * LCAP) + slot), R0 + lane);
        gst<f32x4>(wts + ((unsigned)(bucket * LCAP) + slot) * 4, (f32x4){wa, wb, rstd, 0.f});
    }
}

__device__ __forceinline__ void norm_rows4b(bf16* XB, const float* gain, bf16* H, int row0, int lane, float* RSo) {
    f32x4 x[4][4]; float rstd[4];
#pragma unroll
    for (int r = 0; r < 4; ++r) { float ss = 0.f;
#pragma unroll
        for (int j = 0; j < 4; ++j) { const unsigned off = (unsigned)((row0 + r) * 1024 + 256 * j + 4 * lane); const u32x2 a = gld<u32x2>(XB + off), d = gld<u32x2>(H + off);
            x[r][j] = (f32x4){bflo(a.x) + bflo(d.x), bfhi(a.x) + bfhi(d.x), bflo(a.y) + bflo(d.y), bfhi(a.y) + bfhi(d.y)};
            u32x2 w; w.x = cvt_pk_bf16(x[r][j][0], x[r][j][1]); w.y = cvt_pk_bf16(x[r][j][2], x[r][j][3]); gst<u32x2>(XB + off, w);
            ss += (x[r][j][0] * x[r][j][0] + x[r][j][1] * x[r][j][1]) + (x[r][j][2] * x[r][j][2] + x[r][j][3] * x[r][j][3]); }
        ss = wave_sum(ss, lane); rstd[r] = 1.0f / sqrtf(ss * (1.0f / 1024.0f) + RMS_EPS); }
    if (lane < 4) { float rr = rstd[0]; rr = lane == 1 ? rstd[1] : rr; rr = lane == 2 ? rstd[2] : rr; rr = lane == 3 ? rstd[3] : rr; gst<float>(RSo + row0 + lane, rr); }
}

__device__ __forceinline__ void final_norm_row(const bf16* XB, const bf16* Dl, float* out, const float* gain, int row, int lane) {
    f32x4 x[4]; float ss = 0.f;
#pragma unroll
    for (int j = 0; j < 4; ++j) { const unsigned off = (unsigned)(row * 1024 + 256 * j + 4 * lane); const u32x2 a = gld<u32x2>(XB + off);
        x[j] = (f32x4){bflo(a.x), bfhi(a.x), bflo(a.y), bfhi(a.y)};
        ss += (x[j][0] * x[j][0] + x[j][1] * x[j][1]) + (x[j][2] * x[j][2] + x[j][3] * x[j][3]); }
    ss = wave_sum(ss, lane); const float rstd = 1.0f / sqrtf(ss * (1.0f / 1024.0f) + RMS_EPS);
#pragma unroll
    for (int j = 0; j < 4; ++j) { const f32x4 g4 = gld<f32x4>(gain + 256 * j + 4 * lane); gst<f32x4>(out + (size_t)row * 1024 + 256 * j + 4 * lane, x[j] * rstd * g4); }
}

__device__ __forceinline__ void s5_scan_item(int item, const float* ST, bf16* At, const f32x2* apow_l, LAS float* sc, int tid) {
    const int d = item & 1, bg = item >> 1, g = bg & 15, seg = tid >> 6, p = tid & 63;
    const f32x2 A32 = gld<f32x2>(apow_l + ((d * 16 + g) * 33 + 32) * 64 + p);
    const int chunk0 = d ? 255 - seg * 32 : seg * 32; const long cstep = d ? -1 : 1;
    const float* rp0 = ST + (size_t)(bg * 256 + chunk0) * 256 + d * 128 + p;
    float tr = 0.f, ti = 0.f;
#pragma unroll 8
    for (int j = 0; j < 32; ++j) { const float* rp = rp0 + cstep * j * 256; const float sr = gld<float>(rp), si = gld<float>(rp + 64); const float nr = A32.x * tr - A32.y * ti + sr, ni = A32.x * ti + A32.y * tr + si; tr = nr; ti = ni; }
    sc[(seg * 64 + p) * 2] = tr; sc[(seg * 64 + p) * 2 + 1] = ti;
    __syncthreads();
    float pr = A32.x, pi = A32.y;
#pragma unroll
    for (int k = 0; k < 5; ++k) { const float nr = pr * pr - pi * pi, ni = 2.f * pr * pi; pr = nr; pi = ni; }
    float er = 0.f, ei = 0.f;
    for (int s2 = 0; s2 < seg; ++s2) { const float qr = sc[(s2 * 64 + p) * 2], qi = sc[(s2 * 64 + p) * 2 + 1]; const float nr = pr * er - pi * ei + qr, ni = pr * ei + pi * er + qi; er = nr; ei = ni; }
    bf16* op0 = At + (size_t)(bg * 256 + chunk0) * ATK + 512 + d * 128 + p;
#pragma unroll 8
    for (int j = 0; j < 32; ++j) { const float* rp = rp0 + cstep * j * 256; const float sr = gld<float>(rp), si = gld<float>(rp + 64); bf16* op = op0 + cstep * j * ATK;
        gst<bf16>(op, (bf16)(cvt_pk_bf16(er, er) & 0xffffu)); gst<bf16>(op + 64, (bf16)(cvt_pk_bf16(ei, ei) & 0xffffu));
        const float nr = A32.x * er - A32.y * ei + sr, ni = A32.x * ei + A32.y * er + si; er = nr; ei = ni; }
    __syncthreads();
}

#define NA_ITEM(item) do { \
    const bf16* QK = WP(bf16, WS_QK); const bf16* VT8 = WP(bf16, WS_VT8); bf16* Hn = WP(bf16, WS_H); const float* RPBP = WP(float, WS_RPBP); \
    const int n = lane & 15, q = lane >> 4, cb = wave & 3, qsel = wave >> 2, c_lo = cb == 0 ? 0 : (cb == 1 ? 8 : (cb == 2 ? 24 : 32)); \
    const int kcol = tid >> 3, kdst = kcol * 128 + (((tid & 7) ^ kswz(kcol)) << 4); \
    const int b = (item) >> 7, h = ((item) >> 4) & 7, r0 = ((item) & 15) * 8; \
    const bf16* Kg = QK + (size_t)b * SEQ * 1024 + 512 + h * 64 + (unsigned)(kcol * 1024 + (tid & 7) * 8); \
    const bf16* Vg = VT8 + (size_t)(b * 8 + h) * 1024 * 512 + (unsigned)(tid * 8); \
    const float* rp = RPBP + (size_t)(l * 8 + h) * 15 * 64; \
    int hi = min(max(r0 + 1 - 4, 0), 120) + 7; \
    { const int lo = min(max(r0 - 4, 0), 120); \
      u32x4 kv[9], vv[9]; \
      _Pragma("unroll") for (int j = 0; j < 9; ++j) { const int kr = min(lo + j, 127); kv[j] = gld<u32x4>(Kg + (size_t)kr * 65536); vv[j] = gld<u32x4>(Vg + (size_t)kr * 4096); } \
      _Pragma("unroll") for (int j = 0; j < 9; ++j) { const int kr = lo + j; if (kr <= hi) { const int slot = kr % 9; *(LAS u32x4*)(F.lds + slot * AT_SLOT + kdst) = kv[j]; *(LAS u32x4*)(F.lds + AT_VOFF + slot * AT_SLOT + tid * 16) = vv[j]; } } \
    } \
    bf16x8 qf[2]; \
    { const bf16* qb = QK + (size_t)(b * SEQ + (r0 + qsel) * 64 + cb * 16) * 1024 + h * 64 + (unsigned)(n * 1024 + 8 * q); qf[0] = gld<bf16x8>(qb); qf[1] = gld<bf16x8>(qb + 32); } \
    __syncthreads(); \
    _Pragma("unroll 1") for (int st = 0; st < 4; ++st) { \
        const int r = r0 + 2 * st + qsel, rs = min(max(r - 4, 0), 120); \
        const bool more = st < 3; \
        const int hi_next = more ? min(max(r0 + 2 * st + 3 - 4, 0), 120) + 7 : hi; \
        const int kr1 = hi + 1, kr2 = hi + 2; \
        u32x4 k1 = (u32x4){0u, 0u, 0u, 0u}, v1 = k1, k2 = k1, v2 = k1; bf16x8 qn[2]; qn[0] = qf[0]; qn[1] = qf[1]; \
        if (more) { \
            k1 = gld<u32x4>(Kg + (size_t)min(kr1, 127) * 65536); v1 = gld<u32x4>(Vg + (size_t)min(kr1, 127) * 4096); \
            k2 = gld<u32x4>(Kg + (size_t)min(kr2, 127) * 65536); v2 = gld<u32x4>(Vg + (size_t)min(kr2, 127) * 4096); \
            const bf16* qb = QK + (size_t)(b * SEQ + (r + 2) * 64 + cb * 16) * 1024 + h * 64 + (unsigned)(n * 1024 + 8 * q); qn[0] = gld<bf16x8>(qb); qn[1] = gld<bf16x8>(qb + 32); \
        } \
        attn_core<true>(qf, F.lds, rs, c_lo, Hn + (size_t)(b * SEQ + r * 64 + cb * 16) * 1024 + h * 64, rp, rs - r + 7, cb * 16, lane); \
        __syncthreads(); \
        if (more) { \
            if (kr1 <= hi_next) { const int slot = kr1 % 9; *(LAS u32x4*)(F.lds + slot * AT_SLOT + kdst) = k1; *(LAS u32x4*)(F.lds + AT_VOFF + slot * AT_SLOT + tid * 16) = v1; } \
            if (kr2 <= hi_next) { const int slot = kr2 % 9; *(LAS u32x4*)(F.lds + slot * AT_SLOT + kdst) = k2; *(LAS u32x4*)(F.lds + AT_VOFF + slot * AT_SLOT + tid * 16) = v2; } \
            hi = hi_next; qf[0] = qn[0]; qf[1] = qn[1]; \
        } \
        __syncthreads(); \
    } } while (0)
#define WG_MEM_SYNC() do { asm volatile("s_waitcnt vmcnt(0)" ::: "memory"); __syncthreads(); __builtin_amdgcn_fence(__ATOMIC_ACQUIRE, "agent"); asm volatile("s_waitcnt vmcnt(0)" ::: "memory"); } while (0)

#define XA_ITEMS(first, last, stride) do { \
    const bf16* QX = WP(bf16, WS_QX); const bf16* KM = WP(bf16, WS_KM); const bf16* VM8 = WP(bf16, WS_VM8); bf16* Hx = WP(bf16, WS_H); \
    const int n_ = lane & 15, q_ = lane >> 4, kcol = tid >> 3, kdst = kcol * 128 + (((tid & 7) ^ kswz(kcol)) << 4); \
    for (int item = (first); item < (last); item += (stride)) { \
        const int b = item >> 6, h = (item >> 4) & 3, qc = item & 15; \
        const bf16* Kg = KM + ((size_t)(l * 4 + b) * 256) * 256 + h * 64 + (unsigned)(kcol * 256 + (tid & 7) * 8); \
        const bf16* Vg = VM8 + (size_t)((l * 4 + b) * 4 + h) * 32 * 512 + (unsigned)(tid * 8); \
        _Pragma("unroll") for (int j = 0; j < 4; ++j) { const u32x4 kv = gld<u32x4>(Kg + j * 64 * 256), vv = gld<u32x4>(Vg + j * 4096); \
            *(LAS u32x4*)(F.lds + j * AT_SLOT + kdst) = kv; *(LAS u32x4*)(F.lds + AT_VOFF + j * AT_SLOT + tid * 16) = vv; } \
        __syncthreads(); \
        _Pragma("unroll 1") for (int j = 0; j < 4; ++j) { \
            const int t0 = b * SEQ + qc * 512 + wave * 64 + j * 16; \
            bf16x8 qf[2]; { const bf16* qb = QX + (size_t)t0 * 256 + h * 64 + (unsigned)(n_ * 256 + 8 * q_); qf[0] = gld<bf16x8>(qb); qf[1] = gld<bf16x8>(qb + 32); } \
            attn_core<false>(qf, F.lds, 0, 0, Hx + (size_t)t0 * 1024 + 768 + h * 64, nullptr, 0, 0, lane); } \
        __syncthreads(); \
    } } while (0)

#ifndef PHMASK
#define PHMASK 0xffffffffu
#endif
#define PH(k) ((PHMASK >> (k)) & 1u)
#ifndef FUSE1
#define FUSE1 0
#endif
#ifndef REPMASK
#define REPMASK 0u
#endif
#define NREP(k) (1 + (int)((REPMASK >> (k)) & 1u))
constexpr int PTR_OFF = MISC_OFF + 1024;
__device__ __forceinline__ const float* inp(LAS unsigned char* lds, int i, int z) {
    const LAS unsigned* q = (const LAS unsigned*)(lds + PTR_OFF + 8 * i + z);
    const unsigned lo = __builtin_amdgcn_readfirstlane(q[0]), hi = __builtin_amdgcn_readfirstlane(q[1]);
    return (const float*)(((unsigned long long)hi << 32) | lo);
}
#define WSL() unsigned char* wsl = args.ws; int wave = F.wave, bid = blockIdx.x, G = gridDim.x, zz = 0; unsigned mm_ = ~0u; asm volatile("" : "+s"(mm_)); int lane = (int)__builtin_amdgcn_mbcnt_hi(mm_, __builtin_amdgcn_mbcnt_lo(mm_, 0u)); \
    asm volatile("" : "+s"(wsl), "+s"(wave), "+v"(lane), "+s"(bid), "+s"(G), "+s"(zz)); \
    const int tid = wave * 64 + lane, vcu = (G % 8 == 0) ? (bid % 8) * (G / 8) + bid / 8 : bid, gw = vcu * NWAVES + wave, NGW = G * NWAVES, NGT = G * NWAVES * 64; \
    (void)tid; (void)gw; (void)NGW; (void)NGT; (void)wsl
#define WP(T, off) ((T*)(wsl + (off)))
#define IN(i) inp(F.lds, (i), zz)

__global__ void __launch_bounds__(NWAVES * 64, 2) fwd_kernel(Args args) {
    extern __shared__ __attribute__((aligned(16))) unsigned char lds_raw[];
    Frame F;
    F.lds = (LAS unsigned char*)lds_raw;
    F.tid = threadIdx.x; F.lane = F.tid & 63; F.wave = __builtin_amdgcn_readfirstlane(F.tid >> 6);
    F.G = gridDim.x; { const int bx = blockIdx.x; F.vcu = (F.G % 8 == 0) ? (bx % 8) * (F.G / 8) + bx / 8 : bx; }
    for (int u = F.tid; u < (LDS_BYTES - MISC_OFF) / 4; u += NWAVES * 64) ((LAS unsigned*)(F.lds + MISC_OFF))[u] = 0u;
    __syncthreads();
    if (F.tid < 30) { const unsigned long long p = (unsigned long long)args.in[F.tid]; LAS unsigned* q = (LAS unsigned*)(F.lds + PTR_OFF + 8 * F.tid); q[0] = (unsigned)p; q[1] = (unsigned)(p >> 32); }
    __syncthreads();
    (void)xcd_barrier_post((unsigned*)(args.ws + WS_CTL) + CW_BAR, (volatile LAS unsigned*)(F.lds + MISC_OFF));
#define GRID_BAR() do { unsigned char* w_ = args.ws; asm volatile("" : "+s"(w_)); XcdBarrier b_; b_.bar = (unsigned*)(w_ + WS_CTL) + CW_BAR; b_.x = xb_xcc_id(); b_.st = (volatile LAS unsigned*)(F.lds + MISC_OFF); unsigned m_ = ~0u; int wv_ = F.wave; asm volatile("" : "+s"(m_), "+s"(wv_)); \
    xcd_barrier(b_, (wv_ == 0) && (__builtin_amdgcn_mbcnt_hi(m_, __builtin_amdgcn_mbcnt_lo(m_, 0u)) == 0u)); } while (0)
#define GT() (vcu * (NWAVES * 64) + tid)
#define SCR() ((LAS float*)(F.lds + wave * 16384))

    if (PH(0)) {
        WSL();
        f32x2* APOW = WP(f32x2, WS_APOW); f32x2* BBAR = WP(f32x2, WS_BBAR); bf16* WRT = WP(bf16, WS_WRT); bf16* MEMN = WP(bf16, WS_MEMN); bf16* WMKV = WP(bf16, WS_WMKV);
        for (int it = gw; it < 1024; it += NGW) { const int l = it >> 8, r = it & 255;
            transpose_job_item(IN(I_WMKV) + (size_t)l * 1024 * 512, 512, 512, r, WMKV + (size_t)l * 512 * 1024, 1024, 0, 0, 1, 0, 0, nullptr, SCR(), lane); }
        for (int it = gw; it < 4096; it += NGW) { const int l = it >> 10, row = it & 1023;
            const float* xr = IN(I_MEM) + (size_t)row * 1024; const float* gn = IN(I_NMEM) + l * 1024;
            f32x4 x[4]; float ss = 0.f;
#pragma unroll
            for (int j = 0; j < 4; ++j) { x[j] = gld<f32x4>(xr + 256 * j + 4 * lane); ss += (x[j][0] * x[j][0] + x[j][1] * x[j][1]) + (x[j][2] * x[j][2] + x[j][3] * x[j][3]); }
            ss = wave_sum(ss, lane); const float rstd = 1.0f / sqrtf(ss * (1.0f / 1024.0f) + RMS_EPS);
#pragma unroll
            for (int j = 0; j < 4; ++j) { const f32x4 v = x[j] * rstd * gld<f32x4>(gn + 256 * j + 4 * lane); u32x2 w; w.x = cvt_pk_bf16(v[0], v[1]); w.y = cvt_pk_bf16(v[2], v[3]);
                gst<u32x2>(MEMN + (size_t)it * 1024 + 256 * j + 4 * lane, w); } }
        for (int it = GT(); it < 8192; it += NGT) {
            const int p = it & 63, ldg = it >> 6;
            const double lr = fmin((double)IN(I_LRE)[it], -1e-4), li = (double)IN(I_LIM)[it];
            double dt, dum; cexp_d((double)IN(I_LDT)[ldg], 0.0, dt, dum);
            double ar, ai; cexp_d(lr * dt, li * dt, ar, ai);
            const double den = lr * lr + li * li, fr = ((ar - 1.0) * lr + ai * li) / den, fi = (ai * lr - (ar - 1.0) * li) / den;
            const float* bre = IN(I_BRE) + (size_t)it * 16; const float* bim = IN(I_BIM) + (size_t)it * 16;
#pragma unroll 4
            for (int c = 0; c < 16; ++c) { const double br = (double)bre[c], bi = (double)bim[c];
                BBAR[(size_t)it * 16 + c] = (f32x2){(float)(fr * br - fi * bi), (float)(fr * bi + fi * br)}; }
            double pr = 1.0, pi = 0.0;
            for (int n = 0; n <= 32; ++n) { APOW[((size_t)ldg * 33 + n) * 64 + p] = (f32x2){(float)pr, (float)pi}; const double nr = pr * ar - pi * ai, ni = pr * ai + pi * ar; pr = nr; pi = ni; }
        }
        { float* RPBP = WP(float, WS_RPBP); const float* rpb = IN(I_RPB);
          for (int it = GT(); it < 4 * 8 * 15 * 64; it += NGT) { const int j = it & 63; RPBP[it] = (j >= 16 && j < 47) ? rpb[(it >> 6) * 31 + (j - 16)] : 0.f; } }
        for (int it = GT(); it < 4 * 20480; it += NGT) { const int l = it / 20480, r = it % 20480, c = r >> 10, k = r & 1023;
            const float gk = IN(I_NFFN)[l * 1024 + k];
            const float v = gk * (c < 16 ? IN(I_WFI)[(size_t)(l * 1024 + k) * 16 + c] : IN(I_WCO)[(size_t)(l * 1024 + k) * 4 + (c - 16)]);
            const unsigned hw = cvt_pk_bf16(v, v) & 0xffffu; const float lo = v - bflo(hw);
            WRT[(size_t)(l * 2 + 0) * 20480 + r] = (bf16)hw; WRT[(size_t)(l * 2 + 1) * 20480 + r] = (bf16)(cvt_pk_bf16(lo, lo) & 0xffffu); }
    }
    GRID_BAR();

    if (PH(1)) {
        WSL();
        { pg8::Gemm g{WP(bf16, WS_MEMN), WP(bf16, WS_WMKV), 1024, 1024, 1024}; pg8::MemOrder S{G, bid}; EpiMemKV E{WP(bf16, WS_KM), WP(bf16, WS_VM8)};
          pg8::gemm_phase<EpiMemKV, pg8::MemOrder>(F.lds, g, S, E, tid); }
        const f32x2* APOW = WP(f32x2, WS_APOW); const f32x2* BBAR = WP(f32x2, WS_BBAR); float* KT = WP(float, WS_KT);
        const float* CRE = IN(I_CRE); const float* CIM = IN(I_CIM); const float* S5D = IN(I_S5D);
        for (int it = GT(); it < 4 * 16 * 63 * 64; it += NGT) {
            const int c2 = (it & 3) * 4, c = (it >> 2) & 15, rest = it >> 6, tp = rest % 63, lg = rest / 63, l = lg >> 4, g = lg & 15;
            f32x4 sum = (f32x4){0.f, 0.f, 0.f, 0.f};
#pragma unroll 1
            for (int d = 0; d < 2; ++d) {
                if (d == 0 ? (tp < 31) : (tp > 31)) continue;
                const int n = d == 0 ? tp - 31 : 31 - tp, base = (l * 2 + d) * 16 + g;
                const float* cre = CRE + ((size_t)base * 16 + c) * 64; const float* cim = CIM + ((size_t)base * 16 + c) * 64;
                const f32x2* ap = APOW + ((size_t)base * 33 + n) * 64; const f32x4* bb = (const f32x4*)(BBAR + (size_t)base * 64 * 16 + c2);
#pragma unroll 8
                for (int p = 0; p < 64; ++p) { const f32x2 a = ap[p]; const f32x4 b0 = bb[p * 8], b1 = bb[p * 8 + 1]; const float cr = cre[p], ci = cim[p];
                    const float er = cr * a.x - ci * a.y, ei = cr * a.y + ci * a.x;
                    sum[0] += er * b0[0] - ei * b0[1]; sum[1] += er * b0[2] - ei * b0[3]; sum[2] += er * b1[0] - ei * b1[1]; sum[3] += er * b1[2] - ei * b1[3]; }
            }
            if (tp == 31 && c >= c2 && c < c2 + 4) sum[c - c2] += S5D[l * 256 + g * 16 + c];
            gst<f32x4>(KT + (size_t)it * 4, sum);
        }
    }
    GRID_BAR();

    const float* xin0 = (const float*)(GASP const float*)args.in[I_X];
    float* XO = (float*)(GASP float*)args.out;
#pragma unroll 1
    for (int l = 0; l < DEPTH; ++l) {
        for (int rep_ = 0; rep_ < NREP(2); ++rep_) {
        if (PH(2)) {
            WSL();
            {
            bf16* WIN = WP(bf16, WS_WIN); bf16* WCAT = WP(bf16, WS_WCAT); bf16* WOUT = WP(bf16, WS_WOUT); bf16* WGLU = WP(bf16, WS_WGLU);
            for (int it = gw; it < 3648; it += NGW) {
                int r = it;
                if (r < 2560) { transpose_job_item(IN(I_WIN) + (size_t)l * 1024 * 5120, 5120, 5120, r, WIN, 1024, 0, 0, 1, 0, 1, IN(I_NMIX) + l * 1024, SCR(), lane); continue; } r -= 2560;
                if (r < 256) { transpose_job_item(IN(I_WBNA) + (size_t)l * 512 * 1024, 1024, 1024, r, WCAT, 1024, 0, 0, 1, 0, 0, nullptr, SCR(), lane); continue; } r -= 256;
                if (r < 128) { transpose_job_item(IN(I_WBS5) + (size_t)l * 256 * 1024, 1024, 1024, r, WCAT, 1024, 512, 0, 1, 0, 0, nullptr, SCR(), lane); continue; } r -= 128;
                if (r < 128) { transpose_job_item(IN(I_WBXA) + (size_t)l * 256 * 1024, 1024, 1024, r, WCAT, 1024, 768, 0, 1, 0, 0, nullptr, SCR(), lane); continue; } r -= 128;
                if (r < 512) { transpose_job_item(IN(I_WOUT) + (size_t)l * 1024 * 1024, 1024, 1024, r, WOUT, 1024, 0, 0, 1, 0, 0, nullptr, SCR(), lane); continue; } r -= 512;
                if (r < 32) { transpose_job_item(IN(I_WGLU) + (size_t)l * 256 * 512, 512, 256, r, WGLU, 256, 0, 0, 2, 0, 0, nullptr, SCR(), lane); continue; } r -= 32;
                transpose_job_item(IN(I_WGLU) + (size_t)l * 256 * 512 + 256, 512, 256, r, WGLU, 256, 0, 0, 2, 1, 0, nullptr, SCR(), lane);
            }
            }
            {
            const f32x2* APOW = WP(f32x2, WS_APOW); const f32x2* BBAR = WP(f32x2, WS_BBAR); bf16* S5W = WP(bf16, WS_S5W);
            for (int it = GT(); it < 16 * 256 * 64; it += NGT) {
                const int k8 = it & 63, n = (it >> 6) & 255, g = it >> 14;
                const int s = k8 >> 1, c0 = (k8 & 1) * 8, d = n >> 7, ri = (n >> 6) & 1, p = n & 63, e = d == 0 ? 31 - s : s, base = (l * 2 + d) * 16 + g;
                const f32x2 a = APOW[((size_t)base * 33 + e) * 64 + p]; const f32x2* bb = BBAR + ((size_t)base * 64 + p) * 16 + c0;
                float v[8];
#pragma unroll
                for (int j = 0; j < 8; ++j) { const f32x2 b = bb[j]; v[j] = ri == 0 ? a.x * b.x - a.y * b.y : a.x * b.y + a.y * b.x; }
                u32x4 w; w.x = cvt_pk_bf16(v[0], v[1]); w.y = cvt_pk_bf16(v[2], v[3]); w.z = cvt_pk_bf16(v[4], v[5]); w.w = cvt_pk_bf16(v[6], v[7]);
                gst<u32x4>(S5W + ((size_t)(g * 256 + n) * 512 + k8 * 8), w);
            }
            const float* KT = WP(float, WS_KT); bf16* S5KV = WP(bf16, WS_S5KV); const float* CRE = IN(I_CRE); const float* CIM = IN(I_CIM);
            for (int it = GT(); it < 16 * 512 * 96; it += NGT) {
                const int k8 = it % 96, rest = it / 96, n = rest & 511, g = rest >> 9, t = n >> 4, c = n & 15;
                float v[8];
                if (k8 < 64) { const int s = k8 >> 1, c0 = (k8 & 1) * 8, tp = t - s + 31; const float* kp = KT + ((size_t)(((l * 16 + g) * 63 + tp) * 16 + c) * 16 + c0);
                    const f32x4 a = gld<f32x4>(kp), b = gld<f32x4>(kp + 4); v[0] = a[0]; v[1] = a[1]; v[2] = a[2]; v[3] = a[3]; v[4] = b[0]; v[5] = b[1]; v[6] = b[2]; v[7] = b[3]; }
                else { const int jj = (k8 - 64) * 8, d = jj >> 7, ri = (jj >> 6) & 1, p0 = jj & 63, e = d == 0 ? t + 1 : 32 - t, base = (l * 2 + d) * 16 + g;
                    const float* cre = CRE + ((size_t)base * 16 + c) * 64 + p0; const float* cim = CIM + ((size_t)base * 16 + c) * 64 + p0; const f32x2* ap = APOW + ((size_t)base * 33 + e) * 64 + p0;
#pragma unroll
                    for (int j = 0; j < 8; ++j) { const f32x2 a = ap[j]; const float cr = cre[j], ci = cim[j]; v[j] = ri == 0 ? cr * a.x - ci * a.y : -(cr * a.y + ci * a.x); } }
                u32x4 w; w.x = cvt_pk_bf16(v[0], v[1]); w.y = cvt_pk_bf16(v[2], v[3]); w.z = cvt_pk_bf16(v[4], v[5]); w.w = cvt_pk_bf16(v[6], v[7]);
                gst<u32x4>(S5KV + ((size_t)(g * 512 + n) * ATK + k8 * 8), w);
            }
            }
            if (!FUSE1) { bf16* H = WP(bf16, WS_H); const float* gn = IN(I_NMIX) + l * 1024;
              if (l == 0) { for (int grp = gw; grp < M / 4; grp += NGW) norm_rows4<false>(xin0, gn, H, grp * 4, lane, nullptr, nullptr, nullptr, nullptr, nullptr, WP(float, WS_SS + 4 * MiB)); }
              else { const float* SSP = WP(float, WS_SS); float* RS = WP(float, WS_SS + 4 * MiB);
                for (int row = GT(); row < M; row += NGT) { const f32x4 a = gld<f32x4>(SSP + (size_t)row * 16), b = gld<f32x4>(SSP + (size_t)row * 16 + 4), c = gld<f32x4>(SSP + (size_t)row * 16 + 8), d = gld<f32x4>(SSP + (size_t)row * 16 + 12);
                  const float ss = (((a[0] + a[1]) + (a[2] + a[3])) + ((b[0] + b[1]) + (b[2] + b[3]))) + (((c[0] + c[1]) + (c[2] + c[3])) + ((d[0] + d[1]) + (d[2] + d[3])));
                  gst<float>(RS + row, 1.0f / sqrtf(ss * (1.0f / 1024.0f) + RMS_EPS)); } } }
        }
        GRID_BAR();
        }

        for (int rep_ = 0; rep_ < NREP(3); ++rep_) {
        if (PH(3)) {
            WSL();
            pg8::Gemm g{l == 0 ? WP(bf16, WS_H) : (const bf16*)XO, WP(bf16, WS_WIN), 1024, 1024, 1024}; pg8::StaticOrder S; S.init(M / 256, INC / 256, G, bid);
            EpiProj E{WP(bf16, WS_QK), WP(bf16, WS_VT8), WP(bf16, WS_AT), WP(bf16, WS_QX), WP(bf16, WS_GATES), IN(I_BGATE) + l * 3072, WP(float, WS_SS + 4 * MiB)};
            pg8::gemm_phase<EpiProj, pg8::StaticOrder>(F.lds, g, S, E, tid);
        }
        GRID_BAR();
        }

        for (int rep_ = 0; rep_ < NREP(4); ++rep_) {
        if (PH(4)) {
            WSL();
            for (int bg = bid; bg < 64; bg += G) {
                { pg8::Gemm g{WP(bf16, WS_AT), WP(bf16, WS_S5W), ATK, 512, 512}; pg8::ListOrder S{bg, 1, 1}; EpiS5a E{WP(float, WS_ST)};
                  pg8::gemm_phase<EpiS5a, pg8::ListOrder>(F.lds, g, S, E, tid); }
                WG_MEM_SYNC();
                s5_scan_item(bg * 2, WP(float, WS_ST), WP(bf16, WS_AT), WP(f32x2, WS_APOW) + (size_t)l * 2 * 16 * 33 * 64, (LAS float*)F.lds, tid);
                s5_scan_item(bg * 2 + 1, WP(float, WS_ST), WP(bf16, WS_AT), WP(f32x2, WS_APOW) + (size_t)l * 2 * 16 * 33 * 64, (LAS float*)F.lds, tid);
                WG_MEM_SYNC();
                { pg8::Gemm g{WP(bf16, WS_AT), WP(bf16, WS_S5KV), ATK, ATK, ATK}; pg8::ListOrder S{bg, 2, 2}; EpiS5c E{WP(bf16, WS_Y)};
                  pg8::gemm_phase<EpiS5c, pg8::ListOrder>(F.lds, g, S, E, tid); }
            }
            unsigned* qhead = WP(unsigned, WS_CTL) + CW_Q + (l + 4 * rep_) * 64;
            volatile LAS int* qslot = (volatile LAS int*)(F.lds + MISC_OFF + 64);
            for (;;) {
                if (tid == 0) qslot[0] = (int)__hip_atomic_fetch_add((GASP unsigned*)qhead, 1u, __ATOMIC_RELAXED, __HIP_MEMORY_SCOPE_AGENT);
                __syncthreads();
                const int qi = __builtin_amdgcn_readfirstlane(qslot[0]);
                __syncthreads();
                if (qi >= 768) break;
                if (qi < 512) NA_ITEM(qi); else XA_ITEMS(qi - 512, qi - 511, 1);
            }
        }
        GRID_BAR();
        }

        for (int rep_ = 0; rep_ < NREP(7); ++rep_) {
        if (PH(7)) {
            WSL();
            pg8::Gemm g{WP(bf16, WS_Y), WP(bf16, WS_WGLU), 256, 256, 256}; pg8::StaticOrder S; S.init(M / 256, 2, G, bid); EpiGlu E{WP(bf16, WS_H)};
            pg8::gemm_phase<EpiGlu, pg8::StaticOrder>(F.lds, g, S, E, tid);
        }
        GRID_BAR();
        }

        for (int rep_ = 0; rep_ < NREP(8); ++rep_) {
        if (PH(8)) {
            WSL();
            pg8::Gemm g{WP(bf16, WS_H), WP(bf16, WS_WCAT), 1024, 1024, 1024}; pg8::StaticOrder S; S.init(M / 256, 4, G, bid); EpiMerge E{WP(unsigned char, WS_GATES), WP(bf16, WS_QK)};
            pg8::gemm_phase<EpiMerge, pg8::StaticOrder, false, true>(F.lds, g, S, E, tid);
        }
        GRID_BAR();
        }

        for (int rep_ = 0; rep_ < NREP(9); ++rep_) {
        if (PH(9)) {
            WSL();
            pg8::Gemm g{WP(bf16, WS_QK), WP(bf16, WS_WOUT), 1024, 1024, 1024}; pg8::StaticOrder S; S.init(M / 256, 4, G, bid); EpiResB E{l == 0 ? xin0 : nullptr, (bf16*)XO};
            pg8::gemm_phase<EpiResB, pg8::StaticOrder>(F.lds, g, S, E, tid);
        }
        GRID_BAR();
        }

        for (int rep_ = 0; rep_ < NREP(10); ++rep_) {
        if (PH(10)) {
            WSL();
            {
            unsigned* cnt = WP(unsigned, WS_CTL) + CW_CNT + (l + 4 * rep_) * NBUCKET * 64;
            const float* bco = IN(I_BCO) + l * 4; const float* bfi = IN(I_BFI) + l * 16;
            int* LIST = rep_ ? WP(int, WS_GATES + 100 * MiB) : WP(int, WS_LIST); float* WTS = rep_ ? WP(float, WS_GATES + 104 * MiB) : WP(float, WS_WTS);
            { const u32x4* src = (const u32x4*)(WP(bf16, WS_WRT) + (size_t)l * 2 * 20480);
              for (int idx = tid; idx < 40 * 128; idx += NWAVES * 64) *(LAS u32x4*)(F.lds + (idx >> 7) * RT_STRIDE + (idx & 127) * 16) = gld<u32x4>(src + idx); }
            __syncthreads();
            for (int grp = gw; grp < M / 16; grp += NGW) router_rows16(nullptr, (const bf16*)XO, nullptr, nullptr, grp * 16, lane, F.lds, wave, bco, bfi, cnt, LIST, WTS);
            __syncthreads();
            }
            bf16* WGU = WP(bf16, WS_WGU); bf16* WDP = WP(bf16, WS_WDP);
            for (int it = gw; it < 10240; it += NGW) {
                int r = it;
                if (r < 2048) { const int e = r >> 7; transpose_job_item(IN(I_WG) + (size_t)(l * 16 + e) * 1024 * 256, 256, 256, r & 127, WGU + (size_t)e * 512 * 1024, 1024, 0, 0, 2, 0, 0, IN(I_NFFN) + l * 1024, SCR(), lane); continue; } r -= 2048;
                if (r < 2048) { const int e = r >> 7; transpose_job_item(IN(I_WU) + (size_t)(l * 16 + e) * 1024 * 256, 256, 256, r & 127, WGU + (size_t)e * 512 * 1024, 1024, 0, 0, 2, 1, 0, IN(I_NFFN) + l * 1024, SCR(), lane); continue; } r -= 2048;
                const int ej = r >> 7, e = ej / 3, jj = ej % 3, i = e & 3, grpI = e >> 2, o = jj + (jj >= i ? 1 : 0), a = i < o ? i : o, b = i < o ? o : i;
                const int pair = grpI * 6 + (a == 0 ? b - 1 : (a == 1 ? b + 1 : 5)), slot = (i == a) ? 0 : 1;
                transpose_job_item(IN(I_WD) + (size_t)(l * 16 + e) * 256 * 1024, 1024, 1024, r & 127, WDP + (size_t)pair * 1024 * 512, 512, slot * 256, 0, 1, 0, 0, nullptr, SCR(), lane);
            }
        }
        GRID_BAR();
        }

        LAS int* tab = (LAS int*)(F.lds + TAB_OFF);
        for (int rep_ = 0; rep_ < NREP(11); ++rep_) {
        if (PH(11)) {
            WSL();
            unsigned* cnt = WP(unsigned, WS_CTL) + CW_CNT + l * NBUCKET * 64;
            if (tid == 0) { int st = 0;
                for (int b = 0; b < NBUCKET; ++b) { const int c = (int)__hip_atomic_load((GASP unsigned*)(cnt + b * 64), __ATOMIC_RELAXED, __HIP_MEMORY_SCOPE_AGENT); tab[b] = c; tab[32 + b] = st; st += (c + 255) >> 8; }
                tab[32 + NBUCKET] = st; tab[64] = st; }
            __syncthreads();
            pg8::Gemm g{(const bf16*)XO, WP(bf16, WS_WGU), 1024, 1024, 1024}; pg8::MoeOrder S{tab, WP(int, WS_LIST), G, bid, 0}; EpiMoe1 E{WP(bf16, WS_ACT), WP(float, WS_WTS)};
            pg8::gemm_phase<EpiMoe1, pg8::MoeOrder, true>(F.lds, g, S, E, tid);
        }
        GRID_BAR();
        }

        for (int rep_ = 0; rep_ < NREP(12); ++rep_) {
        if (PH(12)) {
            WSL();
            pg8::Gemm g{WP(bf16, WS_ACT), WP(bf16, WS_WDP), 512, 512, 512}; pg8::MoeOrder S{tab, WP(int, WS_LIST), G, bid, 1}; EpiMoe2 E{rep_ ? WP(bf16, WS_GATES + 120 * MiB) : (l == DEPTH - 1 ? WP(bf16, WS_QK) : (bf16*)XO), WP(int, WS_LIST), (bf16*)XO, (l < DEPTH - 1 && !rep_) ? WP(float, WS_SS) : nullptr};
            pg8::gemm_phase<EpiMoe2, pg8::MoeOrder>(F.lds, g, S, E, tid);
        }
        GRID_BAR();
        }
    }
    { WSL(); const float* gn = IN(I_FNORM);
      for (int row = gw; row < M; row += NGW) final_norm_row(WP(bf16, WS_QK), WP(bf16, WS_H), XO, gn, row, lane); }
#undef GRID_BAR
}

extern "C" void kernel_launch(void* const* d_in, const int* in_sizes, int n_in, void* d_out, int out_size, void* d_ws, size_t ws_size, hipStream_t stream) {
    static int grid = 0;
    if (grid == 0) {
        if (n_in != 30 || out_size != M * D || ws_size < WS_END) { fprintf(stderr, "kernel_launch: unexpected shapes (n_in %d, out %d, ws %zu)\n", n_in, out_size, ws_size); grid = -1; return; }
        int dev = 0, cus = 0, per_cu = 0;
        if (hipGetDevice(&dev) != hipSuccess || hipDeviceGetAttribute(&cus, hipDeviceAttributeMultiprocessorCount, dev) != hipSuccess) { grid = -1; return; }
        if (hipFuncSetAttribute((const void*)fwd_kernel, hipFuncAttributeMaxDynamicSharedMemorySize, LDS_BYTES) != hipSuccess) { fprintf(stderr, "kernel_launch: hipFuncSetAttribute failed\n"); grid = -1; return; }
        if (hipOccupancyMaxActiveBlocksPerMultiprocessor(&per_cu, (const void*)fwd_kernel, NWAVES * 64, LDS_BYTES) != hipSuccess || per_cu < 1) { fprintf(stderr, "kernel_launch: occupancy query reports %d\n", per_cu); }
        (void)hipGetLastError();
        grid = cus;
    }
    if (grid < 0) return;
    (void)in_sizes;
    (void)hipMemsetAsync((char*)d_ws + WS_CTL, 0, CTL_BYTES, stream);
    Args a{};
    for (int i = 0; i < 30; ++i) a.in[i] = (const float*)d_in[i];
    a.out = (float*)d_out; a.ws = (unsigned char*)d_ws;
    hipLaunchKernelGGL(fwd_kernel, dim3(grid), dim3(NWAVES * 64), LDS_BYTES, stream, a);
}
```

```cpp
#include <hip/hip_runtime.h>
#include <cstdio>
#include <cstdint>

#define LAS __attribute__((address_space(3)))
typedef unsigned short bf16;
typedef short bf16x8 __attribute__((ext_vector_type(8)));
typedef float f32x4 __attribute__((ext_vector_type(4)));
typedef float f32x2 __attribute__((ext_vector_type(2)));
typedef unsigned u32x4 __attribute__((ext_vector_type(4)));
typedef unsigned u32x2 __attribute__((ext_vector_type(2)));

constexpr int D = 1024, BATCH = 4, SEQ = 8192, M = BATCH * SEQ, DEPTH = 4;
constexpr int INC = 5120, NMEM = 256;
constexpr int NCHUNK = 256, TCH = 32;
constexpr int ATK = 768;
constexpr int LCAP = 32768;
constexpr int NBUCKET = 24;
constexpr float RMS_EPS = 1e-6f;

constexpr size_t MiB = 1u << 20;
constexpr size_t WS_CTL = 0, CTL_BYTES = 1 * MiB;
constexpr size_t WS_APOW = 1 * MiB;
constexpr size_t WS_BBAR = 4 * MiB;
constexpr size_t WS_KT = 5 * MiB;
constexpr size_t WS_WRT = 10 * MiB;
constexpr size_t WS_RPBP = 10 * MiB + 512 * 1024;
constexpr size_t WS_MEMN = 11 * MiB;
constexpr size_t WS_WMKV = 19 * MiB;
constexpr size_t WS_KM = 23 * MiB;
constexpr size_t WS_VM8 = 25 * MiB;
constexpr size_t WS_WIN = 27 * MiB;
constexpr size_t WS_WCAT = 37 * MiB;
constexpr size_t WS_WOUT = 39 * MiB;
constexpr size_t WS_WGLU = 41 * MiB;
constexpr size_t WS_S5W = 42 * MiB;
constexpr size_t WS_S5KV = 46 * MiB;
constexpr size_t WS_H = 58 * MiB;
constexpr size_t WS_QK = 122 * MiB;
constexpr size_t WS_VT8 = 186 * MiB;
constexpr size_t WS_AT = 218 * MiB;
constexpr size_t WS_QX = 242 * MiB;
constexpr size_t WS_ST = 258 * MiB;
constexpr size_t WS_Y = 274 * MiB;
constexpr size_t WS_GATES = 290 * MiB;
constexpr size_t WS_WGU = WS_GATES;
constexpr size_t WS_WDP = WS_GATES + 16 * MiB;
constexpr size_t WS_ACT = WS_GATES + 40 * MiB;
constexpr size_t WS_LIST = 482 * MiB;
constexpr size_t WS_WTS = 485 * MiB;
constexpr size_t WS_SS = 497 * MiB;
constexpr size_t WS_END = 505 * MiB;
constexpr int CW_BAR = 4096;
constexpr int CW_CNT = 16384;
constexpr int CW_Q = 32768;

__device__ __forceinline__ unsigned cvt_pk_bf16(float lo, float hi) { unsigned r; asm volatile("v_cvt_pk_bf16_f32 %0, %1, %2" : "=v"(r) : "v"(lo), "v"(hi)); return r; }
__device__ __forceinline__ float bf2f(unsigned short b) { return __uint_as_float(((unsigned)b) << 16); }
__device__ __forceinline__ float bflo(unsigned w) { return __uint_as_float(w << 16); }
__device__ __forceinline__ float bfhi(unsigned w) { return __uint_as_float(w & 0xffff0000u); }
__device__ __forceinline__ float fast_rcp(float x) { return __builtin_amdgcn_rcpf(x); }
__device__ __forceinline__ float fast_exp(float x) { return __builtin_amdgcn_exp2f(x * 1.4426950408889634f); }
__device__ __forceinline__ float sigmoid_f(float x) { return fast_rcp(1.0f + fast_exp(-x)); }
__device__ __forceinline__ float gelu_tanh_f(float x) { const float u = 1.5957691216057308f * (x + 0.044715f * x * x * x); return x * fast_rcp(1.0f + fast_exp(-u)); }
__device__ __forceinline__ float shfl_xor_f(float v, int o, int lane) { return __int_as_float(__builtin_amdgcn_ds_bpermute((lane ^ o) << 2, __float_as_int(v))); }
__device__ __forceinline__ float shfl_idx_f(float v, int src) { return __int_as_float(__builtin_amdgcn_ds_bpermute(src << 2, __float_as_int(v))); }
__device__ __forceinline__ float wave_sum(float v, int lane) {
#pragma unroll
    for (int o = 1; o < 64; o <<= 1) v += shfl_xor_f(v, o, lane);
    return v;
}
#define GASP __attribute__((address_space(1)))
template <class T> __device__ __forceinline__ T gld(const void* p) { return *(const GASP T*)p; }
template <class T> __device__ __forceinline__ void gst(void* p, const T& v) { *(GASP T*)p = v; }
__device__ __forceinline__ unsigned q8(float g) { return (unsigned)__builtin_fminf(__builtin_fmaxf(__builtin_rintf(g * 255.0f), 1.0f), 255.0f); }
__device__ __forceinline__ unsigned q8x4(float a, float b, float c, float d) { return q8(a) | (q8(b) << 8) | (q8(c) << 16) | (q8(d) << 24); }
#define LDS_WAIT() asm volatile("s_waitcnt lgkmcnt(0)" ::: "memory")
#define VM_WAIT() asm volatile("s_waitcnt vmcnt(0)" ::: "memory")

namespace pg8 {
constexpr int BM = 256, BK = 64, HALF = 128, HTB = HALF * BK * 2, STAGE_BYTES = 8 * HTB, NXCD = 8, WGM = 8;
__host__ __device__ __forceinline__ int lds_byte(int r, int c) { const int st = (r >> 4) * 2 + (c >> 5), rr = r & 15, cc = c & 31, ob = rr * 64 + cc * 2; return st * 1024 + (ob ^ (((ob >> 9) & 1) << 5)); }
__host__ __device__ __forceinline__ void stage_rc(int b, int& R, int& C) { const int st = b / 1024, sb = b % 1024, swz = sb ^ (((sb >> 9) & 1) << 5); R = (st >> 1) * 16 + swz / 64; C = (st & 1) * 32 + (swz % 64) / 2; }
__host__ __device__ __forceinline__ int perm32(int rho) { const int n = rho >> 4, i = rho & 15; return 8 * (i >> 2) + 4 * n + (i & 3); }

struct Unit { int pm, pn, am, bn, x0, x1, x2; };
struct Gemm { const bf16* A; const bf16* Bt; int lda, ldb, K; };

struct StaticOrder {
    int nM, nN, nwg, G, c;
    __device__ void init(int nM_, int nN_, int G_, int c_) { nM = nM_; nN = nN_; nwg = nM * nN; G = G_; c = c_; }
    __device__ bool next(int i, Unit& u) const {
        const long L = (long)i * G + c; if (L >= nwg) return false;
        int wgid = (int)L; { const int q = nwg / NXCD, r = nwg % NXCD, xcd = wgid % NXCD, off = wgid / NXCD; wgid = (xcd < r ? xcd * (q + 1) : r * (q + 1) + (xcd - r) * q) + off; }
        const int nig = WGM * nN, gid = wgid / nig, fm = gid * WGM, gsz = (nM - fm) < WGM ? (nM - fm) : WGM;
        u.pm = __builtin_amdgcn_readfirstlane(fm + ((wgid % nig) % gsz)); u.pn = __builtin_amdgcn_readfirstlane((wgid % nig) / gsz);
        u.am = u.pm; u.bn = u.pn; u.x0 = 0; u.x1 = 0; u.x2 = 0; return true;
    }
    __device__ __forceinline__ int a_row(const Unit&, int) const { return 0; }
};
struct S5Order : StaticOrder {
    __device__ bool next(int i, Unit& u) const { if (!StaticOrder::next(i, u)) return false; u.bn = (u.pm & 15) * nN + u.pn; return true; }
};
struct ListOrder {
    int pm, n, nN;
    __device__ bool next(int i, Unit& u) const { if (i >= n) return false; u.pm = pm; u.pn = i; u.am = pm; u.bn = (pm & 15) * nN + i; u.x0 = 0; u.x1 = 0; u.x2 = 0; return true; }
    __device__ __forceinline__ int a_row(const Unit&, int) const { return 0; }
};
struct MemOrder {
    int G, c;
    __device__ bool next(int i, Unit& u) const { const int L = i * G + c; if (L >= 32) return false; u.pm = L >> 1; u.pn = L & 1; u.am = u.pm; u.bn = (u.pm >> 2) * 2 + u.pn; u.x0 = 0; u.x1 = 0; u.x2 = 0; return true; }
    __device__ __forceinline__ int a_row(const Unit&, int) const { return 0; }
};
struct MoeOrder {
    const LAS int* tab; const int* list; int G, c, mode;
    __device__ bool next(int i, Unit& u) const {
        const int T = __builtin_amdgcn_readfirstlane(tab[64]); const int L = i * G + c; if (L >= T * 4) return false;
        const int tile = L >> 2, pn = L & 3; int b = 0;
#pragma unroll 1
        for (int j = 1; j < NBUCKET; ++j) if (__builtin_amdgcn_readfirstlane(tab[32 + j]) <= tile) b = j;
        u.pm = tile; u.pn = pn; u.am = tile; u.x0 = b; u.x1 = (tile - __builtin_amdgcn_readfirstlane(tab[32 + b])) * 256; u.x2 = __builtin_amdgcn_readfirstlane(tab[b]);
        const int grp = __builtin_amdgcn_readfirstlane(b / 6), pi = __builtin_amdgcn_readfirstlane(b % 6); const int ea = pi < 3 ? 0 : (pi < 5 ? 1 : 2), eb = pi < 3 ? pi + 1 : (pi < 5 ? pi - 1 : 3);
        if (mode == 0) { const int e = grp * 4 + ((pn >> 1) ? eb : ea); u.bn = e * 2 + (pn & 1); } else u.bn = b * 4 + pn;
        return true;
    }
    __device__ __forceinline__ int a_row(const Unit& u, int r) const { const int slot = u.x1 + r; return slot < u.x2 ? gld<int>(list + (unsigned)(u.x0 * LCAP + slot)) : 0; }
};

template <class Epi, class Sched, bool GATHER = false, bool KHOOK = false>
__device__ __forceinline__ void gemm_phase(LAS unsigned char* lds, const Gemm g, const Sched& S, const Epi& E, int tid_in) {
    int tid = tid_in; asm volatile("" : "+v"(tid));
    const int wid = __builtin_amdgcn_readfirstlane(tid >> 6), lane = tid & 63, wr = wid >> 2, wc = wid & 3, fr = lane & 15, fq = lane >> 4;
    int K = g.K, lda = g.lda, ldb = g.ldb;
    asm volatile("" : "+s"(K), "+s"(lda), "+s"(ldb));
    const int nt = K / BK;
    unsigned voffA[2], voffB[2]; int Rr[2], Cc[2];
#pragma unroll
    for (int i = 0; i < 2; ++i) { int R, C; stage_rc(tid * 16 + i * 8192, R, C); const int Rb = Epi::PERM ? ((R & ~31) + perm32(R & 31)) : R;
        voffA[i] = (unsigned)(R * lda + C) * 2u; voffB[i] = (unsigned)(Rb * ldb + C) * 2u; Rr[i] = R; Cc[i] = C; }
    const unsigned kstep = (unsigned)(BK * 2);
    const unsigned hstepA = (unsigned)(HALF * lda * 2), tstepA = 2u * hstepA, hstepB = (unsigned)(HALF * ldb * 2), tstepB = 2u * hstepB;
    const unsigned ldsw = (unsigned)wid * 1024u;
    const int aoff = lds_byte(wr * 64 + fr, fq * 8), boff = lds_byte(wc * 32 + fr, fq * 8);
    unsigned vC[2][2] = {{0u, 0u}, {0u, 0u}}, vN[2][2] = {{0u, 0u}, {0u, 0u}};
#define PG8_SA(b, h) (((b) * 2 + (h)) * HTB)
#define PG8_SB(b, h) ((4 + (b) * 2 + (h)) * HTB)
#define PG8_STAGE(bufoff, gbase, voff) do { _Pragma("unroll") for (int _i = 0; _i < 2; ++_i) \
        __builtin_amdgcn_global_load_lds((const unsigned*)((const char*)(gbase) + (voff)[_i]), (LAS unsigned*)(lds + (bufoff) + ldsw + _i * 8192), 16, 0, 0); } while (0)
#define PG8_STA(bufoff, ptr, h, nx) do { if constexpr (GATHER) { unsigned _v[2]; _v[0] = (nx) ? vN[h][0] : vC[h][0]; _v[1] = (nx) ? vN[h][1] : vC[h][1]; PG8_STAGE(bufoff, ptr, _v); } \
        else { PG8_STAGE(bufoff, (ptr) + (h) * hstepA, voffA); } } while (0)
#define PG8_STB(bufoff, ptr, h) PG8_STAGE(bufoff, (ptr) + (h) * hstepB, voffB)
#define PG8_LDA(dst, b, h) do { _Pragma("unroll") for (int m = 0; m < 4; ++m) _Pragma("unroll") for (int k = 0; k < 2; ++k) dst[m][k] = *(const LAS bf16x8*)(lds + PG8_SA(b, h) + aoff + m * 2048 + k * 1024); } while (0)
#define PG8_LDB(dst, b, h) do { _Pragma("unroll") for (int n = 0; n < 2; ++n) _Pragma("unroll") for (int k = 0; k < 2; ++k) dst[n][k] = *(const LAS bf16x8*)(lds + PG8_SB(b, h) + boff + n * 2048 + k * 1024); } while (0)
#define PG8_MMA(ai, bj, At, Bt) do { __builtin_amdgcn_s_setprio(1); _Pragma("unroll") for (int m = 0; m < 4; ++m) _Pragma("unroll") for (int n = 0; n < 2; ++n) _Pragma("unroll") for (int k = 0; k < 2; ++k) \
        acc[ai][bj][m][n] = __builtin_amdgcn_mfma_f32_16x16x32_bf16(Bt[n][k], At[m][k], acc[ai][bj][m][n], 0, 0, 0); __builtin_amdgcn_s_setprio(0); } while (0)
#define PG8_WAIT_V(n) asm volatile("s_waitcnt vmcnt(" #n ")" ::: "memory")
#define PG8_WAIT_L(n) asm volatile("s_waitcnt lgkmcnt(" #n ")" ::: "memory")
#define PG8_BAR __builtin_amdgcn_s_barrier()
#define PG8_SCHED __builtin_amdgcn_sched_barrier(0)
    Unit cur, nxt; int ui = 0;
    if (!S.next(0, cur)) return;
    f32x4 acc[2][2][4][2];
#pragma unroll
    for (int a = 0; a < 2; ++a)
#pragma unroll
        for (int b = 0; b < 2; ++b)
#pragma unroll
            for (int m = 0; m < 4; ++m)
#pragma unroll
                for (int n = 0; n < 2; ++n) acc[a][b][m][n] = (f32x4){0.f, 0.f, 0.f, 0.f};
    bf16x8 At[4][2], B0[2][2], B1[2][2];
    const char* cA = GATHER ? (const char*)g.A : (const char*)g.A + (unsigned)cur.am * tstepA;
    const char* cB = (const char*)g.Bt + (unsigned)cur.bn * tstepB;
    if constexpr (GATHER) {
#pragma unroll
        for (int h = 0; h < 2; ++h)
#pragma unroll
            for (int i = 0; i < 2; ++i) vC[h][i] = (unsigned)(S.a_row(cur, h * HALF + Rr[i]) * lda + Cc[i]) * 2u;
    }
    PG8_STB(PG8_SB(0, 0), cB, 0); PG8_STB(PG8_SB(0, 1), cB, 1); PG8_STA(PG8_SA(0, 0), cA, 0, false); PG8_STA(PG8_SA(0, 1), cA, 1, false);
    if (wr == 1) PG8_BAR;
    PG8_WAIT_V(2); PG8_BAR;
    PG8_STB(PG8_SB(1, 0), cB + kstep, 0); PG8_STA(PG8_SA(1, 0), cA + kstep, 0, false); PG8_STB(PG8_SB(1, 1), cB + kstep, 1);
    PG8_WAIT_V(6); PG8_BAR;
    for (;;) {
        const bool has_next = S.next(ui + 1, nxt);
        const char* nA = GATHER ? (const char*)g.A : (has_next ? (const char*)g.A + (unsigned)nxt.am * tstepA : cA);
        const char* nB = has_next ? (const char*)g.Bt + (unsigned)nxt.bn * tstepB : cB;
        if constexpr (GATHER) {
#pragma unroll
            for (int h = 0; h < 2; ++h)
#pragma unroll
                for (int i = 0; i < 2; ++i) vN[h][i] = has_next ? (unsigned)(S.a_row(nxt, h * HALF + Rr[i]) * lda + Cc[i]) * 2u : vC[h][i];
        }
        int tb = 0;
#pragma unroll 1
        for (int seg = 0; seg < (KHOOK ? 3 : 1); ++seg) {
        const int te = KHOOK ? (seg == 0 ? 8 : (seg == 1 ? 12 : nt)) : nt;
        for (int t = tb; t < te; t += 2) {
            const bool last = (t == nt - 2);
            const char* a1 = cA + (unsigned)(t + 1) * kstep;
            const char* a2 = last ? nA : cA + (unsigned)(t + 2) * kstep; const char* b2 = last ? nB : cB + (unsigned)(t + 2) * kstep;
            const char* a3 = a2 + kstep; const char* b3 = b2 + kstep;
            PG8_LDB(B0, 0, 0); PG8_LDB(B1, 0, 1); PG8_SCHED; PG8_LDA(At, 0, 0); PG8_STA(PG8_SA(1, 1), a1, 1, false);
            PG8_WAIT_V(8); PG8_WAIT_L(0); PG8_BAR; PG8_MMA(0, 0, At, B0); PG8_MMA(0, 1, At, B1); PG8_BAR; PG8_SCHED;
            PG8_LDA(At, 0, 1); PG8_STB(PG8_SB(0, 0), b2, 0); PG8_STB(PG8_SB(0, 1), b2, 1); PG8_STA(PG8_SA(0, 0), a2, 0, last);
            PG8_WAIT_V(8); PG8_WAIT_L(0); PG8_BAR; PG8_MMA(1, 0, At, B0); PG8_MMA(1, 1, At, B1); PG8_BAR; PG8_SCHED;
            PG8_LDB(B0, 1, 0); PG8_LDB(B1, 1, 1); PG8_SCHED; PG8_LDA(At, 1, 0); PG8_STA(PG8_SA(0, 1), a2, 1, last);
            PG8_WAIT_V(8); PG8_WAIT_L(0); PG8_BAR; PG8_MMA(0, 0, At, B0); PG8_MMA(0, 1, At, B1); PG8_BAR; PG8_SCHED;
            PG8_LDA(At, 1, 1); PG8_STB(PG8_SB(1, 0), b3, 0); PG8_STB(PG8_SB(1, 1), b3, 1); PG8_STA(PG8_SA(1, 0), a3, 0, last);
            PG8_WAIT_V(8); PG8_WAIT_L(0); PG8_BAR; PG8_MMA(1, 0, At, B0); PG8_MMA(1, 1, At, B1); PG8_BAR; PG8_SCHED;
        }
        if constexpr (KHOOK) { if (seg < 2) { unsigned mm_ = ~0u; asm volatile("" : "+s"(mm_)); const int ln_ = (int)__builtin_amdgcn_mbcnt_hi(mm_, __builtin_amdgcn_mbcnt_lo(mm_, 0u)); E.khook(acc, cur, te, wr, wc, ln_ & 15, ln_ >> 4); } }
        tb = te;
        }
        if (wr == 0) PG8_BAR;
        { unsigned mm_ = ~0u; asm volatile("" : "+s"(mm_)); const int ln_ = (int)__builtin_amdgcn_mbcnt_hi(mm_, __builtin_amdgcn_mbcnt_lo(mm_, 0u)); E(acc, cur, wr, wc, ln_ & 15, ln_ >> 4); }
        if (!has_next) break;
#pragma unroll
        for (int a = 0; a < 2; ++a)
#pragma unroll
            for (int b = 0; b < 2; ++b)
#pragma unroll
                for (int m = 0; m < 4; ++m)
#pragma unroll
                    for (int n = 0; n < 2; ++n) acc[a][b][m][n] = (f32x4){0.f, 0.f, 0.f, 0.f};
        cur = nxt; cA = nA; cB = nB; ++ui;
        if constexpr (GATHER) {
#pragma unroll
            for (int h = 0; h < 2; ++h)
#pragma unroll
                for (int i = 0; i < 2; ++i) vC[h][i] = vN[h][i];
        }
        if (wr == 1) PG8_BAR;
    }
    PG8_WAIT_V(0);
    PG8_BAR;
#undef PG8_SA
#undef PG8_SB
#undef PG8_STAGE
#undef PG8_STA
#undef PG8_STB
#undef PG8_LDA
#undef PG8_LDB
#undef PG8_MMA
#undef PG8_WAIT_V
#undef PG8_WAIT_L
#undef PG8_BAR
#undef PG8_SCHED
}
}

using pg8::Unit;
struct EpiProj {
    static constexpr bool PERM = true;
    bf16 *QK, *Vt8, *At, *QX, *GATES; const float* bgate; const float* ssq;
#define EP_LOOP_BEGIN _Pragma("unroll") for (int ai = 0; ai < 2; ++ai) _Pragma("unroll") for (int m = 0; m < 4; ++m) { const int row = row0 + ai * 128 + m * 16; const float rs = rstd[ai][m]; _Pragma("unroll") for (int bj = 0; bj < 2; ++bj) { \
        const f32x4 v0 = acc[ai][bj][m][0] * rs, v1 = acc[ai][bj][m][1] * rs; const int cl = cl0 + bj * 128;
#define EP_LOOP_END } asm volatile("" ::: "memory"); }
    __device__ __forceinline__ void operator()(const f32x4 (&acc)[2][2][4][2], const Unit& u, int wr, int wc, int fr, int fq) const {
        const int pn = u.pn, row0 = u.pm * 256 + wr * 64 + fr, cl0 = wc * 32 + 8 * fq;
        float rstd[2][4];
#pragma unroll
        for (int ai = 0; ai < 2; ++ai)
#pragma unroll
            for (int m = 0; m < 4; ++m) rstd[ai][m] = ssq ? gld<float>(ssq + row0 + ai * 128 + m * 16) : 1.0f;
        if (pn < 4) {
            EP_LOOP_BEGIN
                u32x4 w; w.x = cvt_pk_bf16(v0[0], v0[1]); w.y = cvt_pk_bf16(v0[2], v0[3]); w.z = cvt_pk_bf16(v1[0], v1[1]); w.w = cvt_pk_bf16(v1[2], v1[3]);
                gst<u32x4>(QK + (unsigned)row * 1024 + pn * 256 + cl, w);
            EP_LOOP_END
        } else if (pn < 6) {
            EP_LOOP_BEGIN
                const int vc = (pn - 4) * 256 + cl, hh = vc >> 6, dh = vc & 63, b = row >> 13, s = row & 8191;
                bf16* p = Vt8 + ((unsigned)((b * 8 + hh) * 1024 + (s >> 3)) * 64 + dh) * 8 + (s & 7);
                const unsigned w0 = cvt_pk_bf16(v0[0], v0[1]), w1 = cvt_pk_bf16(v0[2], v0[3]), w2 = cvt_pk_bf16(v1[0], v1[1]), w3 = cvt_pk_bf16(v1[2], v1[3]);
                gst<bf16>(p, (bf16)w0); gst<bf16>(p + 8, (bf16)(w0 >> 16)); gst<bf16>(p + 16, (bf16)w1); gst<bf16>(p + 24, (bf16)(w1 >> 16)); gst<bf16>(p + 32, (bf16)w2); gst<bf16>(p + 40, (bf16)(w2 >> 16)); gst<bf16>(p + 48, (bf16)w3); gst<bf16>(p + 56, (bf16)(w3 >> 16));
            EP_LOOP_END
        } else if (pn == 6) {
            EP_LOOP_BEGIN
                const int g = cl >> 4, c0 = cl & 15, b = row >> 13, s = row & 8191;
                u32x4 w; w.x = cvt_pk_bf16(v0[0], v0[1]); w.y = cvt_pk_bf16(v0[2], v0[3]); w.z = cvt_pk_bf16(v1[0], v1[1]); w.w = cvt_pk_bf16(v1[2], v1[3]);
                gst<u32x4>(At + ((unsigned)((b * 16 + g) * 256 + (s >> 5))) * ATK + (s & 31) * 16 + c0, w);
            EP_LOOP_END
        } else if (pn == 7) {
            EP_LOOP_BEGIN
                u32x4 w; w.x = cvt_pk_bf16(v0[0], v0[1]); w.y = cvt_pk_bf16(v0[2], v0[3]); w.z = cvt_pk_bf16(v1[0], v1[1]); w.w = cvt_pk_bf16(v1[2], v1[3]);
                gst<u32x4>(QX + (unsigned)row * 256 + cl, w);
            EP_LOOP_END
        } else {
            EP_LOOP_BEGIN
                const int gc = (pn - 8) * 256 + cl;
                const f32x4 b0 = gld<f32x4>(bgate + gc), b1 = gld<f32x4>(bgate + gc + 4);
                u32x2 w; w.x = q8x4(sigmoid_f(v0[0] + b0[0]), sigmoid_f(v0[1] + b0[1]), sigmoid_f(v0[2] + b0[2]), sigmoid_f(v0[3] + b0[3]));
                w.y = q8x4(sigmoid_f(v1[0] + b1[0]), sigmoid_f(v1[1] + b1[1]), sigmoid_f(v1[2] + b1[2]), sigmoid_f(v1[3] + b1[3]));
                gst<u32x2>((unsigned char*)GATES + (unsigned)row * 3072 + gc, w);
            EP_LOOP_END
        }
    }
#undef EP_LOOP_BEGIN
#undef EP_LOOP_END
};
struct EpiMemKV {
    static constexpr bool PERM = true;
    bf16 *Km, *Vm8;
    __device__ __forceinline__ void operator()(const f32x4 (&acc)[2][2][4][2], const Unit& u, int wr, int wc, int fr, int fq) const {
        const int row0 = u.pm * 256 + wr * 64 + fr, cl0 = wc * 32 + 8 * fq;
#pragma unroll
        for (int ai = 0; ai < 2; ++ai)
#pragma unroll
            for (int m = 0; m < 4; ++m) {
                const int row = row0 + ai * 128 + m * 16;
#pragma unroll
                for (int bj = 0; bj < 2; ++bj) {
                    const f32x4 v0 = acc[ai][bj][m][0], v1 = acc[ai][bj][m][1];
                    const int cl = cl0 + bj * 128;
                    const unsigned w0 = cvt_pk_bf16(v0[0], v0[1]), w1 = cvt_pk_bf16(v0[2], v0[3]), w2 = cvt_pk_bf16(v1[0], v1[1]), w3 = cvt_pk_bf16(v1[2], v1[3]);
                    if (u.pn == 0) { u32x4 w; w.x = w0; w.y = w1; w.z = w2; w.w = w3; gst<u32x4>(Km + (unsigned)row * 256 + cl, w); }
                    else {
                        const int hh = cl >> 6, dh = cl & 63, lb = row >> 8, mm = row & 255;
                        bf16* p = Vm8 + ((unsigned)((lb * 4 + hh) * 32 + (mm >> 3)) * 64 + dh) * 8 + (mm & 7);
                        gst<bf16>(p, (bf16)w0); gst<bf16>(p + 8, (bf16)(w0 >> 16)); gst<bf16>(p + 16, (bf16)w1); gst<bf16>(p + 24, (bf16)(w1 >> 16)); gst<bf16>(p + 32, (bf16)w2); gst<bf16>(p + 40, (bf16)(w2 >> 16)); gst<bf16>(p + 48, (bf16)w3); gst<bf16>(p + 56, (bf16)(w3 >> 16));
                    }
                }
                asm volatile("" ::: "memory");
            }
    }
};
struct EpiS5a {
    static constexpr bool PERM = false;
    float* ST;
    __device__ __forceinline__ void operator()(const f32x4 (&acc)[2][2][4][2], const Unit& u, int wr, int wc, int fr, int fq) const {
        const int row0 = u.am * 256 + wr * 64 + fr, col0 = wc * 32 + 4 * fq;
#pragma unroll
        for (int ai = 0; ai < 2; ++ai)
#pragma unroll
            for (int m = 0; m < 4; ++m) { float* rowp = ST + (unsigned)(row0 + ai * 128 + m * 16) * 256 + col0;
#pragma unroll
                for (int bj = 0; bj < 2; ++bj)
#pragma unroll
                    for (int n = 0; n < 2; ++n) gst<f32x4>(rowp + bj * 128 + n * 16, acc[ai][bj][m][n]);
                asm volatile("" ::: "memory"); }
    }
};
struct EpiS5c {
    static constexpr bool PERM = true;
    bf16* Y;
    __device__ __forceinline__ void operator()(const f32x4 (&acc)[2][2][4][2], const Unit& u, int wr, int wc, int fr, int fq) const {
        const int b = u.am >> 4, g = u.am & 15, r0 = wr * 64 + fr, cl0 = u.pn * 256 + wc * 32 + 8 * fq;
#pragma unroll
        for (int ai = 0; ai < 2; ++ai)
#pragma unroll
            for (int m = 0; m < 4; ++m) {
                const int chunk = r0 + ai * 128 + m * 16;
#pragma unroll
                for (int bj = 0; bj < 2; ++bj) {
                    const f32x4 v0 = acc[ai][bj][m][0], v1 = acc[ai][bj][m][1];
                    const int col = cl0 + bj * 128, t = col >> 4, c0 = col & 15;
                    u32x4 w; w.x = cvt_pk_bf16(gelu_tanh_f(v0[0]), gelu_tanh_f(v0[1])); w.y = cvt_pk_bf16(gelu_tanh_f(v0[2]), gelu_tanh_f(v0[3]));
                    w.z = cvt_pk_bf16(gelu_tanh_f(v1[0]), gelu_tanh_f(v1[1])); w.w = cvt_pk_bf16(gelu_tanh_f(v1[2]), gelu_tanh_f(v1[3]));
                    gst<u32x4>(Y + (unsigned)(b * SEQ + chunk * 32 + t) * 256 + g * 16 + c0, w);
                }
                asm volatile("" ::: "memory");
            }
    }
};
struct EpiGlu {
    static constexpr bool PERM = true;
    bf16* CAT;
    __device__ __forceinline__ void operator()(const f32x4 (&acc)[2][2][4][2], const Unit& u, int wr, int wc, int fr, int fq) const {
        const int row0 = u.pm * 256 + wr * 64 + fr, cl0 = u.pn * 256 + wc * 32 + 8 * fq;
#pragma unroll
        for (int ai = 0; ai < 2; ++ai)
#pragma unroll
            for (int m = 0; m < 4; ++m) {
                const int row = row0 + ai * 128 + m * 16;
#pragma unroll
                for (int bj = 0; bj < 2; ++bj) {
                    const f32x4 v0 = acc[ai][bj][m][0], v1 = acc[ai][bj][m][1];
                    const int col = cl0 + bj * 128;
                    u32x2 w; w.x = cvt_pk_bf16(v0[0] * sigmoid_f(v0[1]), v0[2] * sigmoid_f(v0[3])); w.y = cvt_pk_bf16(v1[0] * sigmoid_f(v1[1]), v1[2] * sigmoid_f(v1[3]));
                    gst<u32x2>(CAT + (unsigned)row * 1024 + 512 + (col >> 1), w);
                }
                asm volatile("" ::: "memory");
            }
    }
};
struct EpiMerge {
    static constexpr bool PERM = true;
    const unsigned char* GATES; bf16* MG;
    static __device__ __forceinline__ float ub(unsigned w, int i) { return (float)((w >> (8 * i)) & 0xffu); }
    __device__ __forceinline__ void khook(f32x4 (&acc)[2][2][4][2], const Unit& u, int t, int wr, int wc, int fr, int fq) const {
        const int row0 = u.pm * 256 + wr * 64 + fr, cl0 = u.pn * 256 + wc * 32 + 8 * fq;
        const int ga = (t == 8) ? 0 : 1024;
        u32x2 na[2][4][2], nb[2][4][2];
#pragma unroll
        for (int ai = 0; ai < 2; ++ai)
#pragma unroll
            for (int m = 0; m < 4; ++m)
#pragma unroll
                for (int bj = 0; bj < 2; ++bj) { const unsigned char* gp = GATES + (unsigned)((row0 + ai * 128 + m * 16) * 3072 + ga + cl0 + bj * 128); na[ai][m][bj] = gld<u32x2>(gp); nb[ai][m][bj] = gld<u32x2>(gp + 1024); }
#pragma unroll
        for (int ai = 0; ai < 2; ++ai)
#pragma unroll
            for (int m = 0; m < 4; ++m)
#pragma unroll
                for (int bj = 0; bj < 2; ++bj) {
                    const u32x2 a = na[ai][m][bj], b = nb[ai][m][bj];
                    f32x4 r0, r1;
#pragma unroll
                    for (int i = 0; i < 4; ++i) { r0[i] = ub(a.x, i) * fast_rcp(ub(b.x, i)); r1[i] = ub(a.y, i) * fast_rcp(ub(b.y, i)); }
                    acc[ai][bj][m][0] *= r0; acc[ai][bj][m][1] *= r1;
                }
        asm volatile("" ::: "memory");
    }
    __device__ __forceinline__ void operator()(const f32x4 (&acc)[2][2][4][2], const Unit& u, int wr, int wc, int fr, int fq) const {
        const int row0 = u.pm * 256 + wr * 64 + fr, cl0 = u.pn * 256 + wc * 32 + 8 * fq;
#pragma unroll
        for (int ai = 0; ai < 2; ++ai) {
            u32x2 g2[4][2];
#pragma unroll
            for (int m = 0; m < 4; ++m)
#pragma unroll
                for (int bj = 0; bj < 2; ++bj) g2[m][bj] = gld<u32x2>(GATES + (unsigned)((row0 + ai * 128 + m * 16) * 3072 + 2048 + cl0 + bj * 128));
#pragma unroll
            for (int m = 0; m < 4; ++m)
#pragma unroll
                for (int bj = 0; bj < 2; ++bj) {
                    const u32x2 g = g2[m][bj]; const f32x4 v0 = acc[ai][bj][m][0] * (1.0f / 255.0f), v1 = acc[ai][bj][m][1] * (1.0f / 255.0f);
                    u32x4 w; w.x = cvt_pk_bf16(v0[0] * ub(g.x, 0), v0[1] * ub(g.x, 1)); w.y = cvt_pk_bf16(v0[2] * ub(g.x, 2), v0[3] * ub(g.x, 3));
                    w.z = cvt_pk_bf16(v1[0] * ub(g.y, 0), v1[1] * ub(g.y, 1)); w.w = cvt_pk_bf16(v1[2] * ub(g.y, 2), v1[3] * ub(g.y, 3));
                    gst<u32x4>(MG + (unsigned)((row0 + ai * 128 + m * 16) * 1024 + cl0 + bj * 128), w);
                }
            asm volatile("" ::: "memory");
        }
    }
};
struct EpiResB {
    static constexpr bool PERM = true;
    const float* Xf; bf16* XB;
    __device__ __forceinline__ void operator()(const f32x4 (&acc)[2][2][4][2], const Unit& u, int wr, int wc, int fr, int fq) const {
        const int row0 = u.pm * 256 + wr * 64 + fr, cl0 = u.pn * 256 + wc * 32 + 8 * fq;
#pragma unroll
        for (int ai = 0; ai < 2; ++ai)
#pragma unroll
            for (int mh = 0; mh < 2; ++mh) {
                f32x4 b0[2][2], b1[2][2];
#pragma unroll
                for (int mm = 0; mm < 2; ++mm)
#pragma unroll
                    for (int bj = 0; bj < 2; ++bj) { const unsigned off = (unsigned)((row0 + ai * 128 + (mh * 2 + mm) * 16) * 1024 + cl0 + bj * 128);
                        if (Xf) { b0[mm][bj] = gld<f32x4>(Xf + off); b1[mm][bj] = gld<f32x4>(Xf + off + 4); }
                        else { const u32x4 a = gld<u32x4>(XB + off); b0[mm][bj] = (f32x4){bflo(a.x), bfhi(a.x), bflo(a.y), bfhi(a.y)}; b1[mm][bj] = (f32x4){bflo(a.z), bfhi(a.z), bflo(a.w), bfhi(a.w)}; } }
#pragma unroll
                for (int mm = 0; mm < 2; ++mm)
#pragma unroll
                    for (int bj = 0; bj < 2; ++bj) { const unsigned off = (unsigned)((row0 + ai * 128 + (mh * 2 + mm) * 16) * 1024 + cl0 + bj * 128);
                        const f32x4 v0 = b0[mm][bj] + acc[ai][bj][mh * 2 + mm][0], v1 = b1[mm][bj] + acc[ai][bj][mh * 2 + mm][1];
                        u32x4 w; w.x = cvt_pk_bf16(v0[0], v0[1]); w.y = cvt_pk_bf16(v0[2], v0[3]); w.z = cvt_pk_bf16(v1[0], v1[1]); w.w = cvt_pk_bf16(v1[2], v1[3]);
                        gst<u32x4>(XB + off, w); }
                asm volatile("" ::: "memory");
            }
    }
};
struct EpiMoe1 {
    static constexpr bool PERM = true;
    bf16* ACT; const float* wts;
    __device__ __forceinline__ void operator()(const f32x4 (&acc)[2][2][4][2], const Unit& u, int wr, int wc, int fr, int fq) const {
        const int r0 = wr * 64 + fr, cl0 = wc * 32 + 8 * fq, es = u.pn >> 1;
        float wv[2][4], rv[2][4];
#pragma unroll
        for (int ai = 0; ai < 2; ++ai)
#pragma unroll
            for (int m = 0; m < 4; ++m) { const int slot = u.x1 + r0 + ai * 128 + m * 16; const f32x4 t = slot < u.x2 ? gld<f32x4>(wts + (unsigned)((u.x0 * LCAP + slot) * 4)) : (f32x4){0.f, 0.f, 0.f, 0.f}; wv[ai][m] = es ? t[1] : t[0]; rv[ai][m] = t[2]; }
#pragma unroll
        for (int ai = 0; ai < 2; ++ai)
#pragma unroll
            for (int m = 0; m < 4; ++m) {
                const int r = r0 + ai * 128 + m * 16; const float w = wv[ai][m], rs = rv[ai][m];
#pragma unroll
                for (int bj = 0; bj < 2; ++bj) {
                    const f32x4 v0 = acc[ai][bj][m][0] * rs, v1 = acc[ai][bj][m][1] * rs;
                    const int col = cl0 + bj * 128;
                    u32x2 o; o.x = cvt_pk_bf16(v0[0] * sigmoid_f(v0[0]) * v0[1] * w, v0[2] * sigmoid_f(v0[2]) * v0[3] * w); o.y = cvt_pk_bf16(v1[0] * sigmoid_f(v1[0]) * v1[1] * w, v1[2] * sigmoid_f(v1[2]) * v1[3] * w);
                    gst<u32x2>(ACT + (unsigned)((u.pm * 256 + r) * 512 + es * 256 + (u.pn & 1) * 128 + (col >> 1)), o);
                }
                asm volatile("" ::: "memory");
            }
    }
};
struct EpiMoe2 {
    static constexpr bool PERM = true;
    bf16* XBo; const int* list; bf16* XB; float* SSP;
    __device__ __forceinline__ void operator()(const f32x4 (&acc)[2][2][4][2], const Unit& u, int wr, int wc, int fr, int fq) const {
        const int r0 = wr * 64 + fr, cl0 = u.pn * 256 + wc * 32 + 8 * fq, ln = fq * 16 + fr;
        int tok[2][4];
#pragma unroll
        for (int ai = 0; ai < 2; ++ai)
#pragma unroll
            for (int m = 0; m < 4; ++m) { const int slot = u.x1 + r0 + ai * 128 + m * 16; tok[ai][m] = slot < u.x2 ? gld<int>(list + (unsigned)(u.x0 * LCAP + slot)) : -1; }
        {
#pragma unroll
            for (int ai = 0; ai < 2; ++ai) {
                u32x4 xb[4][2];
#pragma unroll
                for (int m = 0; m < 4; ++m)
#pragma unroll
                    for (int bj = 0; bj < 2; ++bj) xb[m][bj] = tok[ai][m] >= 0 ? gld<u32x4>(XB + (unsigned)(tok[ai][m] * 1024 + cl0 + bj * 128)) : (u32x4){0u, 0u, 0u, 0u};
#pragma unroll
                for (int m = 0; m < 4; ++m) {
                    const int t = tok[ai][m]; float ssp = 0.f;
#pragma unroll
                    for (int bj = 0; bj < 2; ++bj) { const u32x4 a = xb[m][bj]; f32x4 v0 = acc[ai][bj][m][0], v1 = acc[ai][bj][m][1];
                        v0[0] += bflo(a.x); v0[1] += bfhi(a.x); v0[2] += bflo(a.y); v0[3] += bfhi(a.y); v1[0] += bflo(a.z); v1[1] += bfhi(a.z); v1[2] += bflo(a.w); v1[3] += bfhi(a.w);
                        ssp += ((v0[0] * v0[0] + v0[1] * v0[1]) + (v0[2] * v0[2] + v0[3] * v0[3])) + ((v1[0] * v1[0] + v1[1] * v1[1]) + (v1[2] * v1[2] + v1[3] * v1[3]));
                        u32x4 w; w.x = cvt_pk_bf16(v0[0], v0[1]); w.y = cvt_pk_bf16(v0[2], v0[3]); w.z = cvt_pk_bf16(v1[0], v1[1]); w.w = cvt_pk_bf16(v1[2], v1[3]);
                        if (t >= 0) gst<u32x4>(XBo + (unsigned)(t * 1024 + cl0 + bj * 128), w); }
                    ssp += shfl_xor_f(ssp, 16, ln); ssp += shfl_xor_f(ssp, 32, ln);
                    if (SSP && fq == 0 && t >= 0) __hip_atomic_store((GASP float*)(SSP + (unsigned)(t * 16 + u.pn * 4 + wc)), ssp, __ATOMIC_RELAXED, __HIP_MEMORY_SCOPE_AGENT);
                }
                asm volatile("" ::: "memory");
            }
        }
    }
};
#define XB_TMO      128
#define XB_XCNT(j)  (256  + 64 * (j))
#define XB_XSUB(j)  (1280 + 64 * (j))
#define XB_XGEN(j)  (2304 + 64 * (j))
#define XB_TOP      3328
#define XB_TOPGEN   3392
#define XCD_BAR_WORDS 3456
#define XB_SPIN_CAP (1u << 18)
__device__ __forceinline__ unsigned xb_ld(unsigned* p)              { return __hip_atomic_load((__attribute__((address_space(1))) unsigned*)p, __ATOMIC_RELAXED, __HIP_MEMORY_SCOPE_AGENT); }
__device__ __forceinline__ unsigned xb_add(unsigned* p, unsigned v) { return __hip_atomic_fetch_add((__attribute__((address_space(1))) unsigned*)p, v, __ATOMIC_RELAXED, __HIP_MEMORY_SCOPE_AGENT); }
__device__ __forceinline__ unsigned xb_xcc_id() { return (unsigned)__builtin_amdgcn_s_getreg((3 << 11) | 20) & 0xFu; }
#define XB_SPIN(cond, bar) do { unsigned _sp = 0; while (cond) { __builtin_amdgcn_s_sleep(1); \
    if ((++_sp & 255u) == 0u) { if (xb_ld(&(bar)[XB_TMO])) break; if (_sp > XB_SPIN_CAP) { atomicAdd(&(bar)[XB_TMO], 1u); break; } } } } while (0)
struct XcdBarrier { unsigned* bar; unsigned x; volatile LAS unsigned* st; };
__device__ __forceinline__ XcdBarrier xcd_barrier_post(unsigned* bar, volatile LAS unsigned* st) {
    XcdBarrier b; b.bar = bar; b.x = xb_xcc_id(); b.st = st;
    if (threadIdx.x == 0) (void)xb_add(&bar[XB_XCNT(b.x)], 1u);
    return b;
}
__device__ __forceinline__ void xcd_barrier_complete(unsigned* bar, unsigned x, unsigned& nloc, unsigned& nx) {
    const unsigned G = gridDim.x * gridDim.y * gridDim.z;
    unsigned sum, cnt, mine, sp = 0u;
    for (;;) {
        sum = 0u; cnt = 0u; mine = 0u;
#pragma unroll
        for (unsigned j = 0; j < 16; ++j) { const unsigned c = xb_ld(&bar[XB_XCNT(j)]); sum += c; cnt += (c > 0u) ? 1u : 0u; mine = (j == x) ? c : mine; }
        if (sum == G) break;
        __builtin_amdgcn_s_sleep(1);
        if ((++sp & 255u) == 0u) { if (xb_ld(&bar[XB_TMO])) break; if (sp > XB_SPIN_CAP) { atomicAdd(&bar[XB_TMO], 1u); break; } }
    }
    nloc = mine > 0u ? mine : 1u; nx = cnt > 0u ? cnt : 1u;
}
__device__ __forceinline__ void xcd_barrier(const XcdBarrier& b, bool is_t0) {
    asm volatile("s_waitcnt vmcnt(0)" ::: "memory");
    __syncthreads();
    if (is_t0) {
        unsigned* bar = b.bar;
        __builtin_amdgcn_s_waitcnt(0);
        unsigned nloc = b.st[0], nx = b.st[1];
        if (nloc == 0u) { xcd_barrier_complete(bar, b.x, nloc, nx); b.st[0] = nloc; b.st[1] = nx; }
        const unsigned old = xb_add(&bar[XB_XSUB(b.x)], 1u);
        const unsigned gen = old / nloc;
        if (old + 1u == (gen + 1u) * nloc) {
            __builtin_amdgcn_fence(__ATOMIC_RELEASE, "agent");
            asm volatile("s_waitcnt vmcnt(0)" ::: "memory");
            const unsigned og = xb_add(&bar[XB_TOP], 1u);
            const unsigned tg = og / nx;
            if (og + 1u == (tg + 1u) * nx) xb_add(&bar[XB_TOPGEN], 1u);
            else XB_SPIN(xb_ld(&bar[XB_TOPGEN]) == tg, bar);
            __builtin_amdgcn_fence(__ATOMIC_ACQUIRE, "agent");
            xb_add(&bar[XB_XGEN(b.x)], 1u);
            asm volatile("s_waitcnt vmcnt(0)" ::: "memory");
        } else {
            XB_SPIN(xb_ld(&bar[XB_XGEN(b.x)]) == gen, bar);
            __builtin_amdgcn_fence(__ATOMIC_ACQUIRE, "agent");
            asm volatile("s_waitcnt vmcnt(0)" ::: "memory");
        }
    }
    __syncthreads();
}

constexpr int AT_SLOT = 8192, AT_VOFF = 9 * AT_SLOT;
__device__ __forceinline__ int kswz(int col) { return ((col >> 1) & 1) | (((col >> 3) & 3) << 1); }
template <bool NA>
__device__ __forceinline__ void attn_core(const bf16x8 (&qf)[2], const LAS unsigned char* lds, int rs, int c_lo, bf16* obase, const float* rpbp_h, int rbias0, int c0q, int lane) {
    const int n = lane & 15, q = lane >> 4, cq = c0q + n;
    f32x4 bias0[8], bias1[8];
    if (NA) {
        const float* bp = rpbp_h + (c_lo - c0q + 8 * q - n + 31);
#pragma unroll
        for (int kb = 0; kb < 8; ++kb) { bias0[kb] = gld<f32x4>(bp + (rbias0 + kb) * 64); bias1[kb] = gld<f32x4>(bp + (rbias0 + kb) * 64 + 4); }
    }
    f32x4 s[8][2];
#pragma unroll
    for (int kb = 0; kb < 8; ++kb) {
        const int slot = NA ? (rs + kb) % 9 : (kb >> 1); const int cb0 = NA ? c_lo : (kb & 1) * 32;
        const LAS unsigned char* kp = lds + slot * AT_SLOT;
#pragma unroll
        for (int blk = 0; blk < 2; ++blk) {
            const int col = cb0 + 8 * (n >> 2) + 4 * blk + (n & 3), f = kswz(col);
            const bf16x8 a0 = *(const LAS bf16x8*)(kp + col * 128 + ((q ^ f) << 4)), a1 = *(const LAS bf16x8*)(kp + col * 128 + (((4 + q) ^ f) << 4));
            f32x4 a = (f32x4){0.f, 0.f, 0.f, 0.f};
            a = __builtin_amdgcn_mfma_f32_16x16x32_bf16(a0, qf[0], a, 0, 0, 0);
            a = __builtin_amdgcn_mfma_f32_16x16x32_bf16(a1, qf[1], a, 0, 0, 0);
            s[kb][blk] = a;
        }
    }
    if (NA) {
        const int cs = min(max(cq - 8, 0), 48);
#pragma unroll
        for (int kb = 0; kb < 8; ++kb) {
            const f32x4 b0 = bias0[kb], b1 = bias1[kb];
#pragma unroll
            for (int i = 0; i < 4; ++i) {
                const int kc0 = c_lo + 8 * q + i, kc1 = kc0 + 4;
                s[kb][0][i] = (kc0 >= cs && kc0 < cs + 16) ? s[kb][0][i] + b0[i] : -1e30f;
                s[kb][1][i] = (kc1 >= cs && kc1 < cs + 16) ? s[kb][1][i] + b1[i] : -1e30f;
            }
        }
    }
    float mx = -1e30f;
#pragma unroll
    for (int kb = 0; kb < 8; ++kb)
#pragma unroll
        for (int blk = 0; blk < 2; ++blk)
#pragma unroll
            for (int i = 0; i < 4; ++i) mx = fmaxf(mx, s[kb][blk][i]);
    mx = fmaxf(mx, shfl_xor_f(mx, 16, lane)); mx = fmaxf(mx, shfl_xor_f(mx, 32, lane));
    float sum = 0.f; bf16x8 pf[8];
#pragma unroll
    for (int kb = 0; kb < 8; ++kb) {
        float p[8];
#pragma unroll
        for (int blk = 0; blk < 2; ++blk)
#pragma unroll
            for (int i = 0; i < 4; ++i) { const float e = fast_exp(s[kb][blk][i] - mx); p[blk * 4 + i] = e; sum += e; }
        u32x4 w; w.x = cvt_pk_bf16(p[0], p[1]); w.y = cvt_pk_bf16(p[2], p[3]); w.z = cvt_pk_bf16(p[4], p[5]); w.w = cvt_pk_bf16(p[6], p[7]);
        pf[kb] = __builtin_bit_cast(bf16x8, w);
    }
    sum += shfl_xor_f(sum, 16, lane); sum += shfl_xor_f(sum, 32, lane);
    const float inv = fast_rcp(sum);
#pragma unroll
    for (int db = 0; db < 4; ++db) {
        f32x4 o = (f32x4){0.f, 0.f, 0.f, 0.f};
#pragma unroll
        for (int kb = 0; kb < 8; ++kb) {
            const int slot = NA ? (rs + kb) % 9 : (kb >> 1); const int cb0 = NA ? c_lo : (kb & 1) * 32;
            const bf16x8 vf = *(const LAS bf16x8*)(lds + AT_VOFF + slot * AT_SLOT + ((((cb0 >> 3) + q) * 64 + db * 16 + n) << 4));
            o = __builtin_amdgcn_mfma_f32_16x16x32_bf16(vf, pf[kb], o, 0, 0, 0);
        }
        u32x2 w; w.x = cvt_pk_bf16(o[0] * inv, o[1] * inv); w.y = cvt_pk_bf16(o[2] * inv, o[3] * inv);
        gst<u32x2>(obase + (unsigned)(n * 1024 + 4 * q) + db * 16, w);
    }
}

constexpr int NWAVES = 8;
constexpr int RING_BYTES = 131072, ATT_BYTES = 147456, MISC_OFF = ATT_BYTES, TAB_OFF = MISC_OFF + 256, LDS_BYTES = 163840;
struct Args { const float* in[30]; float* out; unsigned char* ws; };
struct Frame { LAS unsigned char* lds; int tid, lane, wave, vcu, G; };
enum { I_X = 0, I_MEM, I_NMIX, I_NFFN, I_NMEM, I_WIN, I_BGATE, I_RPB, I_LRE, I_LIM, I_LDT, I_BRE, I_BIM, I_CRE, I_CIM, I_S5D, I_WGLU, I_WMKV, I_WBNA, I_WBS5, I_WBXA, I_WOUT,
       I_WCO, I_BCO, I_WFI, I_BFI, I_WG, I_WU, I_WD, I_FNORM };

__device__ __forceinline__ void transpose_item(const float* W, int ldn, int k0, int n0, bf16* WT, int ldk, int dk0, int row_off, int rmul, int radd, int qs, const float* kscale, LAS float* scr, int lane) {
    { float t[32]; const float* wp = W + (size_t)(k0 + (lane >> 5)) * ldn + n0 + (lane & 31);
#pragma unroll
      for (int i = 0; i < 32; ++i) t[i] = gld<float>(wp + (size_t)(2 * i) * ldn);
#pragma unroll
      for (int i = 0; i < 32; ++i) scr[(2 * i + (lane >> 5)) * 33 + (lane & 31)] = t[i]; }
    LDS_WAIT(); asm volatile("" ::: "memory");
    const int c = lane & 7;
    f32x4 ka = (f32x4){1.f, 1.f, 1.f, 1.f}, kb = ka;
    if (kscale) { ka = gld<f32x4>(kscale + k0 + 8 * c); kb = gld<f32x4>(kscale + k0 + 8 * c + 4); }
#pragma unroll
    for (int j = 0; j < 4; ++j) { const int n = (lane >> 3) + 8 * j, nn = n0 + n; const LAS float* s = scr + (8 * c) * 33 + n;
        const float sc = (qs && (nn < 512 || (nn >= 1792 && nn < 2048))) ? 0.125f : 1.0f;
        u32x4 o; o.x = cvt_pk_bf16(s[0 * 33] * sc * ka[0], s[1 * 33] * sc * ka[1]); o.y = cvt_pk_bf16(s[2 * 33] * sc * ka[2], s[3 * 33] * sc * ka[3]); o.z = cvt_pk_bf16(s[4 * 33] * sc * kb[0], s[5 * 33] * sc * kb[1]); o.w = cvt_pk_bf16(s[6 * 33] * sc * kb[2], s[7 * 33] * sc * kb[3]);
        gst<u32x4>(WT + (size_t)(row_off + nn * rmul + radd) * ldk + dk0 + k0 + 8 * c, o); }
    LDS_WAIT(); asm volatile("" ::: "memory");
}
__device__ __forceinline__ void transpose_job_item(const float* W, int ldn, int N, int it, bf16* WT, int ldk, int dk0, int row_off, int rmul, int radd, int qs, const float* kscale, LAS float* scr, int lane) {
    const int nblk = N / 32, kb = it / nblk, nb = it % nblk;
    transpose_item(W, ldn, 64 * kb, 32 * nb, WT, ldk, dk0, row_off, rmul, radd, qs, kscale, scr, lane);
}

__device__ __forceinline__ void cexp_d(double zr, double zi, double& er, double& ei) {
    const double wr_ = zr * (1.0 / 1024.0), wi_ = zi * (1.0 / 1024.0);
    double tr = 1.0, ti = 0.0;
#pragma unroll
    for (int n = 12; n >= 1; --n) { const double ar = wr_ * (1.0 / n), ai = wi_ * (1.0 / n); const double nr = 1.0 + (ar * tr - ai * ti), ni = ar * ti + ai * tr; tr = nr; ti = ni; }
#pragma unroll
    for (int k = 0; k < 10; ++k) { const double nr = tr * tr - ti * ti, ni = 2.0 * tr * ti; tr = nr; ti = ni; }
    er = tr; ei = ti;
}

template <bool ROUTER>
__device__ __forceinline__ void norm_rows4(const float* X, const float* gain, bf16* H, int row0, int lane,
                                           const float* wrt, const float* bco, const float* bfi, unsigned* cnt, int* list, float* wts, float* Xout = nullptr) {
    f32x4 x[4][4]; float rstd[4];
#pragma unroll
    for (int r = 0; r < 4; ++r) { float ss = 0.f;
#pragma unroll
        for (int j = 0; j < 4; ++j) { x[r][j] = gld<f32x4>(X + (size_t)(row0 + r) * 1024 + 256 * j + 4 * lane);
            if (Xout) { const u32x2 d = gld<u32x2>(H + (size_t)(row0 + r) * 1024 + 256 * j + 4 * lane); x[r][j][0] += bflo(d.x); x[r][j][1] += bfhi(d.x); x[r][j][2] += bflo(d.y); x[r][j][3] += bfhi(d.y);
                gst<f32x4>(Xout + (size_t)(row0 + r) * 1024 + 256 * j + 4 * lane, x[r][j]); }
            ss += (x[r][j][0] * x[r][j][0] + x[r][j][1] * x[r][j][1]) + (x[r][j][2] * x[r][j][2] + x[r][j][3] * x[r][j][3]); }
        ss = wave_sum(ss, lane); rstd[r] = 1.0f / sqrtf(ss * (1.0f / 1024.0f) + RMS_EPS); }
#pragma unroll
    for (int j = 0; j < 4; ++j) { const f32x4 g4 = ROUTER ? gld<f32x4>(gain + 256 * j + 4 * lane) : (f32x4){1.f, 1.f, 1.f, 1.f};
#pragma unroll
        for (int r = 0; r < 4; ++r) { const f32x4 v = ROUTER ? x[r][j] * rstd[r] * g4 : x[r][j]; u32x2 w; w.x = cvt_pk_bf16(v[0], v[1]); w.y = cvt_pk_bf16(v[2], v[3]);
            gst<u32x2>(H + (size_t)(row0 + r) * 1024 + 256 * j + 4 * lane, w); } }
    if (!ROUTER && wts && lane < 4) { float rr = rstd[0]; rr = lane == 1 ? rstd[1] : rr; rr = lane == 2 ? rstd[2] : rr; rr = lane == 3 ? rstd[3] : rr; gst<float>(wts + row0 + lane, rr); }
    if constexpr (ROUTER) {
        float keep[4] = {0.f, 0.f, 0.f, 0.f};
#pragma unroll 2
        for (int c = 0; c < 20; ++c) {
            float a0 = 0.f, a1 = 0.f, a2 = 0.f, a3 = 0.f;
#pragma unroll
            for (int j = 0; j < 4; ++j) { const f32x4 w4 = gld<f32x4>(wrt + c * 1024 + 256 * j + 4 * lane);
                a0 += (x[0][j][0] * w4[0] + x[0][j][1] * w4[1]) + (x[0][j][2] * w4[2] + x[0][j][3] * w4[3]);
                a1 += (x[1][j][0] * w4[0] + x[1][j][1] * w4[1]) + (x[1][j][2] * w4[2] + x[1][j][3] * w4[3]);
                a2 += (x[2][j][0] * w4[0] + x[2][j][1] * w4[1]) + (x[2][j][2] * w4[2] + x[2][j][3] * w4[3]);
                a3 += (x[3][j][0] * w4[0] + x[3][j][1] * w4[1]) + (x[3][j][2] * w4[2] + x[3][j][3] * w4[3]); }
            a0 = wave_sum(a0, lane); a1 = wave_sum(a1, lane); a2 = wave_sum(a2, lane); a3 = wave_sum(a3, lane);
            if (lane == c) { keep[0] = a0 * rstd[0]; keep[1] = a1 * rstd[1]; keep[2] = a2 * rstd[2]; keep[3] = a3 * rstd[3]; }
        }
#pragma unroll
        for (int r = 0; r < 4; ++r) {
            float co[4];
#pragma unroll
            for (int i = 0; i < 4; ++i) co[i] = shfl_idx_f(keep[r], i) + bco[i];
            int grp = 0; float cm = co[0];
#pragma unroll
            for (int i = 1; i < 4; ++i) if (co[i] > cm) { cm = co[i]; grp = i; }
            float den = 0.f;
#pragma unroll
            for (int i = 0; i < 4; ++i) den += __expf(co[i] - cm);
            const float pgrp = 1.0f / den;
            float fv[4];
#pragma unroll
            for (int i = 0; i < 4; ++i) fv[i] = shfl_idx_f(keep[r], 4 + grp * 4 + i) + bfi[grp * 4 + i];
            int i1 = 0; float v1 = fv[0];
#pragma unroll
            for (int i = 1; i < 4; ++i) if (fv[i] > v1) { v1 = fv[i]; i1 = i; }
            int i2 = -1; float v2 = -3.0e38f;
#pragma unroll
            for (int i = 0; i < 4; ++i) if (i != i1 && fv[i] > v2) { v2 = fv[i]; i2 = i; }
            const float w1 = pgrp / (1.0f + __expf(v2 - v1)), w2 = pgrp - w1;
            const int a = i1 < i2 ? i1 : i2, b = i1 < i2 ? i2 : i1;
            const int pidx = a == 0 ? b - 1 : (a == 1 ? b + 1 : 5);
            const int bucket = grp * 6 + pidx;
            const float wa = (i1 == a) ? w1 : w2, wb = (i1 == a) ? w2 : w1;
            if (lane == 0) {
                const unsigned slot = __hip_atomic_fetch_add(cnt + bucket * 64, 1u, __ATOMIC_RELAXED, __HIP_MEMORY_SCOPE_AGENT);
                list[(size_t)bucket * LCAP + slot] = row0 + r;
                gst<f32x2>(wts + ((size_t)bucket * LCAP + slot) * 2, (f32x2){wa, wb});
            }
        }
    }
}

constexpr int RT_STRIDE = 2064;
constexpr int RT_BYTES = 40 * RT_STRIDE;
constexpr int RT_SCR = 98304;
__device__ __forceinline__ void router_rows16(const float* X, const bf16* XBi, const bf16* DH, bf16* XB, int R0, int lane, LAS unsigned char* lds, int wave,
                                              const float* bco, const float* bfi, unsigned* cnt, int* list, float* wts) {
    const int n = lane & 15, q = lane >> 4;
    f32x4 accF = (f32x4){0.f, 0.f, 0.f, 0.f}, accC = (f32x4){0.f, 0.f, 0.f, 0.f};
    float ss = 0.f;
    const unsigned xo = (unsigned)((R0 + n) * 1024 + 8 * q);
    const LAS unsigned char* tF = lds + n * RT_STRIDE + 16 * q; const LAS unsigned char* tC = lds + (16 + (n & 3)) * RT_STRIDE + 16 * q;
#pragma unroll 4
    for (int ks = 0; ks < 32; ++ks) {
        f32x4 x0, x1;
        if (XBi) { const u32x4 xb = gld<u32x4>(XBi + xo + ks * 32); x0 = (f32x4){bflo(xb.x), bfhi(xb.x), bflo(xb.y), bfhi(xb.y)}; x1 = (f32x4){bflo(xb.z), bfhi(xb.z), bflo(xb.w), bfhi(xb.w)}; }
        else { x0 = gld<f32x4>(X + xo + ks * 32); x1 = gld<f32x4>(X + xo + ks * 32 + 4); }
        if (DH) { const u32x4 d = gld<u32x4>(DH + xo + ks * 32); x0[0] += bflo(d.x); x0[1] += bfhi(d.x); x0[2] += bflo(d.y); x0[3] += bfhi(d.y); x1[0] += bflo(d.z); x1[1] += bfhi(d.z); x1[2] += bflo(d.w); x1[3] += bfhi(d.w); }
        ss += (x0[0] * x0[0] + x0[1] * x0[1]) + (x0[2] * x0[2] + x0[3] * x0[3]) + (x1[0] * x1[0] + x1[1] * x1[1]) + (x1[2] * x1[2] + x1[3] * x1[3]);
        u32x4 hw; hw.x = cvt_pk_bf16(x0[0], x0[1]); hw.y = cvt_pk_bf16(x0[2], x0[3]); hw.z = cvt_pk_bf16(x1[0], x1[1]); hw.w = cvt_pk_bf16(x1[2], x1[3]);
        u32x4 lw; lw.x = cvt_pk_bf16(x0[0] - bflo(hw.x), x0[1] - bfhi(hw.x)); lw.y = cvt_pk_bf16(x0[2] - bflo(hw.y), x0[3] - bfhi(hw.y));
        lw.z = cvt_pk_bf16(x1[0] - bflo(hw.z), x1[1] - bfhi(hw.z)); lw.w = cvt_pk_bf16(x1[2] - bflo(hw.w), x1[3] - bfhi(hw.w));
        if (XB) gst<u32x4>(XB + xo + ks * 32, hw);
        const bf16x8 ah = __builtin_bit_cast(bf16x8, hw), al = __builtin_bit_cast(bf16x8, lw);
        const bf16x8 fh = *(const LAS bf16x8*)(tF + ks * 64), fl = *(const LAS bf16x8*)(tF + 20 * RT_STRIDE + ks * 64);
        const bf16x8 ch = *(const LAS bf16x8*)(tC + ks * 64), cl = *(const LAS bf16x8*)(tC + 20 * RT_STRIDE + ks * 64);
        accF = __builtin_amdgcn_mfma_f32_16x16x32_bf16(ah, fh, accF, 0, 0, 0); accF = __builtin_amdgcn_mfma_f32_16x16x32_bf16(ah, fl, accF, 0, 0, 0); accF = __builtin_amdgcn_mfma_f32_16x16x32_bf16(al, fh, accF, 0, 0, 0);
        accC = __builtin_amdgcn_mfma_f32_16x16x32_bf16(ah, ch, accC, 0, 0, 0); accC = __builtin_amdgcn_mfma_f32_16x16x32_bf16(ah, cl, accC, 0, 0, 0); accC = __builtin_amdgcn_mfma_f32_16x16x32_bf16(al, ch, accC, 0, 0, 0);
    }
    ss += shfl_xor_f(ss, 16, lane); ss += shfl_xor_f(ss, 32, lane);
    const float rstd = 1.0f / sqrtf(ss * (1.0f / 1024.0f) + RMS_EPS);
    LAS float* sc = (LAS float*)(lds + RT_SCR + wave * 1536);
#pragma unroll
    for (int r = 0; r < 4; ++r) { const float rs = shfl_idx_f(rstd, 4 * q + r); sc[(4 * q + r) * 24 + n] = accF[r] * rs; if (n < 4) sc[(4 * q + r) * 24 + 16 + n] = accC[r] * rs; }
    LDS_WAIT(); asm volatile("" ::: "memory");
    if (lane < 16) {
        const LAS float* my = sc + lane * 24;
        float co[4];
#pragma unroll
        for (int i = 0; i < 4; ++i) co[i] = my[16 + i] + gld<float>(bco + i);
        int grp = 0; float cm = co[0];
#pragma unroll
        for (int i = 1; i < 4; ++i) if (co[i] > cm) { cm = co[i]; grp = i; }
        float den = 0.f;
#pragma unroll
        for (int i = 0; i < 4; ++i) den += __expf(co[i] - cm);
        const float pgrp = 1.0f / den;
        float fv[4];
#pragma unroll
        for (int i = 0; i < 4; ++i) fv[i] = my[grp * 4 + i] + gld<float>(bfi + grp * 4 + i);
        int i1 = 0; float v1 = fv[0];
#pragma unroll
        for (int i = 1; i < 4; ++i) if (fv[i] > v1) { v1 = fv[i]; i1 = i; }
        int i2 = -1; float v2 = -3.0e38f;
#pragma unroll
        for (int i = 0; i < 4; ++i) if (i != i1 && fv[i] > v2) { v2 = fv[i]; i2 = i; }
        const float w1 = pgrp / (1.0f + __expf(v2 - v1)), w2 = pgrp - w1;
        const int a = i1 < i2 ? i1 : i2, b = i1 < i2 ? i2 : i1;
        const int pidx = a == 0 ? b - 1 : (a == 1 ? b + 1 : 5);
        const int bucket = grp * 6 + pidx;
        const float wa = (i1 == a) ? w1 : w2, wb = (i1 == a) ? w2 : w1;
        const unsigned slot = __hip_atomic_fetch_add((GASP unsigned*)(cnt + bucket * 64), 1u, __ATOMIC_RELAXED, __HIP_MEMORY_SCOPE_AGENT);
        gst<int>(list + ((unsigned)(bucket * LCAP) + slot), R0 + lane);
        gst<f32x4>(wts + ((unsigned)(bucket * LCAP) + slot) * 4, (f32x4){wa, wb, rstd, 0.f});
    }
}

__device__ __forceinline__ void final_norm_row(const bf16* XB, float* out, const float* gain, int row, int lane) {
    f32x4 x[4]; float ss = 0.f;
#pragma unroll
    for (int j = 0; j < 4; ++j) { const unsigned off = (unsigned)(row * 1024 + 256 * j + 4 * lane); const u32x2 a = gld<u32x2>(XB + off);
        x[j] = (f32x4){bflo(a.x), bfhi(a.x), bflo(a.y), bfhi(a.y)};
        ss += (x[j][0] * x[j][0] + x[j][1] * x[j][1]) + (x[j][2] * x[j][2] + x[j][3] * x[j][3]); }
    ss = wave_sum(ss, lane); const float rstd = 1.0f / sqrtf(ss * (1.0f / 1024.0f) + RMS_EPS);
#pragma unroll
    for (int j = 0; j < 4; ++j) { const f32x4 g4 = gld<f32x4>(gain + 256 * j + 4 * lane); gst<f32x4>(out + (size_t)row * 1024 + 256 * j + 4 * lane, x[j] * rstd * g4); }
}

__device__ __forceinline__ void s5_scan_item(int item, const float* ST, bf16* At, const f32x2* apow_l, LAS float* sc, int tid) {
    const int d = item & 1, bg = item >> 1, g = bg & 15, seg = tid >> 6, p = tid & 63;
    const f32x2 A32 = gld<f32x2>(apow_l + ((d * 16 + g) * 33 + 32) * 64 + p);
    const int chunk0 = d ? 255 - seg * 32 : seg * 32; const long cstep = d ? -1 : 1;
    const float* rp0 = ST + (size_t)(bg * 256 + chunk0) * 256 + d * 128 + p;
    float tr = 0.f, ti = 0.f;
#pragma unroll 8
    for (int j = 0; j < 32; ++j) { const float* rp = rp0 + cstep * j * 256; const float sr = gld<float>(rp), si = gld<float>(rp + 64); const float nr = A32.x * tr - A32.y * ti + sr, ni = A32.x * ti + A32.y * tr + si; tr = nr; ti = ni; }
    sc[(seg * 64 + p) * 2] = tr; sc[(seg * 64 + p) * 2 + 1] = ti;
    __syncthreads();
    float pr = A32.x, pi = A32.y;
#pragma unroll
    for (int k = 0; k < 5; ++k) { const float nr = pr * pr - pi * pi, ni = 2.f * pr * pi; pr = nr; pi = ni; }
    float er = 0.f, ei = 0.f;
    for (int s2 = 0; s2 < seg; ++s2) { const float qr = sc[(s2 * 64 + p) * 2], qi = sc[(s2 * 64 + p) * 2 + 1]; const float nr = pr * er - pi * ei + qr, ni = pr * ei + pi * er + qi; er = nr; ei = ni; }
    bf16* op0 = At + (size_t)(bg * 256 + chunk0) * ATK + 512 + d * 128 + p;
#pragma unroll 8
    for (int j = 0; j < 32; ++j) { const float* rp = rp0 + cstep * j * 256; const float sr = gld<float>(rp), si = gld<float>(rp + 64); bf16* op = op0 + cstep * j * ATK;
        gst<bf16>(op, (bf16)(cvt_pk_bf16(er, er) & 0xffffu)); gst<bf16>(op + 64, (bf16)(cvt_pk_bf16(ei, ei) & 0xffffu));
        const float nr = A32.x * er - A32.y * ei + sr, ni = A32.x * ei + A32.y * er + si; er = nr; ei = ni; }
    __syncthreads();
}

#define NA_ITEM(item) do { \
    const bf16* QK = WP(bf16, WS_QK); const bf16* VT8 = WP(bf16, WS_VT8); bf16* Hn = WP(bf16, WS_H); const float* RPBP = WP(float, WS_RPBP); \
    const int n = lane & 15, q = lane >> 4, cb = wave & 3, qsel = wave >> 2, c_lo = cb == 0 ? 0 : (cb == 1 ? 8 : (cb == 2 ? 24 : 32)); \
    const int kcol = tid >> 3, kdst = kcol * 128 + (((tid & 7) ^ kswz(kcol)) << 4); \
    const int b = (item) >> 7, h = ((item) >> 4) & 7, r0 = ((item) & 15) * 8; \
    const bf16* Kg = QK + (size_t)b * SEQ * 1024 + 512 + h * 64 + (unsigned)(kcol * 1024 + (tid & 7) * 8); \
    const bf16* Vg = VT8 + (size_t)(b * 8 + h) * 1024 * 512 + (unsigned)(tid * 8); \
    const float* rp = RPBP + (size_t)(l * 8 + h) * 15 * 64; \
    int hi = min(max(r0 + 1 - 4, 0), 120) + 7; \
    { const int lo = min(max(r0 - 4, 0), 120); \
      u32x4 kv[9], vv[9]; \
      _Pragma("unroll") for (int j = 0; j < 9; ++j) { const int kr = min(lo + j, 127); kv[j] = gld<u32x4>(Kg + (size_t)kr * 65536); vv[j] = gld<u32x4>(Vg + (size_t)kr * 4096); } \
      _Pragma("unroll") for (int j = 0; j < 9; ++j) { const int kr = lo + j; if (kr <= hi) { const int slot = kr % 9; *(LAS u32x4*)(F.lds + slot * AT_SLOT + kdst) = kv[j]; *(LAS u32x4*)(F.lds + AT_VOFF + slot * AT_SLOT + tid * 16) = vv[j]; } } \
    } \
    bf16x8 qf[2]; \
    { const bf16* qb = QK + (size_t)(b * SEQ + (r0 + qsel) * 64 + cb * 16) * 1024 + h * 64 + (unsigned)(n * 1024 + 8 * q); qf[0] = gld<bf16x8>(qb); qf[1] = gld<bf16x8>(qb + 32); } \
    __syncthreads(); \
    _Pragma("unroll 1") for (int st = 0; st < 4; ++st) { \
        const int r = r0 + 2 * st + qsel, rs = min(max(r - 4, 0), 120); \
        const bool more = st < 3; \
        const int hi_next = more ? min(max(r0 + 2 * st + 3 - 4, 0), 120) + 7 : hi; \
        const int kr1 = hi + 1, kr2 = hi + 2; \
        u32x4 k1 = (u32x4){0u, 0u, 0u, 0u}, v1 = k1, k2 = k1, v2 = k1; bf16x8 qn[2]; qn[0] = qf[0]; qn[1] = qf[1]; \
        if (more) { \
            k1 = gld<u32x4>(Kg + (size_t)min(kr1, 127) * 65536); v1 = gld<u32x4>(Vg + (size_t)min(kr1, 127) * 4096); \
            k2 = gld<u32x4>(Kg + (size_t)min(kr2, 127) * 65536); v2 = gld<u32x4>(Vg + (size_t)min(kr2, 127) * 4096); \
            const bf16* qb = QK + (size_t)(b * SEQ + (r + 2) * 64 + cb * 16) * 1024 + h * 64 + (unsigned)(n * 1024 + 8 * q); qn[0] = gld<bf16x8>(qb); qn[1] = gld<bf16x8>(qb + 32); \
        } \
        attn_core<true>(qf, F.lds, rs, c_lo, Hn + (size_t)(b * SEQ + r * 64 + cb * 16) * 1024 + h * 64, rp, rs - r + 7, cb * 16, lane); \
        __syncthreads(); \
        if (more) { \
            if (kr1 <= hi_next) { const int slot = kr1 % 9; *(LAS u32x4*)(F.lds + slot * AT_SLOT + kdst) = k1; *(LAS u32x4*)(F.lds + AT_VOFF + slot * AT_SLOT + tid * 16) = v1; } \
            if (kr2 <= hi_next) { const int slot = kr2 % 9; *(LAS u32x4*)(F.lds + slot * AT_SLOT + kdst) = k2; *(LAS u32x4*)(F.lds + AT_VOFF + slot * AT_SLOT + tid * 16) = v2; } \
            hi = hi_next; qf[0] = qn[0]; qf[1] = qn[1]; \
        } \
        __syncthreads(); \
    } } while (0)
#define WG_MEM_SYNC() do { asm volatile("s_waitcnt vmcnt(0)" ::: "memory"); __syncthreads(); __builtin_amdgcn_fence(__ATOMIC_ACQUIRE, "agent"); asm volatile("s_waitcnt vmcnt(0)" ::: "memory"); } while (0)

#define XA_ITEMS(first, last, stride) do { \
    const bf16* QX = WP(bf16, WS_QX); const bf16* KM = WP(bf16, WS_KM); const bf16* VM8 = WP(bf16, WS_VM8); bf16* Hx = WP(bf16, WS_H); \
    const int n_ = lane & 15, q_ = lane >> 4, kcol = tid >> 3, kdst = kcol * 128 + (((tid & 7) ^ kswz(kcol)) << 4); \
    for (int item = (first); item < (last); item += (stride)) { \
        const int b = item >> 6, h = (item >> 4) & 3, qc = item & 15; \
        const bf16* Kg = KM + ((size_t)(l * 4 + b) * 256) * 256 + h * 64 + (unsigned)(kcol * 256 + (tid & 7) * 8); \
        const bf16* Vg = VM8 + (size_t)((l * 4 + b) * 4 + h) * 32 * 512 + (unsigned)(tid * 8); \
        _Pragma("unroll") for (int j = 0; j < 4; ++j) { const u32x4 kv = gld<u32x4>(Kg + j * 64 * 256), vv = gld<u32x4>(Vg + j * 4096); \
            *(LAS u32x4*)(F.lds + j * AT_SLOT + kdst) = kv; *(LAS u32x4*)(F.lds + AT_VOFF + j * AT_SLOT + tid * 16) = vv; } \
        __syncthreads(); \
        _Pragma("unroll 1") for (int j = 0; j < 4; ++j) { \
            const int t0 = b * SEQ + qc * 512 + wave * 64 + j * 16; \
            bf16x8 qf[2]; { const bf16* qb = QX + (size_t)t0 * 256 + h * 64 + (unsigned)(n_ * 256 + 8 * q_); qf[0] = gld<bf16x8>(qb); qf[1] = gld<bf16x8>(qb + 32); } \
            attn_core<false>(qf, F.lds, 0, 0, Hx + (size_t)t0 * 1024 + 768 + h * 64, nullptr, 0, 0, lane); } \
        __syncthreads(); \
    } } while (0)

#ifndef PHMASK
#define PHMASK 0xffffffffu
#endif
#define PH(k) ((PHMASK >> (k)) & 1u)
#ifndef REPMASK
#define REPMASK 0u
#endif
#define NREP(k) (1 + (int)((REPMASK >> (k)) & 1u))
constexpr int PTR_OFF = MISC_OFF + 1024;
__device__ __forceinline__ const float* inp(LAS unsigned char* lds, int i, int z) {
    const LAS unsigned* q = (const LAS unsigned*)(lds + PTR_OFF + 8 * i + z);
    const unsigned lo = __builtin_amdgcn_readfirstlane(q[0]), hi = __builtin_amdgcn_readfirstlane(q[1]);
    return (const float*)(((unsigned long long)hi << 32) | lo);
}
#define WSL() unsigned char* wsl = args.ws; int wave = F.wave, bid = blockIdx.x, G = gridDim.x, zz = 0; unsigned mm_ = ~0u; asm volatile("" : "+s"(mm_)); int lane = (int)__builtin_amdgcn_mbcnt_hi(mm_, __builtin_amdgcn_mbcnt_lo(mm_, 0u)); \
    asm volatile("" : "+s"(wsl), "+s"(wave), "+v"(lane), "+s"(bid), "+s"(G), "+s"(zz)); \
    const int tid = wave * 64 + lane, vcu = (G % 8 == 0) ? (bid % 8) * (G / 8) + bid / 8 : bid, gw = vcu * NWAVES + wave, NGW = G * NWAVES, NGT = G * NWAVES * 64; \
    (void)tid; (void)gw; (void)NGW; (void)NGT; (void)wsl
#define WP(T, off) ((T*)(wsl + (off)))
#define IN(i) inp(F.lds, (i), zz)

__global__ void __launch_bounds__(NWAVES * 64, 2) fwd_kernel(Args args) {
    extern __shared__ __attribute__((aligned(16))) unsigned char lds_raw[];
    Frame F;
    F.lds = (LAS unsigned char*)lds_raw;
    F.tid = threadIdx.x; F.lane = F.tid & 63; F.wave = __builtin_amdgcn_readfirstlane(F.tid >> 6);
    F.G = gridDim.x; { const int bx = blockIdx.x; F.vcu = (F.G % 8 == 0) ? (bx % 8) * (F.G / 8) + bx / 8 : bx; }
    for (int u = F.tid; u < (LDS_BYTES - MISC_OFF) / 4; u += NWAVES * 64) ((LAS unsigned*)(F.lds + MISC_OFF))[u] = 0u;
    __syncthreads();
    if (F.tid < 30) { const unsigned long long p = (unsigned long long)args.in[F.tid]; LAS unsigned* q = (LAS unsigned*)(F.lds + PTR_OFF + 8 * F.tid); q[0] = (unsigned)p; q[1] = (unsigned)(p >> 32); }
    __syncthreads();
    (void)xcd_barrier_post((unsigned*)(args.ws + WS_CTL) + CW_BAR, (volatile LAS unsigned*)(F.lds + MISC_OFF));
#define GRID_BAR() do { unsigned char* w_ = args.ws; asm volatile("" : "+s"(w_)); XcdBarrier b_; b_.bar = (unsigned*)(w_ + WS_CTL) + CW_BAR; b_.x = xb_xcc_id(); b_.st = (volatile LAS unsigned*)(F.lds + MISC_OFF); unsigned m_ = ~0u; int wv_ = F.wave; asm volatile("" : "+s"(m_), "+s"(wv_)); \
    xcd_barrier(b_, (wv_ == 0) && (__builtin_amdgcn_mbcnt_hi(m_, __builtin_amdgcn_mbcnt_lo(m_, 0u)) == 0u)); } while (0)
#define GT() (vcu * (NWAVES * 64) + tid)
#define SCR() ((LAS float*)(F.lds + wave * 16384))

    if (PH(0)) {
        WSL();
        f32x2* APOW = WP(f32x2, WS_APOW); f32x2* BBAR = WP(f32x2, WS_BBAR); bf16* WRT = WP(bf16, WS_WRT); bf16* MEMN = WP(bf16, WS_MEMN); bf16* WMKV = WP(bf16, WS_WMKV);
        for (int it = gw; it < 1024; it += NGW) { const int l = it >> 8, r = it & 255;
            transpose_job_item(IN(I_WMKV) + (size_t)l * 1024 * 512, 512, 512, r, WMKV + (size_t)l * 512 * 1024, 1024, 0, 0, 1, 0, 0, nullptr, SCR(), lane); }
        for (int it = gw; it < 4096; it += NGW) { const int l = it >> 10, row = it & 1023;
            const float* xr = IN(I_MEM) + (size_t)row * 1024; const float* gn = IN(I_NMEM) + l * 1024;
            f32x4 x[4]; float ss = 0.f;
#pragma unroll
            for (int j = 0; j < 4; ++j) { x[j] = gld<f32x4>(xr + 256 * j + 4 * lane); ss += (x[j][0] * x[j][0] + x[j][1] * x[j][1]) + (x[j][2] * x[j][2] + x[j][3] * x[j][3]); }
            ss = wave_sum(ss, lane); const float rstd = 1.0f / sqrtf(ss * (1.0f / 1024.0f) + RMS_EPS);
#pragma unroll
            for (int j = 0; j < 4; ++j) { const f32x4 v = x[j] * rstd * gld<f32x4>(gn + 256 * j + 4 * lane); u32x2 w; w.x = cvt_pk_bf16(v[0], v[1]); w.y = cvt_pk_bf16(v[2], v[3]);
                gst<u32x2>(MEMN + (size_t)it * 1024 + 256 * j + 4 * lane, w); } }
        for (int it = GT(); it < 8192; it += NGT) {
            const int p = it & 63, ldg = it >> 6;
            const double lr = fmin((double)IN(I_LRE)[it], -1e-4), li = (double)IN(I_LIM)[it];
            double dt, dum; cexp_d((double)IN(I_LDT)[ldg], 0.0, dt, dum);
            double ar, ai; cexp_d(lr * dt, li * dt, ar, ai);
            const double den = lr * lr + li * li, fr = ((ar - 1.0) * lr + ai * li) / den, fi = (ai * lr - (ar - 1.0) * li) / den;
            const float* bre = IN(I_BRE) + (size_t)it * 16; const float* bim = IN(I_BIM) + (size_t)it * 16;
#pragma unroll 4
            for (int c = 0; c < 16; ++c) { const double br = (double)bre[c], bi = (double)bim[c];
                BBAR[(size_t)it * 16 + c] = (f32x2){(float)(fr * br - fi * bi), (float)(fr * bi + fi * br)}; }
            double pr = 1.0, pi = 0.0;
            for (int n = 0; n <= 32; ++n) { APOW[((size_t)ldg * 33 + n) * 64 + p] = (f32x2){(float)pr, (float)pi}; const double nr = pr * ar - pi * ai, ni = pr * ai + pi * ar; pr = nr; pi = ni; }
        }
        { float* RPBP = WP(float, WS_RPBP); const float* rpb = IN(I_RPB);
          for (int it = GT(); it < 4 * 8 * 15 * 64; it += NGT) { const int j = it & 63; RPBP[it] = (j >= 16 && j < 47) ? rpb[(it >> 6) * 31 + (j - 16)] : 0.f; } }
        for (int it = GT(); it < 4 * 20480; it += NGT) { const int l = it / 20480, r = it % 20480, c = r >> 10, k = r & 1023;
            const float gk = IN(I_NFFN)[l * 1024 + k];
            const float v = gk * (c < 16 ? IN(I_WFI)[(size_t)(l * 1024 + k) * 16 + c] : IN(I_WCO)[(size_t)(l * 1024 + k) * 4 + (c - 16)]);
            const unsigned hw = cvt_pk_bf16(v, v) & 0xffffu; const float lo = v - bflo(hw);
            WRT[(size_t)(l * 2 + 0) * 20480 + r] = (bf16)hw; WRT[(size_t)(l * 2 + 1) * 20480 + r] = (bf16)(cvt_pk_bf16(lo, lo) & 0xffffu); }
    }
    GRID_BAR();

    if (PH(1)) {
        WSL();
        { pg8::Gemm g{WP(bf16, WS_MEMN), WP(bf16, WS_WMKV), 1024, 1024, 1024}; pg8::MemOrder S{G, bid}; EpiMemKV E{WP(bf16, WS_KM), WP(bf16, WS_VM8)};
          pg8::gemm_phase<EpiMemKV, pg8::MemOrder>(F.lds, g, S, E, tid); }
        const f32x2* APOW = WP(f32x2, WS_APOW); const f32x2* BBAR = WP(f32x2, WS_BBAR); float* KT = WP(float, WS_KT);
        const float* CRE = IN(I_CRE); const float* CIM = IN(I_CIM); const float* S5D = IN(I_S5D);
        for (int it = GT(); it < 4 * 16 * 63 * 64; it += NGT) {
            const int c2 = (it & 3) * 4, c = (it >> 2) & 15, rest = it >> 6, tp = rest % 63, lg = rest / 63, l = lg >> 4, g = lg & 15;
            f32x4 sum = (f32x4){0.f, 0.f, 0.f, 0.f};
#pragma unroll 1
            for (int d = 0; d < 2; ++d) {
                if (d == 0 ? (tp < 31) : (tp > 31)) continue;
                const int n = d == 0 ? tp - 31 : 31 - tp, base = (l * 2 + d) * 16 + g;
                const float* cre = CRE + ((size_t)base * 16 + c) * 64; const float* cim = CIM + ((size_t)base * 16 + c) * 64;
                const f32x2* ap = APOW + ((size_t)base * 33 + n) * 64; const f32x4* bb = (const f32x4*)(BBAR + (size_t)base * 64 * 16 + c2);
#pragma unroll 8
                for (int p = 0; p < 64; ++p) { const f32x2 a = ap[p]; const f32x4 b0 = bb[p * 8], b1 = bb[p * 8 + 1]; const float cr = cre[p], ci = cim[p];
                    const float er = cr * a.x - ci * a.y, ei = cr * a.y + ci * a.x;
                    sum[0] += er * b0[0] - ei * b0[1]; sum[1] += er * b0[2] - ei * b0[3]; sum[2] += er * b1[0] - ei * b1[1]; sum[3] += er * b1[2] - ei * b1[3]; }
            }
            if (tp == 31 && c >= c2 && c < c2 + 4) sum[c - c2] += S5D[l * 256 + g * 16 + c];
            gst<f32x4>(KT + (size_t)it * 4, sum);
        }
    }
    GRID_BAR();

    const float* xin0 = (const float*)(GASP const float*)args.in[I_X];
    float* XO = (float*)(GASP float*)args.out;
#pragma unroll 1
    for (int l = 0; l < DEPTH; ++l) {
        for (int rep_ = 0; rep_ < NREP(2); ++rep_) {
        if (PH(2)) {
            WSL();
            {
            bf16* WIN = WP(bf16, WS_WIN); bf16* WCAT = WP(bf16, WS_WCAT); bf16* WOUT = WP(bf16, WS_WOUT); bf16* WGLU = WP(bf16, WS_WGLU);
            for (int it = gw; it < 3648; it += NGW) {
                int r = it;
                if (r < 2560) { transpose_job_item(IN(I_WIN) + (size_t)l * 1024 * 5120, 5120, 5120, r, WIN, 1024, 0, 0, 1, 0, 1, IN(I_NMIX) + l * 1024, SCR(), lane); continue; } r -= 2560;
                if (r < 256) { transpose_job_item(IN(I_WBNA) + (size_t)l * 512 * 1024, 1024, 1024, r, WCAT, 1024, 0, 0, 1, 0, 0, nullptr, SCR(), lane); continue; } r -= 256;
                if (r < 128) { transpose_job_item(IN(I_WBS5) + (size_t)l * 256 * 1024, 1024, 1024, r, WCAT, 1024, 512, 0, 1, 0, 0, nullptr, SCR(), lane); continue; } r -= 128;
                if (r < 128) { transpose_job_item(IN(I_WBXA) + (size_t)l * 256 * 1024, 1024, 1024, r, WCAT, 1024, 768, 0, 1, 0, 0, nullptr, SCR(), lane); continue; } r -= 128;
                if (r < 512) { transpose_job_item(IN(I_WOUT) + (size_t)l * 1024 * 1024, 1024, 1024, r, WOUT, 1024, 0, 0, 1, 0, 0, nullptr, SCR(), lane); continue; } r -= 512;
                if (r < 32) { transpose_job_item(IN(I_WGLU) + (size_t)l * 256 * 512, 512, 256, r, WGLU, 256, 0, 0, 2, 0, 0, nullptr, SCR(), lane); continue; } r -= 32;
                transpose_job_item(IN(I_WGLU) + (size_t)l * 256 * 512 + 256, 512, 256, r, WGLU, 256, 0, 0, 2, 1, 0, nullptr, SCR(), lane);
            }
            }
            {
            const f32x2* APOW = WP(f32x2, WS_APOW); const f32x2* BBAR = WP(f32x2, WS_BBAR); bf16* S5W = WP(bf16, WS_S5W);
            for (int it = GT(); it < 16 * 256 * 64; it += NGT) {
                const int k8 = it & 63, n = (it >> 6) & 255, g = it >> 14;
                const int s = k8 >> 1, c0 = (k8 & 1) * 8, d = n >> 7, ri = (n >> 6) & 1, p = n & 63, e = d == 0 ? 31 - s : s, base = (l * 2 + d) * 16 + g;
                const f32x2 a = APOW[((size_t)base * 33 + e) * 64 + p]; const f32x2* bb = BBAR + ((size_t)base * 64 + p) * 16 + c0;
                float v[8];
#pragma unroll
                for (int j = 0; j < 8; ++j) { const f32x2 b = bb[j]; v[j] = ri == 0 ? a.x * b.x - a.y * b.y : a.x * b.y + a.y * b.x; }
                u32x4 w; w.x = cvt_pk_bf16(v[0], v[1]); w.y = cvt_pk_bf16(v[2], v[3]); w.z = cvt_pk_bf16(v[4], v[5]); w.w = cvt_pk_bf16(v[6], v[7]);
                gst<u32x4>(S5W + ((size_t)(g * 256 + n) * 512 + k8 * 8), w);
            }
            const float* KT = WP(float, WS_KT); bf16* S5KV = WP(bf16, WS_S5KV); const float* CRE = IN(I_CRE); const float* CIM = IN(I_CIM);
            for (int it = GT(); it < 16 * 512 * 96; it += NGT) {
                const int k8 = it % 96, rest = it / 96, n = rest & 511, g = rest >> 9, t = n >> 4, c = n & 15;
                float v[8];
                if (k8 < 64) { const int s = k8 >> 1, c0 = (k8 & 1) * 8, tp = t - s + 31; const float* kp = KT + ((size_t)(((l * 16 + g) * 63 + tp) * 16 + c) * 16 + c0);
                    const f32x4 a = gld<f32x4>(kp), b = gld<f32x4>(kp + 4); v[0] = a[0]; v[1] = a[1]; v[2] = a[2]; v[3] = a[3]; v[4] = b[0]; v[5] = b[1]; v[6] = b[2]; v[7] = b[3]; }
                else { const int jj = (k8 - 64) * 8, d = jj >> 7, ri = (jj >> 6) & 1, p0 = jj & 63, e = d == 0 ? t + 1 : 32 - t, base = (l * 2 + d) * 16 + g;
                    const float* cre = CRE + ((size_t)base * 16 + c) * 64 + p0; const float* cim = CIM + ((size_t)base * 16 + c) * 64 + p0; const f32x2* ap = APOW + ((size_t)base * 33 + e) * 64 + p0;
#pragma unroll
                    for (int j = 0; j < 8; ++j) { const f32x2 a = ap[j]; const float cr = cre[j], ci = cim[j]; v[j] = ri == 0 ? cr * a.x - ci * a.y : -(cr * a.y + ci * a.x); } }
                u32x4 w; w.x = cvt_pk_bf16(v[0], v[1]); w.y = cvt_pk_bf16(v[2], v[3]); w.z = cvt_pk_bf16(v[4], v[5]); w.w = cvt_pk_bf16(v[6], v[7]);
                gst<u32x4>(S5KV + ((size_t)(g * 512 + n) * ATK + k8 * 8), w);
            }
            }
            { bf16* H = WP(bf16, WS_H); const float* gn = nullptr;
              if (l == 0) { for (int grp = gw; grp < M / 4; grp += NGW) norm_rows4<false>(xin0, gn, H, grp * 4, lane, nullptr, nullptr, nullptr, nullptr, nullptr, WP(float, WS_SS + 4 * MiB)); }
              else { const float* SSP = WP(float, WS_SS); float* RS = WP(float, WS_SS + 4 * MiB);
                for (int row = GT(); row < M; row += NGT) { const f32x4 a = gld<f32x4>(SSP + (size_t)row * 16), b = gld<f32x4>(SSP + (size_t)row * 16 + 4), c = gld<f32x4>(SSP + (size_t)row * 16 + 8), d = gld<f32x4>(SSP + (size_t)row * 16 + 12);
                  const float ss = (((a[0] + a[1]) + (a[2] + a[3])) + ((b[0] + b[1]) + (b[2] + b[3]))) + (((c[0] + c[1]) + (c[2] + c[3])) + ((d[0] + d[1]) + (d[2] + d[3])));
                  gst<float>(RS + row, 1.0f / sqrtf(ss * (1.0f / 1024.0f) + RMS_EPS)); } } }
        }
        GRID_BAR();
        }

        for (int rep_ = 0; rep_ < NREP(3); ++rep_) {
        if (PH(3)) {
            WSL();
            pg8::Gemm g{l == 0 ? WP(bf16, WS_H) : (const bf16*)XO, WP(bf16, WS_WIN), 1024, 1024, 1024}; pg8::StaticOrder S; S.init(M / 256, INC / 256, G, bid);
            EpiProj E{WP(bf16, WS_QK), WP(bf16, WS_VT8), WP(bf16, WS_AT), WP(bf16, WS_QX), WP(bf16, WS_GATES), IN(I_BGATE) + l * 3072, WP(float, WS_SS + 4 * MiB)};
            pg8::gemm_phase<EpiProj, pg8::StaticOrder>(F.lds, g, S, E, tid);
        }
        GRID_BAR();
        }

        for (int rep_ = 0; rep_ < NREP(4); ++rep_) {
        if (PH(4)) {
            WSL();
            for (int bg = bid; bg < 64; bg += G) {
                { pg8::Gemm g{WP(bf16, WS_AT), WP(bf16, WS_S5W), ATK, 512, 512}; pg8::ListOrder S{bg, 1, 1}; EpiS5a E{WP(float, WS_ST)};
                  pg8::gemm_phase<EpiS5a, pg8::ListOrder>(F.lds, g, S, E, tid); }
                WG_MEM_SYNC();
                s5_scan_item(bg * 2, WP(float, WS_ST), WP(bf16, WS_AT), WP(f32x2, WS_APOW) + (size_t)l * 2 * 16 * 33 * 64, (LAS float*)F.lds, tid);
                s5_scan_item(bg * 2 + 1, WP(float, WS_ST), WP(bf16, WS_AT), WP(f32x2, WS_APOW) + (size_t)l * 2 * 16 * 33 * 64, (LAS float*)F.lds, tid);
                WG_MEM_SYNC();
                { pg8::Gemm g{WP(bf16, WS_AT), WP(bf16, WS_S5KV), ATK, ATK, ATK}; pg8::ListOrder S{bg, 2, 2}; EpiS5c E{WP(bf16, WS_Y)};
                  pg8::gemm_phase<EpiS5c, pg8::ListOrder>(F.lds, g, S, E, tid); }
            }
            unsigned* qhead = WP(unsigned, WS_CTL) + CW_Q + (l + 4 * rep_) * 64;
            volatile LAS int* qslot = (volatile LAS int*)(F.lds + MISC_OFF + 64);
            for (;;) {
                if (tid == 0) qslot[0] = (int)__hip_atomic_fetch_add((GASP unsigned*)qhead, 1u, __ATOMIC_RELAXED, __HIP_MEMORY_SCOPE_AGENT);
                __syncthreads();
                const int qi = __builtin_amdgcn_readfirstlane(qslot[0]);
                __syncthreads();
                if (qi >= 768) break;
                if (qi < 512) NA_ITEM(qi); else XA_ITEMS(qi - 512, qi - 511, 1);
            }
        }
        GRID_BAR();
        }

        for (int rep_ = 0; rep_ < NREP(7); ++rep_) {
        if (PH(7)) {
            WSL();
            pg8::Gemm g{WP(bf16, WS_Y), WP(bf16, WS_WGLU), 256, 256, 256}; pg8::StaticOrder S; S.init(M / 256, 2, G, bid); EpiGlu E{WP(bf16, WS_H)};
            pg8::gemm_phase<EpiGlu, pg8::StaticOrder>(F.lds, g, S, E, tid);
        }
        GRID_BAR();
        }

        for (int rep_ = 0; rep_ < NREP(8); ++rep_) {
        if (PH(8)) {
            WSL();
            pg8::Gemm g{WP(bf16, WS_H), WP(bf16, WS_WCAT), 1024, 1024, 1024}; pg8::StaticOrder S; S.init(M / 256, 4, G, bid); EpiMerge E{WP(unsigned char, WS_GATES), WP(bf16, WS_QK)};
            pg8::gemm_phase<EpiMerge, pg8::StaticOrder, false, true>(F.lds, g, S, E, tid);
        }
        GRID_BAR();
        }

        for (int rep_ = 0; rep_ < NREP(9); ++rep_) {
        if (PH(9)) {
            WSL();
            pg8::Gemm g{WP(bf16, WS_QK), WP(bf16, WS_WOUT), 1024, 1024, 1024}; pg8::StaticOrder S; S.init(M / 256, 4, G, bid); EpiResB E{l == 0 ? xin0 : nullptr, (bf16*)XO};
            pg8::gemm_phase<EpiResB, pg8::StaticOrder>(F.lds, g, S, E, tid);
        }
        GRID_BAR();
        }

        for (int rep_ = 0; rep_ < NREP(10); ++rep_) {
        if (PH(10)) {
            WSL();
            {
            unsigned* cnt = WP(unsigned, WS_CTL) + CW_CNT + (l + 4 * rep_) * NBUCKET * 64;
            const float* bco = IN(I_BCO) + l * 4; const float* bfi = IN(I_BFI) + l * 16;
            int* LIST = rep_ ? WP(int, WS_GATES + 100 * MiB) : WP(int, WS_LIST); float* WTS = rep_ ? WP(float, WS_GATES + 104 * MiB) : WP(float, WS_WTS);
            { const u32x4* src = (const u32x4*)(WP(bf16, WS_WRT) + (size_t)l * 2 * 20480);
              for (int idx = tid; idx < 40 * 128; idx += NWAVES * 64) *(LAS u32x4*)(F.lds + (idx >> 7) * RT_STRIDE + (idx & 127) * 16) = gld<u32x4>(src + idx); }
            __syncthreads();
            for (int grp = gw; grp < M / 16; grp += NGW) router_rows16(nullptr, (const bf16*)XO, nullptr, nullptr, grp * 16, lane, F.lds, wave, bco, bfi, cnt, LIST, WTS);
            __syncthreads();
            }
            bf16* WGU = WP(bf16, WS_WGU); bf16* WDP = WP(bf16, WS_WDP);
            for (int it = gw; it < 10240; it += NGW) {
                int r = it;
                if (r < 2048) { const int e = r >> 7; transpose_job_item(IN(I_WG) + (size_t)(l * 16 + e) * 1024 * 256, 256, 256, r & 127, WGU + (size_t)e * 512 * 1024, 1024, 0, 0, 2, 0, 0, IN(I_NFFN) + l * 1024, SCR(), lane); continue; } r -= 2048;
                if (r < 2048) { const int e = r >> 7; transpose_job_item(IN(I_WU) + (size_t)(l * 16 + e) * 1024 * 256, 256, 256, r & 127, WGU + (size_t)e * 512 * 1024, 1024, 0, 0, 2, 1, 0, IN(I_NFFN) + l * 1024, SCR(), lane); continue; } r -= 2048;
                const int ej = r >> 7, e = ej / 3, jj = ej % 3, i = e & 3, grpI = e >> 2, o = jj + (jj >= i ? 1 : 0), a = i < o ? i : o, b = i < o ? o : i;
                const int pair = grpI * 6 + (a == 0 ? b - 1 : (a == 1 ? b + 1 : 5)), slot = (i == a) ? 0 : 1;
                transpose_job_item(IN(I_WD) + (size_t)(l * 16 + e) * 256 * 1024, 1024, 1024, r & 127, WDP + (size_t)pair * 1024 * 512, 512, slot * 256, 0, 1, 0, 0, nullptr, SCR(), lane);
            }
        }
        GRID_BAR();
        }

        LAS int* tab = (LAS int*)(F.lds + TAB_OFF);
        for (int rep_ = 0; rep_ < NREP(11); ++rep_) {
        if (PH(11)) {
            WSL();
            unsigned* cnt = WP(unsigned, WS_CTL) + CW_CNT + l * NBUCKET * 64;
            if (tid == 0) { int st = 0;
                for (int b = 0; b < NBUCKET; ++b) { const int c = (int)__hip_atomic_load((GASP unsigned*)(cnt + b * 64), __ATOMIC_RELAXED, __HIP_MEMORY_SCOPE_AGENT); tab[b] = c; tab[32 + b] = st; st += (c + 255) >> 8; }
                tab[32 + NBUCKET] = st; tab[64] = st; }
            __syncthreads();
            pg8::Gemm g{(const bf16*)XO, WP(bf16, WS_WGU), 1024, 1024, 1024}; pg8::MoeOrder S{tab, WP(int, WS_LIST), G, bid, 0}; EpiMoe1 E{WP(bf16, WS_ACT), WP(float, WS_WTS)};
            pg8::gemm_phase<EpiMoe1, pg8::MoeOrder, true>(F.lds, g, S, E, tid);
        }
        GRID_BAR();
        }

        for (int rep_ = 0; rep_ < NREP(12); ++rep_) {
        if (PH(12)) {
            WSL();
            pg8::Gemm g{WP(bf16, WS_ACT), WP(bf16, WS_WDP), 512, 512, 512}; pg8::MoeOrder S{tab, WP(int, WS_LIST), G, bid, 1}; EpiMoe2 E{rep_ ? WP(bf16, WS_GATES + 120 * MiB) : (l == DEPTH - 1 ? WP(bf16, WS_QK) : (bf16*)XO), WP(int, WS_LIST), (bf16*)XO, (l < DEPTH - 1 && !rep_) ? WP(float, WS_SS) : nullptr};
            pg8::gemm_phase<EpiMoe2, pg8::MoeOrder>(F.lds, g, S, E, tid);
        }
        GRID_BAR();
        }
    }
    { WSL(); const float* gn = IN(I_FNORM);
      for (int row = gw; row < M; row += NGW) final_norm_row(WP(bf16, WS_QK), XO, gn, row, lane); }
#undef GRID_BAR
}

extern "C" void kernel_launch(void* const* d_in, const int* in_sizes, int n_in, void* d_out, int out_size, void* d_ws, size_t ws_size, hipStream_t stream) {
    static int grid = 0;
    if (grid == 0) {
        if (n_in != 30 || out_size != M * D || ws_size < WS_END) { fprintf(stderr, "kernel_launch: unexpected shapes (n_in %d, out %d, ws %zu)\n", n_in, out_size, ws_size); grid = -1; return; }
        int dev = 0, cus = 0, per_cu = 0;
        if (hipGetDevice(&dev) != hipSuccess || hipDeviceGetAttribute(&cus, hipDeviceAttributeMultiprocessorCount, dev) != hipSuccess) { grid = -1; return; }
        if (hipFuncSetAttribute((const void*)fwd_kernel, hipFuncAttributeMaxDynamicSharedMemorySize, LDS_BYTES) != hipSuccess) { fprintf(stderr, "kernel_launch: hipFuncSetAttribute failed\n"); grid = -1; return; }
        if (hipOccupancyMaxActiveBlocksPerMultiprocessor(&per_cu, (const void*)fwd_kernel, NWAVES * 64, LDS_BYTES) != hipSuccess || per_cu < 1) { fprintf(stderr, "kernel_launch: occupancy query reports %d\n", per_cu); }
        (void)hipGetLastError();
        grid = cus;
    }
    if (grid < 0) return;
    (void)in_sizes;
    (void)hipMemsetAsync((char*)d_ws + WS_CTL, 0, CTL_BYTES, stream);
    Args a{};
    for (int i = 0; i < 30; ++i) a.in[i] = (const float*)d_in[i];
    a.out = (float*)d_out; a.ws = (unsigned char*)d_ws;
    hipLaunchKernelGGL(fwd_kernel, dim3(grid), dim3(NWAVES * 64), LDS_BYTES, stream, a);
}
```
